# Optimizing an MI355X kernel written in HIP

```python
import jax, jax.numpy as jnp
from jax import lax
import numpy as np

D_MODEL = 2048
BATCH = 1
SEQ = 8192
DEPTH = 4

N_MIXERS = 2
N_POOL_LAYERS = (DEPTH + 1) // 2
N_ATTN_LAYERS = DEPTH // 2
EPS = 1e-6

POOL_WINDOWS = (2, 4, 8, 16)
N_POOL_GROUPS = 4
POOL_GROUP_DIM = D_MODEL // N_POOL_GROUPS
POOL_IN = 2 * D_MODEL

N_HEADS = 16
HEAD_DIM = D_MODEL // N_HEADS
ATTN_WIDTH = N_HEADS * HEAD_DIM
ROT_DIM = HEAD_DIM // 4
IDX_HEADS = 16
IDX_DIM = 64
IDX_ROT = IDX_DIM // 4
ROPE_THETA = 500000.0
TOP_K_MAX = 256
Q_BLOCK = 128
ATTN_SPLITS = (ATTN_WIDTH, 2 * ATTN_WIDTH, 3 * ATTN_WIDTH, 4 * ATTN_WIDTH,
               4 * ATTN_WIDTH + IDX_HEADS * IDX_DIM,
               4 * ATTN_WIDTH + IDX_HEADS * IDX_DIM + IDX_DIM)
ATTN_IN = 4 * ATTN_WIDTH + IDX_HEADS * IDX_DIM + IDX_DIM + IDX_HEADS

kernel_name = "hybrid_pool_dsa_adaln_trunk"


def rms_norm(x, g):
    xf = x.astype(jnp.float32)
    y = xf * lax.rsqrt(jnp.mean(xf * xf, axis=-1, keepdims=True) + EPS)
    return (y * g.astype(jnp.float32)).astype(x.dtype)


def rope_partial(x, positions, rot_dim):
    half = rot_dim // 2
    inv_freq = ROPE_THETA ** (-jnp.arange(half, dtype=jnp.float32) * 2.0 / rot_dim)
    ang = positions.astype(jnp.float32)[..., None] * inv_freq
    cos = jnp.cos(ang)[:, :, None, :]
    sin = jnp.sin(ang)[:, :, None, :]
    xf = x.astype(jnp.float32)
    x1, x2, rest = xf[..., :half], xf[..., half:rot_dim], xf[..., rot_dim:]
    out = jnp.concatenate([x1 * cos - x2 * sin, x2 * cos + x1 * sin, rest], axis=-1)
    return out.astype(x.dtype)


def pool_branch(h, w_in, w_grp, layer_scale, w_out):
    B, L, D = h.shape
    v, gate = jnp.split(h @ w_in, 2, axis=-1)
    vf = v.astype(jnp.float32)
    cs = jnp.concatenate([jnp.zeros((B, 1, D), jnp.float32),
                          jnp.cumsum(vf, axis=1)], axis=1)
    t = jnp.arange(L, dtype=jnp.int32)
    outs = []
    for gi, w in enumerate(POOL_WINDOWS):
        sl = slice(gi * POOL_GROUP_DIM, (gi + 1) * POOL_GROUP_DIM)
        lo = jnp.maximum(t + 1 - w, 0)
        window_sum = cs[:, t + 1, sl] - cs[:, lo, sl]
        count = jnp.minimum(t + 1, w).astype(jnp.float32)[None, :, None]
        pooled = (window_sum / count - vf[:, :, sl]).astype(h.dtype)
        outs.append(jnp.einsum('bsc,cd->bsd', pooled, w_grp[gi]))
    mixed = jnp.concatenate(outs, axis=-1) * layer_scale
    return (mixed * jax.nn.silu(gate)) @ w_out


def dsa_branch(h, positions, w_in, w_out):
    B, L, _ = h.shape
    proj = h @ w_in
    q, k, v, gate, qi, ki, wi = jnp.split(proj, ATTN_SPLITS, axis=-1)
    q = rope_partial(q.reshape(B, L, N_HEADS, HEAD_DIM), positions, ROT_DIM)
    k = rope_partial(k.reshape(B, L, N_HEADS, HEAD_DIM), positions, ROT_DIM)
    v = v.reshape(B, L, N_HEADS, HEAD_DIM)
    qi = rope_partial(qi.reshape(B, L, IDX_HEADS, IDX_DIM), positions, IDX_ROT)
    ki = rope_partial(ki.reshape(B, L, 1, IDX_DIM), positions, IDX_ROT)[:, :, 0]
    ki_f = ki.astype(jnp.float32)
    top_k = min(TOP_K_MAX, L // 4)
    nb = L // Q_BLOCK
    key_idx = jnp.arange(L, dtype=jnp.int32)
    idx_scale = (IDX_HEADS ** -0.5) * (IDX_DIM ** -0.5)
    attn_scale = HEAD_DIM ** -0.5

    def to_blocks(a):
        return jnp.moveaxis(a.reshape(B, nb, Q_BLOCK, *a.shape[2:]), 1, 0)

    def block_fn(args):
        qb, qib, wb, tb = args
        s = jnp.einsum('bqhd,bsd->bqhs', qib.astype(jnp.float32), ki_f)
        score = jnp.einsum('bqhs,bqh->bqs', jax.nn.relu(s),
                           wb.astype(jnp.float32)) * idx_scale
        admissible = key_idx[None, None, :] <= tb[None, :, None]
        score = jnp.where(admissible, score, -jnp.inf)
        _, sel = lax.top_k(score, top_k)
        valid = sel <= tb[None, :, None]
        k_sel = jax.vmap(lambda kk, ii: kk[ii])(k, sel)
        v_sel = jax.vmap(lambda vv, ii: vv[ii])(v, sel)
        logits = jnp.einsum('bqhd,bqkhd->bhqk', qb, k_sel).astype(jnp.float32) * attn_scale
        logits = jnp.where(valid[:, None], logits, -jnp.inf)
        p = jax.nn.softmax(logits, axis=-1).astype(v.dtype)
        return jnp.einsum('bhqk,bqkhd->bqhd', p, v_sel)

    t_blocks = key_idx.reshape(nb, Q_BLOCK)
    outs = lax.map(block_fn, (to_blocks(q), to_blocks(qi), to_blocks(wi), t_blocks))
    o = jnp.moveaxis(outs, 0, 1).reshape(B, L, ATTN_WIDTH)
    return (o * jax.nn.silu(gate)) @ w_out


def setup_inputs(seed: int = 0) -> dict:
    key = jax.random.key(seed)
    ks = jax.random.split(key, 13)
    D = D_MODEL
    x = jax.random.normal(ks[0], (BATCH, SEQ, D), jnp.float32)
    c = jax.random.normal(ks[1], (BATCH, D), jnp.float32)
    positions = jnp.broadcast_to(jnp.arange(SEQ, dtype=jnp.int32)[None, :], (BATCH, SEQ))
    norm_g = 1.0 + 0.02 * jax.random.normal(ks[2], (DEPTH, D), jnp.float32)
    mod_w = 0.5 * D ** -0.5 * jax.random.normal(ks[3], (DEPTH, D, 3 * D), jnp.float32)
    mod_b = 0.02 * jax.random.normal(ks[4], (DEPTH, 3 * D), jnp.float32)
    pool_w_in = D ** -0.5 * jax.random.normal(ks[5], (N_POOL_LAYERS, D, POOL_IN), jnp.float32)
    pool_w_grp = POOL_GROUP_DIM ** -0.5 * jax.random.normal(
        ks[6], (N_POOL_LAYERS, N_POOL_GROUPS, POOL_GROUP_DIM, POOL_GROUP_DIM), jnp.float32)
    pool_scale = 1.0 + 0.1 * jax.random.normal(ks[7], (N_POOL_LAYERS, D), jnp.float32)
    pool_w_out = D ** -0.5 * jax.random.normal(ks[8], (N_POOL_LAYERS, D, D), jnp.float32)
    attn_w_in = D ** -0.5 * jax.random.normal(ks[9], (N_ATTN_LAYERS, D, ATTN_IN), jnp.float32)
    attn_w_out = ATTN_WIDTH ** -0.5 * jax.random.normal(
        ks[10], (N_ATTN_LAYERS, ATTN_WIDTH, D), jnp.float32)
    final_g = 1.0 + 0.02 * jax.random.normal(ks[11], (D,), jnp.float32)
    return {"x": x, "c": c, "positions": positions, "norm_g": norm_g,
            "mod_w": mod_w, "mod_b": mod_b, "pool_w_in": pool_w_in,
            "pool_w_grp": pool_w_grp, "pool_scale": pool_scale,
            "pool_w_out": pool_w_out, "attn_w_in": attn_w_in,
            "attn_w_out": attn_w_out, "final_g": final_g}


def reference(x, c, positions, norm_g, mod_w, mod_b, pool_w_in, pool_w_grp,
              pool_scale, pool_w_out, attn_w_in, attn_w_out, final_g):
    cond = jax.nn.silu(c)
    for i in range(DEPTH):
        mod = cond @ mod_w[i] + mod_b[i]
        shift, scale, gate = jnp.split(mod, 3, axis=-1)
        h = rms_norm(x, norm_g[i]) * (1.0 + scale[:, None, :]) + shift[:, None, :]
        j = i // N_MIXERS
        if i % N_MIXERS == 0:
            out = pool_branch(h, pool_w_in[j], pool_w_grp[j], pool_scale[j], pool_w_out[j])
        else:
            out = dsa_branch(h, positions, attn_w_in[j], attn_w_out[j])
        x = x + gate[:, None, :] * out
    return rms_norm(x, final_g)
```

```cpp
#include <hip/hip_runtime.h>
#include <cstdio>
#include <cstdint>
#include <cmath>

#ifndef MK_ONE_LAUNCH
#define MK_ONE_LAUNCH 1
#endif

#define LAS __attribute__((address_space(3)))
#define GAS __attribute__((address_space(1)))
typedef unsigned short bf16_t;
typedef short bf16x8 __attribute__((ext_vector_type(8)));
typedef short s16x4 __attribute__((ext_vector_type(4)));
typedef float f32x4 __attribute__((ext_vector_type(4)));
typedef float f32x2 __attribute__((ext_vector_type(2)));
typedef float f32x16 __attribute__((ext_vector_type(16)));
typedef unsigned u32x4 __attribute__((ext_vector_type(4)));
typedef unsigned u32x2 __attribute__((ext_vector_type(2)));

constexpr int DM = 2048, SEQ = 8192, NHEAD = 16, HD = 128, IDXH = 16, IDXD = 64;
constexpr int POOL_IN = 4096, ATTN_IN = 9296, ATTN_INP = 9472  ;
constexpr int TOPK = 256;
constexpr float EPS = 1e-6f;

constexpr size_t MiB = 1u << 20;
constexpr size_t WS_CTL = 0, CTL_ZERO_BYTES = 64 * 1024;
constexpr size_t WS_MOD = 1 * MiB;
constexpr size_t WS_TAB = 2 * MiB;
constexpr size_t WS_WPI = 4 * MiB;
constexpr size_t WS_WPG = 36 * MiB;
constexpr size_t WS_WPO = 40 * MiB;
constexpr size_t WS_WAI = 56 * MiB;
constexpr size_t WS_WAO = 130 * MiB;
constexpr size_t WS_HU = 146 * MiB;
constexpr size_t WS_L = 178 * MiB;
constexpr size_t WS_VG = WS_L;
constexpr size_t WS_PL = WS_L + 64 * MiB;
constexpr size_t WS_Q = WS_L, WS_K = WS_L + 32 * MiB, WS_V = WS_L + 64 * MiB;
constexpr size_t WS_GATE = WS_L + 96 * MiB;
constexpr size_t WS_QI = WS_L + 128 * MiB;
constexpr size_t WS_KI = WS_L + 144 * MiB;
constexpr size_t WS_WI = WS_L + 145 * MiB;
constexpr size_t WS_MASK = WS_L + 146 * MiB;
constexpr size_t WS_SC = WS_L + 154 * MiB;
constexpr size_t WS_END = WS_SC + 139 * MiB;

__device__ __forceinline__ unsigned cvt_pk_bf16(float lo, float hi) { unsigned r; asm volatile("v_cvt_pk_bf16_f32 %0, %1, %2" : "=v"(r) : "v"(lo), "v"(hi)); return r; }
__device__ __forceinline__ unsigned f2bf(float f) { unsigned u = __builtin_bit_cast(unsigned, f); return (u + 0x7fffu + ((u >> 16) & 1u)) >> 16; }
__device__ __forceinline__ unsigned pk2(float lo, float hi) { return f2bf(lo) | (f2bf(hi) << 16); }
__device__ __forceinline__ float bf2f(unsigned short b) { return __builtin_bit_cast(float, (unsigned)b << 16); }
__device__ __forceinline__ float fast_sigmoid(float x) { return __builtin_amdgcn_rcpf(1.0f + __builtin_amdgcn_exp2f(-1.4426950408889634f * x)); }
__device__ __forceinline__ float silu_f(float x) { return x * fast_sigmoid(x); }
__device__ __forceinline__ float wave_sum(float v) {
#pragma unroll
    for (int o = 1; o < 64; o <<= 1) v += __shfl_xor(v, o);
    return v;
}
__device__ __forceinline__ int opaque_tid(int wv) { int t; asm volatile("v_mbcnt_lo_u32_b32 %0, -1, 0\n\tv_mbcnt_hi_u32_b32 %0, -1, %0\n\tv_lshl_add_u32 %0, %1, 6, %0" : "=&v"(t) : "s"(wv)); return t; }
#define LDS_WAIT() asm volatile("s_waitcnt lgkmcnt(0)" ::: "memory")
#define VM_WAIT() asm volatile("s_waitcnt vmcnt(0)" ::: "memory")

namespace pg8 {
constexpr int BM = 256, BK = 64, HALF = 128, HTB = HALF * BK * 2, STAGE_BYTES = 8 * HTB, NXCD = 8, WGM = 8;
__host__ __device__ __forceinline__ int lds_byte(int r, int c) { const int st = (r >> 4) * 2 + (c >> 5), rr = r & 15, cc = c & 31, ob = rr * 64 + cc * 2; return st * 1024 + (ob ^ (((ob >> 9) & 1) << 5)); }
__host__ __device__ __forceinline__ void stage_rc(int b, int& R, int& C) { const int st = b / 1024, sb = b % 1024, swz = sb ^ (((sb >> 9) & 1) << 5); R = (st >> 1) * 16 + swz / 64; C = (st & 1) * 32 + (swz % 64) / 2; }
__host__ __device__ __forceinline__ int perm32(int rho) { const int n = rho >> 4, i = rho & 15; return 8 * (i >> 2) + 4 * n + (i & 3); }

struct Unit { int pm, pn; };
struct Gemm { const bf16_t* A; const bf16_t* Bt; int M, N, K, lda, ldb, agsh, agstride; };

struct StaticOrder {
    int nM, nN, nwg, G, c;
    __host__ __device__ void init(int M, int N, int G_, int c_) { nM = M / BM; nN = N / BM; nwg = nM * nN; G = G_; c = c_; }
    __host__ __device__ bool next(int i, Unit& u) const {
        const long L = (long)i * G + c; if (L >= nwg) return false;
        int wgid = (int)L; { const int q = nwg / NXCD, r = nwg % NXCD, xcd = wgid % NXCD, off = wgid / NXCD; wgid = (xcd < r ? xcd * (q + 1) : r * (q + 1) + (xcd - r) * q) + off; }
        const int nig = WGM * nN, gid = wgid / nig, fm = gid * WGM, gsz = (nM - fm) < WGM ? (nM - fm) : WGM;
        u.pm = fm + ((wgid % nig) % gsz); u.pn = (wgid % nig) / gsz; return true;
    }
};

template <class Epi, bool ALIGN_EPI>
__device__ __forceinline__ void gemm_phase(int wv, LAS unsigned char* lds, const Gemm g, const StaticOrder& S, const Epi& E) {
    const int tid = opaque_tid(wv), wid = __builtin_amdgcn_readfirstlane(tid >> 6), lane = tid & 63, wr = wid >> 2, wc = wid & 3, fr = lane & 15, fq = lane >> 4;
    const int K = g.K, nt = K / BK;
    unsigned voffA[2], voffB[2];
#pragma unroll
    for (int i = 0; i < 2; ++i) { int R, C; stage_rc(tid * 16 + i * 8192, R, C); const int Rb = Epi::PERM ? ((R & ~31) + perm32(R & 31)) : R;
        voffA[i] = (unsigned)(R * g.lda + C) * 2u; voffB[i] = (unsigned)(Rb * g.ldb + C) * 2u; }
    const size_t kstep = (size_t)(BK * 2);
    const size_t hstepA = (size_t)HALF * g.lda * 2, hstepB = (size_t)HALF * g.ldb * 2;
    const size_t tstepA = 2 * hstepA, tstepB = 2 * hstepB;
    const unsigned ldsw = (unsigned)wid * 1024u;
    const int aoff = lds_byte(wr * 64 + fr, fq * 8), boff = lds_byte(wc * 32 + fr, fq * 8);
#define PG8_SA(b, h) (((b) * 2 + (h)) * HTB)
#define PG8_SB(b, h) ((4 + (b) * 2 + (h)) * HTB)
#define PG8_STAGE(bufoff, gbase, voff) do { _Pragma("unroll") for (int _i = 0; _i < 2; ++_i) \
        __builtin_amdgcn_global_load_lds((const unsigned*)((const char*)(gbase) + (voff)[_i]), (LAS unsigned*)(lds + (bufoff) + ldsw + _i * 8192), 16, 0, 0); } while (0)
#define PG8_LDA(dst, b, h) do { _Pragma("unroll") for (int m = 0; m < 4; ++m) _Pragma("unroll") for (int k = 0; k < 2; ++k) dst[m][k] = *(const LAS bf16x8*)(lds + PG8_SA(b, h) + aoff + m * 2048 + k * 1024); } while (0)
#define PG8_LDB(dst, b, h) do { _Pragma("unroll") for (int n = 0; n < 2; ++n) _Pragma("unroll") for (int k = 0; k < 2; ++k) dst[n][k] = *(const LAS bf16x8*)(lds + PG8_SB(b, h) + boff + n * 2048 + k * 1024); } while (0)
#define PG8_MMA(ai, bj, At, Bt) do { __builtin_amdgcn_s_setprio(1); _Pragma("unroll") for (int m = 0; m < 4; ++m) _Pragma("unroll") for (int n = 0; n < 2; ++n) _Pragma("unroll") for (int k = 0; k < 2; ++k) \
        acc[ai][bj][m][n] = __builtin_amdgcn_mfma_f32_16x16x32_bf16(Bt[n][k], At[m][k], acc[ai][bj][m][n], 0, 0, 0); __builtin_amdgcn_s_setprio(0); } while (0)
#define PG8_WAIT_V(n) asm volatile("s_waitcnt vmcnt(" #n ")" ::: "memory")
#define PG8_WAIT_L(n) asm volatile("s_waitcnt lgkmcnt(" #n ")" ::: "memory")
#define PG8_BAR __builtin_amdgcn_s_barrier()
#define PG8_SCHED __builtin_amdgcn_sched_barrier(0)
#define PG8_AOFF(u) ((size_t)(u).pm * tstepA + (size_t)(((u).pn >> g.agsh) * g.agstride) * 2)
    Unit cur, nxt; int ui = 0;
    if (!S.next(0, cur)) return;
    f32x4 acc[2][2][4][2];
#pragma unroll
    for (int a = 0; a < 2; ++a)
#pragma unroll
        for (int b = 0; b < 2; ++b)
#pragma unroll
            for (int m = 0; m < 4; ++m)
#pragma unroll
                for (int n = 0; n < 2; ++n) acc[a][b][m][n] = (f32x4){0.f, 0.f, 0.f, 0.f};
    bf16x8 At[4][2], B0[2][2], B1[2][2];
    const char* cA = (const char*)g.A + PG8_AOFF(cur); const char* cB = (const char*)g.Bt + (size_t)cur.pn * tstepB;
    PG8_STAGE(PG8_SB(0, 0), cB, voffB); PG8_STAGE(PG8_SB(0, 1), cB + hstepB, voffB); PG8_STAGE(PG8_SA(0, 0), cA, voffA); PG8_STAGE(PG8_SA(0, 1), cA + hstepA, voffA);
    if (wr == 1) PG8_BAR;
    PG8_WAIT_V(2); PG8_BAR;
    PG8_STAGE(PG8_SB(1, 0), cB + kstep, voffB); PG8_STAGE(PG8_SA(1, 0), cA + kstep, voffA); PG8_STAGE(PG8_SB(1, 1), cB + hstepB + kstep, voffB);
    PG8_WAIT_V(6); PG8_BAR;
    for (;;) {
        const bool has_next = S.next(ui + 1, nxt);
        const char* nA = has_next ? (const char*)g.A + PG8_AOFF(nxt) : cA; const char* nB = has_next ? (const char*)g.Bt + (size_t)nxt.pn * tstepB : cB;
        for (int t = 0; t < nt; t += 2) {
            const bool last = (t == nt - 2);
            const char* a1 = cA + (size_t)(t + 1) * kstep;
            const char* a2 = last ? nA : cA + (size_t)(t + 2) * kstep; const char* b2 = last ? nB : cB + (size_t)(t + 2) * kstep;
            const char* a3 = a2 + kstep; const char* b3 = b2 + kstep;
            PG8_LDB(B0, 0, 0); PG8_LDB(B1, 0, 1); PG8_SCHED; PG8_LDA(At, 0, 0); PG8_STAGE(PG8_SA(1, 1), a1 + hstepA, voffA);
            PG8_WAIT_V(8); PG8_WAIT_L(0); PG8_BAR; PG8_MMA(0, 0, At, B0); PG8_MMA(0, 1, At, B1); PG8_BAR; PG8_SCHED;
            PG8_LDA(At, 0, 1); PG8_STAGE(PG8_SB(0, 0), b2, voffB); PG8_STAGE(PG8_SB(0, 1), b2 + hstepB, voffB); PG8_STAGE(PG8_SA(0, 0), a2, voffA);
            PG8_WAIT_V(8); PG8_WAIT_L(0); PG8_BAR; PG8_MMA(1, 0, At, B0); PG8_MMA(1, 1, At, B1); PG8_BAR; PG8_SCHED;
            PG8_LDB(B0, 1, 0); PG8_LDB(B1, 1, 1); PG8_SCHED; PG8_LDA(At, 1, 0); PG8_STAGE(PG8_SA(0, 1), a2 + hstepA, voffA);
            PG8_WAIT_V(8); PG8_WAIT_L(0); PG8_BAR; PG8_MMA(0, 0, At, B0); PG8_MMA(0, 1, At, B1); PG8_BAR; PG8_SCHED;
            PG8_LDA(At, 1, 1); PG8_STAGE(PG8_SB(1, 0), b3, voffB); PG8_STAGE(PG8_SB(1, 1), b3 + hstepB, voffB); PG8_STAGE(PG8_SA(1, 0), a3, voffA);
            PG8_WAIT_V(8); PG8_WAIT_L(0); PG8_BAR; PG8_MMA(1, 0, At, B0); PG8_MMA(1, 1, At, B1); PG8_BAR; PG8_SCHED;
        }
        if constexpr (ALIGN_EPI) { if (wr == 0) PG8_BAR; }
        E(acc, cur, wr, wc, fr, fq);
        if (!has_next) break;
#pragma unroll
        for (int a = 0; a < 2; ++a)
#pragma unroll
            for (int b = 0; b < 2; ++b)
#pragma unroll
                for (int m = 0; m < 4; ++m)
#pragma unroll
                    for (int n = 0; n < 2; ++n) acc[a][b][m][n] = (f32x4){0.f, 0.f, 0.f, 0.f};
        cur = nxt; cA = nA; cB = nB; ++ui;
        if constexpr (ALIGN_EPI) { if (wr == 1) PG8_BAR; }
    }
    PG8_WAIT_V(0);
    if constexpr (!ALIGN_EPI) { if (wr == 0) PG8_BAR; }
    PG8_BAR;
#undef PG8_SA
#undef PG8_SB
#undef PG8_STAGE
#undef PG8_LDA
#undef PG8_LDB
#undef PG8_MMA
#undef PG8_WAIT_V
#undef PG8_WAIT_L
#undef PG8_BAR
#undef PG8_SCHED
#undef PG8_AOFF
}

struct EpiBf16 {
    static constexpr bool PERM = true;
    bf16_t* O; int ldc;
    __device__ __forceinline__ void operator()(const f32x4 (&acc)[2][2][4][2], const Unit& u, int wr, int wc, int fr, int fq) const {
        const int row0 = u.pm * BM + wr * 64 + fr; const int col0 = u.pn * BM + wc * 32 + 8 * fq;
#pragma unroll
        for (int ai = 0; ai < 2; ++ai)
#pragma unroll
            for (int m = 0; m < 4; ++m) { bf16_t* rowp = O + (size_t)(row0 + ai * HALF + m * 16) * ldc + col0;
#pragma unroll
                for (int bj = 0; bj < 2; ++bj) { const f32x4 v0 = acc[ai][bj][m][0], v1 = acc[ai][bj][m][1];
                    u32x4 w; w.x = cvt_pk_bf16(v0[0], v0[1]); w.y = cvt_pk_bf16(v0[2], v0[3]); w.z = cvt_pk_bf16(v1[0], v1[1]); w.w = cvt_pk_bf16(v1[2], v1[3]);
                    *(u32x4*)(rowp + bj * HALF) = w; } }
    }
};
struct EpiPoolGrp {
    static constexpr bool PERM = true;
    bf16_t* U; const bf16_t* VG; const float* ls;
    __device__ __forceinline__ void operator()(const f32x4 (&acc)[2][2][4][2], const Unit& u, int wr, int wc, int fr, int fq) const {
        const int row0 = u.pm * BM + wr * 64 + fr; const int col0 = u.pn * BM + wc * 32 + 8 * fq;
        f32x4 lv[2][2];
#pragma unroll
        for (int bj = 0; bj < 2; ++bj)
#pragma unroll
            for (int n = 0; n < 2; ++n) lv[bj][n] = *(const f32x4*)(ls + col0 + bj * HALF + 4 * n);
#pragma unroll
        for (int ai = 0; ai < 2; ++ai)
#pragma unroll
            for (int m = 0; m < 4; ++m) { const size_t row = (size_t)(row0 + ai * HALF + m * 16);
#pragma unroll
                for (int bj = 0; bj < 2; ++bj) {
                    const u32x4 gw = *(const u32x4*)(VG + row * POOL_IN + DM + col0 + bj * HALF);
                    f32x4 v0 = acc[ai][bj][m][0] * lv[bj][0], v1 = acc[ai][bj][m][1] * lv[bj][1];
                    float g[8];
#pragma unroll
                    for (int e = 0; e < 4; ++e) { g[2 * e] = __builtin_bit_cast(float, gw[e] << 16); g[2 * e + 1] = __builtin_bit_cast(float, gw[e] & 0xffff0000u); }
#pragma unroll
                    for (int e = 0; e < 4; ++e) { v0[e] *= silu_f(g[e]); v1[e] *= silu_f(g[4 + e]); }
                    u32x4 w; w.x = cvt_pk_bf16(v0[0], v0[1]); w.y = cvt_pk_bf16(v0[2], v0[3]); w.z = cvt_pk_bf16(v1[0], v1[1]); w.w = cvt_pk_bf16(v1[2], v1[3]);
                    *(u32x4*)(U + row * DM + col0 + bj * HALF) = w; } }
    }
};
struct EpiResid {
    static constexpr bool PERM = false;
    const float* xin; float* xout; const float* gmod;
    __device__ __forceinline__ void operator()(const f32x4 (&acc)[2][2][4][2], const Unit& u, int wr, int wc, int fr, int fq) const {
        const int row0 = u.pm * BM + wr * 64 + fr; const int col0 = u.pn * BM + wc * 32 + 4 * fq;
        f32x4 gv[2][2];
#pragma unroll
        for (int bj = 0; bj < 2; ++bj)
#pragma unroll
            for (int n = 0; n < 2; ++n) gv[bj][n] = *(const f32x4*)(gmod + col0 + bj * HALF + 16 * n);
#pragma unroll
        for (int ai = 0; ai < 2; ++ai)
#pragma unroll
            for (int m = 0; m < 4; ++m) { const size_t off = (size_t)(row0 + ai * HALF + m * 16) * DM + col0;
#pragma unroll
                for (int bj = 0; bj < 2; ++bj)
#pragma unroll
                    for (int n = 0; n < 2; ++n) { const f32x4 bs = *(const f32x4*)(xin + off + bj * HALF + 16 * n);
                        *(f32x4*)(xout + off + bj * HALF + 16 * n) = bs + gv[bj][n] * acc[ai][bj][m][n]; } }
    }
};
struct EpiAttnIn {
    static constexpr bool PERM = false;
    unsigned char* ws; const int* pos;
    __device__ __forceinline__ void operator()(const f32x4 (&acc)[2][2][4][2], const Unit& u, int wr, int wc, int fr, int fq) const {
        const int row0 = u.pm * BM + wr * 64 + fr; const int pn = u.pn;
        bf16_t* const Qh = (bf16_t*)(ws + WS_Q); bf16_t* const SG = (bf16_t*)(ws + WS_GATE); bf16_t* const QI = (bf16_t*)(ws + WS_QI); bf16_t* const KI = (bf16_t*)(ws + WS_KI); float* const WI = (float*)(ws + WS_WI);
        const float* const cosq = (const float*)(ws + WS_TAB); const float* const sinq = cosq + SEQ * 16; const float* const cosi = sinq + SEQ * 16; const float* const sini = cosi + SEQ * 8;
#pragma unroll
        for (int ai = 0; ai < 2; ++ai)
#pragma unroll
            for (int m = 0; m < 4; ++m) {
                const int row = row0 + ai * HALF + m * 16;
                if (pn < 24) {
                    bf16_t* base = Qh + (size_t)(pn >> 3) * ((size_t)SEQ * DM);
                    const bool rope = (pn < 16) && (wc == 0);
                    f32x4 cs = {1.f, 1.f, 1.f, 1.f}, sn = {0.f, 0.f, 0.f, 0.f};
                    if (rope) { const int p = pos[row]; cs = *(const f32x4*)(cosq + (size_t)p * 16 + 4 * fq); sn = *(const f32x4*)(sinq + (size_t)p * 16 + 4 * fq); }
#pragma unroll
                    for (int bj = 0; bj < 2; ++bj) { const int head = 2 * (pn & 7) + bj;
                        f32x4 v0 = acc[ai][bj][m][0], v1 = acc[ai][bj][m][1];
                        if (rope) { const f32x4 o0 = v0 * cs - v1 * sn, o1 = v1 * cs + v0 * sn; v0 = o0; v1 = o1; }
                        bf16_t* dst = base + ((size_t)head * SEQ + row) * HD + 32 * wc + 4 * fq;
                        u32x2 w0, w1; w0.x = cvt_pk_bf16(v0[0], v0[1]); w0.y = cvt_pk_bf16(v0[2], v0[3]); w1.x = cvt_pk_bf16(v1[0], v1[1]); w1.y = cvt_pk_bf16(v1[2], v1[3]);
                        *(u32x2*)dst = w0; *(u32x2*)(dst + 16) = w1; }
                } else if (pn < 32) {
#pragma unroll
                    for (int bj = 0; bj < 2; ++bj)
#pragma unroll
                        for (int n = 0; n < 2; ++n) { const f32x4 v = acc[ai][bj][m][n];
                            u32x2 w; w.x = cvt_pk_bf16(silu_f(v[0]), silu_f(v[1])); w.y = cvt_pk_bf16(silu_f(v[2]), silu_f(v[3]));
                            *(u32x2*)(SG + (size_t)row * DM + (pn - 24) * BM + bj * HALF + 32 * wc + 16 * n + 4 * fq) = w; }
                } else {
                    const bool isq = pn < 36;
                    const int p = pos[row];
                    const f32x4 cs = *(const f32x4*)(cosi + (size_t)p * 8 + 4 * (fq & 1)), sn = *(const f32x4*)(sini + (size_t)p * 8 + 4 * (fq & 1));
#pragma unroll
                    for (int bj = 0; bj < 2; ++bj) {
                        if (!isq && bj == 1) continue;
#pragma unroll
                        for (int n = 0; n < 2; ++n) {
                            f32x4 v = acc[ai][bj][m][n];
                            const bool rope = ((wc & 1) == 0) && (n == 0) && (isq || wc == 0);
                            if (rope) {
                                f32x4 pr;
#pragma unroll
                                for (int e = 0; e < 4; ++e) pr[e] = __shfl_xor(v[e], 32);
                                v = (fq < 2) ? (v * cs - pr * sn) : (v * cs + pr * sn);
                            }
                            const int cl = bj * HALF + 32 * wc + 16 * n + 4 * fq;
                            if (isq) { u32x2 w; w.x = cvt_pk_bf16(v[0], v[1]); w.y = cvt_pk_bf16(v[2], v[3]); *(u32x2*)(QI + (size_t)row * 1024 + (pn - 32) * BM + cl) = w; }
                            else if (cl < 64) { u32x2 w; w.x = cvt_pk_bf16(v[0], v[1]); w.y = cvt_pk_bf16(v[2], v[3]); *(u32x2*)(KI + (size_t)row * 64 + cl) = w; }
                            else if (cl < 80) { *(f32x4*)(WI + (size_t)row * 16 + (cl - 64)) = v; }
                        }
                    }
                }
                asm volatile("" ::: "memory");
            }
    }
};
}

namespace att {
constexpr int D = 128, NW = 8, QBLK = 32, KVBLK = 64, QB = NW * QBLK;
constexpr int SHM_V = KVBLK * D * 2, SHM_K = KVBLK * D * 2;
constexpr int QROWB = 272;
constexpr int Q_OFF = 2 * SHM_V + 2 * SHM_K + NW * 64 * 4;
constexpr int LDS_BYTES = Q_OFF + QB * QROWB;
constexpr float SCALE = 0.08838834764831845f;
constexpr float THR = 8.f;
#define KSWZ(row, colB) ((row) * 256 + ((colB) ^ (((row) & 7) << 4)))
#define SBAR() __builtin_amdgcn_sched_barrier(0)
__device__ __forceinline__ int v_st(int k, int c) { const int kk = (k & ~0xC) | ((k & 4) << 1) | ((k & 8) >> 1); return ((kk >> 3) * 4 + (c >> 5)) * 512 + ((kk & 7) * 32 + (c & 31)) * 2; }
__device__ __forceinline__ int v_rd_base(int lane) { return ((lane & 3) << 3) | (((lane >> 2) & 3) << 6) | (((lane >> 4) & 1) << 5) | (((lane >> 5) & 1) << 8); }
constexpr int v_rd_off(int d0, int ks, int half) { return d0 * 512 + ks * 4096 + half * 2048; }
__device__ __forceinline__ int crow(int r, int hi) { return (r & 3) + 8 * (r >> 2) + 4 * hi; }
__device__ __forceinline__ unsigned cvtpk(float lo, float hi) { unsigned r; asm volatile("v_cvt_pk_bf16_f32 %0, %1, %2" : "=v"(r) : "v"(lo), "v"(hi)); return r; }
__device__ __forceinline__ bf16x8 load8(const bf16_t* p) { return *reinterpret_cast<const bf16x8*>(p); }
__device__ __forceinline__ float mask_and(float v, unsigned mlo, unsigned mhi, int r, int p) {
    const int pos = (r & 3) + 8 * (r >> 2);
    const unsigned w = p ? mhi : mlo;
    const int bits = __builtin_amdgcn_sbfe((int)w, pos, 1);
    return __builtin_bit_cast(float, __builtin_bit_cast(unsigned, v) & (unsigned)bits);
}
__device__ __forceinline__ void partialSM(f32x16& p0, f32x16& p1, float& m_reg, float& mn, float& alpha, unsigned mlo, unsigned mhi) {
    float pmax = p0[0];
#pragma unroll
    for (int r = 1; r < 16; ++r) pmax = fmaxf(pmax, p0[r]);
#pragma unroll
    for (int r = 0; r < 16; ++r) pmax = fmaxf(pmax, p1[r]);
    { auto rr = __builtin_amdgcn_permlane32_swap(__float_as_uint(pmax), __float_as_uint(pmax), false, false);
      pmax = fmaxf(__uint_as_float(rr[0]), __uint_as_float(rr[1])); }
    constexpr float C2 = 1.4426950408889634f * SCALE;
    if (__builtin_expect(__all((pmax - m_reg) * SCALE <= THR), 1)) { mn = m_reg; alpha = 1.f; }
    else { mn = fmaxf(m_reg, pmax); alpha = __builtin_amdgcn_exp2f((m_reg - mn) * C2); m_reg = mn; }
    const float mnL = -mn * C2;
#pragma unroll
    for (int r = 0; r < 16; ++r) p0[r] = fmaf(p0[r], C2, mnL);
#pragma unroll
    for (int r = 0; r < 16; ++r) p1[r] = fmaf(p1[r], C2, mnL);
#pragma unroll
    for (int r = 0; r < 16; ++r) p0[r] = mask_and(__builtin_amdgcn_exp2f(p0[r]), mlo, mhi, r, 0);
}
__device__ __forceinline__ void finishSM(f32x16& p0, f32x16& p1, float alpha, float& l_reg, bf16x8& pa0, bf16x8& pa1, bf16x8& pa2, bf16x8& pa3, unsigned mlo, unsigned mhi) {
#pragma unroll
    for (int r = 0; r < 16; ++r) p1[r] = mask_and(__builtin_amdgcn_exp2f(p1[r]), mlo, mhi, r, 1);
    float ps = 0;
#pragma unroll
    for (int r = 0; r < 16; ++r) ps += p0[r];
#pragma unroll
    for (int r = 0; r < 16; ++r) ps += p1[r];
    { auto rr = __builtin_amdgcn_permlane32_swap(__float_as_uint(ps), __float_as_uint(ps), false, false);
      ps = __uint_as_float(rr[0]) + __uint_as_float(rr[1]); }
    l_reg = l_reg * alpha + ps;
#define PK4(P, B_, OUT) do { unsigned a0 = cvtpk(P[B_+0], P[B_+1]), a1 = cvtpk(P[B_+2], P[B_+3]);                          \
        unsigned b0 = cvtpk(P[B_+4], P[B_+5]), b1 = cvtpk(P[B_+6], P[B_+7]);                                             \
        auto r0 = __builtin_amdgcn_permlane32_swap(a0, b0, false, false); auto r1 = __builtin_amdgcn_permlane32_swap(a1, b1, false, false); \
        u32x4 w = {r0[0], r1[0], r0[1], r1[1]}; OUT = *reinterpret_cast<bf16x8*>(&w); } while (0)
    PK4(p0, 0, pa0); PK4(p0, 8, pa1); PK4(p1, 0, pa2); PK4(p1, 8, pa3);
#undef PK4
}
template <int KB>
__device__ __forceinline__ void qkt(f32x16& p0, f32x16& p1, const char* K_lds, int r32, int hi, const char* qa  ) {
    p0 = f32x16{}; p1 = f32x16{};
    const char* kb[4];
#pragma unroll
    for (int dd = 0; dd < 4; ++dd) kb[dd] = K_lds + KB * SHM_K + KSWZ(r32, (dd * 16 + hi * 8) * 2);
#pragma unroll
    for (int d0 = 0; d0 < 8; ++d0) { const char* a = kb[d0 & 3] + (d0 >> 2) * 128;
        bf16x8 b0 = *reinterpret_cast<const bf16x8*>(a);
        bf16x8 b1 = *reinterpret_cast<const bf16x8*>(a + 32 * 256);
        const bf16x8 qf = *reinterpret_cast<const bf16x8*>(qa + d0 * 32);
        p0 = __builtin_amdgcn_mfma_f32_32x32x16_bf16(b0, qf, p0, 0, 0, 0);
        p1 = __builtin_amdgcn_mfma_f32_32x32x16_bf16(b1, qf, p1, 0, 0, 0); }
}
template <int VB>
__device__ __forceinline__ void pv_tile(f32x16* o, int vb0, bf16x8 pa0, bf16x8 pa1, bf16x8 pa2, bf16x8 pa3) {
#define TRRD(dst, off) asm volatile("ds_read_b64_tr_b16 %0, %1 offset:%2" : "=&v"(dst) : "v"(vb0), "i"(off) : "memory")
#define PV_D0(d0) do { s16x4 l0, l1, l2, l3, h0, h1, h2, h3; constexpr int b_ = VB * SHM_V + v_rd_off(d0, 0, 0); \
        TRRD(l0, b_); TRRD(h0, b_ + 2048); TRRD(l1, b_ + 4096); TRRD(h1, b_ + 6144); TRRD(l2, b_ + 8192); TRRD(h2, b_ + 10240); TRRD(l3, b_ + 12288); TRRD(h3, b_ + 14336); \
        asm volatile("s_waitcnt lgkmcnt(0)" ::: "memory"); SBAR();   \
        o[d0] = __builtin_amdgcn_mfma_f32_32x32x16_bf16(pa0, (bf16x8){l0[0], l0[1], l0[2], l0[3], h0[0], h0[1], h0[2], h0[3]}, o[d0], 0, 0, 0);   \
        o[d0] = __builtin_amdgcn_mfma_f32_32x32x16_bf16(pa1, (bf16x8){l1[0], l1[1], l1[2], l1[3], h1[0], h1[1], h1[2], h1[3]}, o[d0], 0, 0, 0);   \
        o[d0] = __builtin_amdgcn_mfma_f32_32x32x16_bf16(pa2, (bf16x8){l2[0], l2[1], l2[2], l2[3], h2[0], h2[1], h2[2], h2[3]}, o[d0], 0, 0, 0);   \
        o[d0] = __builtin_amdgcn_mfma_f32_32x32x16_bf16(pa3, (bf16x8){l3[0], l3[1], l3[2], l3[3], h3[0], h3[1], h3[2], h3[3]}, o[d0], 0, 0, 0); } while (0)
    PV_D0(0); PV_D0(1); PV_D0(2); PV_D0(3);
#undef PV_D0
#undef TRRD
}
struct BlockRef { const bf16_t* Q; const bf16_t* K; const bf16_t* V; bf16_t* O; const bf16_t* G; const unsigned long long* M; int P0; };
struct Seam { bf16x8 st_v0, st_v1, st_k0, st_k1; };
#define ROW(p, k0, rr) ((p) + (size_t)((k0) + (rr)) * D + sc)
#define VMW() asm volatile("s_waitcnt vmcnt(0)" ::: "memory")
#define VMWN(n) asm volatile("s_waitcnt vmcnt(%0)" :: "i"(n) : "memory")
#define SLOAD_H(Kp, Vp, k0) do { S.st_v0 = load8(ROW(Vp, k0, sr)); S.st_v1 = load8(ROW(Vp, k0, 32 + sr));              \
                         S.st_k0 = load8(ROW(Kp, k0, sr)); S.st_k1 = load8(ROW(Kp, k0, 32 + sr)); } while (0)
#define SWRITE_HK(bf) do { *(bf16x8*)(K_lds + (bf) * SHM_K + kws) = S.st_k0; *(bf16x8*)(K_lds + (bf) * SHM_K + kws + 32 * 256) = S.st_k1; } while (0)
#define SWRITE_HV(bf) do { *(bf16x8*)(V_lds + (bf) * SHM_V + vst0) = S.st_v0; *(bf16x8*)(V_lds + (bf) * SHM_V + vst1) = S.st_v1; } while (0)
#define SWRITE_H(bf) do { SWRITE_HV(bf); SWRITE_HK(bf); } while (0)
__device__ __forceinline__ void attn_prime(int wv, const BlockRef& cur, char* lds, Seam& S) {
    const int tid = opaque_tid(wv);
    const int sr = tid >> 4, sc = (tid & 15) * 8, kws = KSWZ(sr, sc * 2); char* K_lds = lds + 2 * SHM_V;
    SLOAD_H(cur.K, cur.V, 0); VMW(); SWRITE_HK(0);
    __syncthreads();
}
__device__ __forceinline__ void attn_block(int wv, const BlockRef& cur, const BlockRef& nxt, char* lds, Seam& S) {
    const int tid = opaque_tid(wv), wid = __builtin_amdgcn_readfirstlane(tid >> 6), lane = tid & 63, r32 = lane & 31, hi = lane >> 5;
    const int NT = cur.P0 / KVBLK + 4;
    char* V_lds = lds; char* K_lds = lds + 2 * SHM_V;
    float* ws = (float*)(lds + 2 * SHM_V + 2 * SHM_K) + wid * 64; float* li_l = ws, * al_l = ws + 32;
    float m_reg = -1e30f, l_reg = 0; f32x16 o[4] = {};
    const int sr = tid >> 4, sc = (tid & 15) * 8, vst0 = v_st(sr, sc), vst1 = v_st(32 + sr, sc), kws = KSWZ(sr, sc * 2);
    const int vb0 = (int)(uintptr_t)V_lds + v_rd_base(lane);
    const bf16_t* Kh = cur.K; const bf16_t* Vh = cur.V;
    const unsigned long long* mp = cur.M + (wid * QBLK + r32);
#define MLOAD(lo_, hi_, t) do { const unsigned long long w_ = mp[(size_t)(t) * SEQ] >> (4 * hi); lo_ = (unsigned)w_; hi_ = (unsigned)(w_ >> 32); } while (0)
#define RESC(a) do { if (__any((a) < 1.f)) { if (hi == 0) al_l[r32] = (a); asm volatile("s_waitcnt lgkmcnt(0)" ::: "memory");              \
                     for (int d_ = 0; d_ < 4; ++d_) for (int r = 0; r < 16; ++r) o[d_][r] *= al_l[crow(r, hi)]; } } while (0)
#define KBASE(t) ((t) * KVBLK)
#define SEAM_K0() do { VMW(); SWRITE_HK(0); SBAR(); } while (0)
    f32x16 pA0, pA1, pB0, pB1; float mnA, mnB, alA, alB; bf16x8 pa0, pa1, pa2, pa3;
    unsigned mAlo, mAhi, mBlo, mBhi;
    MLOAD(mAlo, mAhi, 0);
    char* Qw_lds = lds + Q_OFF + wid * (QBLK * QROWB);
    { u32x4 tq[8];
#pragma unroll
        for (int i = 0; i < 8; ++i) tq[i] = *(const u32x4*)(cur.Q + (size_t)(wid * QBLK + 4 * i + (lane >> 4)) * D + (lane & 15) * 8);
#pragma unroll
        for (int i = 0; i < 8; ++i) *(u32x4*)(Qw_lds + (4 * i + (lane >> 4)) * QROWB + (lane & 15) * 16) = tq[i];
        asm volatile("s_waitcnt lgkmcnt(0)" ::: "memory"); }
    const char* qa = Qw_lds + r32 * QROWB + hi * 16;
    SWRITE_HV(0); SBAR();
    if (NT > 1) { SLOAD_H(Kh, Vh, KBASE(1)); }
    SBAR(); qkt<0>(pA0, pA1, K_lds, r32, hi, qa);
    partialSM(pA0, pA1, m_reg, mnA, alA, mAlo, mAhi);
    if (NT > 1) { VMW(); SWRITE_H(1); }
    __syncthreads();
#define HALF_STEP(PX0, PX1, mnX, alX, mXlo, mXhi, PY0, PY1, alY, mYlo, mYhi, t, KB, VB, SB) do {                                  \
        SBAR(); MLOAD(mXlo, mXhi, t); qkt<KB>(PX0, PX1, K_lds, r32, hi, qa);                                                  \
        finishSM(PY0, PY1, alY, l_reg, pa0, pa1, pa2, pa3, mYlo, mYhi); SBAR();                                                 \
        if ((t) + 1 < NT) { SLOAD_H(Kh, Vh, KBASE((t) + 1)); SBAR(); }                                                          \
        pv_tile<VB>(o, vb0, pa0, pa1, pa2, pa3); partialSM(PX0, PX1, m_reg, mnX, alX, mXlo, mXhi);                              \
        __syncthreads();                                                                                                      \
        if ((t) + 1 < NT) { VMW(); SWRITE_H(SB); }                                                                            \
        RESC(alX); __syncthreads(); } while (0)
    for (int t = 1; t + 1 < NT; t += 2) {
        HALF_STEP(pB0, pB1, mnB, alB, mBlo, mBhi, pA0, pA1, alA, mAlo, mAhi, t, 1, 0, 0);
        HALF_STEP(pA0, pA1, mnA, alA, mAlo, mAhi, pB0, pB1, alB, mBlo, mBhi, t + 1, 0, 1, 1);
    }
    MLOAD(mBlo, mBhi, NT - 1);
    SBAR(); qkt<1>(pB0, pB1, K_lds, r32, hi, qa); SBAR();
    SLOAD_H(nxt.K, nxt.V, 0); SBAR();
    finishSM(pA0, pA1, alA, l_reg, pa0, pa1, pa2, pa3, mAlo, mAhi); SBAR();
    pv_tile<0>(o, vb0, pa0, pa1, pa2, pa3);
    partialSM(pB0, pB1, m_reg, mnB, alB, mBlo, mBhi); __syncthreads(); RESC(alB);
    finishSM(pB0, pB1, alB, l_reg, pa0, pa1, pa2, pa3, mBlo, mBhi); SBAR(); pv_tile<1>(o, vb0, pa0, pa1, pa2, pa3);
    SBAR(); SEAM_K0();
    if (hi == 0) li_l[r32] = l_reg; asm volatile("s_waitcnt lgkmcnt(0)" ::: "memory");
    float rli[16];
#pragma unroll
    for (int r = 0; r < 16; ++r) rli[r] = __builtin_amdgcn_rcpf(li_l[crow(r, hi)]);
    bf16_t* Ow = cur.O + (size_t)(wid * QBLK) * DM; const bf16_t* Gw = cur.G + (size_t)(wid * QBLK) * DM;
#pragma unroll
    for (int r = 0; r < 16; ++r) { const int orow = crow(r, hi);
#pragma unroll
        for (int d0 = 0; d0 < 4; ++d0) { const float gt = bf2f(Gw[(size_t)orow * DM + d0 * 32 + r32]);
            const float v = o[d0][r] * rli[r] * gt;
            const float vn = __shfl_xor(v, 1);
            if ((r32 & 1) == 0) *(unsigned*)(Ow + (size_t)orow * DM + d0 * 32 + r32) = cvtpk(v, vn); } }
    __syncthreads();
#undef MLOAD
#undef RESC
#undef KBASE
#undef SEAM_K0
#undef HALF_STEP
}
#undef ROW
#undef VMW
#undef VMWN
#undef SLOAD_H
#undef SWRITE_HK
#undef SWRITE_HV
#undef SWRITE_H
#undef KSWZ
#undef SBAR
}

#define XB_TMO      128
#define XB_XCNT(j)  (256  + 64 * (j))
#define XB_XSUB(j)  (1280 + 64 * (j))
#define XB_XGEN(j)  (2304 + 64 * (j))
#define XB_TOP      3328
#define XB_TOPGEN   3392
#define XCD_BAR_WORDS 3456
#define XB_SPIN_CAP (1u << 22)
__device__ __forceinline__ unsigned xb_ld(unsigned* p)              { return __hip_atomic_load(p, __ATOMIC_RELAXED, __HIP_MEMORY_SCOPE_AGENT); }
__device__ __forceinline__ unsigned xb_add(unsigned* p, unsigned v) { return __hip_atomic_fetch_add(p, v, __ATOMIC_RELAXED, __HIP_MEMORY_SCOPE_AGENT); }
__device__ __forceinline__ unsigned xb_xcc_id() { return (unsigned)__builtin_amdgcn_s_getreg((3 << 11) | 20) & 0xFu; }
#define XB_SPIN(cond, bar) do { unsigned _sp = 0; while (cond) { __builtin_amdgcn_s_sleep(1); \
    if ((++_sp & 255u) == 0u) { if (xb_ld(&(bar)[XB_TMO])) break; if (_sp > XB_SPIN_CAP) { atomicAdd(&(bar)[XB_TMO], 1u); break; } } } } while (0)
struct XcdBarrier { unsigned* bar; unsigned x; volatile LAS unsigned* st; };
__device__ __forceinline__ XcdBarrier xcd_barrier_post(unsigned* bar, volatile LAS unsigned* st) {
    XcdBarrier b; b.bar = bar; b.x = xb_xcc_id(); b.st = st;
    if (threadIdx.x == 0) (void)xb_add(&bar[XB_XCNT(b.x)], 1u);
    return b;
}
__device__ __forceinline__ void xcd_barrier_complete(unsigned* bar, unsigned x, unsigned& nloc, unsigned& nx) {
    const unsigned G = gridDim.x * gridDim.y * gridDim.z;
    unsigned sum, cnt, mine, sp = 0u;
    for (;;) {
        sum = 0u; cnt = 0u; mine = 0u;
#pragma unroll
        for (unsigned j = 0; j < 16; ++j) { const unsigned c = xb_ld(&bar[XB_XCNT(j)]); sum += c; cnt += (c > 0u) ? 1u : 0u; mine = (j == x) ? c : mine; }
        if (sum == G) break;
        __builtin_amdgcn_s_sleep(1);
        if ((++sp & 255u) == 0u) { if (xb_ld(&bar[XB_TMO])) break; if (sp > XB_SPIN_CAP) { atomicAdd(&bar[XB_TMO], 1u); break; } }
    }
    nloc = mine > 0u ? mine : 1u; nx = cnt > 0u ? cnt : 1u;
}
__device__ __forceinline__ void xcd_barrier(const XcdBarrier& b) {
    asm volatile("s_waitcnt vmcnt(0)" ::: "memory");
    __syncthreads();
    if (threadIdx.x == 0) {
        unsigned* bar = b.bar;
        __builtin_amdgcn_s_waitcnt(0);
        unsigned nloc = b.st[0], nx = b.st[1];
        if (nloc == 0u) { xcd_barrier_complete(bar, b.x, nloc, nx); b.st[0] = nloc; b.st[1] = nx; }
        const unsigned old = xb_add(&bar[XB_XSUB(b.x)], 1u);
        const unsigned gen = old / nloc;
        if (old + 1u == (gen + 1u) * nloc) {
            __builtin_amdgcn_fence(__ATOMIC_RELEASE, "agent");
            asm volatile("s_waitcnt vmcnt(0)" ::: "memory");
            const unsigned og = xb_add(&bar[XB_TOP], 1u);
            const unsigned tg = og / nx;
            if (og + 1u == (tg + 1u) * nx) xb_add(&bar[XB_TOPGEN], 1u);
            else XB_SPIN(xb_ld(&bar[XB_TOPGEN]) == tg, bar);
            __builtin_amdgcn_fence(__ATOMIC_ACQUIRE, "agent");
            xb_add(&bar[XB_XGEN(b.x)], 1u);
            asm volatile("s_waitcnt vmcnt(0)" ::: "memory");
        } else {
            XB_SPIN(xb_ld(&bar[XB_XGEN(b.x)]) == gen, bar);
            __builtin_amdgcn_fence(__ATOMIC_ACQUIRE, "agent");
            asm volatile("s_waitcnt vmcnt(0)" ::: "memory");
        }
    }
    __syncthreads();
}

struct Args {
    const float* x; const float* c; const int* pos; const float* norm_g; const float* mod_w; const float* mod_b;
    const float* pwi; const float* pwg; const float* pls; const float* pwo; const float* awi; const float* awo; const float* fg;
    float* out; unsigned char* ws;
    int ph_lo, ph_hi;
    float invf_q[16]; float invf_i[8];
};
constexpr int NWAVES = 8, NTHR = 512;
constexpr int RING_BYTES = 131072, LDS_BYTES = 147456, MISC_OFF = LDS_BYTES - 256;

__device__ __forceinline__ void sincos_d(double a, float& s_out, float& c_out) {
    const double k = __builtin_rint(a * 0.6366197723675814);
    double r = __builtin_fma(-k, 1.5707963267948966, a); r = __builtin_fma(-k, 6.123233995736766e-17, r);
    const double r2 = r * r;
    double sp = -7.647163731819816e-13; sp = sp * r2 + 1.6059043836821613e-10; sp = sp * r2 - 2.505210838544172e-08; sp = sp * r2 + 2.7557319223985893e-06;
    sp = sp * r2 - 1.984126984126984e-04; sp = sp * r2 + 8.333333333333333e-03; sp = sp * r2 - 1.6666666666666666e-01; const double s = r + r * r2 * sp;
    double cp = 4.779477332387385e-14; cp = cp * r2 - 1.1470745597729725e-11; cp = cp * r2 + 2.08767569878681e-09; cp = cp * r2 - 2.755731922398589e-07;
    cp = cp * r2 + 2.48015873015873e-05; cp = cp * r2 - 1.388888888888889e-03; cp = cp * r2 + 4.1666666666666664e-02; cp = cp * r2 - 0.5; const double c = 1.0 + r2 * cp;
    const int q = (int)((long long)k & 3);
    const double ss = (q == 0) ? s : (q == 1) ? c : (q == 2) ? -s : -c;
    const double cc = (q == 0) ? c : (q == 1) ? -s : (q == 2) ? -c : s;
    s_out = (float)ss; c_out = (float)cc;
}
__device__ __forceinline__ void transpose_item(const float* W, int K, int N, bf16_t* WT, int row_off, LAS float* scr, int nblk, int item, int lane) {
    const int kb = item / nblk, nb = item % nblk, k0 = 64 * kb, n0 = 32 * nb;
    const int nn = n0 + (lane & 31);
#pragma unroll 8
    for (int i = 0; i < 32; ++i) { const int kk = 2 * i + (lane >> 5); scr[kk * 33 + (lane & 31)] = (nn < N) ? W[(size_t)(k0 + kk) * N + nn] : 0.f; }
    LDS_WAIT(); asm volatile("" ::: "memory");
    const int c = lane & 7;
#pragma unroll
    for (int j = 0; j < 4; ++j) { const int n = (lane >> 3) + 8 * j; const LAS float* s = scr + (8 * c) * 33 + n;
        u32x4 o; o.x = pk2(s[0 * 33], s[1 * 33]); o.y = pk2(s[2 * 33], s[3 * 33]); o.z = pk2(s[4 * 33], s[5 * 33]); o.w = pk2(s[6 * 33], s[7 * 33]);
        *(u32x4*)(WT + (size_t)(row_off + n0 + n) * K + k0 + 8 * c) = o; }
    LDS_WAIT(); asm volatile("" ::: "memory");
}
__device__ __forceinline__ void phase0(int wv, const Args& a, LAS unsigned char* lds) {
    const int tid = opaque_tid(wv), lane = tid & 63, wave = __builtin_amdgcn_readfirstlane(tid >> 6);
    const int G = gridDim.x, bx = blockIdx.x;
    unsigned char* ws = a.ws;
    for (int unit = bx; unit < 256; unit += G) {
        const int n0 = unit * 96;
        const int layer = n0 / 6144, nl = n0 - layer * 6144;
        const float* W = a.mod_w + (size_t)layer * DM * 6144 + nl;
        LAS float* red = (LAS float*)lds;
        if (tid < 504) {
            const int kg = tid / 24, ln = tid - kg * 24;
            f32x4 acc4 = {0.f, 0.f, 0.f, 0.f};
#pragma unroll 7
            for (int i = 0; i < 98; ++i) { const int k = kg + 21 * i;
                if (k < DM) { const float cv = a.c[k]; const float cd = silu_f(cv); const f32x4 w = *(const f32x4*)(W + (size_t)k * 6144 + 4 * ln); acc4 += w * cd; } }
            *(LAS f32x4*)(red + kg * 96 + 4 * ln) = acc4;
        }
        __syncthreads();
        if (tid < 96) { float s = 0.f;
#pragma unroll
            for (int kg = 0; kg < 21; ++kg) s += red[kg * 96 + tid];
            ((float*)(ws + WS_MOD))[n0 + tid] = s + a.mod_b[n0 + tid]; }
        __syncthreads();
    }
    {
        float* cosq = (float*)(ws + WS_TAB); float* sinq = cosq + SEQ * 16; float* cosi = sinq + SEQ * 16; float* sini = cosi + SEQ * 8;
        for (int e = bx * NTHR + tid; e < SEQ * 24; e += G * NTHR) {
            const int p = e / 24, i = e - p * 24;
            const float pf = (float)a.pos[p];
            const float inv = i < 16 ? a.invf_q[i] : a.invf_i[i - 16];
            const float ang = pf * inv;
            float s, c; sincos_d((double)ang, s, c);
            if (i < 16) { cosq[p * 16 + i] = c; sinq[p * 16 + i] = s; } else { cosi[p * 8 + i - 16] = c; sini[p * 8 + i - 16] = s; }
        }
    }
    {
        LAS float* scr = (LAS float*)(lds + 16384 + wave * 8704);
        const int gw = bx * NWAVES + wave, NGW = G * NWAVES;
        constexpr int I_PI = 32 * 128, I_PG = 8 * 16, I_PO = 32 * 64, I_AI = 32 * 296, I_AO = 32 * 64;
        constexpr int NITEMS = 2 * I_PI + 8 * I_PG + 2 * I_PO + 2 * I_AI + 2 * I_AO;
        for (int it = gw; it < NITEMS; it += NGW) {
            int r = it;
            if (r < 2 * I_AI) { const int l = r / I_AI; r -= l * I_AI; transpose_item(a.awi + (size_t)l * DM * ATTN_IN, DM, ATTN_IN, (bf16_t*)(ws + WS_WAI) + (size_t)l * ATTN_INP * DM, 0, scr, 296, r, lane); continue; } r -= 2 * I_AI;
            if (r < 2 * I_PI) { const int l = r / I_PI; r -= l * I_PI; transpose_item(a.pwi + (size_t)l * DM * POOL_IN, DM, POOL_IN, (bf16_t*)(ws + WS_WPI) + (size_t)l * POOL_IN * DM, 0, scr, 128, r, lane); continue; } r -= 2 * I_PI;
            if (r < 2 * I_PO) { const int l = r / I_PO; r -= l * I_PO; transpose_item(a.pwo + (size_t)l * DM * DM, DM, DM, (bf16_t*)(ws + WS_WPO) + (size_t)l * DM * DM, 0, scr, 64, r, lane); continue; } r -= 2 * I_PO;
            if (r < 2 * I_AO) { const int l = r / I_AO; r -= l * I_AO; transpose_item(a.awo + (size_t)l * DM * DM, DM, DM, (bf16_t*)(ws + WS_WAO) + (size_t)l * DM * DM, 0, scr, 64, r, lane); continue; } r -= 2 * I_AO;
            { const int lg = r / I_PG; r -= lg * I_PG; const int l = lg >> 2, gi = lg & 3;
              transpose_item(a.pwg + (size_t)lg * 512 * 512, 512, 512, (bf16_t*)(ws + WS_WPG) + (size_t)l * DM * 512, gi * 512, scr, 16, r, lane); }
        }
    }
}

__device__ __forceinline__ void phase_norm(int wv, const float* x, const float* g, const float* mod  , bf16_t* h) {
    const int tid = opaque_tid(wv), lane = tid & 63, wave = tid >> 6;
    const int gw = blockIdx.x * NWAVES + wave, NGW = gridDim.x * NWAVES;
    for (int row = gw; row < SEQ; row += NGW) {
        const f32x4* xr = (const f32x4*)(x + (size_t)row * DM) + lane;
        f32x4 v[8]; float s = 0.f;
#pragma unroll
        for (int j = 0; j < 8; ++j) { v[j] = xr[64 * j]; s += (v[j].x * v[j].x + v[j].y * v[j].y) + (v[j].z * v[j].z + v[j].w * v[j].w); }
        const float rstd = 1.0f / sqrtf(wave_sum(s) * (1.f / DM) + EPS);
        unsigned long long* o8 = (unsigned long long*)(h + (size_t)row * DM) + lane;
#pragma unroll
        for (int j = 0; j < 8; ++j) { const int col = 4 * lane + 256 * j;
            const f32x4 gg = *(const f32x4*)(g + col), sh = *(const f32x4*)(mod + col), sc = *(const f32x4*)(mod + DM + col);
            const f32x4 y = v[j] * rstd * gg * (sc + 1.0f) + sh;
            o8[64 * j] = (unsigned long long)cvt_pk_bf16(y.x, y.y) | ((unsigned long long)cvt_pk_bf16(y.z, y.w) << 32); }
    }
}
__device__ __forceinline__ void phase_final(int wv, const float* x, float* y, const float* g) {
    const int tid = opaque_tid(wv), lane = tid & 63, wave = tid >> 6;
    const int gw = blockIdx.x * NWAVES + wave, NGW = gridDim.x * NWAVES;
    for (int row = gw; row < SEQ; row += NGW) {
        const f32x4* xr = (const f32x4*)(x + (size_t)row * DM) + lane; f32x4* yr = (f32x4*)(y + (size_t)row * DM) + lane;
        f32x4 v[8]; float s = 0.f;
#pragma unroll
        for (int j = 0; j < 8; ++j) { v[j] = xr[64 * j]; s += (v[j].x * v[j].x + v[j].y * v[j].y) + (v[j].z * v[j].z + v[j].w * v[j].w); }
        const float rstd = 1.0f / sqrtf(wave_sum(s) * (1.f / DM) + EPS);
#pragma unroll
        for (int j = 0; j < 8; ++j) { const int col = 4 * lane + 256 * j; const f32x4 gg = *(const f32x4*)(g + col); yr[64 * j] = v[j] * rstd * gg; }
    }
}

__device__ __forceinline__ void phase_pool(int wv, const bf16_t* VG, bf16_t* PL) {
    const int total = 512 * 256;
    const int tid = opaque_tid(wv);
    for (int it = blockIdx.x * NTHR + tid; it < total; it += gridDim.x * NTHR) {
        const int cg = it & 255, strip = it >> 8; const int c0 = cg * 8, t0 = strip * 16;
        const int w = 2 << (c0 >> 9);
        float S[8];
#pragma unroll
        for (int e = 0; e < 8; ++e) S[e] = 0.f;
        for (int t = t0 - w + 1; t < t0; ++t) if (t >= 0) {
            const u32x4 r = *(const u32x4*)(VG + (size_t)t * POOL_IN + c0);
#pragma unroll
            for (int e = 0; e < 4; ++e) { S[2 * e] += __builtin_bit_cast(float, r[e] << 16); S[2 * e + 1] += __builtin_bit_cast(float, r[e] & 0xffff0000u); } }
        for (int t = t0; t < t0 + 16; ++t) {
            const u32x4 r = *(const u32x4*)(VG + (size_t)t * POOL_IN + c0);
            float v[8];
#pragma unroll
            for (int e = 0; e < 4; ++e) { v[2 * e] = __builtin_bit_cast(float, r[e] << 16); v[2 * e + 1] = __builtin_bit_cast(float, r[e] & 0xffff0000u); }
            const int cnt = (t + 1 < w) ? (t + 1) : w; const float ic = 1.0f / (float)cnt;
            float o[8];
#pragma unroll
            for (int e = 0; e < 8; ++e) { S[e] += v[e]; o[e] = S[e] * ic - v[e]; }
            u32x4 pw; pw.x = cvt_pk_bf16(o[0], o[1]); pw.y = cvt_pk_bf16(o[2], o[3]); pw.z = cvt_pk_bf16(o[4], o[5]); pw.w = cvt_pk_bf16(o[6], o[7]);
            *(u32x4*)(PL + (size_t)t * DM + c0) = pw;
            const int tl = t - w + 1;
            if (tl >= 0) { const u32x4 q = *(const u32x4*)(VG + (size_t)tl * POOL_IN + c0);
#pragma unroll
                for (int e = 0; e < 4; ++e) { S[2 * e] -= __builtin_bit_cast(float, q[e] << 16); S[2 * e + 1] -= __builtin_bit_cast(float, q[e] & 0xffff0000u); } }
        }
    }
}

__device__ __forceinline__ size_t sc_block_base(int qb) { return (size_t)65536 * (size_t)(qb * (qb + 1) / 2); }
__device__ __forceinline__ void phase_scores(int wv, const bf16_t* QI, const bf16_t* KI, const float* WI, float* SC, LAS unsigned char* lds, char* lds_g) {
    const int tid = opaque_tid(wv), wid = __builtin_amdgcn_readfirstlane(tid >> 6), lane = tid & 63, r32 = lane & 31, hi = lane >> 5;
    constexpr int QROW = 2064;
    LAS float* wl = (LAS float*)(lds + 32 * QROW);
    for (int L = blockIdx.x; L < 1152; L += gridDim.x) {
        int kc = 0, base = 0;
        for (; kc < 8; ++kc) { const int n = 256 - 32 * kc; if (L < base + n) break; base += n; }
        const int u = 32 * kc + (L - base);
        const int q0 = 32 * u, qb = u >> 3;
        const int klim = (qb + 1) * 256;
        __syncthreads();
#pragma unroll
        for (int i = 0; i < 8; ++i) { const int piece = tid + 512 * i, row = piece >> 7, c16 = piece & 127;
            const u32x4 v = *(const u32x4*)(QI + (size_t)(q0 + row) * 1024 + c16 * 8);
            *(LAS u32x4*)(lds + row * QROW + c16 * 16) = v; }
        { const int q = tid >> 4, h = tid & 15; wl[h * 32 + q] = WI[(size_t)(q0 + q) * 16 + h]; }
        __syncthreads();
        for (int sl = wid; sl < 16; sl += 8) {
            const int key0 = kc * 1024 + sl * 64;
            if (key0 >= klim) continue;
            bf16x8 kf[2][4];
#pragma unroll
            for (int b = 0; b < 2; ++b)
#pragma unroll
                for (int kk = 0; kk < 4; ++kk) kf[b][kk] = *(const bf16x8*)(KI + (size_t)(key0 + 32 * b + r32) * 64 + 16 * kk + 8 * hi);
            f32x16 acc0 = {}, acc1 = {};
            const LAS unsigned char* qa = lds + r32 * QROW + hi * 16;
#pragma unroll 2
            for (int h = 0; h < 16; ++h) {
                bf16x8 af[4];
#pragma unroll
                for (int kk = 0; kk < 4; ++kk) af[kk] = *(const LAS bf16x8*)(qa + h * 128 + kk * 32);
                f32x16 s0 = {}, s1 = {};
#pragma unroll
                for (int kk = 0; kk < 4; ++kk) { s0 = __builtin_amdgcn_mfma_f32_32x32x16_bf16(af[kk], kf[0][kk], s0, 0, 0, 0); s1 = __builtin_amdgcn_mfma_f32_32x32x16_bf16(af[kk], kf[1][kk], s1, 0, 0, 0); }
                f32x4 w4[4];
#pragma unroll
                for (int gq = 0; gq < 4; ++gq) w4[gq] = *(const LAS f32x4*)(wl + h * 32 + 8 * gq + 4 * hi);
#pragma unroll
                for (int r = 0; r < 16; ++r) { const float w = w4[r >> 2][r & 3]; acc0[r] = fmaf(fmaxf(s0[r], 0.f), w, acc0[r]); acc1[r] = fmaf(fmaxf(s1[r], 0.f), w, acc1[r]); }
            }
            float* out = SC + sc_block_base(qb) + (size_t)(q0 - qb * 256) * (size_t)klim + key0 + r32;
#pragma unroll
            for (int r = 0; r < 16; ++r) { const int qr_ = (r & 3) + 8 * (r >> 2) + 4 * hi;
                out[(size_t)qr_ * klim] = acc0[r]; out[(size_t)qr_ * klim + 32] = acc1[r]; }
        }
    }
    __syncthreads();
}

__device__ __forceinline__ void phase_select(int wv, const float* SC, unsigned long long* MASK, LAS unsigned char* lds) {
    const int tid = opaque_tid(wv), lane0 = tid & 63, wave = __builtin_amdgcn_readfirstlane(tid >> 6);
    LAS unsigned* hist = (LAS unsigned*)(lds + wave * 8704);
    const int gw = blockIdx.x * NWAVES + wave, NGW = gridDim.x * NWAVES;
    for (int q = gw; q < SEQ; q += NGW) {
        int lane = lane0; asm volatile("" : "+v"(lane));
        const int qb = q >> 8, klim = (qb + 1) * 256;
        const float* rowp = SC + sc_block_base(qb) + (size_t)(q - qb * 256) * (size_t)klim;
        const int ntile = 4 * (qb + 1);
        unsigned key[128];
#pragma unroll
        for (int g = 0; g < 8; ++g) {
            if (16 * g < ntile) {
                float v[16];
#pragma unroll
                for (int i = 0; i < 16; ++i) v[i] = rowp[64 * (16 * g + i) + lane];
#pragma unroll
                for (int i = 0; i < 16; ++i) { const int t = 16 * g + i; const unsigned uu = __builtin_bit_cast(unsigned, v[i]);
                    const unsigned kx = uu ^ ((unsigned)((int)uu >> 31) | 0x80000000u); key[t] = (64 * t + lane <= q) ? kx : 0u; }
            } else {
#pragma unroll
                for (int i = 0; i < 16; ++i) key[16 * g + i] = 0u;
            }
            if (g & 1) asm volatile("" ::: "memory");
        }
        unsigned T = 1u; unsigned need_eq = 0xffffffffu, n_eq = 0u;
        if (q + 1 > TOPK) {
            unsigned prefix = 0u, pmask = 0u, kk = TOPK;
#pragma unroll 1
            for (int pass = 0; pass < 3; ++pass) {
                const int shift = (pass == 0) ? 21 : (pass == 1) ? 10 : 0;
                const unsigned dmask = (pass == 2) ? 1023u : 2047u;
                const int nb = (pass == 2) ? 1024 : 2048, per = nb >> 6;
#pragma unroll 1
                for (int i = lane; i < 2112; i += 64) hist[i] = 0u;
                LDS_WAIT();
#pragma unroll
                for (int g = 0; g < 8; ++g) if (16 * g < ntile) {
#pragma unroll
                    for (int i = 0; i < 16; ++i) { const unsigned k = key[16 * g + i];
                        if ((k & pmask) == prefix) {     const unsigned b = (k >> shift) & dmask; __hip_atomic_fetch_add(hist + b + (b >> 5), 1u, __ATOMIC_RELAXED, __HIP_MEMORY_SCOPE_WORKGROUP); } }
                }
                LDS_WAIT();
                unsigned s = 0u;
#pragma unroll 1
                for (int i = 0; i < per; ++i) { const unsigned b = (unsigned)(per * lane + i); s += hist[b + (b >> 5)]; }
                unsigned suf = s;
#pragma unroll
                for (int off = 1; off < 64; off <<= 1) { const unsigned tt = __shfl_down(suf, off); if (lane + off < 64) suf += tt; }
                const unsigned long long bal = __ballot(suf >= kk);
                const int Ls = 63 - __builtin_clzll(bal);
                unsigned above = suf - s;
                int dsel = 0; unsigned kk_new = kk, cnt_sel = 0u; bool found = false;
#pragma unroll 1
                for (int i = per - 1; i >= 0; --i) { const unsigned b = (unsigned)(per * lane + i); const unsigned c = hist[b + (b >> 5)];
                    if (!found && above + c >= kk) { found = true; dsel = (int)b; kk_new = kk - above; cnt_sel = c; }
                    above += c; }
                const unsigned d = (unsigned)__builtin_amdgcn_readlane(dsel, Ls);
                kk = (unsigned)__builtin_amdgcn_readlane((int)kk_new, Ls);
                n_eq = (unsigned)__builtin_amdgcn_readlane((int)cnt_sel, Ls);
                prefix |= d << shift; pmask |= dmask << shift;
                LDS_WAIT();
            }
            T = prefix; need_eq = kk;
        }
        const bool tie_path = (need_eq != 0xffffffffu) && (n_eq > need_eq);
        unsigned tie_seen = 0u;
        const unsigned long long lt = (lane == 0) ? 0ull : (~0ull >> (64 - lane));
#pragma unroll
        for (int g = 0; g < 8; ++g) if (16 * g < ntile) {
#pragma unroll
            for (int i = 0; i < 16; ++i) { const int t = 16 * g + i;
                unsigned long long B;
                if (!tie_path) { B = __ballot(key[t] >= T); }
                else { const unsigned long long E = __ballot(key[t] == T);
                    const unsigned before = tie_seen + (unsigned)__builtin_popcountll(E & lt);
                    B = __ballot(key[t] > T || (key[t] == T && before < need_eq));
                    tie_seen += (unsigned)__builtin_popcountll(E); }
                if (lane == 0) MASK[(size_t)t * SEQ + q] = B;
            }
            __builtin_amdgcn_sched_barrier(0);
        }
    }
}

__device__ __forceinline__ att::BlockRef attn_ref(int h, int qb, const bf16_t* Qh, const bf16_t* Kh, const bf16_t* Vh, bf16_t* O, const bf16_t* SG, const unsigned long long* MASK) {
    att::BlockRef r;
    r.Q = Qh + ((size_t)h * SEQ + (size_t)qb * 256) * HD; r.K = Kh + (size_t)h * SEQ * HD; r.V = Vh + (size_t)h * SEQ * HD;
    r.O = O + (size_t)qb * 256 * DM + h * HD; r.G = SG + (size_t)qb * 256 * DM + h * HD; r.M = MASK + qb * 256; r.P0 = qb * 256;
    return r;
}
__device__ __forceinline__ void phase_attn(int wv, const bf16_t* Qh, const bf16_t* Kh, const bf16_t* Vh, bf16_t* O, const bf16_t* SG, const unsigned long long* MASK, char* lds) {
    const int total = NHEAD * 16, stride = gridDim.x;
    int L = blockIdx.x; if (L >= total) return;
    int pass = 0;
    att::BlockRef cur = attn_ref(L >> 4, L & 15, Qh, Kh, Vh, O, SG, MASK);
    att::Seam S;
    att::attn_prime(wv, cur, lds, S);
    for (;;) {
        const bool more_pass = pass == 0, more_item = L + stride < total, last = !more_pass && !more_item;
        int passn = pass + 1, Ln = L;
        if (!more_pass) { passn = 0; Ln = more_item ? L + stride : L; }
        const int hn = Ln >> 4, xn = Ln & 15;
        const att::BlockRef nxt = last ? cur : attn_ref(hn, passn ? 31 - xn : xn, Qh, Kh, Vh, O, SG, MASK);
        att::attn_block(wv, cur, nxt, lds, S);
        if (last) break;
        cur = nxt; pass = passn; L = Ln;
    }
}

__global__ void __launch_bounds__(NTHR, 2) trunk_fwd(Args args) {
    extern __shared__ __attribute__((aligned(16))) unsigned char lds_raw[];
    LAS unsigned char* lds = (LAS unsigned char*)lds_raw;
    volatile LAS unsigned* MISC = (volatile LAS unsigned*)(lds + MISC_OFF);
    const int wv = __builtin_amdgcn_readfirstlane((int)threadIdx.x >> 6);
    const int tid = opaque_tid(wv);
    unsigned char* ws = args.ws;
    if (tid < 32) MISC[tid] = 0u;
    __syncthreads();
    XcdBarrier bar; bar.bar = (unsigned*)(ws + WS_CTL) + 1024; bar.x = 0; bar.st = nullptr;
    if (MK_ONE_LAUNCH) bar = xcd_barrier_post((unsigned*)(ws + WS_CTL) + 1024, MISC + 8);
    const int lo = args.ph_lo, hi = args.ph_hi;
    int ph = 0;
#ifndef PHASE_MASK
#define PHASE_MASK 0xFFFF
#endif
#define IN(k) (lo <= (k) && (k) < hi)
#define PM(b) ((PHASE_MASK >> (b)) & 1)
#ifndef DUP_MASK
#define DUP_MASK 0
#endif
#define DUP(b) ((DUP_MASK >> (b)) & 1)
#define REDO(b, stmt) do { if (DUP(b)) { if (MK_ONE_LAUNCH) xcd_barrier(bar); else __syncthreads(); stmt; } } while (0)
#define SEAM() do { if (IN(ph) && IN(ph + 1)) xcd_barrier(bar); ++ph; } while (0)

    float* mod = (float*)(ws + WS_MOD);
    bf16_t* HU = (bf16_t*)(ws + WS_HU);
    const float* cosq = (const float*)(ws + WS_TAB); const float* sinq = cosq + SEQ * 16; const float* cosi = sinq + SEQ * 16; const float* sini = cosi + SEQ * 8;
    const int G = gridDim.x, bx = blockIdx.x;

    if (PM(0) && IN(ph)) { phase0(wv, args, lds); REDO(0, phase0(wv, args, lds)); }
    SEAM();
#pragma unroll 1
    for (int layer = 0; layer < 4; ++layer) {
        const int j = layer >> 1;
        const float* xin = (layer == 0) ? args.x : args.out;
        const float* lmod = mod + layer * 6144;
        if (PM(1) && IN(ph)) { phase_norm(wv, xin, args.norm_g + layer * DM, lmod, HU); REDO(1, phase_norm(wv, xin, args.norm_g + layer * DM, lmod, HU)); }
        SEAM();
        if ((layer & 1) == 0) {
            bf16_t* VG = (bf16_t*)(ws + WS_VG); bf16_t* PL = (bf16_t*)(ws + WS_PL);
            if (PM(2) && IN(ph)) { pg8::Gemm g{HU, (const bf16_t*)(ws + WS_WPI) + (size_t)j * POOL_IN * DM, SEQ, POOL_IN, DM, DM, DM, 0, 0};
                pg8::StaticOrder S; S.init(SEQ, POOL_IN, G, bx); pg8::EpiBf16 E{VG, POOL_IN};
                pg8::gemm_phase<pg8::EpiBf16, true>(wv, lds, g, S, E); REDO(2, (pg8::gemm_phase<pg8::EpiBf16, true>(wv, lds, g, S, E))); }
            SEAM();
            if (PM(3) && IN(ph)) { phase_pool(wv, VG, PL); REDO(3, phase_pool(wv, VG, PL)); }
            SEAM();
            if (PM(4) && IN(ph)) { pg8::Gemm g{PL, (const bf16_t*)(ws + WS_WPG) + (size_t)j * DM * 512, SEQ, DM, 512, DM, 512, 1, 512};
                pg8::StaticOrder S; S.init(SEQ, DM, G, bx); pg8::EpiPoolGrp E{HU, VG, args.pls + j * DM};
                pg8::gemm_phase<pg8::EpiPoolGrp, true>(wv, lds, g, S, E); REDO(4, (pg8::gemm_phase<pg8::EpiPoolGrp, true>(wv, lds, g, S, E))); }
            SEAM();
            if (PM(5) && IN(ph)) { pg8::Gemm g{HU, (const bf16_t*)(ws + WS_WPO) + (size_t)j * DM * DM, SEQ, DM, DM, DM, DM, 0, 0};
                pg8::StaticOrder S; S.init(SEQ, DM, G, bx); pg8::EpiResid E{xin, args.out, lmod + 2 * DM};
                pg8::gemm_phase<pg8::EpiResid, true>(wv, lds, g, S, E);
                if (DUP(5)) { pg8::EpiResid E2{xin, (float*)(ws + WS_SC), lmod + 2 * DM}; REDO(5, (pg8::gemm_phase<pg8::EpiResid, true>(wv, lds, g, S, E2))); } }
            SEAM();
        } else {
            bf16_t* Qh = (bf16_t*)(ws + WS_Q); bf16_t* Kh = (bf16_t*)(ws + WS_K); bf16_t* Vh = (bf16_t*)(ws + WS_V); bf16_t* SG = (bf16_t*)(ws + WS_GATE);
            bf16_t* QI = (bf16_t*)(ws + WS_QI); bf16_t* KI = (bf16_t*)(ws + WS_KI); float* WI = (float*)(ws + WS_WI);
            unsigned long long* MASK = (unsigned long long*)(ws + WS_MASK); float* SC = (float*)(ws + WS_SC);
            if (PM(6) && IN(ph)) { pg8::Gemm g{HU, (const bf16_t*)(ws + WS_WAI) + (size_t)j * ATTN_INP * DM, SEQ, ATTN_INP, DM, DM, DM, 0, 0};
                pg8::StaticOrder S; S.init(SEQ, ATTN_INP, G, bx); pg8::EpiAttnIn E{ws, args.pos};
                pg8::gemm_phase<pg8::EpiAttnIn, true>(wv, lds, g, S, E); REDO(6, (pg8::gemm_phase<pg8::EpiAttnIn, true>(wv, lds, g, S, E))); }
            SEAM();
            if (PM(7) && IN(ph)) { phase_scores(wv, QI, KI, WI, SC, lds, (char*)lds_raw); REDO(7, phase_scores(wv, QI, KI, WI, SC, lds, (char*)lds_raw)); }
            SEAM();
            if (PM(8) && IN(ph)) { phase_select(wv, SC, MASK, lds); REDO(8, phase_select(wv, SC, MASK, lds)); }
            SEAM();
            if (PM(9) && IN(ph)) { phase_attn(wv, Qh, Kh, Vh, HU, SG, MASK, (char*)lds_raw); REDO(9, phase_attn(wv, Qh, Kh, Vh, HU, SG, MASK, (char*)lds_raw)); }
            SEAM();
            if (PM(5) && IN(ph)) { pg8::Gemm g{HU, (const bf16_t*)(ws + WS_WAO) + (size_t)j * DM * DM, SEQ, DM, DM, DM, DM, 0, 0};
                pg8::StaticOrder S; S.init(SEQ, DM, G, bx); pg8::EpiResid E{xin, args.out, lmod + 2 * DM};
                pg8::gemm_phase<pg8::EpiResid, true>(wv, lds, g, S, E);
                if (DUP(5)) { pg8::EpiResid E2{xin, (float*)(ws + WS_SC), lmod + 2 * DM}; REDO(5, (pg8::gemm_phase<pg8::EpiResid, true>(wv, lds, g, S, E2))); } }
            SEAM();
        }
    }
    if (PM(10) && IN(ph)) { REDO(10, phase_final(wv, args.out, (float*)(ws + WS_L), args.fg)); phase_final(wv, args.out, args.out, args.fg); }
#undef IN
#undef PM
#undef SEAM
#undef REDO
}
constexpr int N_PHASES = 1 + 2 * 5 + 2 * 6 + 1;

extern "C" void kernel_launch(void* const* d_in, const int* in_sizes, int n_in, void* d_out, int out_size, void* d_ws, size_t ws_size, hipStream_t stream) {
    static int grid = 0;
    if (grid == 0) {
        if (n_in != 13 || in_sizes[0] != SEQ * DM || out_size != SEQ * DM || ws_size < WS_END) {
            fprintf(stderr, "kernel_launch: unexpected shapes / workspace (n_in %d, in0 %d, out %d, ws %zu, need %zu)\n", n_in, n_in > 0 ? in_sizes[0] : -1, out_size, ws_size, (size_t)WS_END);
            grid = -1; return; }
        int dev = 0, cus = 0, per_cu = 0;
        if (hipGetDevice(&dev) != hipSuccess || hipDeviceGetAttribute(&cus, hipDeviceAttributeMultiprocessorCount, dev) != hipSuccess) { grid = -1; return; }
        if (hipFuncSetAttribute((const void*)trunk_fwd, hipFuncAttributeMaxDynamicSharedMemorySize, LDS_BYTES) != hipSuccess) { fprintf(stderr, "kernel_launch: hipFuncSetAttribute failed\n"); grid = -1; return; }
        if (hipOccupancyMaxActiveBlocksPerMultiprocessor(&per_cu, (const void*)trunk_fwd, NTHR, LDS_BYTES) != hipSuccess || per_cu < 1) {
            fprintf(stderr, "kernel_launch: occupancy query reports %d workgroups per CU\n", per_cu); per_cu = 1; }
        (void)hipGetLastError();
        grid = cus;
        if (grid > 256) grid = 256;
    }
    if (grid < 0) return;
    (void)hipMemsetAsync((char*)d_ws + WS_CTL, 0, CTL_ZERO_BYTES, stream);
    Args a{};
    a.x = (const float*)d_in[0]; a.c = (const float*)d_in[1]; a.pos = (const int*)d_in[2]; a.norm_g = (const float*)d_in[3];
    a.mod_w = (const float*)d_in[4]; a.mod_b = (const float*)d_in[5]; a.pwi = (const float*)d_in[6]; a.pwg = (const float*)d_in[7];
    a.pls = (const float*)d_in[8]; a.pwo = (const float*)d_in[9]; a.awi = (const float*)d_in[10]; a.awo = (const float*)d_in[11]; a.fg = (const float*)d_in[12];
    a.out = (float*)d_out; a.ws = (unsigned char*)d_ws;
    for (int i = 0; i < 16; ++i) a.invf_q[i] = powf(500000.0f, -(float)i * 2.0f / 32.0f);
    for (int i = 0; i < 8; ++i) a.invf_i[i] = powf(500000.0f, -(float)i * 2.0f / 16.0f);
#if MK_ONE_LAUNCH
    a.ph_lo = 0; a.ph_hi = N_PHASES;
    hipLaunchKernelGGL(trunk_fwd, dim3(grid), dim3(NTHR), LDS_BYTES, stream, a);
#else
    for (int p = 0; p < N_PHASES; ++p) { a.ph_lo = p; a.ph_hi = p + 1; hipLaunchKernelGGL(trunk_fwd, dim3(grid), dim3(NTHR), LDS_BYTES, stream, a); }
#endif
}
```

```cpp
#include <hip/hip_runtime.h>
#include <cstdio>
#include <cstdint>
#include <cmath>

#ifndef MK_ONE_LAUNCH
#define MK_ONE_LAUNCH 1
#endif

#define LAS __attribute__((address_space(3)))
#define GAS __attribute__((address_space(1)))
typedef unsigned short bf16_t;
typedef short bf16x8 __attribute__((ext_vector_type(8)));
typedef short s16x4 __attribute__((ext_vector_type(4)));
typedef float f32x4 __attribute__((ext_vector_type(4)));
typedef float f32x2 __attribute__((ext_vector_type(2)));
typedef float f32x16 __attribute__((ext_vector_type(16)));
typedef unsigned u32x4 __attribute__((ext_vector_type(4)));
typedef unsigned u32x2 __attribute__((ext_vector_type(2)));

constexpr int DM = 2048, SEQ = 8192, NHEAD = 16, HD = 128, IDXH = 16, IDXD = 64;
constexpr int POOL_IN = 4096, ATTN_IN = 9296, ATTN_INP = 9472  ;
constexpr int TOPK = 256;
constexpr float EPS = 1e-6f;

constexpr size_t MiB = 1u << 20;
constexpr size_t WS_CTL = 0, CTL_ZERO_BYTES = 64 * 1024;
constexpr size_t WS_MOD = 1 * MiB;
constexpr size_t WS_TAB = 2 * MiB;
constexpr size_t WS_WPI = 4 * MiB;
constexpr size_t WS_WPG = 36 * MiB;
constexpr size_t WS_WPO = 40 * MiB;
constexpr size_t WS_WAI = 56 * MiB;
constexpr size_t WS_WAO = 130 * MiB;
constexpr size_t WS_HU = 146 * MiB;
constexpr size_t WS_L = 178 * MiB;
constexpr size_t WS_VG = WS_L;
constexpr size_t WS_PL = WS_L + 64 * MiB;
constexpr size_t WS_Q = WS_L, WS_K = WS_L + 32 * MiB, WS_V = WS_L + 64 * MiB;
constexpr size_t WS_GATE = WS_L + 96 * MiB;
constexpr size_t WS_QI = WS_L + 128 * MiB;
constexpr size_t WS_KI = WS_L + 144 * MiB;
constexpr size_t WS_WI = WS_L + 145 * MiB;
constexpr size_t WS_MASK = WS_L + 146 * MiB;
constexpr size_t WS_SC = WS_L + 154 * MiB;
constexpr size_t WS_END = WS_SC + 139 * MiB;

__device__ __forceinline__ unsigned cvt_pk_bf16(float lo, float hi) { unsigned r; asm volatile("v_cvt_pk_bf16_f32 %0, %1, %2" : "=v"(r) : "v"(lo), "v"(hi)); return r; }
__device__ __forceinline__ unsigned f2bf(float f) { unsigned u = __builtin_bit_cast(unsigned, f); return (u + 0x7fffu + ((u >> 16) & 1u)) >> 16; }
__device__ __forceinline__ unsigned pk2(float lo, float hi) { return f2bf(lo) | (f2bf(hi) << 16); }
__device__ __forceinline__ float bf2f(unsigned short b) { return __builtin_bit_cast(float, (unsigned)b << 16); }
__device__ __forceinline__ float fast_sigmoid(float x) { return __builtin_amdgcn_rcpf(1.0f + __builtin_amdgcn_exp2f(-1.4426950408889634f * x)); }
__device__ __forceinline__ float silu_f(float x) { return x * fast_sigmoid(x); }
__device__ __forceinline__ float wave_sum(float v) {
#pragma unroll
    for (int o = 1; o < 64; o <<= 1) v += __shfl_xor(v, o);
    return v;
}
__device__ __forceinline__ int opaque_tid(int wv) { int t; asm volatile("v_mbcnt_lo_u32_b32 %0, -1, 0\n\tv_mbcnt_hi_u32_b32 %0, -1, %0\n\tv_lshl_add_u32 %0, %1, 6, %0" : "=&v"(t) : "s"(wv)); return t; }
#define LDS_WAIT() asm volatile("s_waitcnt lgkmcnt(0)" ::: "memory")
#define VM_WAIT() asm volatile("s_waitcnt vmcnt(0)" ::: "memory")

namespace pg8 {
constexpr int BM = 256, BK = 64, HALF = 128, HTB = HALF * BK * 2, STAGE_BYTES = 8 * HTB, NXCD = 8, WGM = 8;
__host__ __device__ __forceinline__ int lds_byte(int r, int c) { const int st = (r >> 4) * 2 + (c >> 5), rr = r & 15, cc = c & 31, ob = rr * 64 + cc * 2; return st * 1024 + (ob ^ (((ob >> 9) & 1) << 5)); }
__host__ __device__ __forceinline__ void stage_rc(int b, int& R, int& C) { const int st = b / 1024, sb = b % 1024, swz = sb ^ (((sb >> 9) & 1) << 5); R = (st >> 1) * 16 + swz / 64; C = (st & 1) * 32 + (swz % 64) / 2; }
__host__ __device__ __forceinline__ int perm32(int rho) { const int n = rho >> 4, i = rho & 15; return 8 * (i >> 2) + 4 * n + (i & 3); }

struct Unit { int pm, pn; };
struct Gemm { const bf16_t* A; const bf16_t* Bt; int M, N, K, lda, ldb, agsh, agstride; };

struct StaticOrder {
    int nM, nN, nwg, G, c;
    __host__ __device__ void init(int M, int N, int G_, int c_) { nM = M / BM; nN = N / BM; nwg = nM * nN; G = G_; c = c_; }
    __host__ __device__ bool next(int i, Unit& u) const {
        const long L = (long)i * G + c; if (L >= nwg) return false;
        int wgid = (int)L; { const int q = nwg / NXCD, r = nwg % NXCD, xcd = wgid % NXCD, off = wgid / NXCD; wgid = (xcd < r ? xcd * (q + 1) : r * (q + 1) + (xcd - r) * q) + off; }
        const int nig = WGM * nN, gid = wgid / nig, fm = gid * WGM, gsz = (nM - fm) < WGM ? (nM - fm) : WGM;
        u.pm = fm + ((wgid % nig) % gsz); u.pn = (wgid % nig) / gsz; return true;
    }
};

template <class Epi, bool ALIGN_EPI>
__device__ __forceinline__ void gemm_phase(int wv, LAS unsigned char* lds, const Gemm g, const StaticOrder& S, const Epi& E) {
    const int tid = opaque_tid(wv), wid = __builtin_amdgcn_readfirstlane(tid >> 6), lane = tid & 63, wr = wid >> 2, wc = wid & 3, fr = lane & 15, fq = lane >> 4;
    const int K = g.K, nt = K / BK;
    unsigned voffA[2], voffB[2];
#pragma unroll
    for (int i = 0; i < 2; ++i) { int R, C; stage_rc(tid * 16 + i * 8192, R, C); const int Rb = Epi::PERM ? ((R & ~31) + perm32(R & 31)) : R;
        voffA[i] = (unsigned)(R * g.lda + C) * 2u; voffB[i] = (unsigned)(Rb * g.ldb + C) * 2u; }
    const size_t kstep = (size_t)(BK * 2);
    const size_t hstepA = (size_t)HALF * g.lda * 2, hstepB = (size_t)HALF * g.ldb * 2;
    const size_t tstepA = 2 * hstepA, tstepB = 2 * hstepB;
    const unsigned ldsw = (unsigned)wid * 1024u;
    const int aoff = lds_byte(wr * 64 + fr, fq * 8), boff = lds_byte(wc * 32 + fr, fq * 8);
#define PG8_SA(b, h) (((b) * 2 + (h)) * HTB)
#define PG8_SB(b, h) ((4 + (b) * 2 + (h)) * HTB)
#define PG8_STAGE(bufoff, gbase, voff) do { _Pragma("unroll") for (int _i = 0; _i < 2; ++_i) \
        __builtin_amdgcn_global_load_lds((const unsigned*)((const char*)(gbase) + (voff)[_i]), (LAS unsigned*)(lds + (bufoff) + ldsw + _i * 8192), 16, 0, 0); } while (0)
#define PG8_LDA(dst, b, h) do { _Pragma("unroll") for (int m = 0; m < 4; ++m) _Pragma("unroll") for (int k = 0; k < 2; ++k) dst[m][k] = *(const LAS bf16x8*)(lds + PG8_SA(b, h) + aoff + m * 2048 + k * 1024); } while (0)
#define PG8_LDB(dst, b, h) do { _Pragma("unroll") for (int n = 0; n < 2; ++n) _Pragma("unroll") for (int k = 0; k < 2; ++k) dst[n][k] = *(const LAS bf16x8*)(lds + PG8_SB(b, h) + boff + n * 2048 + k * 1024); } while (0)
#define PG8_MMA(ai, bj, At, Bt) do { __builtin_amdgcn_s_setprio(1); _Pragma("unroll") for (int m = 0; m < 4; ++m) _Pragma("unroll") for (int n = 0; n < 2; ++n) _Pragma("unroll") for (int k = 0; k < 2; ++k) \
        acc[ai][bj][m][n] = __builtin_amdgcn_mfma_f32_16x16x32_bf16(Bt[n][k], At[m][k], acc[ai][bj][m][n], 0, 0, 0); __builtin_amdgcn_s_setprio(0); } while (0)
#define PG8_WAIT_V(n) asm volatile("s_waitcnt vmcnt(" #n ")" ::: "memory")
#define PG8_WAIT_L(n) asm volatile("s_waitcnt lgkmcnt(" #n ")" ::: "memory")
#define PG8_BAR __builtin_amdgcn_s_barrier()
#define PG8_SCHED __builtin_amdgcn_sched_barrier(0)
#define PG8_AOFF(u) ((size_t)(u).pm * tstepA + (size_t)(((u).pn >> g.agsh) * g.agstride) * 2)
    Unit cur, nxt; int ui = 0;
    if (!S.next(0, cur)) return;
    f32x4 acc[2][2][4][2];
#pragma unroll
    for (int a = 0; a < 2; ++a)
#pragma unroll
        for (int b = 0; b < 2; ++b)
#pragma unroll
            for (int m = 0; m < 4; ++m)
#pragma unroll
                for (int n = 0; n < 2; ++n) acc[a][b][m][n] = (f32x4){0.f, 0.f, 0.f, 0.f};
    bf16x8 At[4][2], B0[2][2], B1[2][2];
    const char* cA = (const char*)g.A + PG8_AOFF(cur); const char* cB = (const char*)g.Bt + (size_t)cur.pn * tstepB;
    PG8_STAGE(PG8_SB(0, 0), cB, voffB); PG8_STAGE(PG8_SB(0, 1), cB + hstepB, voffB); PG8_STAGE(PG8_SA(0, 0), cA, voffA); PG8_STAGE(PG8_SA(0, 1), cA + hstepA, voffA);
    if (wr == 1) PG8_BAR;
    PG8_WAIT_V(2); PG8_BAR;
    PG8_STAGE(PG8_SB(1, 0), cB + kstep, voffB); PG8_STAGE(PG8_SA(1, 0), cA + kstep, voffA); PG8_STAGE(PG8_SB(1, 1), cB + hstepB + kstep, voffB);
    PG8_WAIT_V(6); PG8_BAR;
    for (;;) {
        const bool has_next = S.next(ui + 1, nxt);
        const char* nA = has_next ? (const char*)g.A + PG8_AOFF(nxt) : cA; const char* nB = has_next ? (const char*)g.Bt + (size_t)nxt.pn * tstepB : cB;
        for (int t = 0; t < nt; t += 2) {
            const bool last = (t == nt - 2);
            const char* a1 = cA + (size_t)(t + 1) * kstep;
            const char* a2 = last ? nA : cA + (size_t)(t + 2) * kstep; const char* b2 = last ? nB : cB + (size_t)(t + 2) * kstep;
            const char* a3 = a2 + kstep; const char* b3 = b2 + kstep;
            PG8_LDB(B0, 0, 0); PG8_LDB(B1, 0, 1); PG8_SCHED; PG8_LDA(At, 0, 0); PG8_STAGE(PG8_SA(1, 1), a1 + hstepA, voffA);
            PG8_WAIT_V(8); PG8_WAIT_L(0); PG8_BAR; PG8_MMA(0, 0, At, B0); PG8_MMA(0, 1, At, B1); PG8_BAR; PG8_SCHED;
            PG8_LDA(At, 0, 1); PG8_STAGE(PG8_SB(0, 0), b2, voffB); PG8_STAGE(PG8_SB(0, 1), b2 + hstepB, voffB); PG8_STAGE(PG8_SA(0, 0), a2, voffA);
            PG8_WAIT_V(8); PG8_WAIT_L(0); PG8_BAR; PG8_MMA(1, 0, At, B0); PG8_MMA(1, 1, At, B1); PG8_BAR; PG8_SCHED;
            PG8_LDB(B0, 1, 0); PG8_LDB(B1, 1, 1); PG8_SCHED; PG8_LDA(At, 1, 0); PG8_STAGE(PG8_SA(0, 1), a2 + hstepA, voffA);
            PG8_WAIT_V(8); PG8_WAIT_L(0); PG8_BAR; PG8_MMA(0, 0, At, B0); PG8_MMA(0, 1, At, B1); PG8_BAR; PG8_SCHED;
            PG8_LDA(At, 1, 1); PG8_STAGE(PG8_SB(1, 0), b3, voffB); PG8_STAGE(PG8_SB(1, 1), b3 + hstepB, voffB); PG8_STAGE(PG8_SA(1, 0), a3, voffA);
            PG8_WAIT_V(8); PG8_WAIT_L(0); PG8_BAR; PG8_MMA(1, 0, At, B0); PG8_MMA(1, 1, At, B1); PG8_BAR; PG8_SCHED;
        }
        if constexpr (ALIGN_EPI) { if (wr == 0) PG8_BAR; }
        E(acc, cur, wr, wc, fr, fq);
        if (!has_next) break;
#pragma unroll
        for (int a = 0; a < 2; ++a)
#pragma unroll
            for (int b = 0; b < 2; ++b)
#pragma unroll
                for (int m = 0; m < 4; ++m)
#pragma unroll
                    for (int n = 0; n < 2; ++n) acc[a][b][m][n] = (f32x4){0.f, 0.f, 0.f, 0.f};
        cur = nxt; cA = nA; cB = nB; ++ui;
        if constexpr (ALIGN_EPI) { if (wr == 1) PG8_BAR; }
    }
    PG8_WAIT_V(0);
    if constexpr (!ALIGN_EPI) { if (wr == 0) PG8_BAR; }
    PG8_BAR;
#undef PG8_SA
#undef PG8_SB
#undef PG8_STAGE
#undef PG8_LDA
#undef PG8_LDB
#undef PG8_MMA
#undef PG8_WAIT_V
#undef PG8_WAIT_L
#undef PG8_BAR
#undef PG8_SCHED
#undef PG8_AOFF
}

struct EpiBf16 {
    static constexpr bool PERM = true;
    bf16_t* O; int ldc;
    __device__ __forceinline__ void operator()(const f32x4 (&acc)[2][2][4][2], const Unit& u, int wr, int wc, int fr, int fq) const {
        const int row0 = u.pm * BM + wr * 64 + fr; const int col0 = u.pn * BM + wc * 32 + 8 * fq;
#pragma unroll
        for (int ai = 0; ai < 2; ++ai)
#pragma unroll
            for (int m = 0; m < 4; ++m) { bf16_t* rowp = O + (size_t)(row0 + ai * HALF + m * 16) * ldc + col0;
#pragma unroll
                for (int bj = 0; bj < 2; ++bj) { const f32x4 v0 = acc[ai][bj][m][0], v1 = acc[ai][bj][m][1];
                    u32x4 w; w.x = cvt_pk_bf16(v0[0], v0[1]); w.y = cvt_pk_bf16(v0[2], v0[3]); w.z = cvt_pk_bf16(v1[0], v1[1]); w.w = cvt_pk_bf16(v1[2], v1[3]);
                    *(u32x4*)(rowp + bj * HALF) = w; } }
    }
};
struct EpiPoolGrp {
    static constexpr bool PERM = true;
    bf16_t* U; const bf16_t* VG; const float* ls;
    __device__ __forceinline__ void operator()(const f32x4 (&acc)[2][2][4][2], const Unit& u, int wr, int wc, int fr, int fq) const {
        const int row0 = u.pm * BM + wr * 64 + fr; const int col0 = u.pn * BM + wc * 32 + 8 * fq;
        f32x4 lv[2][2];
#pragma unroll
        for (int bj = 0; bj < 2; ++bj)
#pragma unroll
            for (int n = 0; n < 2; ++n) lv[bj][n] = *(const f32x4*)(ls + col0 + bj * HALF + 4 * n);
#pragma unroll
        for (int ai = 0; ai < 2; ++ai)
#pragma unroll
            for (int m = 0; m < 4; ++m) { const size_t row = (size_t)(row0 + ai * HALF + m * 16);
#pragma unroll
                for (int bj = 0; bj < 2; ++bj) {
                    const u32x4 gw = *(const u32x4*)(VG + row * POOL_IN + DM + col0 + bj * HALF);
                    f32x4 v0 = acc[ai][bj][m][0] * lv[bj][0], v1 = acc[ai][bj][m][1] * lv[bj][1];
                    float g[8];
#pragma unroll
                    for (int e = 0; e < 4; ++e) { g[2 * e] = __builtin_bit_cast(float, gw[e] << 16); g[2 * e + 1] = __builtin_bit_cast(float, gw[e] & 0xffff0000u); }
#pragma unroll
                    for (int e = 0; e < 4; ++e) { v0[e] *= silu_f(g[e]); v1[e] *= silu_f(g[4 + e]); }
                    u32x4 w; w.x = cvt_pk_bf16(v0[0], v0[1]); w.y = cvt_pk_bf16(v0[2], v0[3]); w.z = cvt_pk_bf16(v1[0], v1[1]); w.w = cvt_pk_bf16(v1[2], v1[3]);
                    *(u32x4*)(U + row * DM + col0 + bj * HALF) = w; } }
    }
};
struct EpiResid {
    static constexpr bool PERM = false;
    const float* xin; float* xout; const float* gmod;
    __device__ __forceinline__ void operator()(const f32x4 (&acc)[2][2][4][2], const Unit& u, int wr, int wc, int fr, int fq) const {
        const int row0 = u.pm * BM + wr * 64 + fr; const int col0 = u.pn * BM + wc * 32 + 4 * fq;
        f32x4 gv[2][2];
#pragma unroll
        for (int bj = 0; bj < 2; ++bj)
#pragma unroll
            for (int n = 0; n < 2; ++n) gv[bj][n] = *(const f32x4*)(gmod + col0 + bj * HALF + 16 * n);
#pragma unroll
        for (int ai = 0; ai < 2; ++ai)
#pragma unroll
            for (int m = 0; m < 4; ++m) { const size_t off = (size_t)(row0 + ai * HALF + m * 16) * DM + col0;
#pragma unroll
                for (int bj = 0; bj < 2; ++bj)
#pragma unroll
                    for (int n = 0; n < 2; ++n) { const f32x4 bs = *(const f32x4*)(xin + off + bj * HALF + 16 * n);
                        *(f32x4*)(xout + off + bj * HALF + 16 * n) = bs + gv[bj][n] * acc[ai][bj][m][n]; } }
    }
};
struct EpiAttnIn {
    static constexpr bool PERM = false;
    unsigned char* ws; const int* pos;
    __device__ __forceinline__ void operator()(const f32x4 (&acc)[2][2][4][2], const Unit& u, int wr, int wc, int fr, int fq) const {
        const int row0 = u.pm * BM + wr * 64 + fr; const int pn = u.pn;
        bf16_t* const Qh = (bf16_t*)(ws + WS_Q); bf16_t* const SG = (bf16_t*)(ws + WS_GATE); bf16_t* const QI = (bf16_t*)(ws + WS_QI); bf16_t* const KI = (bf16_t*)(ws + WS_KI); float* const WI = (float*)(ws + WS_WI);
        const float* const cosq = (const float*)(ws + WS_TAB); const float* const sinq = cosq + SEQ * 16; const float* const cosi = sinq + SEQ * 16; const float* const sini = cosi + SEQ * 8;
#pragma unroll
        for (int ai = 0; ai < 2; ++ai)
#pragma unroll
            for (int m = 0; m < 4; ++m) {
                const int row = row0 + ai * HALF + m * 16;
                if (pn < 24) {
                    bf16_t* base = Qh + (size_t)(pn >> 3) * ((size_t)SEQ * DM);
                    const bool rope = (pn < 16) && (wc == 0);
                    f32x4 cs = {1.f, 1.f, 1.f, 1.f}, sn = {0.f, 0.f, 0.f, 0.f};
                    if (rope) { const int p = pos[row]; cs = *(const f32x4*)(cosq + (size_t)p * 16 + 4 * fq); sn = *(const f32x4*)(sinq + (size_t)p * 16 + 4 * fq); }
#pragma unroll
                    for (int bj = 0; bj < 2; ++bj) { const int head = 2 * (pn & 7) + bj;
                        f32x4 v0 = acc[ai][bj][m][0], v1 = acc[ai][bj][m][1];
                        if (rope) { const f32x4 o0 = v0 * cs - v1 * sn, o1 = v1 * cs + v0 * sn; v0 = o0; v1 = o1; }
                        bf16_t* dst = base + ((size_t)head * SEQ + row) * HD + 32 * wc + 4 * fq;
                        u32x2 w0, w1; w0.x = cvt_pk_bf16(v0[0], v0[1]); w0.y = cvt_pk_bf16(v0[2], v0[3]); w1.x = cvt_pk_bf16(v1[0], v1[1]); w1.y = cvt_pk_bf16(v1[2], v1[3]);
                        *(u32x2*)dst = w0; *(u32x2*)(dst + 16) = w1; }
                } else if (pn < 32) {
#pragma unroll
                    for (int bj = 0; bj < 2; ++bj)
#pragma unroll
                        for (int n = 0; n < 2; ++n) { const f32x4 v = acc[ai][bj][m][n];
                            u32x2 w; w.x = cvt_pk_bf16(silu_f(v[0]), silu_f(v[1])); w.y = cvt_pk_bf16(silu_f(v[2]), silu_f(v[3]));
                            *(u32x2*)(SG + (size_t)row * DM + (pn - 24) * BM + bj * HALF + 32 * wc + 16 * n + 4 * fq) = w; }
                } else {
                    const bool isq = pn < 36;
                    const int p = pos[row];
                    const f32x4 cs = *(const f32x4*)(cosi + (size_t)p * 8 + 4 * (fq & 1)), sn = *(const f32x4*)(sini + (size_t)p * 8 + 4 * (fq & 1));
#pragma unroll
                    for (int bj = 0; bj < 2; ++bj) {
                        if (!isq && bj == 1) continue;
#pragma unroll
                        for (int n = 0; n < 2; ++n) {
                            f32x4 v = acc[ai][bj][m][n];
                            const bool rope = ((wc & 1) == 0) && (n == 0) && (isq || wc == 0);
                            if (rope) {
                                f32x4 pr;
#pragma unroll
                                for (int e = 0; e < 4; ++e) pr[e] = __shfl_xor(v[e], 32);
                                v = (fq < 2) ? (v * cs - pr * sn) : (v * cs + pr * sn);
                            }
                            const int cl = bj * HALF + 32 * wc + 16 * n + 4 * fq;
                            if (isq) { u32x2 w; w.x = cvt_pk_bf16(v[0], v[1]); w.y = cvt_pk_bf16(v[2], v[3]); *(u32x2*)(QI + (size_t)row * 1024 + (pn - 32) * BM + cl) = w; }
                            else if (cl < 64) { u32x2 w; w.x = cvt_pk_bf16(v[0], v[1]); w.y = cvt_pk_bf16(v[2], v[3]); *(u32x2*)(KI + (size_t)row * 64 + cl) = w; }
                            else if (cl < 80) { *(f32x4*)(WI + (size_t)row * 16 + (cl - 64)) = v; }
                        }
                    }
                }
                asm volatile("" ::: "memory");
            }
    }
};
}

namespace att {
constexpr int D = 128, NW = 8, QBLK = 32, KVBLK = 64, QB = NW * QBLK;
constexpr int SHM_V = KVBLK * D * 2, SHM_K = KVBLK * D * 2;
constexpr int QROWB = 272;
constexpr int Q_OFF = 2 * SHM_V + 2 * SHM_K + NW * 64 * 4;
constexpr int LDS_BYTES = Q_OFF + QB * QROWB;
constexpr float SCALE = 0.08838834764831845f;
constexpr float THR = 8.f;
#define KSWZ(row, colB) ((row) * 256 + ((colB) ^ (((row) & 7) << 4)))
#define SBAR() __builtin_amdgcn_sched_barrier(0)
__device__ __forceinline__ int v_st(int k, int c) { const int kk = (k & ~0xC) | ((k & 4) << 1) | ((k & 8) >> 1); return ((kk >> 3) * 4 + (c >> 5)) * 512 + ((kk & 7) * 32 + (c & 31)) * 2; }
__device__ __forceinline__ int v_rd_base(int lane) { return ((lane & 3) << 3) | (((lane >> 2) & 3) << 6) | (((lane >> 4) & 1) << 5) | (((lane >> 5) & 1) << 8); }
constexpr int v_rd_off(int d0, int ks, int half) { return d0 * 512 + ks * 4096 + half * 2048; }
__device__ __forceinline__ int crow(int r, int hi) { return (r & 3) + 8 * (r >> 2) + 4 * hi; }
__device__ __forceinline__ unsigned cvtpk(float lo, float hi) { unsigned r; asm volatile("v_cvt_pk_bf16_f32 %0, %1, %2" : "=v"(r) : "v"(lo), "v"(hi)); return r; }
__device__ __forceinline__ bf16x8 load8(const bf16_t* p) { return *reinterpret_cast<const bf16x8*>(p); }
__device__ __forceinline__ float mask_and(float v, unsigned mlo, unsigned mhi, int r, int p) {
    const int pos = (r & 3) + 8 * (r >> 2);
    const unsigned w = p ? mhi : mlo;
    const int bits = __builtin_amdgcn_sbfe((int)w, pos, 1);
    return __builtin_bit_cast(float, __builtin_bit_cast(unsigned, v) & (unsigned)bits);
}
__device__ __forceinline__ void partialSM(f32x16& p0, f32x16& p1, float& m_reg, float& mn, float& alpha, unsigned mlo, unsigned mhi) {
    float pmax = p0[0];
#pragma unroll
    for (int r = 1; r < 16; ++r) pmax = fmaxf(pmax, p0[r]);
#pragma unroll
    for (int r = 0; r < 16; ++r) pmax = fmaxf(pmax, p1[r]);
    { auto rr = __builtin_amdgcn_permlane32_swap(__float_as_uint(pmax), __float_as_uint(pmax), false, false);
      pmax = fmaxf(__uint_as_float(rr[0]), __uint_as_float(rr[1])); }
    constexpr float C2 = 1.4426950408889634f * SCALE;
    if (__builtin_expect(__all((pmax - m_reg) * SCALE <= THR), 1)) { mn = m_reg; alpha = 1.f; }
    else { mn = fmaxf(m_reg, pmax); alpha = __builtin_amdgcn_exp2f((m_reg - mn) * C2); m_reg = mn; }
    const float mnL = -mn * C2;
#pragma unroll
    for (int r = 0; r < 16; ++r) p0[r] = fmaf(p0[r], C2, mnL);
#pragma unroll
    for (int r = 0; r < 16; ++r) p1[r] = fmaf(p1[r], C2, mnL);
#pragma unroll
    for (int r = 0; r < 16; ++r) p0[r] = mask_and(__builtin_amdgcn_exp2f(p0[r]), mlo, mhi, r, 0);
}
__device__ __forceinline__ void finishSM(f32x16& p0, f32x16& p1, float alpha, float& l_reg, bf16x8& pa0, bf16x8& pa1, bf16x8& pa2, bf16x8& pa3, unsigned mlo, unsigned mhi) {
#pragma unroll
    for (int r = 0; r < 16; ++r) p1[r] = mask_and(__builtin_amdgcn_exp2f(p1[r]), mlo, mhi, r, 1);
    float ps = 0;
#pragma unroll
    for (int r = 0; r < 16; ++r) ps += p0[r];
#pragma unroll
    for (int r = 0; r < 16; ++r) ps += p1[r];
    { auto rr = __builtin_amdgcn_permlane32_swap(__float_as_uint(ps), __float_as_uint(ps), false, false);
      ps = __uint_as_float(rr[0]) + __uint_as_float(rr[1]); }
    l_reg = l_reg * alpha + ps;
#define PK4(P, B_, OUT) do { unsigned a0 = cvtpk(P[B_+0], P[B_+1]), a1 = cvtpk(P[B_+2], P[B_+3]);                          \
        unsigned b0 = cvtpk(P[B_+4], P[B_+5]), b1 = cvtpk(P[B_+6], P[B_+7]);                                             \
        auto r0 = __builtin_amdgcn_permlane32_swap(a0, b0, false, false); auto r1 = __builtin_amdgcn_permlane32_swap(a1, b1, false, false); \
        u32x4 w = {r0[0], r1[0], r0[1], r1[1]}; OUT = *reinterpret_cast<bf16x8*>(&w); } while (0)
    PK4(p0, 0, pa0); PK4(p0, 8, pa1); PK4(p1, 0, pa2); PK4(p1, 8, pa3);
#undef PK4
}
template <int KB>
__device__ __forceinline__ void qkt(f32x16& p0, f32x16& p1, const char* K_lds, int r32, int hi, const char* qa  ) {
    p0 = f32x16{}; p1 = f32x16{};
    const char* kb[4];
#pragma unroll
    for (int dd = 0; dd < 4; ++dd) kb[dd] = K_lds + KB * SHM_K + KSWZ(r32, (dd * 16 + hi * 8) * 2);
#pragma unroll
    for (int d0 = 0; d0 < 8; ++d0) { const char* a = kb[d0 & 3] + (d0 >> 2) * 128;
        bf16x8 b0 = *reinterpret_cast<const bf16x8*>(a);
        bf16x8 b1 = *reinterpret_cast<const bf16x8*>(a + 32 * 256);
        const bf16x8 qf = *reinterpret_cast<const bf16x8*>(qa + d0 * 32);
        p0 = __builtin_amdgcn_mfma_f32_32x32x16_bf16(b0, qf, p0, 0, 0, 0);
        p1 = __builtin_amdgcn_mfma_f32_32x32x16_bf16(b1, qf, p1, 0, 0, 0); }
}
template <int VB>
__device__ __forceinline__ void pv_tile(f32x16* o, int vb0, bf16x8 pa0, bf16x8 pa1, bf16x8 pa2, bf16x8 pa3) {
#define TRRD(dst, off) asm volatile("ds_read_b64_tr_b16 %0, %1 offset:%2" : "=&v"(dst) : "v"(vb0), "i"(off) : "memory")
#define PV_D0(d0) do { s16x4 l0, l1, l2, l3, h0, h1, h2, h3; constexpr int b_ = VB * SHM_V + v_rd_off(d0, 0, 0); \
        TRRD(l0, b_); TRRD(h0, b_ + 2048); TRRD(l1, b_ + 4096); TRRD(h1, b_ + 6144); TRRD(l2, b_ + 8192); TRRD(h2, b_ + 10240); TRRD(l3, b_ + 12288); TRRD(h3, b_ + 14336); \
        asm volatile("s_waitcnt lgkmcnt(0)" ::: "memory"); SBAR();   \
        o[d0] = __builtin_amdgcn_mfma_f32_32x32x16_bf16(pa0, (bf16x8){l0[0], l0[1], l0[2], l0[3], h0[0], h0[1], h0[2], h0[3]}, o[d0], 0, 0, 0);   \
        o[d0] = __builtin_amdgcn_mfma_f32_32x32x16_bf16(pa1, (bf16x8){l1[0], l1[1], l1[2], l1[3], h1[0], h1[1], h1[2], h1[3]}, o[d0], 0, 0, 0);   \
        o[d0] = __builtin_amdgcn_mfma_f32_32x32x16_bf16(pa2, (bf16x8){l2[0], l2[1], l2[2], l2[3], h2[0], h2[1], h2[2], h2[3]}, o[d0], 0, 0, 0);   \
        o[d0] = __builtin_amdgcn_mfma_f32_32x32x16_bf16(pa3, (bf16x8){l3[0], l3[1], l3[2], l3[3], h3[0], h3[1], h3[2], h3[3]}, o[d0], 0, 0, 0); } while (0)
    PV_D0(0); PV_D0(1); PV_D0(2); PV_D0(3);
#undef PV_D0
#undef TRRD
}
struct BlockRef { const bf16_t* Q; const bf16_t* K; const bf16_t* V; bf16_t* O; const bf16_t* G; const unsigned long long* M; int P0; };
struct Seam { bf16x8 st_v0, st_v1, st_k0, st_k1; };
#define ROW(p, k0, rr) ((p) + (size_t)((k0) + (rr)) * D + sc)
#define VMW() asm volatile("s_waitcnt vmcnt(0)" ::: "memory")
#define VMWN(n) asm volatile("s_waitcnt vmcnt(%0)" :: "i"(n) : "memory")
#define SLOAD_H(Kp, Vp, k0) do { S.st_v0 = load8(ROW(Vp, k0, sr)); S.st_v1 = load8(ROW(Vp, k0, 32 + sr));              \
                         S.st_k0 = load8(ROW(Kp, k0, sr)); S.st_k1 = load8(ROW(Kp, k0, 32 + sr)); } while (0)
#define SWRITE_HK(bf) do { *(bf16x8*)(K_lds + (bf) * SHM_K + kws) = S.st_k0; *(bf16x8*)(K_lds + (bf) * SHM_K + kws + 32 * 256) = S.st_k1; } while (0)
#define SWRITE_HV(bf) do { *(bf16x8*)(V_lds + (bf) * SHM_V + vst0) = S.st_v0; *(bf16x8*)(V_lds + (bf) * SHM_V + vst1) = S.st_v1; } while (0)
#define SWRITE_H(bf) do { SWRITE_HV(bf); SWRITE_HK(bf); } while (0)
__device__ __forceinline__ void attn_prime(int wv, const BlockRef& cur, char* lds, Seam& S) {
    const int tid = opaque_tid(wv);
    const int sr = tid >> 4, sc = (tid & 15) * 8, kws = KSWZ(sr, sc * 2); char* K_lds = lds + 2 * SHM_V;
    SLOAD_H(cur.K, cur.V, 0); VMW(); SWRITE_HK(0);
    __syncthreads();
}
__device__ __forceinline__ void attn_block(int wv, const BlockRef& cur, const BlockRef& nxt, char* lds, Seam& S) {
    const int tid = opaque_tid(wv), wid = __builtin_amdgcn_readfirstlane(tid >> 6), lane = tid & 63, r32 = lane & 31, hi = lane >> 5;
    const int NT = cur.P0 / KVBLK + 4;
    char* V_lds = lds; char* K_lds = lds + 2 * SHM_V;
    float* ws = (float*)(lds + 2 * SHM_V + 2 * SHM_K) + wid * 64; float* li_l = ws, * al_l = ws + 32;
    float m_reg = -1e30f, l_reg = 0; f32x16 o[4] = {};
    const int sr = tid >> 4, sc = (tid & 15) * 8, vst0 = v_st(sr, sc), vst1 = v_st(32 + sr, sc), kws = KSWZ(sr, sc * 2);
    const int vb0 = (int)(uintptr_t)V_lds + v_rd_base(lane);
    const bf16_t* Kh = cur.K; const bf16_t* Vh = cur.V;
    const unsigned long long* mp = cur.M + (wid * QBLK + r32);
#define MLOAD(lo_, hi_, t) do { const unsigned long long w_ = mp[(size_t)(t) * SEQ] >> (4 * hi); lo_ = (unsigned)w_; hi_ = (unsigned)(w_ >> 32); } while (0)
#define RESC(a) do { if (__any((a) < 1.f)) { if (hi == 0) al_l[r32] = (a); asm volatile("s_waitcnt lgkmcnt(0)" ::: "memory");              \
                     for (int d_ = 0; d_ < 4; ++d_) for (int r = 0; r < 16; ++r) o[d_][r] *= al_l[crow(r, hi)]; } } while (0)
#define KBASE(t) ((t) * KVBLK)
#define SEAM_K0() do { VMW(); SWRITE_HK(0); SBAR(); } while (0)
    f32x16 pA0, pA1, pB0, pB1; float mnA, mnB, alA, alB; bf16x8 pa0, pa1, pa2, pa3;
    unsigned mAlo, mAhi, mBlo, mBhi;
    MLOAD(mAlo, mAhi, 0);
    char* Qw_lds = lds + Q_OFF + wid * (QBLK * QROWB);
    { u32x4 tq[8];
#pragma unroll
        for (int i = 0; i < 8; ++i) tq[i] = *(const u32x4*)(cur.Q + (size_t)(wid * QBLK + 4 * i + (lane >> 4)) * D + (lane & 15) * 8);
#pragma unroll
        for (int i = 0; i < 8; ++i) *(u32x4*)(Qw_lds + (4 * i + (lane >> 4)) * QROWB + (lane & 15) * 16) = tq[i];
        asm volatile("s_waitcnt lgkmcnt(0)" ::: "memory"); }
    const char* qa = Qw_lds + r32 * QROWB + hi * 16;
    SWRITE_HV(0); SBAR();
    if (NT > 1) { SLOAD_H(Kh, Vh, KBASE(1)); }
    SBAR(); qkt<0>(pA0, pA1, K_lds, r32, hi, qa);
    partialSM(pA0, pA1, m_reg, mnA, alA, mAlo, mAhi);
    if (NT > 1) { VMW(); SWRITE_H(1); }
    __syncthreads();
#define HALF_STEP(PX0, PX1, mnX, alX, mXlo, mXhi, PY0, PY1, alY, mYlo, mYhi, t, KB, VB, SB) do {                                  \
        SBAR(); MLOAD(mXlo, mXhi, t); qkt<KB>(PX0, PX1, K_lds, r32, hi, qa);                                                  \
        finishSM(PY0, PY1, alY, l_reg, pa0, pa1, pa2, pa3, mYlo, mYhi); SBAR();                                                 \
        if ((t) + 1 < NT) { SLOAD_H(Kh, Vh, KBASE((t) + 1)); SBAR(); }                                                          \
        pv_tile<VB>(o, vb0, pa0, pa1, pa2, pa3); partialSM(PX0, PX1, m_reg, mnX, alX, mXlo, mXhi);                              \
        __syncthreads();                                                                                                      \
        if ((t) + 1 < NT) { VMW(); SWRITE_H(SB); }                                                                            \
        RESC(alX); __syncthreads(); } while (0)
    for (int t = 1; t + 1 < NT; t += 2) {
        HALF_STEP(pB0, pB1, mnB, alB, mBlo, mBhi, pA0, pA1, alA, mAlo, mAhi, t, 1, 0, 0);
        HALF_STEP(pA0, pA1, mnA, alA, mAlo, mAhi, pB0, pB1, alB, mBlo, mBhi, t + 1, 0, 1, 1);
    }
    MLOAD(mBlo, mBhi, NT - 1);
    SBAR(); qkt<1>(pB0, pB1, K_lds, r32, hi, qa); SBAR();
    SLOAD_H(nxt.K, nxt.V, 0); SBAR();
    finishSM(pA0, pA1, alA, l_reg, pa0, pa1, pa2, pa3, mAlo, mAhi); SBAR();
    pv_tile<0>(o, vb0, pa0, pa1, pa2, pa3);
    partialSM(pB0, pB1, m_reg, mnB, alB, mBlo, mBhi); __syncthreads(); RESC(alB);
    finishSM(pB0, pB1, alB, l_reg, pa0, pa1, pa2, pa3, mBlo, mBhi); SBAR(); pv_tile<1>(o, vb0, pa0, pa1, pa2, pa3);
    SBAR(); SEAM_K0();
    if (hi == 0) li_l[r32] = l_reg; asm volatile("s_waitcnt lgkmcnt(0)" ::: "memory");
    float rli[16];
#pragma unroll
    for (int r = 0; r < 16; ++r) rli[r] = __builtin_amdgcn_rcpf(li_l[crow(r, hi)]);
    bf16_t* Ow = cur.O + (size_t)(wid * QBLK) * DM; const bf16_t* Gw = cur.G + (size_t)(wid * QBLK) * DM;
#pragma unroll
    for (int r = 0; r < 16; ++r) { const int orow = crow(r, hi);
#pragma unroll
        for (int d0 = 0; d0 < 4; ++d0) { const float gt = bf2f(Gw[(size_t)orow * DM + d0 * 32 + r32]);
            const float v = o[d0][r] * rli[r] * gt;
            const float vn = __shfl_xor(v, 1);
            if ((r32 & 1) == 0) *(unsigned*)(Ow + (size_t)orow * DM + d0 * 32 + r32) = cvtpk(v, vn); } }
    __syncthreads();
#undef MLOAD
#undef RESC
#undef KBASE
#undef SEAM_K0
#undef HALF_STEP
}
#undef ROW
#undef VMW
#undef VMWN
#undef SLOAD_H
#undef SWRITE_HK
#undef SWRITE_HV
#undef SWRITE_H
#undef KSWZ
#undef SBAR
}

#define XB_TMO      128
#define XB_XCNT(j)  (256  + 64 * (j))
#define XB_XSUB(j)  (1280 + 64 * (j))
#define XB_XGEN(j)  (2304 + 64 * (j))
#define XB_TOP      3328
#define XB_TOPGEN   3392
#define XCD_BAR_WORDS 3456
#define XB_SPIN_CAP (1u << 22)
__device__ __forceinline__ unsigned xb_ld(unsigned* p)              { return __hip_atomic_load(p, __ATOMIC_RELAXED, __HIP_MEMORY_SCOPE_AGENT); }
__device__ __forceinline__ unsigned xb_add(unsigned* p, unsigned v) { return __hip_atomic_fetch_add(p, v, __ATOMIC_RELAXED, __HIP_MEMORY_SCOPE_AGENT); }
__device__ __forceinline__ unsigned xb_xcc_id() { return (unsigned)__builtin_amdgcn_s_getreg((3 << 11) | 20) & 0xFu; }
#define XB_SPIN(cond, bar) do { unsigned _sp = 0; while (cond) { __builtin_amdgcn_s_sleep(1); \
    if ((++_sp & 255u) == 0u) { if (xb_ld(&(bar)[XB_TMO])) break; if (_sp > XB_SPIN_CAP) { atomicAdd(&(bar)[XB_TMO], 1u); break; } } } } while (0)
struct XcdBarrier { unsigned* bar; unsigned x; volatile LAS unsigned* st; };
__device__ __forceinline__ XcdBarrier xcd_barrier_post(unsigned* bar, volatile LAS unsigned* st) {
    XcdBarrier b; b.bar = bar; b.x = xb_xcc_id(); b.st = st;
    if (threadIdx.x == 0) (void)xb_add(&bar[XB_XCNT(b.x)], 1u);
    return b;
}
__device__ __forceinline__ void xcd_barrier_complete(unsigned* bar, unsigned x, unsigned& nloc, unsigned& nx) {
    const unsigned G = gridDim.x * gridDim.y * gridDim.z;
    unsigned sum, cnt, mine, sp = 0u;
    for (;;) {
        sum = 0u; cnt = 0u; mine = 0u;
#pragma unroll
        for (unsigned j = 0; j < 16; ++j) { const unsigned c = xb_ld(&bar[XB_XCNT(j)]); sum += c; cnt += (c > 0u) ? 1u : 0u; mine = (j == x) ? c : mine; }
        if (sum == G) break;
        __builtin_amdgcn_s_sleep(1);
        if ((++sp & 255u) == 0u) { if (xb_ld(&bar[XB_TMO])) break; if (sp > XB_SPIN_CAP) { atomicAdd(&bar[XB_TMO], 1u); break; } }
    }
    nloc = mine > 0u ? mine : 1u; nx = cnt > 0u ? cnt : 1u;
}
__device__ __forceinline__ void xcd_barrier(const XcdBarrier& b) {
    asm volatile("s_waitcnt vmcnt(0)" ::: "memory");
    __syncthreads();
    if (threadIdx.x == 0) {
        unsigned* bar = b.bar;
        __builtin_amdgcn_s_waitcnt(0);
        unsigned nloc = b.st[0], nx = b.st[1];
        if (nloc == 0u) { xcd_barrier_complete(bar, b.x, nloc, nx); b.st[0] = nloc; b.st[1] = nx; }
        const unsigned old = xb_add(&bar[XB_XSUB(b.x)], 1u);
        const unsigned gen = old / nloc;
        if (old + 1u == (gen + 1u) * nloc) {
            __builtin_amdgcn_fence(__ATOMIC_RELEASE, "agent");
            asm volatile("s_waitcnt vmcnt(0)" ::: "memory");
            const unsigned og = xb_add(&bar[XB_TOP], 1u);
            const unsigned tg = og / nx;
            if (og + 1u == (tg + 1u) * nx) xb_add(&bar[XB_TOPGEN], 1u);
            else XB_SPIN(xb_ld(&bar[XB_TOPGEN]) == tg, bar);
            __builtin_amdgcn_fence(__ATOMIC_ACQUIRE, "agent");
            xb_add(&bar[XB_XGEN(b.x)], 1u);
            asm volatile("s_waitcnt vmcnt(0)" ::: "memory");
        } else {
            XB_SPIN(xb_ld(&bar[XB_XGEN(b.x)]) == gen, bar);
            __builtin_amdgcn_fence(__ATOMIC_ACQUIRE, "agent");
            asm volatile("s_waitcnt vmcnt(0)" ::: "memory");
        }
    }
    __syncthreads();
}

struct Args {
    const float* x; const float* c; const int* pos; const float* norm_g; const float* mod_w; const float* mod_b;
    const float* pwi; const float* pwg; const float* pls; const float* pwo; const float* awi; const float* awo; const float* fg;
    float* out; unsigned char* ws;
    int ph_lo, ph_hi;
    float invf_q[16]; float invf_i[8];
};
constexpr int NWAVES = 8, NTHR = 512;
constexpr int RING_BYTES = 131072, LDS_BYTES = 147456, MISC_OFF = LDS_BYTES - 256;

__device__ __forceinline__ void sincos_d(double a, float& s_out, float& c_out) {
    const double k = __builtin_rint(a * 0.6366197723675814);
    double r = __builtin_fma(-k, 1.5707963267948966, a); r = __builtin_fma(-k, 6.123233995736766e-17, r);
    const double r2 = r * r;
    double sp = -7.647163731819816e-13; sp = sp * r2 + 1.6059043836821613e-10; sp = sp * r2 - 2.505210838544172e-08; sp = sp * r2 + 2.7557319223985893e-06;
    sp = sp * r2 - 1.984126984126984e-04; sp = sp * r2 + 8.333333333333333e-03; sp = sp * r2 - 1.6666666666666666e-01; const double s = r + r * r2 * sp;
    double cp = 4.779477332387385e-14; cp = cp * r2 - 1.1470745597729725e-11; cp = cp * r2 + 2.08767569878681e-09; cp = cp * r2 - 2.755731922398589e-07;
    cp = cp * r2 + 2.48015873015873e-05; cp = cp * r2 - 1.388888888888889e-03; cp = cp * r2 + 4.1666666666666664e-02; cp = cp * r2 - 0.5; const double c = 1.0 + r2 * cp;
    const int q = (int)((long long)k & 3);
    const double ss = (q == 0) ? s : (q == 1) ? c : (q == 2) ? -s : -c;
    const double cc = (q == 0) ? c : (q == 1) ? -s : (q == 2) ? -c : s;
    s_out = (float)ss; c_out = (float)cc;
}
__device__ __forceinline__ void transpose_item(const float* W, int K, int N, bf16_t* WT, int row_off, LAS float* scr, int nblk, int item, int lane) {
    const int kb = item / nblk, nb = item % nblk, k0 = 64 * kb, n0 = 32 * nb;
    const int nn = n0 + (lane & 31);
    float tv[32];
#pragma unroll
    for (int i = 0; i < 32; ++i) { const int kk = 2 * i + (lane >> 5); tv[i] = (nn < N) ? W[(size_t)(k0 + kk) * N + nn] : 0.f; }
#pragma unroll
    for (int i = 0; i < 32; ++i) { const int kk = 2 * i + (lane >> 5); scr[kk * 33 + (lane & 31)] = tv[i]; }
    LDS_WAIT(); asm volatile("" ::: "memory");
    const int c = lane & 7;
#pragma unroll
    for (int j = 0; j < 4; ++j) { const int n = (lane >> 3) + 8 * j; const LAS float* s = scr + (8 * c) * 33 + n;
        u32x4 o; o.x = pk2(s[0 * 33], s[1 * 33]); o.y = pk2(s[2 * 33], s[3 * 33]); o.z = pk2(s[4 * 33], s[5 * 33]); o.w = pk2(s[6 * 33], s[7 * 33]);
        *(u32x4*)(WT + (size_t)(row_off + n0 + n) * K + k0 + 8 * c) = o; }
    LDS_WAIT(); asm volatile("" ::: "memory");
}
__device__ __forceinline__ void phase0(int wv, const Args& a, LAS unsigned char* lds) {
    const int tid = opaque_tid(wv), lane = tid & 63, wave = __builtin_amdgcn_readfirstlane(tid >> 6);
    const int G = gridDim.x, bx = blockIdx.x;
    unsigned char* ws = a.ws;
    for (int unit = bx; unit < 256; unit += G) {
        const int n0 = unit * 96;
        const int layer = n0 / 6144, nl = n0 - layer * 6144;
        const float* W = a.mod_w + (size_t)layer * DM * 6144 + nl;
        LAS float* red = (LAS float*)lds;
        if (tid < 504) {
            const int kg = tid / 24, ln = tid - kg * 24;
            f32x4 acc4 = {0.f, 0.f, 0.f, 0.f};
#pragma unroll 14
            for (int i = 0; i < 98; ++i) { const int k = kg + 21 * i;
                if (k < DM) { const float cv = a.c[k]; const float cd = silu_f(cv); const f32x4 w = *(const f32x4*)(W + (size_t)k * 6144 + 4 * ln); acc4 += w * cd; } }
            *(LAS f32x4*)(red + kg * 96 + 4 * ln) = acc4;
        }
        __syncthreads();
        if (tid < 96) { float s = 0.f;
#pragma unroll
            for (int kg = 0; kg < 21; ++kg) s += red[kg * 96 + tid];
            ((float*)(ws + WS_MOD))[n0 + tid] = s + a.mod_b[n0 + tid]; }
        __syncthreads();
    }
    {
        float* cosq = (float*)(ws + WS_TAB); float* sinq = cosq + SEQ * 16; float* cosi = sinq + SEQ * 16; float* sini = cosi + SEQ * 8;
        for (int e = bx * NTHR + tid; e < SEQ * 24; e += G * NTHR) {
            const int p = e / 24, i = e - p * 24;
            const float pf = (float)a.pos[p];
            const float inv = i < 16 ? a.invf_q[i] : a.invf_i[i - 16];
            const float ang = pf * inv;
            float s, c; sincos_d((double)ang, s, c);
            if (i < 16) { cosq[p * 16 + i] = c; sinq[p * 16 + i] = s; } else { cosi[p * 8 + i - 16] = c; sini[p * 8 + i - 16] = s; }
        }
    }
    {
        LAS float* scr = (LAS float*)(lds + 16384 + wave * 8704);
        const int gw = bx * NWAVES + wave, NGW = G * NWAVES;
        constexpr int I_PI = 32 * 128, I_PG = 8 * 16, I_PO = 32 * 64, I_AI = 32 * 296, I_AO = 32 * 64;
        constexpr int NITEMS = 2 * I_PI + 8 * I_PG + 2 * I_PO + 2 * I_AI + 2 * I_AO;
        for (int it = gw; it < NITEMS; it += NGW) {
            int r = it;
            if (r < 2 * I_AI) { const int l = r / I_AI; r -= l * I_AI; transpose_item(a.awi + (size_t)l * DM * ATTN_IN, DM, ATTN_IN, (bf16_t*)(ws + WS_WAI) + (size_t)l * ATTN_INP * DM, 0, scr, 296, r, lane); continue; } r -= 2 * I_AI;
            if (r < 2 * I_PI) { const int l = r / I_PI; r -= l * I_PI; transpose_item(a.pwi + (size_t)l * DM * POOL_IN, DM, POOL_IN, (bf16_t*)(ws + WS_WPI) + (size_t)l * POOL_IN * DM, 0, scr, 128, r, lane); continue; } r -= 2 * I_PI;
            if (r < 2 * I_PO) { const int l = r / I_PO; r -= l * I_PO; transpose_item(a.pwo + (size_t)l * DM * DM, DM, DM, (bf16_t*)(ws + WS_WPO) + (size_t)l * DM * DM, 0, scr, 64, r, lane); continue; } r -= 2 * I_PO;
            if (r < 2 * I_AO) { const int l = r / I_AO; r -= l * I_AO; transpose_item(a.awo + (size_t)l * DM * DM, DM, DM, (bf16_t*)(ws + WS_WAO) + (size_t)l * DM * DM, 0, scr, 64, r, lane); continue; } r -= 2 * I_AO;
            { const int lg = r / I_PG; r -= lg * I_PG; const int l = lg >> 2, gi = lg & 3;
              transpose_item(a.pwg + (size_t)lg * 512 * 512, 512, 512, (bf16_t*)(ws + WS_WPG) + (size_t)l * DM * 512, gi * 512, scr, 16, r, lane); }
        }
    }
}

__device__ __forceinline__ void phase_norm(int wv, const float* x, const float* g, const float* mod  , bf16_t* h) {
    const int tid = opaque_tid(wv), lane = tid & 63, wave = tid >> 6;
    const int gw = blockIdx.x * NWAVES + wave, NGW = gridDim.x * NWAVES;
    for (int row = gw; row < SEQ; row += NGW) {
        const f32x4* xr = (const f32x4*)(x + (size_t)row * DM) + lane;
        f32x4 v[8]; float s = 0.f;
#pragma unroll
        for (int j = 0; j < 8; ++j) { v[j] = xr[64 * j]; s += (v[j].x * v[j].x + v[j].y * v[j].y) + (v[j].z * v[j].z + v[j].w * v[j].w); }
        const float rstd = 1.0f / sqrtf(wave_sum(s) * (1.f / DM) + EPS);
        unsigned long long* o8 = (unsigned long long*)(h + (size_t)row * DM) + lane;
#pragma unroll
        for (int j = 0; j < 8; ++j) { const int col = 4 * lane + 256 * j;
            const f32x4 gg = *(const f32x4*)(g + col), sh = *(const f32x4*)(mod + col), sc = *(const f32x4*)(mod + DM + col);
            const f32x4 y = v[j] * rstd * gg * (sc + 1.0f) + sh;
            o8[64 * j] = (unsigned long long)cvt_pk_bf16(y.x, y.y) | ((unsigned long long)cvt_pk_bf16(y.z, y.w) << 32); }
    }
}
__device__ __forceinline__ void phase_final(int wv, const float* x, float* y, const float* g) {
    const int tid = opaque_tid(wv), lane = tid & 63, wave = tid >> 6;
    const int gw = blockIdx.x * NWAVES + wave, NGW = gridDim.x * NWAVES;
    for (int row = gw; row < SEQ; row += NGW) {
        const f32x4* xr = (const f32x4*)(x + (size_t)row * DM) + lane; f32x4* yr = (f32x4*)(y + (size_t)row * DM) + lane;
        f32x4 v[8]; float s = 0.f;
#pragma unroll
        for (int j = 0; j < 8; ++j) { v[j] = xr[64 * j]; s += (v[j].x * v[j].x + v[j].y * v[j].y) + (v[j].z * v[j].z + v[j].w * v[j].w); }
        const float rstd = 1.0f / sqrtf(wave_sum(s) * (1.f / DM) + EPS);
#pragma unroll
        for (int j = 0; j < 8; ++j) { const int col = 4 * lane + 256 * j; const f32x4 gg = *(const f32x4*)(g + col); yr[64 * j] = v[j] * rstd * gg; }
    }
}

__device__ __forceinline__ void phase_pool(int wv, const bf16_t* VG, bf16_t* PL) {
    const int total = 512 * 256;
    const int tid = opaque_tid(wv);
    for (int it = blockIdx.x * NTHR + tid; it < total; it += gridDim.x * NTHR) {
        const int cg = it & 255, strip = it >> 8; const int c0 = cg * 8, t0 = strip * 16;
        const int w = 2 << (c0 >> 9);
        float S[8];
#pragma unroll
        for (int e = 0; e < 8; ++e) S[e] = 0.f;
        for (int t = t0 - w + 1; t < t0; ++t) if (t >= 0) {
            const u32x4 r = *(const u32x4*)(VG + (size_t)t * POOL_IN + c0);
#pragma unroll
            for (int e = 0; e < 4; ++e) { S[2 * e] += __builtin_bit_cast(float, r[e] << 16); S[2 * e + 1] += __builtin_bit_cast(float, r[e] & 0xffff0000u); } }
        for (int t = t0; t < t0 + 16; ++t) {
            const u32x4 r = *(const u32x4*)(VG + (size_t)t * POOL_IN + c0);
            float v[8];
#pragma unroll
            for (int e = 0; e < 4; ++e) { v[2 * e] = __builtin_bit_cast(float, r[e] << 16); v[2 * e + 1] = __builtin_bit_cast(float, r[e] & 0xffff0000u); }
            const int cnt = (t + 1 < w) ? (t + 1) : w; const float ic = 1.0f / (float)cnt;
            float o[8];
#pragma unroll
            for (int e = 0; e < 8; ++e) { S[e] += v[e]; o[e] = S[e] * ic - v[e]; }
            u32x4 pw; pw.x = cvt_pk_bf16(o[0], o[1]); pw.y = cvt_pk_bf16(o[2], o[3]); pw.z = cvt_pk_bf16(o[4], o[5]); pw.w = cvt_pk_bf16(o[6], o[7]);
            *(u32x4*)(PL + (size_t)t * DM + c0) = pw;
            const int tl = t - w + 1;
            if (tl >= 0) { const u32x4 q = *(const u32x4*)(VG + (size_t)tl * POOL_IN + c0);
#pragma unroll
                for (int e = 0; e < 4; ++e) { S[2 * e] -= __builtin_bit_cast(float, q[e] << 16); S[2 * e + 1] -= __builtin_bit_cast(float, q[e] & 0xffff0000u); } }
        }
    }
}

__device__ __forceinline__ size_t sc_block_base(int qb) { return (size_t)65536 * (size_t)(qb * (qb + 1) / 2); }
__device__ __forceinline__ float relu_i(float x) { const int b = __builtin_bit_cast(int, x); return __builtin_bit_cast(float, b > 0 ? b : 0); }
__device__ __forceinline__ void phase_scores(int wv, const bf16_t* QI, const bf16_t* KI, const float* WI, float* SC, LAS unsigned char* lds, unsigned* ctr  ) {
    const int tid = opaque_tid(wv), wid = __builtin_amdgcn_readfirstlane(tid >> 6), lane = tid & 63, r32 = lane & 31, hi = lane >> 5;
    constexpr int QROW = 2064;
    LAS float* wl = (LAS float*)(lds + 32 * QROW);
    volatile LAS int* slot = (volatile LAS int*)(lds + 32 * QROW + 2048);
    for (;;) {
        __syncthreads();
        if (tid == 0) slot[0] = (int)__hip_atomic_fetch_add(ctr, 1u, __ATOMIC_RELAXED, __HIP_MEMORY_SCOPE_AGENT);
        __syncthreads();
        const int L = slot[0];
        if (L >= 1152) break;
        int kc = 0, base = 0;
        for (; kc < 8; ++kc) { const int n = 256 - 32 * kc; if (L < base + n) break; base += n; }
        const int u = 32 * kc + (L - base);
        const int q0 = 32 * u, qb = u >> 3;
        const int klim = (qb + 1) * 256;
#pragma unroll
        for (int i = 0; i < 8; ++i) { const int piece = tid + 512 * i, row = piece >> 7, c16 = piece & 127;
            const u32x4 v = *(const u32x4*)(QI + (size_t)(q0 + row) * 1024 + c16 * 8);
            *(LAS u32x4*)(lds + row * QROW + c16 * 16) = v; }
        { const int q = tid >> 4, h = tid & 15; wl[h * 32 + q] = WI[(size_t)(q0 + q) * 16 + h]; }
        __syncthreads();
        for (int sl = wid; sl < 16; sl += 8) {
            const int key0 = kc * 1024 + sl * 64;
            if (key0 >= klim) continue;
            bf16x8 kf[2][4];
#pragma unroll
            for (int b = 0; b < 2; ++b)
#pragma unroll
                for (int kk = 0; kk < 4; ++kk) kf[b][kk] = *(const bf16x8*)(KI + (size_t)(key0 + 32 * b + r32) * 64 + 16 * kk + 8 * hi);
            f32x16 acc0 = {}, acc1 = {};
            const LAS unsigned char* qa = lds + r32 * QROW + hi * 16;
            const LAS float* wa = wl + 4 * hi;
#define SC_MM(h, S0, S1) do { bf16x8 af_[4];                                                                                  \
                _Pragma("unroll") for (int kk = 0; kk < 4; ++kk) af_[kk] = *(const LAS bf16x8*)(qa + (h) * 128 + kk * 32);     \
                S0 = __builtin_amdgcn_mfma_f32_32x32x16_bf16(af_[0], kf[0][0], f32x16{}, 0, 0, 0); S1 = __builtin_amdgcn_mfma_f32_32x32x16_bf16(af_[0], kf[1][0], f32x16{}, 0, 0, 0); \
                _Pragma("unroll") for (int kk = 1; kk < 4; ++kk) { S0 = __builtin_amdgcn_mfma_f32_32x32x16_bf16(af_[kk], kf[0][kk], S0, 0, 0, 0); S1 = __builtin_amdgcn_mfma_f32_32x32x16_bf16(af_[kk], kf[1][kk], S1, 0, 0, 0); } } while (0)
#define SC_VA(h, S0, S1) do { f32x4 w4_[4];                                                                                   \
                _Pragma("unroll") for (int gq = 0; gq < 4; ++gq) w4_[gq] = *(const LAS f32x4*)(wa + (h) * 32 + 8 * gq);        \
                _Pragma("unroll") for (int r = 0; r < 16; ++r) { const float w_ = w4_[r >> 2][r & 3]; acc0[r] = fmaf(relu_i(S0[r]), w_, acc0[r]); acc1[r] = fmaf(relu_i(S1[r]), w_, acc1[r]); } } while (0)
#define SC_ILV() do { __builtin_amdgcn_sched_group_barrier(0x100, 8, 0);                                                        \
                _Pragma("unroll") for (int i_ = 0; i_ < 8; ++i_) { __builtin_amdgcn_sched_group_barrier(0x008, 1, 0); __builtin_amdgcn_sched_group_barrier(0x002, 6, 0); } \
                __builtin_amdgcn_sched_barrier(0); } while (0)
            f32x16 sA0, sA1, sB0, sB1;
            SC_MM(0, sA0, sA1);
            __builtin_amdgcn_sched_barrier(0);
#pragma unroll 1
            for (int h = 0; h < 14; h += 2) {
                SC_MM(h + 1, sB0, sB1); SC_VA(h, sA0, sA1); SC_ILV();
                SC_MM(h + 2, sA0, sA1); SC_VA(h + 1, sB0, sB1); SC_ILV();
            }
            SC_MM(15, sB0, sB1); SC_VA(14, sA0, sA1); SC_ILV();
            SC_VA(15, sB0, sB1);
#undef SC_MM
#undef SC_VA
#undef SC_ILV
            float* out = SC + sc_block_base(qb) + (size_t)(q0 - qb * 256) * (size_t)klim + key0 + r32;
#pragma unroll
            for (int r = 0; r < 16; ++r) { const int qr_ = (r & 3) + 8 * (r >> 2) + 4 * hi;
                out[(size_t)qr_ * klim] = acc0[r]; out[(size_t)qr_ * klim + 32] = acc1[r]; }
        }
    }
}

__device__ __forceinline__ void phase_select(int wv, const float* SC, unsigned long long* MASK, LAS unsigned char* lds) {
    const int tid = opaque_tid(wv), lane0 = tid & 63, wave = __builtin_amdgcn_readfirstlane(tid >> 6);
    LAS unsigned* hist = (LAS unsigned*)(lds + wave * 8704);
    const int gw = blockIdx.x * NWAVES + wave, NGW = gridDim.x * NWAVES;
    for (int q = gw; q < SEQ; q += NGW) {
        int lane = lane0; asm volatile("" : "+v"(lane));
        const int qb = q >> 8, klim = (qb + 1) * 256;
        const float* rowp = SC + sc_block_base(qb) + (size_t)(q - qb * 256) * (size_t)klim;
        const int ntile = 4 * (qb + 1);
        unsigned key[128];
#pragma unroll
        for (int g = 0; g < 8; ++g) {
            if (16 * g < ntile) {
#pragma unroll
                for (int i = 0; i < 16; ++i) key[16 * g + i] = __builtin_bit_cast(unsigned, rowp[64 * (16 * g + i) + lane]);
            } else {
#pragma unroll
                for (int i = 0; i < 16; ++i) key[16 * g + i] = 0u;
            }
        }
#pragma unroll
        for (int g = 0; g < 8; ++g) if (16 * g < ntile) {
#pragma unroll
            for (int i = 0; i < 16; ++i) { const int t = 16 * g + i; const unsigned uu = key[t];
                const unsigned kx = uu ^ ((unsigned)((int)uu >> 31) | 0x80000000u); key[t] = (64 * t + lane <= q) ? kx : 0u; }
        }
        unsigned T = 1u; unsigned need_eq = 0xffffffffu, n_eq = 0u;
        if (q + 1 > TOPK) {
            unsigned prefix = 0u, pmask = 0u, kk = TOPK;
#pragma unroll 1
            for (int pass = 0; pass < 3; ++pass) {
                const int shift = (pass == 0) ? 21 : (pass == 1) ? 10 : 0;
                const unsigned dmask = (pass == 2) ? 1023u : 2047u;
                const int nb = (pass == 2) ? 1024 : 2048, per = nb >> 6;
#pragma unroll 1
                for (int i = lane; i < 2112; i += 64) hist[i] = 0u;
                LDS_WAIT();
#pragma unroll
                for (int g = 0; g < 8; ++g) if (16 * g < ntile) {
#pragma unroll
                    for (int i = 0; i < 16; ++i) { const unsigned k = key[16 * g + i];
                        if ((k & pmask) == prefix) {     const unsigned b = (k >> shift) & dmask; __hip_atomic_fetch_add(hist + b + (b >> 5), 1u, __ATOMIC_RELAXED, __HIP_MEMORY_SCOPE_WORKGROUP); } }
                }
                LDS_WAIT();
                unsigned s = 0u;
#pragma unroll 8
                for (int i = 0; i < per; ++i) { const unsigned b = (unsigned)(per * lane + i); s += hist[b + (b >> 5)]; }
                unsigned suf = s;
#pragma unroll
                for (int off = 1; off < 64; off <<= 1) { const unsigned tt = __shfl_down(suf, off); if (lane + off < 64) suf += tt; }
                const unsigned long long bal = __ballot(suf >= kk);
                const int Ls = 63 - __builtin_clzll(bal);
                unsigned above = suf - s;
                int dsel = 0; unsigned kk_new = kk, cnt_sel = 0u; bool found = false;
#pragma unroll 8
                for (int i = per - 1; i >= 0; --i) { const unsigned b = (unsigned)(per * lane + i); const unsigned c = hist[b + (b >> 5)];
                    if (!found && above + c >= kk) { found = true; dsel = (int)b; kk_new = kk - above; cnt_sel = c; }
                    above += c; }
                const unsigned d = (unsigned)__builtin_amdgcn_readlane(dsel, Ls);
                kk = (unsigned)__builtin_amdgcn_readlane((int)kk_new, Ls);
                n_eq = (unsigned)__builtin_amdgcn_readlane((int)cnt_sel, Ls);
                prefix |= d << shift; pmask |= dmask << shift;
                LDS_WAIT();
            }
            T = prefix; need_eq = kk;
        }
        const bool tie_path = (need_eq != 0xffffffffu) && (n_eq > need_eq);
        unsigned tie_seen = 0u;
        const unsigned long long lt = (lane == 0) ? 0ull : (~0ull >> (64 - lane));
#pragma unroll
        for (int g = 0; g < 8; ++g) if (16 * g < ntile) {
#pragma unroll
            for (int i = 0; i < 16; ++i) { const int t = 16 * g + i;
                unsigned long long B;
                if (!tie_path) { B = __ballot(key[t] >= T); }
                else { const unsigned long long E = __ballot(key[t] == T);
                    const unsigned before = tie_seen + (unsigned)__builtin_popcountll(E & lt);
                    B = __ballot(key[t] > T || (key[t] == T && before < need_eq));
                    tie_seen += (unsigned)__builtin_popcountll(E); }
                if (lane == 0) MASK[(size_t)t * SEQ + q] = B;
            }
            __builtin_amdgcn_sched_barrier(0);
        }
    }
}

__device__ __forceinline__ att::BlockRef attn_ref(int h, int qb, const bf16_t* Qh, const bf16_t* Kh, const bf16_t* Vh, bf16_t* O, const bf16_t* SG, const unsigned long long* MASK) {
    att::BlockRef r;
    r.Q = Qh + ((size_t)h * SEQ + (size_t)qb * 256) * HD; r.K = Kh + (size_t)h * SEQ * HD; r.V = Vh + (size_t)h * SEQ * HD;
    r.O = O + (size_t)qb * 256 * DM + h * HD; r.G = SG + (size_t)qb * 256 * DM + h * HD; r.M = MASK + qb * 256; r.P0 = qb * 256;
    return r;
}
__device__ __forceinline__ void phase_attn(int wv, const bf16_t* Qh, const bf16_t* Kh, const bf16_t* Vh, bf16_t* O, const bf16_t* SG, const unsigned long long* MASK, char* lds) {
    const int total = NHEAD * 16, stride = gridDim.x;
    int L = blockIdx.x; if (L >= total) return;
    int pass = 0;
    att::BlockRef cur = attn_ref(L >> 4, L & 15, Qh, Kh, Vh, O, SG, MASK);
    att::Seam S;
    att::attn_prime(wv, cur, lds, S);
    for (;;) {
        const bool more_pass = pass == 0, more_item = L + stride < total, last = !more_pass && !more_item;
        int passn = pass + 1, Ln = L;
        if (!more_pass) { passn = 0; Ln = more_item ? L + stride : L; }
        const int hn = Ln >> 4, xn = Ln & 15;
        const att::BlockRef nxt = last ? cur : attn_ref(hn, passn ? 31 - xn : xn, Qh, Kh, Vh, O, SG, MASK);
        att::attn_block(wv, cur, nxt, lds, S);
        if (last) break;
        cur = nxt; pass = passn; L = Ln;
    }
}

__global__ void __launch_bounds__(NTHR, 2) trunk_fwd(Args args) {
    extern __shared__ __attribute__((aligned(16))) unsigned char lds_raw[];
    LAS unsigned char* lds = (LAS unsigned char*)lds_raw;
    volatile LAS unsigned* MISC = (volatile LAS unsigned*)(lds + MISC_OFF);
    const int wv = __builtin_amdgcn_readfirstlane((int)threadIdx.x >> 6);
    const int tid = opaque_tid(wv);
    unsigned char* ws = args.ws;
    if (tid < 32) MISC[tid] = 0u;
    __syncthreads();
    XcdBarrier bar; bar.bar = (unsigned*)(ws + WS_CTL) + 1024; bar.x = 0; bar.st = nullptr;
    if (MK_ONE_LAUNCH) bar = xcd_barrier_post((unsigned*)(ws + WS_CTL) + 1024, MISC + 8);
    const int lo = args.ph_lo, hi = args.ph_hi;
    int ph = 0;
#ifndef PHASE_MASK
#define PHASE_MASK 0xFFFF
#endif
#define IN(k) (lo <= (k) && (k) < hi)
#define PM(b) ((PHASE_MASK >> (b)) & 1)
#ifndef DUP_MASK
#define DUP_MASK 0
#endif
#define DUP(b) ((DUP_MASK >> (b)) & 1)
#define REDO(b, stmt) do { if (DUP(b)) { if (MK_ONE_LAUNCH) xcd_barrier(bar); else __syncthreads(); stmt; } } while (0)
#define SEAM() do { if (IN(ph) && IN(ph + 1)) xcd_barrier(bar); ++ph; } while (0)

    float* mod = (float*)(ws + WS_MOD);
    bf16_t* HU = (bf16_t*)(ws + WS_HU);
    const float* cosq = (const float*)(ws + WS_TAB); const float* sinq = cosq + SEQ * 16; const float* cosi = sinq + SEQ * 16; const float* sini = cosi + SEQ * 8;
    const int G = gridDim.x, bx = blockIdx.x;

    if (PM(0) && IN(ph)) { phase0(wv, args, lds); REDO(0, phase0(wv, args, lds)); }
    SEAM();
#pragma unroll 1
    for (int layer = 0; layer < 4; ++layer) {
        const int j = layer >> 1;
        const float* xin = (layer == 0) ? args.x : args.out;
        const float* lmod = mod + layer * 6144;
        if (PM(1) && IN(ph)) { phase_norm(wv, xin, args.norm_g + layer * DM, lmod, HU); REDO(1, phase_norm(wv, xin, args.norm_g + layer * DM, lmod, HU)); }
        SEAM();
        if ((layer & 1) == 0) {
            bf16_t* VG = (bf16_t*)(ws + WS_VG); bf16_t* PL = (bf16_t*)(ws + WS_PL);
            if (PM(2) && IN(ph)) { pg8::Gemm g{HU, (const bf16_t*)(ws + WS_WPI) + (size_t)j * POOL_IN * DM, SEQ, POOL_IN, DM, DM, DM, 0, 0};
                pg8::StaticOrder S; S.init(SEQ, POOL_IN, G, bx); pg8::EpiBf16 E{VG, POOL_IN};
                pg8::gemm_phase<pg8::EpiBf16, true>(wv, lds, g, S, E); REDO(2, (pg8::gemm_phase<pg8::EpiBf16, true>(wv, lds, g, S, E))); }
            SEAM();
            if (PM(3) && IN(ph)) { phase_pool(wv, VG, PL); REDO(3, phase_pool(wv, VG, PL)); }
            SEAM();
            if (PM(4) && IN(ph)) { pg8::Gemm g{PL, (const bf16_t*)(ws + WS_WPG) + (size_t)j * DM * 512, SEQ, DM, 512, DM, 512, 1, 512};
                pg8::StaticOrder S; S.init(SEQ, DM, G, bx); pg8::EpiPoolGrp E{HU, VG, args.pls + j * DM};
                pg8::gemm_phase<pg8::EpiPoolGrp, true>(wv, lds, g, S, E); REDO(4, (pg8::gemm_phase<pg8::EpiPoolGrp, true>(wv, lds, g, S, E))); }
            SEAM();
            if (PM(5) && IN(ph)) { pg8::Gemm g{HU, (const bf16_t*)(ws + WS_WPO) + (size_t)j * DM * DM, SEQ, DM, DM, DM, DM, 0, 0};
                pg8::StaticOrder S; S.init(SEQ, DM, G, bx); pg8::EpiResid E{xin, args.out, lmod + 2 * DM};
                pg8::gemm_phase<pg8::EpiResid, true>(wv, lds, g, S, E);
                if (DUP(5)) { pg8::EpiResid E2{xin, (float*)(ws + WS_SC), lmod + 2 * DM}; REDO(5, (pg8::gemm_phase<pg8::EpiResid, true>(wv, lds, g, S, E2))); } }
            SEAM();
        } else {
            bf16_t* Qh = (bf16_t*)(ws + WS_Q); bf16_t* Kh = (bf16_t*)(ws + WS_K); bf16_t* Vh = (bf16_t*)(ws + WS_V); bf16_t* SG = (bf16_t*)(ws + WS_GATE);
            bf16_t* QI = (bf16_t*)(ws + WS_QI); bf16_t* KI = (bf16_t*)(ws + WS_KI); float* WI = (float*)(ws + WS_WI);
            unsigned long long* MASK = (unsigned long long*)(ws + WS_MASK); float* SC = (float*)(ws + WS_SC);
            if (PM(6) && IN(ph)) { pg8::Gemm g{HU, (const bf16_t*)(ws + WS_WAI) + (size_t)j * ATTN_INP * DM, SEQ, ATTN_INP, DM, DM, DM, 0, 0};
                pg8::StaticOrder S; S.init(SEQ, ATTN_INP, G, bx); pg8::EpiAttnIn E{ws, args.pos};
                pg8::gemm_phase<pg8::EpiAttnIn, true>(wv, lds, g, S, E); REDO(6, (pg8::gemm_phase<pg8::EpiAttnIn, true>(wv, lds, g, S, E))); }
            SEAM();
            if (PM(7) && IN(ph)) { unsigned* qctr = (unsigned*)(ws + WS_CTL) + 8192 + 128 * j; phase_scores(wv, QI, KI, WI, SC, lds, qctr); REDO(7, phase_scores(wv, QI, KI, WI, SC, lds, qctr + 64)); }
            SEAM();
            if (PM(8) && IN(ph)) { phase_select(wv, SC, MASK, lds); REDO(8, phase_select(wv, SC, MASK, lds)); }
            SEAM();
            if (PM(9) && IN(ph)) { phase_attn(wv, Qh, Kh, Vh, HU, SG, MASK, (char*)lds_raw); REDO(9, phase_attn(wv, Qh, Kh, Vh, HU, SG, MASK, (char*)lds_raw)); }
            SEAM();
            if (PM(5) && IN(ph)) { pg8::Gemm g{HU, (const bf16_t*)(ws + WS_WAO) + (size_t)j * DM * DM, SEQ, DM, DM, DM, DM, 0, 0};
                pg8::StaticOrder S; S.init(SEQ, DM, G, bx); pg8::EpiResid E{xin, args.out, lmod + 2 * DM};
                pg8::gemm_phase<pg8::EpiResid, true>(wv, lds, g, S, E);
                if (DUP(5)) { pg8::EpiResid E2{xin, (float*)(ws + WS_SC), lmod + 2 * DM}; REDO(5, (pg8::gemm_phase<pg8::EpiResid, true>(wv, lds, g, S, E2))); } }
            SEAM();
        }
    }
    if (PM(10) && IN(ph)) { REDO(10, phase_final(wv, args.out, (float*)(ws + WS_L), args.fg)); phase_final(wv, args.out, args.out, args.fg); }
#undef IN
#undef PM
#undef SEAM
#undef REDO
}
constexpr int N_PHASES = 1 + 2 * 5 + 2 * 6 + 1;

extern "C" void kernel_launch(void* const* d_in, const int* in_sizes, int n_in, void* d_out, int out_size, void* d_ws, size_t ws_size, hipStream_t stream) {
    static int grid = 0;
    if (grid == 0) {
        if (n_in != 13 || in_sizes[0] != SEQ * DM || out_size != SEQ * DM || ws_size < WS_END) {
            fprintf(stderr, "kernel_launch: unexpected shapes / workspace (n_in %d, in0 %d, out %d, ws %zu, need %zu)\n", n_in, n_in > 0 ? in_sizes[0] : -1, out_size, ws_size, (size_t)WS_END);
            grid = -1; return; }
        int dev = 0, cus = 0, per_cu = 0;
        if (hipGetDevice(&dev) != hipSuccess || hipDeviceGetAttribute(&cus, hipDeviceAttributeMultiprocessorCount, dev) != hipSuccess) { grid = -1; return; }
        if (hipFuncSetAttribute((const void*)trunk_fwd, hipFuncAttributeMaxDynamicSharedMemorySize, LDS_BYTES) != hipSuccess) { fprintf(stderr, "kernel_launch: hipFuncSetAttribute failed\n"); grid = -1; return; }
        if (hipOccupancyMaxActiveBlocksPerMultiprocessor(&per_cu, (const void*)trunk_fwd, NTHR, LDS_BYTES) != hipSuccess || per_cu < 1) {
            fprintf(stderr, "kernel_launch: occupancy query reports %d workgroups per CU\n", per_cu); per_cu = 1; }
        (void)hipGetLastError();
        grid = cus;
        if (grid > 256) grid = 256;
    }
    if (grid < 0) return;
    (void)hipMemsetAsync((char*)d_ws + WS_CTL, 0, CTL_ZERO_BYTES, stream);
    Args a{};
    a.x = (const float*)d_in[0]; a.c = (const float*)d_in[1]; a.pos = (const int*)d_in[2]; a.norm_g = (const float*)d_in[3];
    a.mod_w = (const float*)d_in[4]; a.mod_b = (const float*)d_in[5]; a.pwi = (const float*)d_in[6]; a.pwg = (const float*)d_in[7];
    a.pls = (const float*)d_in[8]; a.pwo = (const float*)d_in[9]; a.awi = (const float*)d_in[10]; a.awo = (const float*)d_in[11]; a.fg = (const float*)d_in[12];
    a.out = (float*)d_out; a.ws = (unsigned char*)d_ws;
    for (int i = 0; i < 16; ++i) a.invf_q[i] = powf(500000.0f, -(float)i * 2.0f / 32.0f);
    for (int i = 0; i < 8; ++i) a.invf_i[i] = powf(500000.0f, -(float)i * 2.0f / 16.0f);
#if MK_ONE_LAUNCH
    a.ph_lo = 0; a.ph_hi = N_PHASES;
    hipLaunchKernelGGL(trunk_fwd, dim3(grid), dim3(NTHR), LDS_BYTES, stream, a);
#else
    for (int p = 0; p < N_PHASES; ++p) { a.ph_lo = p; a.ph_hi = p + 1; hipLaunchKernelGGL(trunk_fwd, dim3(grid), dim3(NTHR), LDS_BYTES, stream, a); }
#endif
}
```

```cpp
#include <hip/hip_runtime.h>
#include <cstdio>
#include <cstdint>
#include <cmath>

#ifndef MK_ONE_LAUNCH
#define MK_ONE_LAUNCH 1
#endif

#define LAS __attribute__((address_space(3)))
#define GAS __attribute__((address_space(1)))
typedef unsigned short bf16_t;
typedef short bf16x8 __attribute__((ext_vector_type(8)));
typedef short s16x4 __attribute__((ext_vector_type(4)));
typedef float f32x4 __attribute__((ext_vector_type(4)));
typedef float f32x2 __attribute__((ext_vector_type(2)));
typedef float f32x16 __attribute__((ext_vector_type(16)));
typedef unsigned u32x4 __attribute__((ext_vector_type(4)));
typedef unsigned u32x2 __attribute__((ext_vector_type(2)));

constexpr int DM = 2048, SEQ = 8192, NHEAD = 16, HD = 128, IDXH = 16, IDXD = 64;
constexpr int POOL_IN = 4096, ATTN_IN = 9296, ATTN_INP = 9472  ;
constexpr int TOPK = 256;
constexpr float EPS = 1e-6f;

constexpr size_t MiB = 1u << 20;
constexpr size_t WS_CTL = 0, CTL_ZERO_BYTES = 64 * 1024;
constexpr size_t WS_MOD = 1 * MiB;
constexpr size_t WS_TAB = 2 * MiB;
constexpr size_t WS_WPI = 4 * MiB;
constexpr size_t WS_WPG = 36 * MiB;
constexpr size_t WS_WPO = 40 * MiB;
constexpr size_t WS_WAI = 56 * MiB;
constexpr size_t WS_WAO = 130 * MiB;
constexpr size_t WS_HU = 146 * MiB;
constexpr size_t WS_L = 178 * MiB;
constexpr size_t WS_VG = WS_L;
constexpr size_t WS_PL = WS_L + 64 * MiB;
constexpr size_t WS_Q = WS_L, WS_K = WS_L + 32 * MiB, WS_V = WS_L + 64 * MiB;
constexpr size_t WS_GATE = WS_L + 96 * MiB;
constexpr size_t WS_QI = WS_L + 128 * MiB;
constexpr size_t WS_KI = WS_L + 144 * MiB;
constexpr size_t WS_WI = WS_L + 145 * MiB;
constexpr size_t WS_MASK = WS_L + 146 * MiB;
constexpr size_t WS_SC = WS_L + 154 * MiB;
constexpr size_t WS_XB = WS_SC + 139 * MiB;
constexpr size_t WS_END = WS_XB + 32 * MiB;

__device__ __forceinline__ unsigned cvt_pk_bf16(float lo, float hi) { unsigned r; asm volatile("v_cvt_pk_bf16_f32 %0, %1, %2" : "=v"(r) : "v"(lo), "v"(hi)); return r; }
__device__ __forceinline__ unsigned f2bf(float f) { unsigned u = __builtin_bit_cast(unsigned, f); return (u + 0x7fffu + ((u >> 16) & 1u)) >> 16; }
__device__ __forceinline__ unsigned pk2(float lo, float hi) { return f2bf(lo) | (f2bf(hi) << 16); }
__device__ __forceinline__ float bf2f(unsigned short b) { return __builtin_bit_cast(float, (unsigned)b << 16); }
__device__ __forceinline__ float fast_sigmoid(float x) { return __builtin_amdgcn_rcpf(1.0f + __builtin_amdgcn_exp2f(-1.4426950408889634f * x)); }
__device__ __forceinline__ float silu_f(float x) { return x * fast_sigmoid(x); }
template <int X> __device__ __forceinline__ float swz_xor(float v) {
    return __builtin_bit_cast(float, __builtin_amdgcn_ds_swizzle(__builtin_bit_cast(int, v), (X << 10) | 0x1f)); }
__device__ __forceinline__ float wave_sum(float v) {
    v += swz_xor<1>(v); v += swz_xor<2>(v); v += swz_xor<4>(v); v += swz_xor<8>(v); v += swz_xor<16>(v);
    const auto rr = __builtin_amdgcn_permlane32_swap(__builtin_bit_cast(unsigned, v), __builtin_bit_cast(unsigned, v), false, false);
    const unsigned r0 = rr[0], r1 = rr[1];
    return __builtin_bit_cast(float, r0) + __builtin_bit_cast(float, r1);
}
__device__ __forceinline__ int opaque_tid(int wv) { int t; asm volatile("v_mbcnt_lo_u32_b32 %0, -1, 0\n\tv_mbcnt_hi_u32_b32 %0, -1, %0\n\tv_lshl_add_u32 %0, %1, 6, %0" : "=&v"(t) : "s"(wv)); return t; }
#define LDS_WAIT() asm volatile("s_waitcnt lgkmcnt(0)" ::: "memory")
#define VM_WAIT() asm volatile("s_waitcnt vmcnt(0)" ::: "memory")

__device__ __forceinline__ void unpack8(const u32x4 w, f32x4& a, f32x4& b) {
    const unsigned w0 = w.x, w1 = w.y, w2 = w.z, w3 = w.w;
    a = (f32x4){__builtin_bit_cast(float, w0 << 16), __builtin_bit_cast(float, w0 & 0xffff0000u), __builtin_bit_cast(float, w1 << 16), __builtin_bit_cast(float, w1 & 0xffff0000u)};
    b = (f32x4){__builtin_bit_cast(float, w2 << 16), __builtin_bit_cast(float, w2 & 0xffff0000u), __builtin_bit_cast(float, w3 << 16), __builtin_bit_cast(float, w3 & 0xffff0000u)};
}
__device__ __forceinline__ u32x4 pack8(const f32x4 a, const f32x4 b) { u32x4 w; w.x = cvt_pk_bf16(a[0], a[1]); w.y = cvt_pk_bf16(a[2], a[3]); w.z = cvt_pk_bf16(b[0], b[1]); w.w = cvt_pk_bf16(b[2], b[3]); return w; }

namespace pg8 {
constexpr int BM = 256, BK = 64, HALF = 128, HTB = HALF * BK * 2, STAGE_BYTES = 8 * HTB, NXCD = 8, WGM = 8;
__host__ __device__ __forceinline__ int lds_byte(int r, int c) { const int st = (r >> 4) * 2 + (c >> 5), rr = r & 15, cc = c & 31, ob = rr * 64 + cc * 2; return st * 1024 + (ob ^ (((ob >> 9) & 1) << 5)); }
__host__ __device__ __forceinline__ void stage_rc(int b, int& R, int& C) { const int st = b / 1024, sb = b % 1024, swz = sb ^ (((sb >> 9) & 1) << 5); R = (st >> 1) * 16 + swz / 64; C = (st & 1) * 32 + (swz % 64) / 2; }
__host__ __device__ __forceinline__ int perm32(int rho) { const int n = rho >> 4, i = rho & 15; return 8 * (i >> 2) + 4 * n + (i & 3); }

struct Unit { int pm, pn; };
struct Gemm { const bf16_t* A; const bf16_t* Bt; int M, N, K, lda, ldb, agsh, agstride; };

struct StaticOrder {
    int nM, nN, nwg, G, c;
    __host__ __device__ void init(int M, int N, int G_, int c_) { nM = M / BM; nN = N / BM; nwg = nM * nN; G = G_; c = c_; }
    __host__ __device__ bool next(int i, Unit& u) const {
        const long L = (long)i * G + c; if (L >= nwg) return false;
        int wgid = (int)L; { const int q = nwg / NXCD, r = nwg % NXCD, xcd = wgid % NXCD, off = wgid / NXCD; wgid = (xcd < r ? xcd * (q + 1) : r * (q + 1) + (xcd - r) * q) + off; }
        const int nig = WGM * nN, gid = wgid / nig, fm = gid * WGM, gsz = (nM - fm) < WGM ? (nM - fm) : WGM;
        u.pm = fm + ((wgid % nig) % gsz); u.pn = (wgid % nig) / gsz; return true;
    }
};

template <class Epi, bool ALIGN_EPI>
__device__ __forceinline__ void gemm_phase(int wv, LAS unsigned char* lds, const Gemm g, const StaticOrder& S, const Epi& E) {
    const int tid = opaque_tid(wv), wid = __builtin_amdgcn_readfirstlane(tid >> 6), lane = tid & 63, wr = wid >> 2, wc = wid & 3, fr = lane & 15, fq = lane >> 4;
    const int K = g.K, nt = K / BK;
    unsigned voffA[2], voffB[2];
#pragma unroll
    for (int i = 0; i < 2; ++i) { int R, C; stage_rc(tid * 16 + i * 8192, R, C); const int Rb = Epi::PERM ? ((R & ~31) + perm32(R & 31)) : R;
        voffA[i] = (unsigned)(R * g.lda + C) * 2u; voffB[i] = (unsigned)(Rb * g.ldb + C) * 2u; }
    const size_t kstep = (size_t)(BK * 2);
    const size_t hstepA = (size_t)HALF * g.lda * 2, hstepB = (size_t)HALF * g.ldb * 2;
    const size_t tstepA = 2 * hstepA, tstepB = 2 * hstepB;
    const unsigned ldsw = (unsigned)wid * 1024u;
    const int aoff = lds_byte(wr * 64 + fr, fq * 8), boff = lds_byte(wc * 32 + fr, fq * 8);
#define PG8_SA(b, h) (((b) * 2 + (h)) * HTB)
#define PG8_SB(b, h) ((4 + (b) * 2 + (h)) * HTB)
#define PG8_STAGE(bufoff, gbase, voff) do { _Pragma("unroll") for (int _i = 0; _i < 2; ++_i) \
        __builtin_amdgcn_global_load_lds((const unsigned*)((const char*)(gbase) + (voff)[_i]), (LAS unsigned*)(lds + (bufoff) + ldsw + _i * 8192), 16, 0, 0); } while (0)
#define PG8_LDA(dst, b, h) do { _Pragma("unroll") for (int m = 0; m < 4; ++m) _Pragma("unroll") for (int k = 0; k < 2; ++k) dst[m][k] = *(const LAS bf16x8*)(lds + PG8_SA(b, h) + aoff + m * 2048 + k * 1024); } while (0)
#define PG8_LDB(dst, b, h) do { _Pragma("unroll") for (int n = 0; n < 2; ++n) _Pragma("unroll") for (int k = 0; k < 2; ++k) dst[n][k] = *(const LAS bf16x8*)(lds + PG8_SB(b, h) + boff + n * 2048 + k * 1024); } while (0)
#define PG8_MMA(ai, bj, At, Bt) do { __builtin_amdgcn_s_setprio(1); _Pragma("unroll") for (int m = 0; m < 4; ++m) _Pragma("unroll") for (int n = 0; n < 2; ++n) _Pragma("unroll") for (int k = 0; k < 2; ++k) \
        acc[ai][bj][m][n] = __builtin_amdgcn_mfma_f32_16x16x32_bf16(Bt[n][k], At[m][k], acc[ai][bj][m][n], 0, 0, 0); __builtin_amdgcn_s_setprio(0); } while (0)
#define PG8_WAIT_V(n) asm volatile("s_waitcnt vmcnt(" #n ")" ::: "memory")
#define PG8_WAIT_L(n) asm volatile("s_waitcnt lgkmcnt(" #n ")" ::: "memory")
#define PG8_BAR __builtin_amdgcn_s_barrier()
#define PG8_SCHED __builtin_amdgcn_sched_barrier(0)
#define PG8_AOFF(u) ((size_t)(u).pm * tstepA + (size_t)(((u).pn >> g.agsh) * g.agstride) * 2)
    Unit cur, nxt; int ui = 0;
    if (!S.next(0, cur)) return;
    f32x4 acc[2][2][4][2];
#pragma unroll
    for (int a = 0; a < 2; ++a)
#pragma unroll
        for (int b = 0; b < 2; ++b)
#pragma unroll
            for (int m = 0; m < 4; ++m)
#pragma unroll
                for (int n = 0; n < 2; ++n) acc[a][b][m][n] = (f32x4){0.f, 0.f, 0.f, 0.f};
    bf16x8 At[4][2], B0[2][2], B1[2][2];
    const char* cA = (const char*)g.A + PG8_AOFF(cur); const char* cB = (const char*)g.Bt + (size_t)cur.pn * tstepB;
    PG8_STAGE(PG8_SB(0, 0), cB, voffB); PG8_STAGE(PG8_SB(0, 1), cB + hstepB, voffB); PG8_STAGE(PG8_SA(0, 0), cA, voffA); PG8_STAGE(PG8_SA(0, 1), cA + hstepA, voffA);
    if (wr == 1) PG8_BAR;
    PG8_WAIT_V(2); PG8_BAR;
    PG8_STAGE(PG8_SB(1, 0), cB + kstep, voffB); PG8_STAGE(PG8_SA(1, 0), cA + kstep, voffA); PG8_STAGE(PG8_SB(1, 1), cB + hstepB + kstep, voffB);
    PG8_WAIT_V(6); PG8_BAR;
    for (;;) {
        const bool has_next = S.next(ui + 1, nxt);
        const char* nA = has_next ? (const char*)g.A + PG8_AOFF(nxt) : cA; const char* nB = has_next ? (const char*)g.Bt + (size_t)nxt.pn * tstepB : cB;
        for (int t = 0; t < nt; t += 2) {
            const bool last = (t == nt - 2);
            const char* a1 = cA + (size_t)(t + 1) * kstep;
            const char* a2 = last ? nA : cA + (size_t)(t + 2) * kstep; const char* b2 = last ? nB : cB + (size_t)(t + 2) * kstep;
            const char* a3 = a2 + kstep; const char* b3 = b2 + kstep;
            PG8_LDB(B0, 0, 0); PG8_LDB(B1, 0, 1); PG8_SCHED; PG8_LDA(At, 0, 0); PG8_STAGE(PG8_SA(1, 1), a1 + hstepA, voffA);
            PG8_WAIT_V(8); PG8_WAIT_L(0); PG8_BAR; PG8_MMA(0, 0, At, B0); PG8_MMA(0, 1, At, B1); PG8_BAR; PG8_SCHED;
            PG8_LDA(At, 0, 1); PG8_STAGE(PG8_SB(0, 0), b2, voffB); PG8_STAGE(PG8_SB(0, 1), b2 + hstepB, voffB); PG8_STAGE(PG8_SA(0, 0), a2, voffA);
            PG8_WAIT_V(8); PG8_WAIT_L(0); PG8_BAR; PG8_MMA(1, 0, At, B0); PG8_MMA(1, 1, At, B1); PG8_BAR; PG8_SCHED;
            PG8_LDB(B0, 1, 0); PG8_LDB(B1, 1, 1); PG8_SCHED; PG8_LDA(At, 1, 0); PG8_STAGE(PG8_SA(0, 1), a2 + hstepA, voffA);
            PG8_WAIT_V(8); PG8_WAIT_L(0); PG8_BAR; PG8_MMA(0, 0, At, B0); PG8_MMA(0, 1, At, B1); PG8_BAR; PG8_SCHED;
            PG8_LDA(At, 1, 1); PG8_STAGE(PG8_SB(1, 0), b3, voffB); PG8_STAGE(PG8_SB(1, 1), b3 + hstepB, voffB); PG8_STAGE(PG8_SA(1, 0), a3, voffA);
            PG8_WAIT_V(8); PG8_WAIT_L(0); PG8_BAR; PG8_MMA(1, 0, At, B0); PG8_MMA(1, 1, At, B1); PG8_BAR; PG8_SCHED;
        }
        if constexpr (ALIGN_EPI) { if (wr == 0) PG8_BAR; }
        E(acc, cur, wr, wc, fr, fq);
        if (!has_next) break;
#pragma unroll
        for (int a = 0; a < 2; ++a)
#pragma unroll
            for (int b = 0; b < 2; ++b)
#pragma unroll
                for (int m = 0; m < 4; ++m)
#pragma unroll
                    for (int n = 0; n < 2; ++n) acc[a][b][m][n] = (f32x4){0.f, 0.f, 0.f, 0.f};
        cur = nxt; cA = nA; cB = nB; ++ui;
        if constexpr (ALIGN_EPI) { if (wr == 1) PG8_BAR; }
    }
    PG8_WAIT_V(0);
    if constexpr (!ALIGN_EPI) { if (wr == 0) PG8_BAR; }
    PG8_BAR;
#undef PG8_SA
#undef PG8_SB
#undef PG8_STAGE
#undef PG8_LDA
#undef PG8_LDB
#undef PG8_MMA
#undef PG8_WAIT_V
#undef PG8_WAIT_L
#undef PG8_BAR
#undef PG8_SCHED
#undef PG8_AOFF
}

struct EpiBf16 {
    static constexpr bool PERM = true;
    bf16_t* O; int ldc;
    __device__ __forceinline__ void operator()(const f32x4 (&acc)[2][2][4][2], const Unit& u, int wr, int wc, int fr, int fq) const {
        const int row0 = u.pm * BM + wr * 64 + fr; const int col0 = u.pn * BM + wc * 32 + 8 * fq;
#pragma unroll
        for (int ai = 0; ai < 2; ++ai)
#pragma unroll
            for (int m = 0; m < 4; ++m) { bf16_t* rowp = O + (size_t)(row0 + ai * HALF + m * 16) * ldc + col0;
#pragma unroll
                for (int bj = 0; bj < 2; ++bj) { const f32x4 v0 = acc[ai][bj][m][0], v1 = acc[ai][bj][m][1];
                    u32x4 w; w.x = cvt_pk_bf16(v0[0], v0[1]); w.y = cvt_pk_bf16(v0[2], v0[3]); w.z = cvt_pk_bf16(v1[0], v1[1]); w.w = cvt_pk_bf16(v1[2], v1[3]);
                    *(u32x4*)(rowp + bj * HALF) = w; } }
    }
};
struct EpiPoolGrp {
    static constexpr bool PERM = true;
    bf16_t* U; const bf16_t* VG; const float* ls;
    __device__ __forceinline__ void operator()(const f32x4 (&acc)[2][2][4][2], const Unit& u, int wr, int wc, int fr, int fq) const {
        const int row0 = u.pm * BM + wr * 64 + fr; const int col0 = u.pn * BM + wc * 32 + 8 * fq;
        f32x4 lv[2][2];
#pragma unroll
        for (int bj = 0; bj < 2; ++bj)
#pragma unroll
            for (int n = 0; n < 2; ++n) lv[bj][n] = *(const f32x4*)(ls + col0 + bj * HALF + 4 * n);
#pragma unroll
        for (int ai = 0; ai < 2; ++ai)
#pragma unroll
            for (int m = 0; m < 4; ++m) { const size_t row = (size_t)(row0 + ai * HALF + m * 16);
#pragma unroll
                for (int bj = 0; bj < 2; ++bj) {
                    const u32x4 gw = *(const u32x4*)(VG + row * POOL_IN + DM + col0 + bj * HALF);
                    f32x4 v0 = acc[ai][bj][m][0] * lv[bj][0], v1 = acc[ai][bj][m][1] * lv[bj][1];
                    float g[8];
#pragma unroll
                    for (int e = 0; e < 4; ++e) { g[2 * e] = __builtin_bit_cast(float, gw[e] << 16); g[2 * e + 1] = __builtin_bit_cast(float, gw[e] & 0xffff0000u); }
#pragma unroll
                    for (int e = 0; e < 4; ++e) { v0[e] *= silu_f(g[e]); v1[e] *= silu_f(g[4 + e]); }
                    u32x4 w; w.x = cvt_pk_bf16(v0[0], v0[1]); w.y = cvt_pk_bf16(v0[2], v0[3]); w.z = cvt_pk_bf16(v1[0], v1[1]); w.w = cvt_pk_bf16(v1[2], v1[3]);
                    *(u32x4*)(U + row * DM + col0 + bj * HALF) = w; } }
    }
};
template <bool IN_BF16, bool OUT_BF16> struct EpiResid {
    static constexpr bool PERM = true;
    const void* xin; void* xout; const float* gmod;
    __device__ __forceinline__ void operator()(const f32x4 (&acc)[2][2][4][2], const Unit& u, int wr, int wc, int fr, int fq) const {
        const int row0 = u.pm * BM + wr * 64 + fr; const int col0 = u.pn * BM + wc * 32 + 8 * fq;
        f32x4 gv[2][2];
#pragma unroll
        for (int bj = 0; bj < 2; ++bj)
#pragma unroll
            for (int n = 0; n < 2; ++n) { const float* gp = gmod + col0 + bj * HALF + 4 * n;
                gv[bj][n] = ((*(const f32x4*)gp + *(const f32x4*)(gp + 6144)) + *(const f32x4*)(gp + 2 * 6144)) + *(const f32x4*)(gp + 3 * 6144); }
#pragma unroll
        for (int ai = 0; ai < 2; ++ai)
#pragma unroll
            for (int m = 0; m < 4; ++m) { const size_t off = (size_t)(row0 + ai * HALF + m * 16) * DM + col0;
#pragma unroll
                for (int bj = 0; bj < 2; ++bj) {
                    f32x4 b0, b1;
                    if (IN_BF16) { const u32x4 w = *(const u32x4*)((const bf16_t*)xin + off + bj * HALF);
                        const unsigned w0 = w.x, w1 = w.y, w2 = w.z, w3 = w.w;
                        b0 = (f32x4){__builtin_bit_cast(float, w0 << 16), __builtin_bit_cast(float, w0 & 0xffff0000u), __builtin_bit_cast(float, w1 << 16), __builtin_bit_cast(float, w1 & 0xffff0000u)};
                        b1 = (f32x4){__builtin_bit_cast(float, w2 << 16), __builtin_bit_cast(float, w2 & 0xffff0000u), __builtin_bit_cast(float, w3 << 16), __builtin_bit_cast(float, w3 & 0xffff0000u)}; }
                    else { b0 = *(const f32x4*)((const float*)xin + off + bj * HALF); b1 = *(const f32x4*)((const float*)xin + off + bj * HALF + 4); }
                    const f32x4 y0 = b0 + gv[bj][0] * acc[ai][bj][m][0], y1 = b1 + gv[bj][1] * acc[ai][bj][m][1];
                    if (OUT_BF16) { u32x4 w; w.x = cvt_pk_bf16(y0[0], y0[1]); w.y = cvt_pk_bf16(y0[2], y0[3]); w.z = cvt_pk_bf16(y1[0], y1[1]); w.w = cvt_pk_bf16(y1[2], y1[3]);
                        *(u32x4*)((bf16_t*)xout + off + bj * HALF) = w; }
                    else { *(f32x4*)((float*)xout + off + bj * HALF) = y0; *(f32x4*)((float*)xout + off + bj * HALF + 4) = y1; } } }
    }
};
struct EpiAttnIn {
    static constexpr bool PERM = true;
    unsigned char* ws; const int* pos;
    __device__ __forceinline__ void operator()(const f32x4 (&acc)[2][2][4][2], const Unit& u, int wr, int wc, int fr, int fq) const {
        const int row0 = u.pm * BM + wr * 64 + fr; const int pn = u.pn;
        bf16_t* const Qh = (bf16_t*)(ws + WS_Q); bf16_t* const SG = (bf16_t*)(ws + WS_GATE); bf16_t* const QI = (bf16_t*)(ws + WS_QI); bf16_t* const KI = (bf16_t*)(ws + WS_KI); float* const WI = (float*)(ws + WS_WI);
        const float* const cosq = (const float*)(ws + WS_TAB); const float* const sinq = cosq + SEQ * 16; const float* const cosi = sinq + SEQ * 16; const float* const sini = cosi + SEQ * 8;
#pragma unroll
        for (int ai = 0; ai < 2; ++ai)
#pragma unroll
            for (int m = 0; m < 4; ++m) {
                const int row = row0 + ai * HALF + m * 16;
                if (pn < 24) {
                    bf16_t* base = Qh + (size_t)(pn >> 3) * ((size_t)SEQ * DM);
                    const bool rope = (pn < 16) && (wc == 0);
                    f32x4 cs[2] = {{1.f, 1.f, 1.f, 1.f}, {1.f, 1.f, 1.f, 1.f}}, sn[2] = {{0.f, 0.f, 0.f, 0.f}, {0.f, 0.f, 0.f, 0.f}};
                    if (rope) { const int p = pos[row]; const float* cp = cosq + (size_t)p * 16 + 8 * (fq & 1); const float* sp = sinq + (size_t)p * 16 + 8 * (fq & 1);
                        cs[0] = *(const f32x4*)cp; cs[1] = *(const f32x4*)(cp + 4); sn[0] = *(const f32x4*)sp; sn[1] = *(const f32x4*)(sp + 4); }
#pragma unroll
                    for (int bj = 0; bj < 2; ++bj) { const int head = 2 * (pn & 7) + bj;
                        f32x4 v[2] = {acc[ai][bj][m][0], acc[ai][bj][m][1]};
                        if (rope) {
#pragma unroll
                            for (int n = 0; n < 2; ++n) { f32x4 pr;
#pragma unroll
                                for (int e = 0; e < 4; ++e) { const float ve = v[n][e];
                                    const auto rr = __builtin_amdgcn_permlane32_swap(__builtin_bit_cast(unsigned, ve), __builtin_bit_cast(unsigned, ve), false, false);
                                    const unsigned pu = (fq < 2) ? rr[1] : rr[0]; pr[e] = __builtin_bit_cast(float, pu); }
                                v[n] = (fq < 2) ? (v[n] * cs[n] - pr * sn[n]) : (v[n] * cs[n] + pr * sn[n]); } }
                        *(u32x4*)(base + ((size_t)head * SEQ + row) * HD + 32 * wc + 8 * fq) = pack8(v[0], v[1]); }
                } else if (pn < 32) {
#pragma unroll
                    for (int bj = 0; bj < 2; ++bj) { f32x4 v0 = acc[ai][bj][m][0], v1 = acc[ai][bj][m][1];
#pragma unroll
                        for (int e = 0; e < 4; ++e) { v0[e] = silu_f(v0[e]); v1[e] = silu_f(v1[e]); }
                        *(u32x4*)(SG + (size_t)row * DM + (pn - 24) * BM + bj * HALF + 32 * wc + 8 * fq) = pack8(v0, v1); }
                } else {
                    const bool isq = pn < 36;
                    const bool rope = ((wc & 1) == 0) && (isq || wc == 0);
                    f32x4 cs[2], sn[2];
                    { const int p = pos[row]; const float* cp = cosi + (size_t)p * 8; const float* sp = sini + (size_t)p * 8;
                      cs[0] = *(const f32x4*)cp; cs[1] = *(const f32x4*)(cp + 4); sn[0] = *(const f32x4*)sp; sn[1] = *(const f32x4*)(sp + 4); }
#pragma unroll
                    for (int bj = 0; bj < 2; ++bj) {
                        if (!isq && bj == 1) continue;
                        f32x4 v[2] = {acc[ai][bj][m][0], acc[ai][bj][m][1]};
                        if (rope) {
#pragma unroll
                            for (int n = 0; n < 2; ++n) { f32x4 pr;
#pragma unroll
                                for (int e = 0; e < 4; ++e) pr[e] = swz_xor<16>(v[n][e]);
                                const f32x4 ro = (fq == 0) ? (v[n] * cs[n] - pr * sn[n]) : (v[n] * cs[n] + pr * sn[n]);
                                v[n] = (fq < 2) ? ro : v[n]; } }
                        const int cl = bj * HALF + 32 * wc + 8 * fq;
                        if (isq) *(u32x4*)(QI + (size_t)row * 1024 + (pn - 32) * BM + cl) = pack8(v[0], v[1]);
                        else if (cl < 64) *(u32x4*)(KI + (size_t)row * 64 + cl) = pack8(v[0], v[1]);
                        else if (cl < 80) { *(f32x4*)(WI + (size_t)row * 16 + (cl - 64)) = v[0]; *(f32x4*)(WI + (size_t)row * 16 + (cl - 64) + 4) = v[1]; }
                    }
                }
                asm volatile("" ::: "memory");
            }
    }
};
}

namespace att {
constexpr int D = 128, NW = 8, QBLK = 32, KVBLK = 64, QB = NW * QBLK;
constexpr int KROWB = 272;
constexpr int SHM_V = KVBLK * D * 2, SHM_K = KVBLK * KROWB;
constexpr int QROWB = 272;
constexpr int Q_OFF = 2 * SHM_V + 2 * SHM_K + NW * 64 * 4;
constexpr int LDS_BYTES = Q_OFF + QB * QROWB;
constexpr float SCALE = 0.08838834764831845f;
constexpr float THR = 8.f;
#define KSWZ(row, colB) ((row) * KROWB + (colB))
#define SBAR() __builtin_amdgcn_sched_barrier(0)
__device__ __forceinline__ int v_st(int k, int c) { const int kk = (k & ~0xC) | ((k & 4) << 1) | ((k & 8) >> 1); return ((kk >> 3) * 4 + (c >> 5)) * 512 + ((kk & 7) * 32 + (c & 31)) * 2; }
__device__ __forceinline__ int v_rd_base(int lane) { return ((lane & 3) << 3) | (((lane >> 2) & 3) << 6) | (((lane >> 4) & 1) << 5) | (((lane >> 5) & 1) << 8); }
constexpr int v_rd_off(int d0, int ks, int half) { return d0 * 512 + ks * 4096 + half * 2048; }
__device__ __forceinline__ int crow(int r, int hi) { return (r & 3) + 8 * (r >> 2) + 4 * hi; }
__device__ __forceinline__ unsigned cvtpk(float lo, float hi) { unsigned r; asm volatile("v_cvt_pk_bf16_f32 %0, %1, %2" : "=v"(r) : "v"(lo), "v"(hi)); return r; }
__device__ __forceinline__ bf16x8 load8(const bf16_t* p) { return *reinterpret_cast<const bf16x8*>(p); }
__device__ __forceinline__ float mask_and(float v, unsigned mlo, unsigned mhi, int r, int p) {
    const int pos = 16 * (r & 1) + 2 * (r >> 2) + 8 * p;
    const unsigned w = (r & 2) ? mhi : mlo;
    const int bits = __builtin_amdgcn_sbfe((int)w, pos, 1);
    return __builtin_bit_cast(float, __builtin_bit_cast(unsigned, v) & (unsigned)bits);
}
__device__ __forceinline__ void partialSM(f32x16& p0, f32x16& p1, float& m_reg, float& mn, float& alpha, unsigned mlo, unsigned mhi) {
    float pmax = p0[0];
#pragma unroll
    for (int r = 1; r < 16; ++r) pmax = fmaxf(pmax, p0[r]);
#pragma unroll
    for (int r = 0; r < 16; ++r) pmax = fmaxf(pmax, p1[r]);
    { auto rr = __builtin_amdgcn_permlane32_swap(__float_as_uint(pmax), __float_as_uint(pmax), false, false);
      pmax = fmaxf(__uint_as_float(rr[0]), __uint_as_float(rr[1])); }
    constexpr float C2 = 1.4426950408889634f * SCALE;
    if (__builtin_expect(__all((pmax - m_reg) * SCALE <= THR), 1)) { mn = m_reg; alpha = 1.f; }
    else { mn = fmaxf(m_reg, pmax); alpha = __builtin_amdgcn_exp2f((m_reg - mn) * C2); m_reg = mn; }
    const float mnL = -mn * C2;
#pragma unroll
    for (int r = 0; r < 16; ++r) p0[r] = fmaf(p0[r], C2, mnL);
#pragma unroll
    for (int r = 0; r < 16; ++r) p1[r] = fmaf(p1[r], C2, mnL);
#pragma unroll
    for (int r = 0; r < 16; ++r) p0[r] = mask_and(__builtin_amdgcn_exp2f(p0[r]), mlo, mhi, r, 0);
}
__device__ __forceinline__ void finishSM(f32x16& p0, f32x16& p1, float alpha, float& l_reg, bf16x8& pa0, bf16x8& pa1, bf16x8& pa2, bf16x8& pa3, unsigned mlo, unsigned mhi) {
#pragma unroll
    for (int r = 0; r < 16; ++r) p1[r] = mask_and(__builtin_amdgcn_exp2f(p1[r]), mlo, mhi, r, 1);
    float ps = 0;
#pragma unroll
    for (int r = 0; r < 16; ++r) ps += p0[r];
#pragma unroll
    for (int r = 0; r < 16; ++r) ps += p1[r];
    { auto rr = __builtin_amdgcn_permlane32_swap(__float_as_uint(ps), __float_as_uint(ps), false, false);
      ps = __uint_as_float(rr[0]) + __uint_as_float(rr[1]); }
    l_reg = l_reg * alpha + ps;
#define PK4(P, B_, OUT) do { unsigned a0 = cvtpk(P[B_+0], P[B_+1]), a1 = cvtpk(P[B_+2], P[B_+3]);                          \
        unsigned b0 = cvtpk(P[B_+4], P[B_+5]), b1 = cvtpk(P[B_+6], P[B_+7]);                                             \
        auto r0 = __builtin_amdgcn_permlane32_swap(a0, b0, false, false); auto r1 = __builtin_amdgcn_permlane32_swap(a1, b1, false, false); \
        u32x4 w = {r0[0], r1[0], r0[1], r1[1]}; OUT = *reinterpret_cast<bf16x8*>(&w); } while (0)
    PK4(p0, 0, pa0); PK4(p0, 8, pa1); PK4(p1, 0, pa2); PK4(p1, 8, pa3);
#undef PK4
}
template <int KB>
__device__ __forceinline__ void qkt(f32x16& p0, f32x16& p1, const char* K_lds, int r32, int hi, const char* qa  ) {
    p0 = f32x16{}; p1 = f32x16{};
    const char* kb = K_lds + KB * SHM_K + r32 * KROWB + hi * 16;
#pragma unroll
    for (int d0 = 0; d0 < 8; ++d0) { const char* a = kb + d0 * 32;
        bf16x8 b0 = *reinterpret_cast<const bf16x8*>(a);
        bf16x8 b1 = *reinterpret_cast<const bf16x8*>(a + 32 * KROWB);
        const bf16x8 qf = *reinterpret_cast<const bf16x8*>(qa + d0 * 32);
        p0 = __builtin_amdgcn_mfma_f32_32x32x16_bf16(b0, qf, p0, 0, 0, 0);
        p1 = __builtin_amdgcn_mfma_f32_32x32x16_bf16(b1, qf, p1, 0, 0, 0); }
}
template <int VB>
__device__ __forceinline__ void pv_tile(f32x16* o, int vb0, bf16x8 pa0, bf16x8 pa1, bf16x8 pa2, bf16x8 pa3) {
#define TRRD(dst, off) asm volatile("ds_read_b64_tr_b16 %0, %1 offset:%2" : "=&v"(dst) : "v"(vb0), "i"(off) : "memory")
#define PV_D0(d0) do { s16x4 l0, l1, l2, l3, h0, h1, h2, h3; constexpr int b_ = VB * SHM_V + v_rd_off(d0, 0, 0); \
        TRRD(l0, b_); TRRD(h0, b_ + 2048); TRRD(l1, b_ + 4096); TRRD(h1, b_ + 6144); TRRD(l2, b_ + 8192); TRRD(h2, b_ + 10240); TRRD(l3, b_ + 12288); TRRD(h3, b_ + 14336); \
        asm volatile("s_waitcnt lgkmcnt(0)" ::: "memory"); SBAR();   \
        o[d0] = __builtin_amdgcn_mfma_f32_32x32x16_bf16(pa0, (bf16x8){l0[0], l0[1], l0[2], l0[3], h0[0], h0[1], h0[2], h0[3]}, o[d0], 0, 0, 0);   \
        o[d0] = __builtin_amdgcn_mfma_f32_32x32x16_bf16(pa1, (bf16x8){l1[0], l1[1], l1[2], l1[3], h1[0], h1[1], h1[2], h1[3]}, o[d0], 0, 0, 0);   \
        o[d0] = __builtin_amdgcn_mfma_f32_32x32x16_bf16(pa2, (bf16x8){l2[0], l2[1], l2[2], l2[3], h2[0], h2[1], h2[2], h2[3]}, o[d0], 0, 0, 0);   \
        o[d0] = __builtin_amdgcn_mfma_f32_32x32x16_bf16(pa3, (bf16x8){l3[0], l3[1], l3[2], l3[3], h3[0], h3[1], h3[2], h3[3]}, o[d0], 0, 0, 0); } while (0)
    PV_D0(0); PV_D0(1); PV_D0(2); PV_D0(3);
#undef PV_D0
#undef TRRD
}
struct BlockRef { const bf16_t* Q; const bf16_t* K; const bf16_t* V; bf16_t* O; const bf16_t* G; const unsigned long long* M; int P0; };
struct Seam { bf16x8 st_v0, st_v1, st_k0, st_k1; };
#define ROW(p, k0, rr) ((p) + (size_t)((k0) + (rr)) * D + sc)
#define VMW() asm volatile("s_waitcnt vmcnt(0)" ::: "memory")
#define VMWN(n) asm volatile("s_waitcnt vmcnt(%0)" :: "i"(n) : "memory")
#define SLOAD_H(Kp, Vp, k0) do { S.st_v0 = load8(ROW(Vp, k0, sr)); S.st_v1 = load8(ROW(Vp, k0, 32 + sr));              \
                         S.st_k0 = load8(ROW(Kp, k0, sr)); S.st_k1 = load8(ROW(Kp, k0, 32 + sr)); } while (0)
#define SWRITE_HK(bf) do { *(bf16x8*)(K_lds + (bf) * SHM_K + kws) = S.st_k0; *(bf16x8*)(K_lds + (bf) * SHM_K + kws + 32 * KROWB) = S.st_k1; } while (0)
#define SWRITE_HV(bf) do { *(bf16x8*)(V_lds + (bf) * SHM_V + vst0) = S.st_v0; *(bf16x8*)(V_lds + (bf) * SHM_V + vst1) = S.st_v1; } while (0)
#define SWRITE_H(bf) do { SWRITE_HV(bf); SWRITE_HK(bf); } while (0)
__device__ __forceinline__ void attn_prime(int wv, const BlockRef& cur, char* lds, Seam& S) {
    const int tid = opaque_tid(wv);
    const int sr = tid >> 4, sc = (tid & 15) * 8, kws = KSWZ(sr, sc * 2); char* K_lds = lds + 2 * SHM_V;
    SLOAD_H(cur.K, cur.V, 0); VMW(); SWRITE_HK(0);
    __syncthreads();
}
__device__ __forceinline__ void attn_block(int wv, const BlockRef& cur, const BlockRef& nxt, char* lds, Seam& S) {
    const int tid = opaque_tid(wv), wid = __builtin_amdgcn_readfirstlane(tid >> 6), lane = tid & 63, r32 = lane & 31, hi = lane >> 5;
    const int NT = cur.P0 / KVBLK + 4;
    char* V_lds = lds; char* K_lds = lds + 2 * SHM_V;
    float* ws = (float*)(lds + 2 * SHM_V + 2 * SHM_K) + wid * 64; float* li_l = ws, * al_l = ws + 32;
    float m_reg = -1e30f, l_reg = 0; f32x16 o[4] = {};
    const int sr = tid >> 4, sc = (tid & 15) * 8, vst0 = v_st(sr, sc), vst1 = v_st(32 + sr, sc), kws = KSWZ(sr, sc * 2);
    const int vb0 = (int)(uintptr_t)V_lds + v_rd_base(lane);
    const bf16_t* Kh = cur.K; const bf16_t* Vh = cur.V;
    const unsigned long long* mp = cur.M + (wid * QBLK + r32);
#define MLOAD(lo_, hi_, t) do { const unsigned long long w_ = mp[(size_t)(t) * SEQ] >> hi; lo_ = (unsigned)w_; hi_ = (unsigned)(w_ >> 32); } while (0)
#define RESC(a) do { if (__any((a) < 1.f)) { if (hi == 0) al_l[r32] = (a); asm volatile("s_waitcnt lgkmcnt(0)" ::: "memory");              \
                     for (int d_ = 0; d_ < 4; ++d_) for (int r = 0; r < 16; ++r) o[d_][r] *= al_l[crow(r, hi)]; } } while (0)
#define KBASE(t) ((t) * KVBLK)
#define SEAM_K0() do { VMW(); SWRITE_HK(0); SBAR(); } while (0)
    f32x16 pA0, pA1, pB0, pB1; float mnA, mnB, alA, alB; bf16x8 pa0, pa1, pa2, pa3;
    unsigned mAlo, mAhi, mBlo, mBhi;
    MLOAD(mAlo, mAhi, 0);
    char* Qw_lds = lds + Q_OFF + wid * (QBLK * QROWB);
    { u32x4 tq[8];
#pragma unroll
        for (int i = 0; i < 8; ++i) tq[i] = *(const u32x4*)(cur.Q + (size_t)(wid * QBLK + 4 * i + (lane >> 4)) * D + (lane & 15) * 8);
#pragma unroll
        for (int i = 0; i < 8; ++i) *(u32x4*)(Qw_lds + (4 * i + (lane >> 4)) * QROWB + (lane & 15) * 16) = tq[i];
        asm volatile("s_waitcnt lgkmcnt(0)" ::: "memory"); }
    const char* qa = Qw_lds + r32 * QROWB + hi * 16;
    SWRITE_HV(0); SBAR();
    if (NT > 1) { SLOAD_H(Kh, Vh, KBASE(1)); }
    SBAR(); qkt<0>(pA0, pA1, K_lds, r32, hi, qa);
    partialSM(pA0, pA1, m_reg, mnA, alA, mAlo, mAhi);
    if (NT > 1) { VMW(); SWRITE_H(1); }
    __syncthreads();
#define HALF_STEP(PX0, PX1, mnX, alX, mXlo, mXhi, PY0, PY1, alY, mYlo, mYhi, t, KB, VB, SB) do {                                  \
        SBAR(); MLOAD(mXlo, mXhi, t); qkt<KB>(PX0, PX1, K_lds, r32, hi, qa);                                                  \
        finishSM(PY0, PY1, alY, l_reg, pa0, pa1, pa2, pa3, mYlo, mYhi); SBAR();                                                 \
        if ((t) + 1 < NT) { SLOAD_H(Kh, Vh, KBASE((t) + 1)); SBAR(); }                                                          \
        pv_tile<VB>(o, vb0, pa0, pa1, pa2, pa3); partialSM(PX0, PX1, m_reg, mnX, alX, mXlo, mXhi);                              \
        __syncthreads();                                                                                                      \
        if ((t) + 1 < NT) { VMW(); SWRITE_H(SB); }                                                                            \
        RESC(alX); __syncthreads(); } while (0)
    for (int t = 1; t + 1 < NT; t += 2) {
        HALF_STEP(pB0, pB1, mnB, alB, mBlo, mBhi, pA0, pA1, alA, mAlo, mAhi, t, 1, 0, 0);
        HALF_STEP(pA0, pA1, mnA, alA, mAlo, mAhi, pB0, pB1, alB, mBlo, mBhi, t + 1, 0, 1, 1);
    }
    MLOAD(mBlo, mBhi, NT - 1);
    SBAR(); qkt<1>(pB0, pB1, K_lds, r32, hi, qa); SBAR();
    SLOAD_H(nxt.K, nxt.V, 0); SBAR();
    finishSM(pA0, pA1, alA, l_reg, pa0, pa1, pa2, pa3, mAlo, mAhi); SBAR();
    pv_tile<0>(o, vb0, pa0, pa1, pa2, pa3);
    partialSM(pB0, pB1, m_reg, mnB, alB, mBlo, mBhi); __syncthreads(); RESC(alB);
    finishSM(pB0, pB1, alB, l_reg, pa0, pa1, pa2, pa3, mBlo, mBhi); SBAR(); pv_tile<1>(o, vb0, pa0, pa1, pa2, pa3);
    SBAR(); SEAM_K0();
    if (hi == 0) li_l[r32] = l_reg; asm volatile("s_waitcnt lgkmcnt(0)" ::: "memory");
    float rli[16];
#pragma unroll
    for (int r = 0; r < 16; ++r) rli[r] = __builtin_amdgcn_rcpf(li_l[crow(r, hi)]);
    bf16_t* Ow = cur.O + (size_t)(wid * QBLK) * DM; const bf16_t* Gw = cur.G + (size_t)(wid * QBLK) * DM;
#pragma unroll
    for (int r = 0; r < 16; ++r) { const int orow = crow(r, hi);
#pragma unroll
        for (int d0 = 0; d0 < 4; ++d0) { const float gt = bf2f(Gw[(size_t)orow * DM + d0 * 32 + r32]);
            const float v = o[d0][r] * rli[r] * gt;
            const float vn = __builtin_bit_cast(float, __builtin_amdgcn_update_dpp(0, __builtin_bit_cast(int, v), 0xB1, 0xF, 0xF, true));
            if ((r32 & 1) == 0) *(unsigned*)(Ow + (size_t)orow * DM + d0 * 32 + r32) = cvtpk(v, vn); } }
    __syncthreads();
#undef MLOAD
#undef RESC
#undef KBASE
#undef SEAM_K0
#undef HALF_STEP
}
#undef ROW
#undef VMW
#undef VMWN
#undef SLOAD_H
#undef SWRITE_HK
#undef SWRITE_HV
#undef SWRITE_H
#undef KSWZ
#undef SBAR
}

#define XB_TMO      128
#define XB_XCNT(j)  (256  + 64 * (j))
#define XB_XSUB(j)  (1280 + 64 * (j))
#define XB_XGEN(j)  (2304 + 64 * (j))
#define XB_TOP      3328
#define XB_TOPGEN   3392
#define XCD_BAR_WORDS 3456
#define XB_SPIN_CAP (1u << 22)
__device__ __forceinline__ unsigned xb_ld(unsigned* p)              { return __hip_atomic_load(p, __ATOMIC_RELAXED, __HIP_MEMORY_SCOPE_AGENT); }
__device__ __forceinline__ unsigned xb_add(unsigned* p, unsigned v) { return __hip_atomic_fetch_add(p, v, __ATOMIC_RELAXED, __HIP_MEMORY_SCOPE_AGENT); }
__device__ __forceinline__ unsigned xb_xcc_id() { return (unsigned)__builtin_amdgcn_s_getreg((3 << 11) | 20) & 0xFu; }
#define XB_SPIN(cond, bar) do { unsigned _sp = 0; while (cond) { __builtin_amdgcn_s_sleep(1); \
    if ((++_sp & 255u) == 0u) { if (xb_ld(&(bar)[XB_TMO])) break; if (_sp > XB_SPIN_CAP) { atomicAdd(&(bar)[XB_TMO], 1u); break; } } } } while (0)
struct XcdBarrier { unsigned* bar; unsigned x; volatile LAS unsigned* st; };
__device__ __forceinline__ XcdBarrier xcd_barrier_post(unsigned* bar, volatile LAS unsigned* st) {
    XcdBarrier b; b.bar = bar; b.x = xb_xcc_id(); b.st = st;
    if (threadIdx.x == 0) (void)xb_add(&bar[XB_XCNT(b.x)], 1u);
    return b;
}
__device__ __forceinline__ void xcd_barrier_complete(unsigned* bar, unsigned x, unsigned& nloc, unsigned& nx) {
    const unsigned G = gridDim.x * gridDim.y * gridDim.z;
    unsigned sum, cnt, mine, sp = 0u;
    for (;;) {
        sum = 0u; cnt = 0u; mine = 0u;
#pragma unroll
        for (unsigned j = 0; j < 16; ++j) { const unsigned c = xb_ld(&bar[XB_XCNT(j)]); sum += c; cnt += (c > 0u) ? 1u : 0u; mine = (j == x) ? c : mine; }
        if (sum == G) break;
        __builtin_amdgcn_s_sleep(1);
        if ((++sp & 255u) == 0u) { if (xb_ld(&bar[XB_TMO])) break; if (sp > XB_SPIN_CAP) { atomicAdd(&bar[XB_TMO], 1u); break; } }
    }
    nloc = mine > 0u ? mine : 1u; nx = cnt > 0u ? cnt : 1u;
}
__device__ __forceinline__ void xcd_barrier(const XcdBarrier& b) {
    asm volatile("s_waitcnt vmcnt(0)" ::: "memory");
    __syncthreads();
    if (threadIdx.x == 0) {
        unsigned* bar = b.bar;
        __builtin_amdgcn_s_waitcnt(0);
        unsigned nloc = b.st[0], nx = b.st[1];
        if (nloc == 0u) { xcd_barrier_complete(bar, b.x, nloc, nx); b.st[0] = nloc; b.st[1] = nx; }
        const unsigned old = xb_add(&bar[XB_XSUB(b.x)], 1u);
        const unsigned gen = old / nloc;
        if (old + 1u == (gen + 1u) * nloc) {
            __builtin_amdgcn_fence(__ATOMIC_RELEASE, "agent");
            asm volatile("s_waitcnt vmcnt(0)" ::: "memory");
            const unsigned og = xb_add(&bar[XB_TOP], 1u);
            const unsigned tg = og / nx;
            if (og + 1u == (tg + 1u) * nx) xb_add(&bar[XB_TOPGEN], 1u);
            else XB_SPIN(xb_ld(&bar[XB_TOPGEN]) == tg, bar);
            __builtin_amdgcn_fence(__ATOMIC_ACQUIRE, "agent");
            xb_add(&bar[XB_XGEN(b.x)], 1u);
            asm volatile("s_waitcnt vmcnt(0)" ::: "memory");
        } else {
            XB_SPIN(xb_ld(&bar[XB_XGEN(b.x)]) == gen, bar);
            __builtin_amdgcn_fence(__ATOMIC_ACQUIRE, "agent");
            asm volatile("s_waitcnt vmcnt(0)" ::: "memory");
        }
    }
    __syncthreads();
}

struct Args {
    const float* x; const float* c; const int* pos; const float* norm_g; const float* mod_w; const float* mod_b;
    const float* pwi; const float* pwg; const float* pls; const float* pwo; const float* awi; const float* awo; const float* fg;
    float* out; unsigned char* ws;
    int ph_lo, ph_hi;
};
constexpr int NWAVES = 8, NTHR = 512;
constexpr int RING_BYTES = 131072, LDS_BYTES = 147456, MISC_OFF = LDS_BYTES - 256;

__device__ __forceinline__ void sincos_d(double a, float& s_out, float& c_out) {
    const double k = __builtin_rint(a * 0.6366197723675814);
    double r = __builtin_fma(-k, 1.5707963267948966, a); r = __builtin_fma(-k, 6.123233995736766e-17, r);
    const double r2 = r * r;
    double sp = -7.647163731819816e-13; sp = sp * r2 + 1.6059043836821613e-10; sp = sp * r2 - 2.505210838544172e-08; sp = sp * r2 + 2.7557319223985893e-06;
    sp = sp * r2 - 1.984126984126984e-04; sp = sp * r2 + 8.333333333333333e-03; sp = sp * r2 - 1.6666666666666666e-01; const double s = r + r * r2 * sp;
    double cp = 4.779477332387385e-14; cp = cp * r2 - 1.1470745597729725e-11; cp = cp * r2 + 2.08767569878681e-09; cp = cp * r2 - 2.755731922398589e-07;
    cp = cp * r2 + 2.48015873015873e-05; cp = cp * r2 - 1.388888888888889e-03; cp = cp * r2 + 4.1666666666666664e-02; cp = cp * r2 - 0.5; const double c = 1.0 + r2 * cp;
    const int q = (int)((long long)k & 3);
    const double ss = (q == 0) ? s : (q == 1) ? c : (q == 2) ? -s : -c;
    const double cc = (q == 0) ? c : (q == 1) ? -s : (q == 2) ? -c : s;
    s_out = (float)ss; c_out = (float)cc;
}
__device__ __forceinline__ void transpose_item(const float* W, int K, int N, bf16_t* WT, int row_off, LAS float* scr, int nblk, int item, int lane) {
    const int kb = item / nblk, nb = item % nblk, k0 = 64 * kb, n0 = 32 * nb;
    const int nn = n0 + (lane & 31);
    float tv[32];
#pragma unroll
    for (int i = 0; i < 32; ++i) { const int kk = 2 * i + (lane >> 5); tv[i] = (nn < N) ? W[(size_t)(k0 + kk) * N + nn] : 0.f; }
#pragma unroll
    for (int i = 0; i < 32; ++i) { const int kk = 2 * i + (lane >> 5); scr[kk * 33 + (lane & 31)] = tv[i]; }
    LDS_WAIT(); asm volatile("" ::: "memory");
    const int c = lane & 7;
#pragma unroll
    for (int j = 0; j < 4; ++j) { const int n = (lane >> 3) + 8 * j; const LAS float* s = scr + (8 * c) * 33 + n;
        u32x4 o; o.x = pk2(s[0 * 33], s[1 * 33]); o.y = pk2(s[2 * 33], s[3 * 33]); o.z = pk2(s[4 * 33], s[5 * 33]); o.w = pk2(s[6 * 33], s[7 * 33]);
        *(u32x4*)(WT + (size_t)(row_off + n0 + n) * K + k0 + 8 * c) = o; }
    LDS_WAIT(); asm volatile("" ::: "memory");
}
template <int VAR>
__device__ __forceinline__ void phase0(int wv, const Args& a, LAS unsigned char* lds) {
    const int tid = opaque_tid(wv), lane = tid & 63, wave = __builtin_amdgcn_readfirstlane(tid >> 6);
    const int G = gridDim.x, bx = blockIdx.x;
    unsigned char* ws = a.ws;
    if (VAR == 0 || VAR == 1)
    for (int unit = bx; unit < 256; unit += G) {
        const int layer = unit >> 6, kq = (unit >> 4) & 3, cs = unit & 15;
        const float* W = a.mod_w + ((size_t)layer * DM + 512 * kq) * 6144 + 384 * cs;
        LAS float* red = (LAS float*)lds;
        LAS float* cdl = (LAS float*)(lds + 8192);
        if (tid < 512) cdl[tid] = silu_f(a.c[512 * kq + tid]);
        if (tid < 8) cdl[512 + tid] = 0.f;
        __syncthreads();
        if (tid < 480) {
            const int kg = tid / 96, ln = tid - kg * 96;
            f32x4 acc4 = {0.f, 0.f, 0.f, 0.f};
#pragma unroll 8
            for (int i = 0; i < 103; ++i) { const int k = kg + 5 * i, kc = k < 512 ? k : 511;
                acc4 += *(const f32x4*)(W + (size_t)kc * 6144 + 4 * ln) * cdl[k]; }
            *(LAS f32x4*)(red + kg * 384 + 4 * ln) = acc4;
        }
        __syncthreads();
        if (tid < 384) { float sum = red[tid];
#pragma unroll
            for (int kg = 1; kg < 5; ++kg) sum += red[kg * 384 + tid];
            const int col = 384 * cs + tid;
            if (kq == 0) sum += a.mod_b[layer * 6144 + col];
            ((float*)(ws + WS_MOD))[(layer * 4 + kq) * 6144 + col] = sum; }
        __syncthreads();
    }
    if (VAR == 0 || VAR == 2) {
        float* cosq = (float*)(ws + WS_TAB); float* sinq = cosq + SEQ * 16; float* cosi = sinq + SEQ * 16; float* sini = cosi + SEQ * 8;
        for (int e = bx * NTHR + tid; e < SEQ * 24; e += G * NTHR) {
            const int p = e / 24, i = e - p * 24;
            const float pf = (float)a.pos[p];
            const double frac = i < 16 ? (double)i * (1.0 / 16.0) : (double)(i - 16) * (1.0 / 8.0);
            const float inv = (float)exp2(-18.931568569324174 * frac);
            const float ang = pf * inv;
            float s, c; sincos_d((double)ang, s, c);
            if (i < 16) { cosq[p * 16 + i] = c; sinq[p * 16 + i] = s; } else { cosi[p * 8 + i - 16] = c; sini[p * 8 + i - 16] = s; }
        }
    }
    if (VAR == 0 || VAR == 3) {
        LAS float* scr = (LAS float*)(lds + 16384 + wave * 8704);
        const int gw = bx * NWAVES + wave, NGW = G * NWAVES;
        constexpr int I_PI = 32 * 128, I_PG = 8 * 16, I_PO = 32 * 64, I_AI = 32 * 296, I_AO = 32 * 64;
        constexpr int NITEMS = 2 * I_PI + 8 * I_PG + 2 * I_PO + 2 * I_AI + 2 * I_AO;
        for (int it = gw; it < NITEMS; it += NGW) {
            int r = it;
            if (r < 2 * I_AI) { const int l = r / I_AI; r -= l * I_AI; transpose_item(a.awi + (size_t)l * DM * ATTN_IN, DM, ATTN_IN, (bf16_t*)(ws + WS_WAI) + (size_t)l * ATTN_INP * DM, 0, scr, 296, r, lane); continue; } r -= 2 * I_AI;
            if (r < 2 * I_PI) { const int l = r / I_PI; r -= l * I_PI; transpose_item(a.pwi + (size_t)l * DM * POOL_IN, DM, POOL_IN, (bf16_t*)(ws + WS_WPI) + (size_t)l * POOL_IN * DM, 0, scr, 128, r, lane); continue; } r -= 2 * I_PI;
            if (r < 2 * I_PO) { const int l = r / I_PO; r -= l * I_PO; transpose_item(a.pwo + (size_t)l * DM * DM, DM, DM, (bf16_t*)(ws + WS_WPO) + (size_t)l * DM * DM, 0, scr, 64, r, lane); continue; } r -= 2 * I_PO;
            if (r < 2 * I_AO) { const int l = r / I_AO; r -= l * I_AO; transpose_item(a.awo + (size_t)l * DM * DM, DM, DM, (bf16_t*)(ws + WS_WAO) + (size_t)l * DM * DM, 0, scr, 64, r, lane); continue; } r -= 2 * I_AO;
            { const int lg = r / I_PG; r -= lg * I_PG; const int l = lg >> 2, gi = lg & 3;
              transpose_item(a.pwg + (size_t)lg * 512 * 512, 512, 512, (bf16_t*)(ws + WS_WPG) + (size_t)l * DM * 512, gi * 512, scr, 16, r, lane); }
        }
    }
}

template <bool IN_BF16> __device__ __forceinline__ void phase_norm(int wv, const void* x, const float* g, const float* mod  , bf16_t* h) {
    const int tid = opaque_tid(wv), lane = tid & 63, wave = tid >> 6;
    const int gw = blockIdx.x * NWAVES + wave, NGW = gridDim.x * NWAVES;
    f32x4 av[8], sv[8];
#pragma unroll
    for (int j = 0; j < 8; ++j) { const int col = 8 * lane + 512 * (j >> 1) + 4 * (j & 1);
        const f32x4 gg = *(const f32x4*)(g + col);
        sv[j] = ((*(const f32x4*)(mod + col) + *(const f32x4*)(mod + 6144 + col)) + *(const f32x4*)(mod + 2 * 6144 + col)) + *(const f32x4*)(mod + 3 * 6144 + col);
        const f32x4 sc = ((*(const f32x4*)(mod + DM + col) + *(const f32x4*)(mod + 6144 + DM + col)) + *(const f32x4*)(mod + 2 * 6144 + DM + col)) + *(const f32x4*)(mod + 3 * 6144 + DM + col);
        av[j] = gg * (sc + 1.0f); }
    for (int row = gw; row < SEQ; row += 4 * NGW) {
        u32x4 t[4][4]; f32x4 tf[4][8];
#pragma unroll
        for (int r = 0; r < 4; ++r) { const size_t ro = (size_t)(row + r * NGW) * DM;
            if (IN_BF16) { const u32x4* xr = (const u32x4*)((const bf16_t*)x + ro) + lane;
#pragma unroll
                for (int j = 0; j < 4; ++j) t[r][j] = xr[64 * j]; }
            else { const f32x4* xr = (const f32x4*)((const float*)x + ro) + 2 * lane;
#pragma unroll
                for (int j = 0; j < 4; ++j) { tf[r][2 * j] = xr[128 * j]; tf[r][2 * j + 1] = xr[128 * j + 1]; } } }
#pragma unroll
        for (int r = 0; r < 4; ++r) {
            f32x4 v[8];
#pragma unroll
            for (int j = 0; j < 4; ++j) { if (IN_BF16) unpack8(t[r][j], v[2 * j], v[2 * j + 1]); else { v[2 * j] = tf[r][2 * j]; v[2 * j + 1] = tf[r][2 * j + 1]; } }
            float s = 0.f;
#pragma unroll
            for (int j = 0; j < 8; ++j) s += (v[j].x * v[j].x + v[j].y * v[j].y) + (v[j].z * v[j].z + v[j].w * v[j].w);
            const float rstd = 1.0f / sqrtf(wave_sum(s) * (1.f / DM) + EPS);
            u32x4* o16 = (u32x4*)(h + (size_t)(row + r * NGW) * DM) + lane;
#pragma unroll
            for (int j = 0; j < 4; ++j) o16[64 * j] = pack8(v[2 * j] * rstd * av[2 * j] + sv[2 * j], v[2 * j + 1] * rstd * av[2 * j + 1] + sv[2 * j + 1]);
        }
    }
}
__device__ __forceinline__ void phase_final(int wv, const bf16_t* x, float* y, const float* g) {
    const int tid = opaque_tid(wv), lane = tid & 63, wave = tid >> 6;
    const int gw = blockIdx.x * NWAVES + wave, NGW = gridDim.x * NWAVES;
    for (int row = gw; row < SEQ; row += 2 * NGW) {
        const int rowb = row + NGW;
        const u32x4* xr = (const u32x4*)(x + (size_t)row * DM) + lane; const u32x4* xs = (const u32x4*)(x + (size_t)rowb * DM) + lane;
        f32x4* yr = (f32x4*)(y + (size_t)row * DM) + 2 * lane; f32x4* ys = (f32x4*)(y + (size_t)rowb * DM) + 2 * lane;
        u32x4 t0[4], t1[4];
#pragma unroll
        for (int j = 0; j < 4; ++j) { t0[j] = xr[64 * j]; t1[j] = xs[64 * j]; }
        f32x4 v[8], u[8]; float s = 0.f, s2 = 0.f;
#pragma unroll
        for (int j = 0; j < 4; ++j) { unpack8(t0[j], v[2 * j], v[2 * j + 1]); unpack8(t1[j], u[2 * j], u[2 * j + 1]); }
#pragma unroll
        for (int j = 0; j < 8; ++j) { s += (v[j].x * v[j].x + v[j].y * v[j].y) + (v[j].z * v[j].z + v[j].w * v[j].w); s2 += (u[j].x * u[j].x + u[j].y * u[j].y) + (u[j].z * u[j].z + u[j].w * u[j].w); }
        const float rstd = 1.0f / sqrtf(wave_sum(s) * (1.f / DM) + EPS), rstd2 = 1.0f / sqrtf(wave_sum(s2) * (1.f / DM) + EPS);
#pragma unroll
        for (int j = 0; j < 8; ++j) { const int col = 8 * lane + 512 * (j >> 1) + 4 * (j & 1); const f32x4 gg = *(const f32x4*)(g + col);
            yr[128 * (j >> 1) + (j & 1)] = v[j] * rstd * gg; ys[128 * (j >> 1) + (j & 1)] = u[j] * rstd2 * gg; }
    }
}

template <int W, int R> __device__ __forceinline__ void pool_strip(const bf16_t* VG, bf16_t* PL, int t0, int c0) {
    u32x4 r[W + R - 1];
#pragma unroll
    for (int i = 0; i < W + R - 1; ++i) { const int t = t0 - (W - 1) + i; r[i] = *(const u32x4*)(VG + (size_t)(t < 0 ? 0 : t) * POOL_IN + c0); }
    float S[8];
#pragma unroll
    for (int e = 0; e < 8; ++e) S[e] = 0.f;
#pragma unroll
    for (int i = 0; i < W - 1; ++i) { const float wg = (t0 - (W - 1) + i >= 0) ? 1.f : 0.f;
#pragma unroll
        for (int e = 0; e < 4; ++e) { const unsigned x = r[i][e]; S[2 * e] += wg * __builtin_bit_cast(float, x << 16); S[2 * e + 1] += wg * __builtin_bit_cast(float, x & 0xffff0000u); } }
#pragma unroll
    for (int j = 0; j < R; ++j) { const int t = t0 + j;
        float v[8];
#pragma unroll
        for (int e = 0; e < 4; ++e) { const unsigned x = r[W - 1 + j][e]; v[2 * e] = __builtin_bit_cast(float, x << 16); v[2 * e + 1] = __builtin_bit_cast(float, x & 0xffff0000u); }
        const int cnt = (t + 1 < W) ? (t + 1) : W; const float ic = 1.0f / (float)cnt;
        float o[8];
#pragma unroll
        for (int e = 0; e < 8; ++e) { S[e] += v[e]; o[e] = S[e] * ic - v[e]; }
        u32x4 pw; pw.x = cvt_pk_bf16(o[0], o[1]); pw.y = cvt_pk_bf16(o[2], o[3]); pw.z = cvt_pk_bf16(o[4], o[5]); pw.w = cvt_pk_bf16(o[6], o[7]);
        *(u32x4*)(PL + (size_t)t * DM + c0) = pw;
        const float wg = (t - W + 1 >= 0) ? 1.f : 0.f;
#pragma unroll
        for (int e = 0; e < 4; ++e) { const unsigned x = r[j][e]; S[2 * e] -= wg * __builtin_bit_cast(float, x << 16); S[2 * e + 1] -= wg * __builtin_bit_cast(float, x & 0xffff0000u); } }
}
__device__ __forceinline__ void phase_pool(int wv, const bf16_t* VG, bf16_t* PL) {
    const int total = 512 * 256;
    const int tid = opaque_tid(wv);
    for (int it = blockIdx.x * NTHR + tid; it < total; it += gridDim.x * NTHR) {
        const int cg = it & 255, strip = it >> 8; const int c0 = cg * 8, t0 = strip * 16;
        const int grp = __builtin_amdgcn_readfirstlane(c0 >> 9);
        if (grp == 0) pool_strip<2, 16>(VG, PL, t0, c0); else if (grp == 1) pool_strip<4, 16>(VG, PL, t0, c0); else if (grp == 2) pool_strip<8, 16>(VG, PL, t0, c0);
        else { pool_strip<16, 8>(VG, PL, t0, c0); pool_strip<16, 8>(VG, PL, t0 + 8, c0); }
    }
}

__device__ __forceinline__ size_t sc_block_base(int qb) { return (size_t)65536 * (size_t)(qb * (qb + 1) / 2); }
__device__ __forceinline__ float fma_s(float a, float b, float c) { asm("v_fma_f32 %0, %1, %2, %0" : "+v"(c) : "v"(a), "v"(b)); return c; }
__device__ __forceinline__ float relu_i(float x) { const int b = __builtin_bit_cast(int, x); return __builtin_bit_cast(float, b > 0 ? b : 0); }
template <int VAR>
__device__ __forceinline__ void phase_scores(int wv, const bf16_t* QI, const bf16_t* KI, const float* WI, float* SC, LAS unsigned char* lds, unsigned* ctr  ) {
    const int tid = opaque_tid(wv), wid = __builtin_amdgcn_readfirstlane(tid >> 6), lane = tid & 63, r32 = lane & 31, hi = lane >> 5;
    constexpr int QROW = 2064;
    volatile LAS int* slot = (volatile LAS int*)(lds + 32 * QROW);
    for (;;) {
        __syncthreads();
        if (tid == 0) slot[0] = (int)__hip_atomic_fetch_add(ctr, 1u, __ATOMIC_RELAXED, __HIP_MEMORY_SCOPE_AGENT);
        __syncthreads();
        const int L = slot[0];
        if (L >= 1152) break;
        int kc = 0, base = 0;
        for (; kc < 8; ++kc) { const int n = 256 - 32 * kc; if (L < base + n) break; base += n; }
        const int u = 32 * kc + (L - base);
        const int q0 = 32 * u, qb = u >> 3;
        const int klim = (qb + 1) * 256;
        bf16x8 kf[2][4];
        { const int key0 = kc * 1024 + wid * 64;
#pragma unroll
            for (int b = 0; b < 2; ++b)
#pragma unroll
                for (int kk = 0; kk < 4; ++kk) kf[b][kk] = *(const bf16x8*)(KI + (size_t)(key0 + 32 * b + r32) * 64 + 16 * kk + 8 * hi); }
        {
            int t_ = tid; asm volatile("" : "+v"(t_));
            const bf16_t* src = QI + (size_t)q0 * 1024 + t_ * 8;
            const int ldst = (t_ >> 7) * QROW + (t_ & 127) * 16;
            u32x4 tq[8];
#pragma unroll
            for (int i = 0; i < 8; ++i) tq[i] = *(const u32x4*)(src + i * 4096);
            __builtin_amdgcn_sched_barrier(0);
#pragma unroll
            for (int i = 0; i < 8; ++i) *(LAS u32x4*)(lds + ldst + i * (4 * QROW)) = tq[i];
        }
        f32x4 wq[4];
#pragma unroll
        for (int i = 0; i < 4; ++i) wq[i] = *(const f32x4*)(WI + (size_t)(q0 + r32) * 16 + 4 * i);
        __syncthreads();
        for (int sl = wid; sl < 16; sl += 8) {
            const int key0 = kc * 1024 + sl * 64;
            if (key0 >= klim) continue;
            if (sl != wid) {
#pragma unroll
                for (int b = 0; b < 2; ++b)
#pragma unroll
                    for (int kk = 0; kk < 4; ++kk) kf[b][kk] = *(const bf16x8*)(KI + (size_t)(key0 + 32 * b + r32) * 64 + 16 * kk + 8 * hi); }
            f32x16 acc0 = {}, acc1 = {};
            const LAS unsigned char* qa = lds + r32 * QROW + hi * 16;
#define SC_MM(h, S0, S1) do { bf16x8 af_[4];                                                                                  \
                _Pragma("unroll") for (int kk = 0; kk < 4; ++kk) af_[kk] = *(const LAS bf16x8*)(qa + (h) * 128 + kk * 32);     \
                S0 = __builtin_amdgcn_mfma_f32_32x32x16_bf16(kf[0][0], af_[0], f32x16{}, 0, 0, 0); S1 = __builtin_amdgcn_mfma_f32_32x32x16_bf16(kf[1][0], af_[0], f32x16{}, 0, 0, 0); \
                _Pragma("unroll") for (int kk = 1; kk < 4; ++kk) { S0 = __builtin_amdgcn_mfma_f32_32x32x16_bf16(kf[0][kk], af_[kk], S0, 0, 0, 0); S1 = __builtin_amdgcn_mfma_f32_32x32x16_bf16(kf[1][kk], af_[kk], S1, 0, 0, 0); } } while (0)
#define SC_VA(h, S0, S1) do { const float w_ = wq[(h) >> 2][(h) & 3];                                                          \
                _Pragma("unroll") for (int r = 0; r < 16; ++r) { acc0[r] = fma_s(relu_i(S0[r]), w_, acc0[r]); acc1[r] = fma_s(relu_i(S1[r]), w_, acc1[r]); } } while (0)
#define SC_SB() __builtin_amdgcn_sched_barrier(0)
            f32x16 sA0, sA1, sB0, sB1;
            SC_MM(0, sA0, sA1); SC_SB();
            if (wid < 4) {
#pragma unroll
                for (int h = 0; h < 14; h += 2) {
                    SC_MM(h + 1, sB0, sB1); SC_SB(); SC_VA(h, sA0, sA1); SC_SB();
                    SC_MM(h + 2, sA0, sA1); SC_SB(); SC_VA(h + 1, sB0, sB1); SC_SB();
                }
                SC_MM(15, sB0, sB1); SC_SB(); SC_VA(14, sA0, sA1); SC_SB();
                SC_VA(15, sB0, sB1);
            } else {
                SC_MM(1, sB0, sB1); SC_SB();
#pragma unroll
                for (int h = 0; h < 14; h += 2) {
                    SC_VA(h, sA0, sA1); SC_SB(); SC_MM(h + 2, sA0, sA1); SC_SB();
                    SC_VA(h + 1, sB0, sB1); SC_SB(); SC_MM(h + 3, sB0, sB1); SC_SB();
                }
                SC_VA(14, sA0, sA1); SC_SB();
                SC_VA(15, sB0, sB1);
            }
#undef SC_SB
#undef SC_MM
#undef SC_VA
            float* out = SC + sc_block_base(qb) + (size_t)(q0 - qb * 256 + r32) * (size_t)klim + key0 + 4 * hi;
#pragma unroll
            for (int g = 0; g < 4; ++g) {
                *(f32x4*)(out + 8 * g) = (f32x4){acc0[4 * g], acc0[4 * g + 1], acc0[4 * g + 2], acc0[4 * g + 3]};
                *(f32x4*)(out + 32 + 8 * g) = (f32x4){acc1[4 * g], acc1[4 * g + 1], acc1[4 * g + 2], acc1[4 * g + 3]}; }
        }
    }
}

template <int VAR>
__device__ __forceinline__ void phase_select(int wv, const float* SC, unsigned long long* MASK, LAS unsigned char* lds) {
    const int tid = opaque_tid(wv), lane0 = tid & 63, wave = __builtin_amdgcn_readfirstlane(tid >> 6);
    LAS unsigned* hist = (LAS unsigned*)(lds + wave * 9216);
    const int gw = blockIdx.x * NWAVES + wave, NGW = gridDim.x * NWAVES;
    for (int q = gw; q < SEQ; q += NGW) {
        int lane = lane0; asm volatile("" : "+v"(lane));
        const int qb = q >> 8, klim = (qb + 1) * 256;
        const float* rowp = SC + sc_block_base(qb) + (size_t)(q - qb * 256) * (size_t)klim;
        const int ngrp = qb + 1;
        unsigned key[32][4];
#pragma unroll
        for (int g = 0; g < 8; ++g) {
            if (4 * g < ngrp) {
#pragma unroll
                for (int i = 0; i < 4; ++i) { const u32x4 v = *(const u32x4*)(rowp + 256 * (4 * g + i) + 4 * lane);
                    key[4 * g + i][0] = v.x; key[4 * g + i][1] = v.y; key[4 * g + i][2] = v.z; key[4 * g + i][3] = v.w; }
            } else {
#pragma unroll
                for (int i = 0; i < 4; ++i) { key[4 * g + i][0] = 0u; key[4 * g + i][1] = 0u; key[4 * g + i][2] = 0u; key[4 * g + i][3] = 0u; }
            }
        }
        unsigned T = 1u; unsigned need_eq = 0xffffffffu, n_eq = 0u;
        const bool radix = (q + 1 > TOPK) && (VAR != 1 && VAR != 3);
        if (VAR == 3) { unsigned x_ = 0u;
#pragma unroll
            for (int j = 0; j < 32; ++j) x_ |= key[j][0] & key[j][1] & key[j][2] & key[j][3];
            if (x_ == 0x12345u) MASK[q] = x_; continue; }
        if (radix) {
#pragma unroll
            for (int i = 0; i < 9; ++i) *(LAS u32x4*)(hist + 4 * (lane + 64 * i)) = (u32x4){0u, 0u, 0u, 0u};
        }
        __builtin_amdgcn_sched_barrier(0);
#pragma unroll
        for (int g = 0; g < 8; ++g) { if (4 * g < ngrp) {
#pragma unroll
            for (int i = 0; i < 4; ++i)
#pragma unroll
                for (int e = 0; e < 4; ++e) { const int j = 4 * g + i; const unsigned uu = key[j][e];
                    const unsigned kx = uu ^ ((unsigned)((int)uu >> 31) | 0x80000000u); key[j][e] = (256 * j + 4 * lane + e <= q) ? kx : 0u; }
            } __builtin_amdgcn_sched_barrier(0); }
        if (radix) {
            unsigned gm0 = 0u, gm1 = 0u, gm2 = 0u, gm3 = 0u;
#pragma unroll
            for (int g = 0; g < 8; ++g) if (4 * g < ngrp) {
#pragma unroll
                for (int i = 0; i < 4; ++i) { const int j = 4 * g + i; gm0 = key[j][0] > gm0 ? key[j][0] : gm0; gm1 = key[j][1] > gm1 ? key[j][1] : gm1; gm2 = key[j][2] > gm2 ? key[j][2] : gm2; gm3 = key[j][3] > gm3 ? key[j][3] : gm3; }
            }
            unsigned Pmin = gm0 < gm1 ? gm0 : gm1; { const unsigned p2 = gm2 < gm3 ? gm2 : gm3; Pmin = Pmin < p2 ? Pmin : p2; }
#pragma unroll
            for (int off = 1; off < 64; off <<= 1) { const unsigned tt = (unsigned)__builtin_amdgcn_ds_bpermute((lane ^ off) << 2, (int)Pmin); Pmin = tt < Pmin ? tt : Pmin; }
            LDS_WAIT();
#pragma unroll
            for (int g = 0; g < 8; ++g) if (4 * g < ngrp) {
#pragma unroll
                for (int i = 0; i < 4; ++i) {
#pragma unroll
                    for (int e = 0; e < 4; ++e) { const unsigned k = key[4 * g + i][e];
                        if (k >= Pmin) { const unsigned b = k >> 21; __hip_atomic_fetch_add(hist + b + ((b >> 5) << 2), 1u, __ATOMIC_RELAXED, __HIP_MEMORY_SCOPE_WORKGROUP); } }
                    __builtin_amdgcn_sched_barrier(0); }
            }
            unsigned prefix = 0u, pmask = 0u, kk = TOPK;
#pragma unroll 1
            for (int pass = 0; pass < ((VAR == 4) ? 1 : 3); ++pass) {
                const int shift = (pass == 0) ? 21 : (pass == 1) ? 10 : 0;
                const unsigned dmask = (pass == 2) ? 1023u : 2047u;
                LDS_WAIT();
                if (pass > 0) {
#pragma unroll
                    for (int g = 0; g < 8; ++g) if (4 * g < ngrp) {
#pragma unroll
                        for (int i = 0; i < 4; ++i) {
#pragma unroll
                            for (int e = 0; e < 4; ++e) { const unsigned k = key[4 * g + i][e];
                                if ((k & pmask) == prefix) { const unsigned b = (k >> shift) & dmask; __hip_atomic_fetch_add(hist + b + ((b >> 5) << 2), 1u, __ATOMIC_RELAXED, __HIP_MEMORY_SCOPE_WORKGROUP); } }
                            __builtin_amdgcn_sched_barrier(0); }
                    }
                }
                LDS_WAIT();
                if (VAR == 5) { prefix |= (0x5a5u & dmask) << shift; pmask |= dmask << shift; continue; }
                unsigned s = 0u;
#pragma unroll
                for (int i = 0; i < 8; ++i) { const u32x4 v = *(const LAS u32x4*)(hist + 36 * lane + 4 * i); s += (v.x + v.y) + (v.z + v.w); }
                unsigned suf = s;
#pragma unroll
                for (int off = 1; off < 64; off <<= 1) { const unsigned tt = (unsigned)__builtin_amdgcn_ds_bpermute(((lane + off) & 63) << 2, (int)suf); if (lane + off < 64) suf += tt; }
                const unsigned long long bal = __ballot(suf >= kk);
                const int Ls = 63 - __builtin_clzll(bal);
                const unsigned above1 = (unsigned)__builtin_amdgcn_readlane((int)(suf - s), Ls);
                const unsigned c2 = hist[36 * Ls + (lane & 31)];
                unsigned suf2 = (lane < 32) ? c2 : 0u;
#pragma unroll
                for (int off = 1; off < 32; off <<= 1) { const unsigned tt = (unsigned)__builtin_amdgcn_ds_bpermute(((lane + off) & 63) << 2, (int)suf2); if (lane + off < 32) suf2 += tt; }
                const unsigned long long bal2 = __ballot(lane < 32 && above1 + suf2 >= kk);
                const int Bs = 63 - __builtin_clzll(bal2);
                const int dsel = 32 * Ls + Bs;
                const unsigned cnt_b = (unsigned)__builtin_amdgcn_readlane((int)c2, Bs);
                const unsigned kk_new = kk - (above1 + (unsigned)__builtin_amdgcn_readlane((int)suf2, Bs) - cnt_b);
                LDS_WAIT();
#pragma unroll
                for (int i = 0; i < 9; ++i) *(LAS u32x4*)(hist + 4 * (lane + 64 * i)) = (u32x4){0u, 0u, 0u, 0u};
                const unsigned d = (unsigned)dsel; kk = kk_new; n_eq = cnt_b;
                prefix |= d << shift; pmask |= dmask << shift;
            }
            T = prefix; need_eq = kk;
        }
        if (VAR == 2 || VAR == 4 || VAR == 5) { if (T == 0x12345u) MASK[q] = T; continue; }
        const bool tie_path = (need_eq != 0xffffffffu) && (n_eq > need_eq);
        unsigned tie_seen = 0u;
        const unsigned long long lt = (lane == 0) ? 0ull : (~0ull >> (64 - lane));
        int w0lo = 0, w0hi = 0, w1lo = 0, w1hi = 0;
#pragma unroll
        for (int g = 0; g < 8; ++g) if (4 * g < ngrp) {
#pragma unroll
            for (int i = 0; i < 4; ++i) { const int j = 4 * g + i;
                unsigned long long B[4];
                if (!tie_path) {
#pragma unroll
                    for (int e = 0; e < 4; ++e) B[e] = __ballot(key[j][e] >= T);
                } else {
                    unsigned long long E[4]; unsigned before = tie_seen;
#pragma unroll
                    for (int e = 0; e < 4; ++e) { E[e] = __ballot(key[j][e] == T); before += (unsigned)__builtin_popcountll(E[e] & lt); }
                    unsigned mine = 0u;
#pragma unroll
                    for (int e = 0; e < 4; ++e) { const bool eq = (key[j][e] == T);
                        B[e] = __ballot(key[j][e] > T || (eq && (before + mine) < need_eq)); mine += eq ? 1u : 0u; }
#pragma unroll
                    for (int e = 0; e < 4; ++e) tie_seen += (unsigned)__builtin_popcountll(E[e]);
                }
#pragma unroll
                for (int k = 0; k < 4; ++k) { const int t = 4 * j + k;
                    const unsigned blo_ = (unsigned)((B[0] >> (16 * k)) & 0xffffull) | ((unsigned)((B[1] >> (16 * k)) & 0xffffull) << 16);
                    const unsigned bhi_ = (unsigned)((B[2] >> (16 * k)) & 0xffffull) | ((unsigned)((B[3] >> (16 * k)) & 0xffffull) << 16);
                    if (t < 64) asm volatile("s_nop 3\n\tv_writelane_b32 %0, %2, %4\n\tv_writelane_b32 %1, %3, %4" : "+v"(w0lo), "+v"(w0hi) : "s"(blo_), "s"(bhi_), "n"(t & 63));
                    else asm volatile("s_nop 3\n\tv_writelane_b32 %0, %2, %4\n\tv_writelane_b32 %1, %3, %4" : "+v"(w1lo), "+v"(w1hi) : "s"(blo_), "s"(bhi_), "n"(t & 63)); }
            }
        }
        const int ntile = 4 * ngrp;
        if (lane < ntile) MASK[(size_t)lane * SEQ + q] = ((unsigned long long)(unsigned)w0hi << 32) | (unsigned)w0lo;
        if (lane + 64 < ntile) MASK[(size_t)(lane + 64) * SEQ + q] = ((unsigned long long)(unsigned)w1hi << 32) | (unsigned)w1lo;
    }
}

__device__ __forceinline__ att::BlockRef attn_ref(int h, int qb, const bf16_t* Qh, const bf16_t* Kh, const bf16_t* Vh, bf16_t* O, const bf16_t* SG, const unsigned long long* MASK) {
    att::BlockRef r;
    r.Q = Qh + ((size_t)h * SEQ + (size_t)qb * 256) * HD; r.K = Kh + (size_t)h * SEQ * HD; r.V = Vh + (size_t)h * SEQ * HD;
    r.O = O + (size_t)qb * 256 * DM + h * HD; r.G = SG + (size_t)qb * 256 * DM + h * HD; r.M = MASK + qb * 256; r.P0 = qb * 256;
    return r;
}
__device__ __forceinline__ void phase_attn(int wv, const bf16_t* Qh, const bf16_t* Kh, const bf16_t* Vh, bf16_t* O, const bf16_t* SG, const unsigned long long* MASK, char* lds) {
    const int total = NHEAD * 16, stride = gridDim.x;
    int L = blockIdx.x; if (L >= total) return;
    if (gridDim.x == 256) { const int b = L; L = 16 * ((b & 7) + 8 * (b >> 7)) + ((b >> 3) & 15); }
    int pass = 0;
    att::BlockRef cur = attn_ref(L >> 4, L & 15, Qh, Kh, Vh, O, SG, MASK);
    att::Seam S;
    att::attn_prime(wv, cur, lds, S);
    for (;;) {
        const bool more_pass = pass == 0, more_item = L + stride < total, last = !more_pass && !more_item;
        int passn = pass + 1, Ln = L;
        if (!more_pass) { passn = 0; Ln = more_item ? L + stride : L; }
        const int hn = Ln >> 4, xn = Ln & 15;
        const att::BlockRef nxt = last ? cur : attn_ref(hn, passn ? 31 - xn : xn, Qh, Kh, Vh, O, SG, MASK);
        att::attn_block(wv, cur, nxt, lds, S);
        if (last) break;
        cur = nxt; pass = passn; L = Ln;
    }
}

__global__ void __launch_bounds__(NTHR, 2) trunk_fwd(Args args) {
    extern __shared__ __attribute__((aligned(16))) unsigned char lds_raw[];
    LAS unsigned char* lds = (LAS unsigned char*)lds_raw;
    volatile LAS unsigned* MISC = (volatile LAS unsigned*)(lds + MISC_OFF);
    const int wv = __builtin_amdgcn_readfirstlane((int)threadIdx.x >> 6);
    const int tid = opaque_tid(wv);
    unsigned char* ws = args.ws;
    if (tid < 32) MISC[tid] = 0u;
    __syncthreads();
    XcdBarrier bar; bar.bar = (unsigned*)(ws + WS_CTL) + 1024; bar.x = 0; bar.st = nullptr;
    if (MK_ONE_LAUNCH) bar = xcd_barrier_post((unsigned*)(ws + WS_CTL) + 1024, MISC + 8);
    const int lo = args.ph_lo, hi = args.ph_hi;
    int ph = 0;
#ifndef PHASE_MASK
#define PHASE_MASK 0xFFFF
#endif
#define IN(k) (lo <= (k) && (k) < hi)
#define PM(b) ((PHASE_MASK >> (b)) & 1)
#ifndef DUP_MASK
#define DUP_MASK 0
#endif
#ifndef SC_VAR
#define SC_VAR 0
#endif
#define DUP(b) ((DUP_MASK >> (b)) & 1)
#define REDO(b, stmt) do { if (DUP(b)) { if (MK_ONE_LAUNCH) xcd_barrier(bar); else __syncthreads(); stmt; } } while (0)
#ifndef ECHO_MASK
#define ECHO_MASK 0
#endif
#define ECHO_K 4
    unsigned long long echo_acc = 0ull, echo_prev = ECHO_MASK ? __builtin_amdgcn_s_memrealtime() : 0ull;
#define SEAM(b) do { if (IN(ph) && IN(ph + 1)) xcd_barrier(bar); ++ph; \
        if (ECHO_MASK) { const unsigned long long now_ = __builtin_amdgcn_s_memrealtime(); if ((ECHO_MASK >> (b)) & 1) echo_acc += now_ - echo_prev; echo_prev = now_; } } while (0)

    float* mod = (float*)(ws + WS_MOD);
    bf16_t* HU = (bf16_t*)(ws + WS_HU);
    const float* cosq = (const float*)(ws + WS_TAB); const float* sinq = cosq + SEQ * 16; const float* cosi = sinq + SEQ * 16; const float* sini = cosi + SEQ * 8;
    const int G = gridDim.x, bx = blockIdx.x;

    if (PM(0) && IN(ph)) { phase0<0>(wv, args, lds); REDO(0, phase0<SC_VAR>(wv, args, lds)); }
    SEAM(0);
#pragma unroll 1
    for (int layer = 0; layer < 4; ++layer) {
        const int j = layer >> 1;
        bf16_t* XB = (bf16_t*)(ws + WS_XB);
        const float* lmod = mod + layer * 4 * 6144;
        if (PM(1) && IN(ph)) { if (layer == 0) phase_norm<false>(wv, args.x, args.norm_g, lmod, HU); else phase_norm<true>(wv, XB, args.norm_g + layer * DM, lmod, HU); }
        SEAM(1);
        if ((layer & 1) == 0) {
            bf16_t* VG = (bf16_t*)(ws + WS_VG); bf16_t* PL = (bf16_t*)(ws + WS_PL);
            if (PM(2) && IN(ph)) { pg8::Gemm g{HU, (const bf16_t*)(ws + WS_WPI) + (size_t)j * POOL_IN * DM, SEQ, POOL_IN, DM, DM, DM, 0, 0};
                pg8::StaticOrder S; S.init(SEQ, POOL_IN, G, bx); pg8::EpiBf16 E{VG, POOL_IN};
                pg8::gemm_phase<pg8::EpiBf16, true>(wv, lds, g, S, E); REDO(2, (pg8::gemm_phase<pg8::EpiBf16, true>(wv, lds, g, S, E))); }
            SEAM(2);
            if (PM(3) && IN(ph)) { phase_pool(wv, VG, PL); REDO(3, phase_pool(wv, VG, PL)); }
            SEAM(3);
            if (PM(4) && IN(ph)) { pg8::Gemm g{PL, (const bf16_t*)(ws + WS_WPG) + (size_t)j * DM * 512, SEQ, DM, 512, DM, 512, 1, 512};
                pg8::StaticOrder S; S.init(SEQ, DM, G, bx); pg8::EpiPoolGrp E{HU, VG, args.pls + j * DM};
                pg8::gemm_phase<pg8::EpiPoolGrp, true>(wv, lds, g, S, E); REDO(4, (pg8::gemm_phase<pg8::EpiPoolGrp, true>(wv, lds, g, S, E))); }
            SEAM(4);
            if (PM(5) && IN(ph)) { pg8::Gemm g{HU, (const bf16_t*)(ws + WS_WPO) + (size_t)j * DM * DM, SEQ, DM, DM, DM, DM, 0, 0};
                pg8::StaticOrder S; S.init(SEQ, DM, G, bx);
                if (layer == 0) { pg8::EpiResid<false, true> E{args.x, XB, lmod + 2 * DM}; pg8::gemm_phase<pg8::EpiResid<false, true>, true>(wv, lds, g, S, E); }
                else { pg8::EpiResid<true, true> E{XB, XB, lmod + 2 * DM}; pg8::gemm_phase<pg8::EpiResid<true, true>, true>(wv, lds, g, S, E); } }
            SEAM(5);
        } else {
            bf16_t* Qh = (bf16_t*)(ws + WS_Q); bf16_t* Kh = (bf16_t*)(ws + WS_K); bf16_t* Vh = (bf16_t*)(ws + WS_V); bf16_t* SG = (bf16_t*)(ws + WS_GATE);
            bf16_t* QI = (bf16_t*)(ws + WS_QI); bf16_t* KI = (bf16_t*)(ws + WS_KI); float* WI = (float*)(ws + WS_WI);
            unsigned long long* MASK = (unsigned long long*)(ws + WS_MASK); float* SC = (float*)(ws + WS_SC);
            if (PM(6) && IN(ph)) { pg8::Gemm g{HU, (const bf16_t*)(ws + WS_WAI) + (size_t)j * ATTN_INP * DM, SEQ, ATTN_INP, DM, DM, DM, 0, 0};
                pg8::StaticOrder S; S.init(SEQ, ATTN_INP, G, bx); pg8::EpiAttnIn E{ws, args.pos};
                pg8::gemm_phase<pg8::EpiAttnIn, true>(wv, lds, g, S, E); REDO(6, (pg8::gemm_phase<pg8::EpiAttnIn, true>(wv, lds, g, S, E))); }
            SEAM(6);
            if (PM(7) && IN(ph)) { unsigned* qctr = (unsigned*)(ws + WS_CTL) + 8192 + 128 * j; phase_scores<0>(wv, QI, KI, WI, SC, lds, qctr); REDO(7, phase_scores<SC_VAR>(wv, QI, KI, WI, (float*)(ws + WS_END), lds, qctr + 64)); }
            SEAM(7);
            if (PM(8) && IN(ph)) { phase_select<0>(wv, SC, MASK, lds); REDO(8, phase_select<SC_VAR>(wv, SC, (unsigned long long*)(ws + WS_END), lds)); }
            SEAM(8);
            if (PM(9) && IN(ph)) { phase_attn(wv, Qh, Kh, Vh, HU, SG, MASK, (char*)lds_raw); REDO(9, phase_attn(wv, Qh, Kh, Vh, HU, SG, MASK, (char*)lds_raw)); }
            SEAM(9);
            if (PM(5) && IN(ph)) { pg8::Gemm g{HU, (const bf16_t*)(ws + WS_WAO) + (size_t)j * DM * DM, SEQ, DM, DM, DM, DM, 0, 0};
                pg8::StaticOrder S; S.init(SEQ, DM, G, bx);
                { pg8::EpiResid<true, true> E{XB, XB, lmod + 2 * DM}; pg8::gemm_phase<pg8::EpiResid<true, true>, true>(wv, lds, g, S, E); } }
            SEAM(5);
        }
    }
    if (PM(10) && IN(ph)) { phase_final(wv, (const bf16_t*)(ws + WS_XB), args.out, args.fg); REDO(10, phase_final(wv, (const bf16_t*)(ws + WS_XB), args.out, args.fg)); }
    if (ECHO_MASK) { if ((ECHO_MASK >> 10) & 1) echo_acc += __builtin_amdgcn_s_memrealtime() - echo_prev;
        if (bx == 0) { const unsigned long long target_ = __builtin_amdgcn_s_memrealtime() + (unsigned long long)ECHO_K * echo_acc; while (__builtin_amdgcn_s_memrealtime() < target_) __builtin_amdgcn_s_sleep(32); } }
#undef IN
#undef PM
#undef SEAM
#undef REDO
}
constexpr int N_PHASES = 1 + 2 * 5 + 2 * 6 + 1;

extern "C" void kernel_launch(void* const* d_in, const int* in_sizes, int n_in, void* d_out, int out_size, void* d_ws, size_t ws_size, hipStream_t stream) {
    static int grid = 0;
    if (grid == 0) {
        if (n_in != 13 || in_sizes[0] != SEQ * DM || out_size != SEQ * DM || ws_size < WS_END) {
            fprintf(stderr, "kernel_launch: unexpected shapes / workspace (n_in %d, in0 %d, out %d, ws %zu, need %zu)\n", n_in, n_in > 0 ? in_sizes[0] : -1, out_size, ws_size, (size_t)WS_END);
            grid = -1; return; }
        int dev = 0, cus = 0, per_cu = 0;
        if (hipGetDevice(&dev) != hipSuccess || hipDeviceGetAttribute(&cus, hipDeviceAttributeMultiprocessorCount, dev) != hipSuccess) { grid = -1; return; }
        if (hipFuncSetAttribute((const void*)trunk_fwd, hipFuncAttributeMaxDynamicSharedMemorySize, LDS_BYTES) != hipSuccess) { fprintf(stderr, "kernel_launch: hipFuncSetAttribute failed\n"); grid = -1; return; }
        if (hipOccupancyMaxActiveBlocksPerMultiprocessor(&per_cu, (const void*)trunk_fwd, NTHR, LDS_BYTES) != hipSuccess || per_cu < 1) {
            fprintf(stderr, "kernel_launch: occupancy query reports %d workgroups per CU\n", per_cu); per_cu = 1; }
        (void)hipGetLastError();
        grid = cus;
        if (grid > 256) grid = 256;
    }
    if (grid < 0) return;
    (void)hipMemsetAsync((char*)d_ws + WS_CTL, 0, CTL_ZERO_BYTES, stream);
    Args a{};
    a.x = (const float*)d_in[0]; a.c = (const float*)d_in[1]; a.pos = (const int*)d_in[2]; a.norm_g = (const float*)d_in[3];
    a.mod_w = (const float*)d_in[4]; a.mod_b = (const float*)d_in[5]; a.pwi = (const float*)d_in[6]; a.pwg = (const float*)d_in[7];
    a.pls = (const float*)d_in[8]; a.pwo = (const float*)d_in[9]; a.awi = (const float*)d_in[10]; a.awo = (const float*)d_in[11]; a.fg = (const float*)d_in[12];
    a.out = (float*)d_out; a.ws = (unsigned char*)d_ws;
#if MK_ONE_LAUNCH
    a.ph_lo = 0; a.ph_hi = N_PHASES;
    hipLaunchKernelGGL(trunk_fwd, dim3(grid), dim3(NTHR), LDS_BYTES, stream, a);
#else
    for (int p = 0; p < N_PHASES; ++p) { a.ph_lo = p; a.ph_hi = p + 1; hipLaunchKernelGGL(trunk_fwd, dim3(grid), dim3(NTHR), LDS_BYTES, stream, a); }
#endif
}
```

```cpp
#include <hip/hip_runtime.h>
#include <cstdio>
#include <cstdint>
#include <cmath>

#ifndef MK_ONE_LAUNCH
#define MK_ONE_LAUNCH 1
#endif

#define LAS __attribute__((address_space(3)))
#define GAS __attribute__((address_space(1)))
typedef unsigned short bf16_t;
typedef short bf16x8 __attribute__((ext_vector_type(8)));
typedef short s16x4 __attribute__((ext_vector_type(4)));
typedef float f32x4 __attribute__((ext_vector_type(4)));
typedef float f32x2 __attribute__((ext_vector_type(2)));
typedef float f32x16 __attribute__((ext_vector_type(16)));
typedef unsigned u32x4 __attribute__((ext_vector_type(4)));
typedef unsigned u32x2 __attribute__((ext_vector_type(2)));

constexpr int DM = 2048, SEQ = 8192, NHEAD = 16, HD = 128, IDXH = 16, IDXD = 64;
constexpr int POOL_IN = 4096, ATTN_IN = 9296, ATTN_INP = 9472  ;
constexpr int TOPK = 256;
constexpr float EPS = 1e-6f;

constexpr size_t MiB = 1u << 20;
constexpr size_t WS_CTL = 0, CTL_ZERO_BYTES = 64 * 1024;
constexpr size_t WS_MOD = 1 * MiB;
constexpr size_t WS_TAB = 2 * MiB;
constexpr size_t WS_WPI = 4 * MiB;
constexpr size_t WS_WPG = 36 * MiB;
constexpr size_t WS_WPO = 40 * MiB;
constexpr size_t WS_WAI = 56 * MiB;
constexpr size_t WS_WAO = 130 * MiB;
constexpr size_t WS_HU = 146 * MiB;
constexpr size_t WS_L = 178 * MiB;
constexpr size_t WS_VG = WS_L;
constexpr size_t WS_PL = WS_L + 64 * MiB;
constexpr size_t WS_Q = WS_L, WS_K = WS_L + 32 * MiB, WS_V = WS_L + 64 * MiB;
constexpr size_t WS_GATE = WS_L + 96 * MiB;
constexpr size_t WS_QI = WS_L + 128 * MiB;
constexpr size_t WS_KI = WS_L + 144 * MiB;
constexpr size_t WS_WI = WS_L + 145 * MiB;
constexpr size_t WS_MASK = WS_L + 146 * MiB;
constexpr size_t WS_SC = WS_L + 154 * MiB;
constexpr size_t WS_XB = WS_SC + 139 * MiB;
constexpr size_t WS_END = WS_XB + 32 * MiB;

__device__ __forceinline__ unsigned cvt_pk_bf16(float lo, float hi) { unsigned r; asm volatile("v_cvt_pk_bf16_f32 %0, %1, %2" : "=v"(r) : "v"(lo), "v"(hi)); return r; }
__device__ __forceinline__ unsigned f2bf(float f) { unsigned u = __builtin_bit_cast(unsigned, f); return (u + 0x7fffu + ((u >> 16) & 1u)) >> 16; }
__device__ __forceinline__ unsigned pk2(float lo, float hi) { return f2bf(lo) | (f2bf(hi) << 16); }
__device__ __forceinline__ float bf2f(unsigned short b) { return __builtin_bit_cast(float, (unsigned)b << 16); }
__device__ __forceinline__ float fast_sigmoid(float x) { return __builtin_amdgcn_rcpf(1.0f + __builtin_amdgcn_exp2f(-1.4426950408889634f * x)); }
__device__ __forceinline__ float silu_f(float x) { return x * fast_sigmoid(x); }
template <int X> __device__ __forceinline__ float swz_xor(float v) {
    return __builtin_bit_cast(float, __builtin_amdgcn_ds_swizzle(__builtin_bit_cast(int, v), (X << 10) | 0x1f)); }
__device__ __forceinline__ float wave_sum(float v) {
    v += swz_xor<1>(v); v += swz_xor<2>(v); v += swz_xor<4>(v); v += swz_xor<8>(v); v += swz_xor<16>(v);
    const auto rr = __builtin_amdgcn_permlane32_swap(__builtin_bit_cast(unsigned, v), __builtin_bit_cast(unsigned, v), false, false);
    const unsigned r0 = rr[0], r1 = rr[1];
    return __builtin_bit_cast(float, r0) + __builtin_bit_cast(float, r1);
}
__device__ __forceinline__ int opaque_tid(int wv) { int t; asm volatile("v_mbcnt_lo_u32_b32 %0, -1, 0\n\tv_mbcnt_hi_u32_b32 %0, -1, %0\n\tv_lshl_add_u32 %0, %1, 6, %0" : "=&v"(t) : "s"(wv)); return t; }
#define LDS_WAIT() asm volatile("s_waitcnt lgkmcnt(0)" ::: "memory")
#define VM_WAIT() asm volatile("s_waitcnt vmcnt(0)" ::: "memory")

__device__ __forceinline__ void unpack8(const u32x4 w, f32x4& a, f32x4& b) {
    const unsigned w0 = w.x, w1 = w.y, w2 = w.z, w3 = w.w;
    a = (f32x4){__builtin_bit_cast(float, w0 << 16), __builtin_bit_cast(float, w0 & 0xffff0000u), __builtin_bit_cast(float, w1 << 16), __builtin_bit_cast(float, w1 & 0xffff0000u)};
    b = (f32x4){__builtin_bit_cast(float, w2 << 16), __builtin_bit_cast(float, w2 & 0xffff0000u), __builtin_bit_cast(float, w3 << 16), __builtin_bit_cast(float, w3 & 0xffff0000u)};
}
__device__ __forceinline__ u32x4 pack8(const f32x4 a, const f32x4 b) { u32x4 w; w.x = cvt_pk_bf16(a[0], a[1]); w.y = cvt_pk_bf16(a[2], a[3]); w.z = cvt_pk_bf16(b[0], b[1]); w.w = cvt_pk_bf16(b[2], b[3]); return w; }

namespace pg8 {
constexpr int BM = 256, BK = 64, HALF = 128, HTB = HALF * BK * 2, STAGE_BYTES = 8 * HTB, NXCD = 8, WGM = 8;
__host__ __device__ __forceinline__ int lds_byte(int r, int c) { const int st = (r >> 4) * 2 + (c >> 5), rr = r & 15, cc = c & 31, ob = rr * 64 + cc * 2; return st * 1024 + (ob ^ (((ob >> 9) & 1) << 5)); }
__host__ __device__ __forceinline__ void stage_rc(int b, int& R, int& C) { const int st = b / 1024, sb = b % 1024, swz = sb ^ (((sb >> 9) & 1) << 5); R = (st >> 1) * 16 + swz / 64; C = (st & 1) * 32 + (swz % 64) / 2; }
__host__ __device__ __forceinline__ int perm32(int rho) { const int n = rho >> 4, i = rho & 15; return 8 * (i >> 2) + 4 * n + (i & 3); }

struct Unit { int pm, pn; };
struct Gemm { const bf16_t* A; const bf16_t* Bt; int M, N, K, lda, ldb, agsh, agstride; };

struct StaticOrder {
    int nM, nN, nwg, G, c;
    __host__ __device__ void init(int M, int N, int G_, int c_) { nM = M / BM; nN = N / BM; nwg = nM * nN; G = G_; c = c_; }
    __host__ __device__ bool next(int i, Unit& u) const {
        const long L = (long)i * G + c; if (L >= nwg) return false;
        int wgid = (int)L; { const int q = nwg / NXCD, r = nwg % NXCD, xcd = wgid % NXCD, off = wgid / NXCD; wgid = (xcd < r ? xcd * (q + 1) : r * (q + 1) + (xcd - r) * q) + off; }
        const int nig = WGM * nN, gid = wgid / nig, fm = gid * WGM, gsz = (nM - fm) < WGM ? (nM - fm) : WGM;
        u.pm = fm + ((wgid % nig) % gsz); u.pn = (wgid % nig) / gsz; return true;
    }
};

template <class Epi, bool ALIGN_EPI>
__device__ __forceinline__ void gemm_phase(int wv, LAS unsigned char* lds, const Gemm g, const StaticOrder& S, const Epi& E) {
    const int tid = opaque_tid(wv), wid = __builtin_amdgcn_readfirstlane(tid >> 6), lane = tid & 63, wr = wid >> 2, wc = wid & 3, fr = lane & 15, fq = lane >> 4;
    const int K = g.K, nt = K / BK;
    unsigned voffA[2], voffB[2];
#pragma unroll
    for (int i = 0; i < 2; ++i) { int R, C; stage_rc(tid * 16 + i * 8192, R, C); const int Rb = Epi::PERM ? ((R & ~31) + perm32(R & 31)) : R;
        voffA[i] = (unsigned)(R * g.lda + C) * 2u; voffB[i] = (unsigned)(Rb * g.ldb + C) * 2u; }
    const size_t kstep = (size_t)(BK * 2);
    const size_t hstepA = (size_t)HALF * g.lda * 2, hstepB = (size_t)HALF * g.ldb * 2;
    const size_t tstepA = 2 * hstepA, tstepB = 2 * hstepB;
    const unsigned ldsw = (unsigned)wid * 1024u;
    const int aoff = lds_byte(wr * 64 + fr, fq * 8), boff = lds_byte(wc * 32 + fr, fq * 8);
#define PG8_SA(b, h) (((b) * 2 + (h)) * HTB)
#define PG8_SB(b, h) ((4 + (b) * 2 + (h)) * HTB)
#define PG8_STAGE(bufoff, gbase, voff) do { _Pragma("unroll") for (int _i = 0; _i < 2; ++_i) \
        __builtin_amdgcn_global_load_lds((const unsigned*)((const char*)(gbase) + (voff)[_i]), (LAS unsigned*)(lds + (bufoff) + ldsw + _i * 8192), 16, 0, 0); } while (0)
#define PG8_LDA(dst, b, h) do { _Pragma("unroll") for (int m = 0; m < 4; ++m) _Pragma("unroll") for (int k = 0; k < 2; ++k) dst[m][k] = *(const LAS bf16x8*)(lds + PG8_SA(b, h) + aoff + m * 2048 + k * 1024); } while (0)
#define PG8_LDB(dst, b, h) do { _Pragma("unroll") for (int n = 0; n < 2; ++n) _Pragma("unroll") for (int k = 0; k < 2; ++k) dst[n][k] = *(const LAS bf16x8*)(lds + PG8_SB(b, h) + boff + n * 2048 + k * 1024); } while (0)
#define PG8_MMA(ai, bj, At, Bt) do { __builtin_amdgcn_s_setprio(1); _Pragma("unroll") for (int m = 0; m < 4; ++m) _Pragma("unroll") for (int n = 0; n < 2; ++n) _Pragma("unroll") for (int k = 0; k < 2; ++k) \
        acc[ai][bj][m][n] = __builtin_amdgcn_mfma_f32_16x16x32_bf16(Bt[n][k], At[m][k], acc[ai][bj][m][n], 0, 0, 0); __builtin_amdgcn_s_setprio(0); } while (0)
#define PG8_WAIT_V(n) asm volatile("s_waitcnt vmcnt(" #n ")" ::: "memory")
#define PG8_WAIT_L(n) asm volatile("s_waitcnt lgkmcnt(" #n ")" ::: "memory")
#define PG8_BAR __builtin_amdgcn_s_barrier()
#define PG8_SCHED __builtin_amdgcn_sched_barrier(0)
#define PG8_AOFF(u) ((size_t)(u).pm * tstepA + (size_t)(((u).pn >> g.agsh) * g.agstride) * 2)
    Unit cur, nxt; int ui = 0;
    if (!S.next(0, cur)) return;
    f32x4 acc[2][2][4][2];
#pragma unroll
    for (int a = 0; a < 2; ++a)
#pragma unroll
        for (int b = 0; b < 2; ++b)
#pragma unroll
            for (int m = 0; m < 4; ++m)
#pragma unroll
                for (int n = 0; n < 2; ++n) acc[a][b][m][n] = (f32x4){0.f, 0.f, 0.f, 0.f};
    bf16x8 At[4][2], B0[2][2], B1[2][2];
    const char* cA = (const char*)g.A + PG8_AOFF(cur); const char* cB = (const char*)g.Bt + (size_t)cur.pn * tstepB;
    PG8_STAGE(PG8_SB(0, 0), cB, voffB); PG8_STAGE(PG8_SB(0, 1), cB + hstepB, voffB); PG8_STAGE(PG8_SA(0, 0), cA, voffA); PG8_STAGE(PG8_SA(0, 1), cA + hstepA, voffA);
    if (wr == 1) PG8_BAR;
    PG8_WAIT_V(2); PG8_BAR;
    PG8_STAGE(PG8_SB(1, 0), cB + kstep, voffB); PG8_STAGE(PG8_SA(1, 0), cA + kstep, voffA); PG8_STAGE(PG8_SB(1, 1), cB + hstepB + kstep, voffB);
    PG8_WAIT_V(6); PG8_BAR;
    for (;;) {
        const bool has_next = S.next(ui + 1, nxt);
        const char* nA = has_next ? (const char*)g.A + PG8_AOFF(nxt) : cA; const char* nB = has_next ? (const char*)g.Bt + (size_t)nxt.pn * tstepB : cB;
        for (int t = 0; t < nt; t += 2) {
            const bool last = (t == nt - 2);
            const char* a1 = cA + (size_t)(t + 1) * kstep;
            const char* a2 = last ? nA : cA + (size_t)(t + 2) * kstep; const char* b2 = last ? nB : cB + (size_t)(t + 2) * kstep;
            const char* a3 = a2 + kstep; const char* b3 = b2 + kstep;
            PG8_LDB(B0, 0, 0); PG8_LDB(B1, 0, 1); PG8_SCHED; PG8_LDA(At, 0, 0); PG8_STAGE(PG8_SA(1, 1), a1 + hstepA, voffA);
            PG8_WAIT_V(8); PG8_WAIT_L(0); PG8_BAR; PG8_MMA(0, 0, At, B0); PG8_MMA(0, 1, At, B1); PG8_BAR; PG8_SCHED;
            PG8_LDA(At, 0, 1); PG8_STAGE(PG8_SB(0, 0), b2, voffB); PG8_STAGE(PG8_SB(0, 1), b2 + hstepB, voffB); PG8_STAGE(PG8_SA(0, 0), a2, voffA);
            PG8_WAIT_V(8); PG8_WAIT_L(0); PG8_BAR; PG8_MMA(1, 0, At, B0); PG8_MMA(1, 1, At, B1); PG8_BAR; PG8_SCHED;
            PG8_LDB(B0, 1, 0); PG8_LDB(B1, 1, 1); PG8_SCHED; PG8_LDA(At, 1, 0); PG8_STAGE(PG8_SA(0, 1), a2 + hstepA, voffA);
            PG8_WAIT_V(8); PG8_WAIT_L(0); PG8_BAR; PG8_MMA(0, 0, At, B0); PG8_MMA(0, 1, At, B1); PG8_BAR; PG8_SCHED;
            PG8_LDA(At, 1, 1); PG8_STAGE(PG8_SB(1, 0), b3, voffB); PG8_STAGE(PG8_SB(1, 1), b3 + hstepB, voffB); PG8_STAGE(PG8_SA(1, 0), a3, voffA);
            PG8_WAIT_V(8); PG8_WAIT_L(0); PG8_BAR; PG8_MMA(1, 0, At, B0); PG8_MMA(1, 1, At, B1); PG8_BAR; PG8_SCHED;
        }
        if constexpr (ALIGN_EPI) { if (wr == 0) PG8_BAR; }
        E(acc, cur, wr, wc, fr, fq);
        if (!has_next) break;
#pragma unroll
        for (int a = 0; a < 2; ++a)
#pragma unroll
            for (int b = 0; b < 2; ++b)
#pragma unroll
                for (int m = 0; m < 4; ++m)
#pragma unroll
                    for (int n = 0; n < 2; ++n) acc[a][b][m][n] = (f32x4){0.f, 0.f, 0.f, 0.f};
        cur = nxt; cA = nA; cB = nB; ++ui;
        if constexpr (ALIGN_EPI) { if (wr == 1) PG8_BAR; }
    }
    PG8_WAIT_V(0);
    if constexpr (!ALIGN_EPI) { if (wr == 0) PG8_BAR; }
    PG8_BAR;
#undef PG8_SA
#undef PG8_SB
#undef PG8_STAGE
#undef PG8_LDA
#undef PG8_LDB
#undef PG8_MMA
#undef PG8_WAIT_V
#undef PG8_WAIT_L
#undef PG8_BAR
#undef PG8_SCHED
#undef PG8_AOFF
}

struct EpiBf16 {
    static constexpr bool PERM = true;
    bf16_t* O; int ldc;
    __device__ __forceinline__ void operator()(const f32x4 (&acc)[2][2][4][2], const Unit& u, int wr, int wc, int fr, int fq) const {
        const int row0 = u.pm * BM + wr * 64 + fr; const int col0 = u.pn * BM + wc * 32 + 8 * fq;
#pragma unroll
        for (int ai = 0; ai < 2; ++ai)
#pragma unroll
            for (int m = 0; m < 4; ++m) { bf16_t* rowp = O + (size_t)(row0 + ai * HALF + m * 16) * ldc + col0;
#pragma unroll
                for (int bj = 0; bj < 2; ++bj) { const f32x4 v0 = acc[ai][bj][m][0], v1 = acc[ai][bj][m][1];
                    u32x4 w; w.x = cvt_pk_bf16(v0[0], v0[1]); w.y = cvt_pk_bf16(v0[2], v0[3]); w.z = cvt_pk_bf16(v1[0], v1[1]); w.w = cvt_pk_bf16(v1[2], v1[3]);
                    *(u32x4*)(rowp + bj * HALF) = w; } }
    }
};
struct EpiPoolGrp {
    static constexpr bool PERM = true;
    bf16_t* U; const bf16_t* VG; const float* ls;
    __device__ __forceinline__ void operator()(const f32x4 (&acc)[2][2][4][2], const Unit& u, int wr, int wc, int fr, int fq) const {
        const int row0 = u.pm * BM + wr * 64 + fr; const int col0 = u.pn * BM + wc * 32 + 8 * fq;
        f32x4 lv[2][2];
#pragma unroll
        for (int bj = 0; bj < 2; ++bj)
#pragma unroll
            for (int n = 0; n < 2; ++n) lv[bj][n] = *(const f32x4*)(ls + col0 + bj * HALF + 4 * n);
#pragma unroll
        for (int ai = 0; ai < 2; ++ai)
#pragma unroll
            for (int m = 0; m < 4; ++m) { const size_t row = (size_t)(row0 + ai * HALF + m * 16);
#pragma unroll
                for (int bj = 0; bj < 2; ++bj) {
                    const u32x4 gw = *(const u32x4*)(VG + row * POOL_IN + DM + col0 + bj * HALF);
                    f32x4 v0 = acc[ai][bj][m][0] * lv[bj][0], v1 = acc[ai][bj][m][1] * lv[bj][1];
                    float g[8];
#pragma unroll
                    for (int e = 0; e < 4; ++e) { g[2 * e] = __builtin_bit_cast(float, gw[e] << 16); g[2 * e + 1] = __builtin_bit_cast(float, gw[e] & 0xffff0000u); }
#pragma unroll
                    for (int e = 0; e < 4; ++e) { v0[e] *= silu_f(g[e]); v1[e] *= silu_f(g[4 + e]); }
                    u32x4 w; w.x = cvt_pk_bf16(v0[0], v0[1]); w.y = cvt_pk_bf16(v0[2], v0[3]); w.z = cvt_pk_bf16(v1[0], v1[1]); w.w = cvt_pk_bf16(v1[2], v1[3]);
                    *(u32x4*)(U + row * DM + col0 + bj * HALF) = w; } }
    }
};
template <bool IN_BF16, bool OUT_BF16> struct EpiResid {
    static constexpr bool PERM = true;
    const void* xin; void* xout; const float* gmod;
    __device__ __forceinline__ void operator()(const f32x4 (&acc)[2][2][4][2], const Unit& u, int wr, int wc, int fr, int fq) const {
        const int row0 = u.pm * BM + wr * 64 + fr; const int col0 = u.pn * BM + wc * 32 + 8 * fq;
        f32x4 gv[2][2];
#pragma unroll
        for (int bj = 0; bj < 2; ++bj)
#pragma unroll
            for (int n = 0; n < 2; ++n) { const float* gp = gmod + col0 + bj * HALF + 4 * n;
                gv[bj][n] = ((*(const f32x4*)gp + *(const f32x4*)(gp + 6144)) + *(const f32x4*)(gp + 2 * 6144)) + *(const f32x4*)(gp + 3 * 6144); }
#pragma unroll
        for (int ai = 0; ai < 2; ++ai)
#pragma unroll
            for (int m = 0; m < 4; ++m) { const size_t off = (size_t)(row0 + ai * HALF + m * 16) * DM + col0;
#pragma unroll
                for (int bj = 0; bj < 2; ++bj) {
                    f32x4 b0, b1;
                    if (IN_BF16) { const u32x4 w = *(const u32x4*)((const bf16_t*)xin + off + bj * HALF);
                        const unsigned w0 = w.x, w1 = w.y, w2 = w.z, w3 = w.w;
                        b0 = (f32x4){__builtin_bit_cast(float, w0 << 16), __builtin_bit_cast(float, w0 & 0xffff0000u), __builtin_bit_cast(float, w1 << 16), __builtin_bit_cast(float, w1 & 0xffff0000u)};
                        b1 = (f32x4){__builtin_bit_cast(float, w2 << 16), __builtin_bit_cast(float, w2 & 0xffff0000u), __builtin_bit_cast(float, w3 << 16), __builtin_bit_cast(float, w3 & 0xffff0000u)}; }
                    else { b0 = *(const f32x4*)((const float*)xin + off + bj * HALF); b1 = *(const f32x4*)((const float*)xin + off + bj * HALF + 4); }
                    const f32x4 y0 = b0 + gv[bj][0] * acc[ai][bj][m][0], y1 = b1 + gv[bj][1] * acc[ai][bj][m][1];
                    if (OUT_BF16) { u32x4 w; w.x = cvt_pk_bf16(y0[0], y0[1]); w.y = cvt_pk_bf16(y0[2], y0[3]); w.z = cvt_pk_bf16(y1[0], y1[1]); w.w = cvt_pk_bf16(y1[2], y1[3]);
                        *(u32x4*)((bf16_t*)xout + off + bj * HALF) = w; }
                    else { *(f32x4*)((float*)xout + off + bj * HALF) = y0; *(f32x4*)((float*)xout + off + bj * HALF + 4) = y1; } } }
    }
};
struct EpiAttnIn {
    static constexpr bool PERM = true;
    unsigned char* ws; const int* pos;
    __device__ __forceinline__ void operator()(const f32x4 (&acc)[2][2][4][2], const Unit& u, int wr, int wc, int fr, int fq) const {
        const int row0 = u.pm * BM + wr * 64 + fr; const int pn = u.pn;
        bf16_t* const Qh = (bf16_t*)(ws + WS_Q); bf16_t* const SG = (bf16_t*)(ws + WS_GATE); bf16_t* const QI = (bf16_t*)(ws + WS_QI); bf16_t* const KI = (bf16_t*)(ws + WS_KI); float* const WI = (float*)(ws + WS_WI);
        const float* const cosq = (const float*)(ws + WS_TAB); const float* const sinq = cosq + SEQ * 16; const float* const cosi = sinq + SEQ * 16; const float* const sini = cosi + SEQ * 8;
#pragma unroll
        for (int ai = 0; ai < 2; ++ai)
#pragma unroll
            for (int m = 0; m < 4; ++m) {
                const int row = row0 + ai * HALF + m * 16;
                if (pn < 24) {
                    bf16_t* base = Qh + (size_t)(pn >> 3) * ((size_t)SEQ * DM);
                    const bool rope = (pn < 16) && (wc == 0);
                    f32x4 cs[2] = {{1.f, 1.f, 1.f, 1.f}, {1.f, 1.f, 1.f, 1.f}}, sn[2] = {{0.f, 0.f, 0.f, 0.f}, {0.f, 0.f, 0.f, 0.f}};
                    if (rope) { const float* cp = cosq + (size_t)row * 16 + 8 * (fq & 1); const float* sp = sinq + (size_t)row * 16 + 8 * (fq & 1);
                        cs[0] = *(const f32x4*)cp; cs[1] = *(const f32x4*)(cp + 4); sn[0] = *(const f32x4*)sp; sn[1] = *(const f32x4*)(sp + 4); }
#pragma unroll
                    for (int bj = 0; bj < 2; ++bj) { const int head = 2 * (pn & 7) + bj;
                        f32x4 v[2] = {acc[ai][bj][m][0], acc[ai][bj][m][1]};
                        if (rope) {
#pragma unroll
                            for (int n = 0; n < 2; ++n) { f32x4 pr;
#pragma unroll
                                for (int e = 0; e < 4; ++e) { const float ve = v[n][e];
                                    const auto rr = __builtin_amdgcn_permlane32_swap(__builtin_bit_cast(unsigned, ve), __builtin_bit_cast(unsigned, ve), false, false);
                                    const unsigned pu = (fq < 2) ? rr[1] : rr[0]; pr[e] = __builtin_bit_cast(float, pu); }
                                v[n] = (fq < 2) ? (v[n] * cs[n] - pr * sn[n]) : (v[n] * cs[n] + pr * sn[n]); } }
                        *(u32x4*)(base + ((size_t)head * SEQ + row) * HD + 32 * wc + 8 * fq) = pack8(v[0], v[1]); }
                } else if (pn < 32) {
#pragma unroll
                    for (int bj = 0; bj < 2; ++bj) { f32x4 v0 = acc[ai][bj][m][0], v1 = acc[ai][bj][m][1];
#pragma unroll
                        for (int e = 0; e < 4; ++e) { v0[e] = silu_f(v0[e]); v1[e] = silu_f(v1[e]); }
                        *(u32x4*)(SG + (size_t)row * DM + (pn - 24) * BM + bj * HALF + 32 * wc + 8 * fq) = pack8(v0, v1); }
                } else {
                    const bool isq = pn < 36;
                    const bool rope = ((wc & 1) == 0) && (isq || wc == 0);
                    f32x4 cs[2], sn[2];
                    { const float* cp = cosi + (size_t)row * 8; const float* sp = sini + (size_t)row * 8;
                      cs[0] = *(const f32x4*)cp; cs[1] = *(const f32x4*)(cp + 4); sn[0] = *(const f32x4*)sp; sn[1] = *(const f32x4*)(sp + 4); }
#pragma unroll
                    for (int bj = 0; bj < 2; ++bj) {
                        if (!isq && bj == 1) continue;
                        f32x4 v[2] = {acc[ai][bj][m][0], acc[ai][bj][m][1]};
                        if (rope) {
#pragma unroll
                            for (int n = 0; n < 2; ++n) { f32x4 pr;
#pragma unroll
                                for (int e = 0; e < 4; ++e) pr[e] = swz_xor<16>(v[n][e]);
                                const f32x4 ro = (fq == 0) ? (v[n] * cs[n] - pr * sn[n]) : (v[n] * cs[n] + pr * sn[n]);
                                v[n] = (fq < 2) ? ro : v[n]; } }
                        const int cl = bj * HALF + 32 * wc + 8 * fq;
                        if (isq) *(u32x4*)(QI + (size_t)row * 1024 + (pn - 32) * BM + cl) = pack8(v[0], v[1]);
                        else if (cl < 64) *(u32x4*)(KI + (size_t)row * 64 + cl) = pack8(v[0], v[1]);
                        else if (cl < 80) { *(f32x4*)(WI + (size_t)row * 16 + (cl - 64)) = v[0]; *(f32x4*)(WI + (size_t)row * 16 + (cl - 64) + 4) = v[1]; }
                    }
                }
                asm volatile("" ::: "memory");
            }
    }
};
}

namespace att {
constexpr int D = 128, NW = 8, QBLK = 32, KVBLK = 64, QB = NW * QBLK;
constexpr int KROWB = 272;
constexpr int SHM_V = KVBLK * D * 2, SHM_K = KVBLK * KROWB;
constexpr int QROWB = 272;
constexpr int Q_OFF = 2 * SHM_V + 2 * SHM_K + NW * 64 * 4;
constexpr int LDS_BYTES = Q_OFF + QB * QROWB;
constexpr float SCALE = 0.08838834764831845f;
constexpr float THR = 8.f;
#define KSWZ(row, colB) ((row) * KROWB + (colB))
#define SBAR() __builtin_amdgcn_sched_barrier(0)
__device__ __forceinline__ int v_st(int k, int c) { const int kk = (k & ~0xC) | ((k & 4) << 1) | ((k & 8) >> 1); return ((kk >> 3) * 4 + (c >> 5)) * 512 + ((kk & 7) * 32 + (c & 31)) * 2; }
__device__ __forceinline__ int v_rd_base(int lane) { return ((lane & 3) << 3) | (((lane >> 2) & 3) << 6) | (((lane >> 4) & 1) << 5) | (((lane >> 5) & 1) << 8); }
constexpr int v_rd_off(int d0, int ks, int half) { return d0 * 512 + ks * 4096 + half * 2048; }
__device__ __forceinline__ int crow(int r, int hi) { return (r & 3) + 8 * (r >> 2) + 4 * hi; }
__device__ __forceinline__ unsigned cvtpk(float lo, float hi) { unsigned r; asm volatile("v_cvt_pk_bf16_f32 %0, %1, %2" : "=v"(r) : "v"(lo), "v"(hi)); return r; }
__device__ __forceinline__ bf16x8 load8(const bf16_t* p) { return *reinterpret_cast<const bf16x8*>(p); }
__device__ __forceinline__ float mask_and(float v, unsigned mlo, unsigned mhi, int r, int p) {
    const int pos = 16 * (r & 1) + 2 * (r >> 2) + 8 * p;
    const unsigned w = (r & 2) ? mhi : mlo;
    const int bits = __builtin_amdgcn_sbfe((int)w, pos, 1);
    return __builtin_bit_cast(float, __builtin_bit_cast(unsigned, v) & (unsigned)bits);
}
__device__ __forceinline__ void partialSM(f32x16& p0, f32x16& p1, float& m_reg, float& mn, float& alpha, unsigned mlo, unsigned mhi) {
    float pmax = p0[0];
#pragma unroll
    for (int r = 1; r < 16; ++r) pmax = fmaxf(pmax, p0[r]);
#pragma unroll
    for (int r = 0; r < 16; ++r) pmax = fmaxf(pmax, p1[r]);
    { auto rr = __builtin_amdgcn_permlane32_swap(__float_as_uint(pmax), __float_as_uint(pmax), false, false);
      pmax = fmaxf(__uint_as_float(rr[0]), __uint_as_float(rr[1])); }
    constexpr float C2 = 1.4426950408889634f * SCALE;
    if (__builtin_expect(__all((pmax - m_reg) * SCALE <= THR), 1)) { mn = m_reg; alpha = 1.f; }
    else { mn = fmaxf(m_reg, pmax); alpha = __builtin_amdgcn_exp2f((m_reg - mn) * C2); m_reg = mn; }
    const float mnL = -mn * C2;
#pragma unroll
    for (int r = 0; r < 16; ++r) p0[r] = fmaf(p0[r], C2, mnL);
#pragma unroll
    for (int r = 0; r < 16; ++r) p1[r] = fmaf(p1[r], C2, mnL);
#pragma unroll
    for (int r = 0; r < 16; ++r) p0[r] = mask_and(__builtin_amdgcn_exp2f(p0[r]), mlo, mhi, r, 0);
}
__device__ __forceinline__ void finishSM(f32x16& p0, f32x16& p1, float alpha, float& l_reg, bf16x8& pa0, bf16x8& pa1, bf16x8& pa2, bf16x8& pa3, unsigned mlo, unsigned mhi) {
#pragma unroll
    for (int r = 0; r < 16; ++r) p1[r] = mask_and(__builtin_amdgcn_exp2f(p1[r]), mlo, mhi, r, 1);
    float ps = 0;
#pragma unroll
    for (int r = 0; r < 16; ++r) ps += p0[r];
#pragma unroll
    for (int r = 0; r < 16; ++r) ps += p1[r];
    { auto rr = __builtin_amdgcn_permlane32_swap(__float_as_uint(ps), __float_as_uint(ps), false, false);
      ps = __uint_as_float(rr[0]) + __uint_as_float(rr[1]); }
    l_reg = l_reg * alpha + ps;
#define PK4(P, B_, OUT) do { unsigned a0 = cvtpk(P[B_+0], P[B_+1]), a1 = cvtpk(P[B_+2], P[B_+3]);                          \
        unsigned b0 = cvtpk(P[B_+4], P[B_+5]), b1 = cvtpk(P[B_+6], P[B_+7]);                                             \
        auto r0 = __builtin_amdgcn_permlane32_swap(a0, b0, false, false); auto r1 = __builtin_amdgcn_permlane32_swap(a1, b1, false, false); \
        u32x4 w = {r0[0], r1[0], r0[1], r1[1]}; OUT = *reinterpret_cast<bf16x8*>(&w); } while (0)
    PK4(p0, 0, pa0); PK4(p0, 8, pa1); PK4(p1, 0, pa2); PK4(p1, 8, pa3);
#undef PK4
}
template <int KB>
__device__ __forceinline__ void qkt(f32x16& p0, f32x16& p1, const char* K_lds, int r32, int hi, const char* qa  ) {
    p0 = f32x16{}; p1 = f32x16{};
    const char* kb = K_lds + KB * SHM_K + r32 * KROWB + hi * 16;
#pragma unroll
    for (int d0 = 0; d0 < 8; ++d0) { const char* a = kb + d0 * 32;
        bf16x8 b0 = *reinterpret_cast<const bf16x8*>(a);
        bf16x8 b1 = *reinterpret_cast<const bf16x8*>(a + 32 * KROWB);
        const bf16x8 qf = *reinterpret_cast<const bf16x8*>(qa + d0 * 32);
        p0 = __builtin_amdgcn_mfma_f32_32x32x16_bf16(b0, qf, p0, 0, 0, 0);
        p1 = __builtin_amdgcn_mfma_f32_32x32x16_bf16(b1, qf, p1, 0, 0, 0); }
}
template <int VB>
__device__ __forceinline__ void pv_tile(f32x16* o, int vb0, bf16x8 pa0, bf16x8 pa1, bf16x8 pa2, bf16x8 pa3) {
#define TRRD(dst, off) asm volatile("ds_read_b64_tr_b16 %0, %1 offset:%2" : "=&v"(dst) : "v"(vb0), "i"(off) : "memory")
#define PV_D0(d0) do { s16x4 l0, l1, l2, l3, h0, h1, h2, h3; constexpr int b_ = VB * SHM_V + v_rd_off(d0, 0, 0); \
        TRRD(l0, b_); TRRD(h0, b_ + 2048); TRRD(l1, b_ + 4096); TRRD(h1, b_ + 6144); TRRD(l2, b_ + 8192); TRRD(h2, b_ + 10240); TRRD(l3, b_ + 12288); TRRD(h3, b_ + 14336); \
        asm volatile("s_waitcnt lgkmcnt(0)" ::: "memory"); SBAR();   \
        o[d0] = __builtin_amdgcn_mfma_f32_32x32x16_bf16(pa0, (bf16x8){l0[0], l0[1], l0[2], l0[3], h0[0], h0[1], h0[2], h0[3]}, o[d0], 0, 0, 0);   \
        o[d0] = __builtin_amdgcn_mfma_f32_32x32x16_bf16(pa1, (bf16x8){l1[0], l1[1], l1[2], l1[3], h1[0], h1[1], h1[2], h1[3]}, o[d0], 0, 0, 0);   \
        o[d0] = __builtin_amdgcn_mfma_f32_32x32x16_bf16(pa2, (bf16x8){l2[0], l2[1], l2[2], l2[3], h2[0], h2[1], h2[2], h2[3]}, o[d0], 0, 0, 0);   \
        o[d0] = __builtin_amdgcn_mfma_f32_32x32x16_bf16(pa3, (bf16x8){l3[0], l3[1], l3[2], l3[3], h3[0], h3[1], h3[2], h3[3]}, o[d0], 0, 0, 0); } while (0)
    PV_D0(0); PV_D0(1); PV_D0(2); PV_D0(3);
#undef PV_D0
#undef TRRD
}
struct BlockRef { const bf16_t* Q; const bf16_t* K; const bf16_t* V; bf16_t* O; const bf16_t* G; const unsigned long long* M; int P0; };
struct Seam { bf16x8 st_v0, st_v1, st_k0, st_k1; };
#define ROW(p, k0, rr) ((p) + (size_t)((k0) + (rr)) * D + sc)
#define VMW() asm volatile("s_waitcnt vmcnt(0)" ::: "memory")
#define VMWN(n) asm volatile("s_waitcnt vmcnt(%0)" :: "i"(n) : "memory")
#define SLOAD_H(Kp, Vp, k0) do { S.st_v0 = load8(ROW(Vp, k0, sr)); S.st_v1 = load8(ROW(Vp, k0, 32 + sr));              \
                         S.st_k0 = load8(ROW(Kp, k0, sr)); S.st_k1 = load8(ROW(Kp, k0, 32 + sr)); } while (0)
#define SWRITE_HK(bf) do { *(bf16x8*)(K_lds + (bf) * SHM_K + kws) = S.st_k0; *(bf16x8*)(K_lds + (bf) * SHM_K + kws + 32 * KROWB) = S.st_k1; } while (0)
#define SWRITE_HV(bf) do { *(bf16x8*)(V_lds + (bf) * SHM_V + vst0) = S.st_v0; *(bf16x8*)(V_lds + (bf) * SHM_V + vst1) = S.st_v1; } while (0)
#define SWRITE_H(bf) do { SWRITE_HV(bf); SWRITE_HK(bf); } while (0)
__device__ __forceinline__ void attn_prime(int wv, const BlockRef& cur, char* lds, Seam& S) {
    const int tid = opaque_tid(wv);
    const int sr = tid >> 4, sc = (tid & 15) * 8, kws = KSWZ(sr, sc * 2); char* K_lds = lds + 2 * SHM_V;
    SLOAD_H(cur.K, cur.V, 0); VMW(); SWRITE_HK(0);
    __syncthreads();
}
__device__ __forceinline__ void attn_block(int wv, const BlockRef& cur, const BlockRef& nxt, char* lds, Seam& S) {
    const int tid = opaque_tid(wv), wid = __builtin_amdgcn_readfirstlane(tid >> 6), lane = tid & 63, r32 = lane & 31, hi = lane >> 5;
    const int NT = cur.P0 / KVBLK + 4;
    char* V_lds = lds; char* K_lds = lds + 2 * SHM_V;
    float* ws = (float*)(lds + 2 * SHM_V + 2 * SHM_K) + wid * 64; float* li_l = ws, * al_l = ws + 32;
    float m_reg = -1e30f, l_reg = 0; f32x16 o[4] = {};
    const int sr = tid >> 4, sc = (tid & 15) * 8, vst0 = v_st(sr, sc), vst1 = v_st(32 + sr, sc), kws = KSWZ(sr, sc * 2);
    const int vb0 = (int)(uintptr_t)V_lds + v_rd_base(lane);
    const bf16_t* Kh = cur.K; const bf16_t* Vh = cur.V;
    const unsigned long long* mp = cur.M + (wid * QBLK + r32);
#define MLOAD(lo_, hi_, t) do { const unsigned long long w_ = mp[(size_t)(t) * SEQ] >> hi; lo_ = (unsigned)w_; hi_ = (unsigned)(w_ >> 32); } while (0)
#define RESC(a) do { if (__any((a) < 1.f)) { if (hi == 0) al_l[r32] = (a); asm volatile("s_waitcnt lgkmcnt(0)" ::: "memory");              \
                     for (int d_ = 0; d_ < 4; ++d_) for (int r = 0; r < 16; ++r) o[d_][r] *= al_l[crow(r, hi)]; } } while (0)
#define KBASE(t) ((t) * KVBLK)
#define SEAM_K0() do { VMW(); SWRITE_HK(0); SBAR(); } while (0)
    f32x16 pA0, pA1, pB0, pB1; float mnA, mnB, alA, alB; bf16x8 pa0, pa1, pa2, pa3;
    unsigned mAlo, mAhi, mBlo, mBhi;
    MLOAD(mAlo, mAhi, 0);
    char* Qw_lds = lds + Q_OFF + wid * (QBLK * QROWB);
    { u32x4 tq[8];
#pragma unroll
        for (int i = 0; i < 8; ++i) tq[i] = *(const u32x4*)(cur.Q + (size_t)(wid * QBLK + 4 * i + (lane >> 4)) * D + (lane & 15) * 8);
#pragma unroll
        for (int i = 0; i < 8; ++i) *(u32x4*)(Qw_lds + (4 * i + (lane >> 4)) * QROWB + (lane & 15) * 16) = tq[i];
        asm volatile("s_waitcnt lgkmcnt(0)" ::: "memory"); }
    const char* qa = Qw_lds + r32 * QROWB + hi * 16;
    SWRITE_HV(0); SBAR();
    if (NT > 1) { SLOAD_H(Kh, Vh, KBASE(1)); }
    SBAR(); qkt<0>(pA0, pA1, K_lds, r32, hi, qa);
    partialSM(pA0, pA1, m_reg, mnA, alA, mAlo, mAhi);
    if (NT > 1) { VMW(); SWRITE_H(1); }
    __syncthreads();
#define HALF_STEP(PX0, PX1, mnX, alX, mXlo, mXhi, PY0, PY1, alY, mYlo, mYhi, t, KB, VB, SB) do {                                  \
        SBAR(); MLOAD(mXlo, mXhi, t); qkt<KB>(PX0, PX1, K_lds, r32, hi, qa);                                                  \
        finishSM(PY0, PY1, alY, l_reg, pa0, pa1, pa2, pa3, mYlo, mYhi); SBAR();                                                 \
        if ((t) + 1 < NT) { SLOAD_H(Kh, Vh, KBASE((t) + 1)); SBAR(); }                                                          \
        pv_tile<VB>(o, vb0, pa0, pa1, pa2, pa3); partialSM(PX0, PX1, m_reg, mnX, alX, mXlo, mXhi);                              \
        __syncthreads();                                                                                                      \
        if ((t) + 1 < NT) { VMW(); SWRITE_H(SB); }                                                                            \
        RESC(alX); __syncthreads(); } while (0)
    for (int t = 1; t + 1 < NT; t += 2) {
        HALF_STEP(pB0, pB1, mnB, alB, mBlo, mBhi, pA0, pA1, alA, mAlo, mAhi, t, 1, 0, 0);
        HALF_STEP(pA0, pA1, mnA, alA, mAlo, mAhi, pB0, pB1, alB, mBlo, mBhi, t + 1, 0, 1, 1);
    }
    MLOAD(mBlo, mBhi, NT - 1);
    SBAR(); qkt<1>(pB0, pB1, K_lds, r32, hi, qa); SBAR();
    SLOAD_H(nxt.K, nxt.V, 0); SBAR();
    finishSM(pA0, pA1, alA, l_reg, pa0, pa1, pa2, pa3, mAlo, mAhi); SBAR();
    pv_tile<0>(o, vb0, pa0, pa1, pa2, pa3);
    partialSM(pB0, pB1, m_reg, mnB, alB, mBlo, mBhi); __syncthreads(); RESC(alB);
    finishSM(pB0, pB1, alB, l_reg, pa0, pa1, pa2, pa3, mBlo, mBhi); SBAR(); pv_tile<1>(o, vb0, pa0, pa1, pa2, pa3);
    SBAR(); SEAM_K0();
    if (hi == 0) li_l[r32] = l_reg; asm volatile("s_waitcnt lgkmcnt(0)" ::: "memory");
    float rli[16];
#pragma unroll
    for (int r = 0; r < 16; ++r) rli[r] = __builtin_amdgcn_rcpf(li_l[crow(r, hi)]);
    bf16_t* Ow = cur.O + (size_t)(wid * QBLK) * DM; const bf16_t* Gw = cur.G + (size_t)(wid * QBLK) * DM;
#pragma unroll
    for (int r = 0; r < 16; ++r) { const int orow = crow(r, hi);
#pragma unroll
        for (int d0 = 0; d0 < 4; ++d0) { const float gt = bf2f(Gw[(size_t)orow * DM + d0 * 32 + r32]);
            const float v = o[d0][r] * rli[r] * gt;
            const float vn = __builtin_bit_cast(float, __builtin_amdgcn_update_dpp(0, __builtin_bit_cast(int, v), 0xB1, 0xF, 0xF, true));
            if ((r32 & 1) == 0) *(unsigned*)(Ow + (size_t)orow * DM + d0 * 32 + r32) = cvtpk(v, vn); } }
    __syncthreads();
#undef MLOAD
#undef RESC
#undef KBASE
#undef SEAM_K0
#undef HALF_STEP
}
#undef ROW
#undef VMW
#undef VMWN
#undef SLOAD_H
#undef SWRITE_HK
#undef SWRITE_HV
#undef SWRITE_H
#undef KSWZ
#undef SBAR
}

#define XB_TMO      128
#define XB_XCNT(j)  (256  + 64 * (j))
#define XB_XSUB(j)  (1280 + 64 * (j))
#define XB_XGEN(j)  (2304 + 64 * (j))
#define XB_TOP      3328
#define XB_TOPGEN   3392
#define XCD_BAR_WORDS 3456
#define XB_SPIN_CAP (1u << 22)
__device__ __forceinline__ unsigned xb_ld(unsigned* p)              { return __hip_atomic_load(p, __ATOMIC_RELAXED, __HIP_MEMORY_SCOPE_AGENT); }
__device__ __forceinline__ unsigned xb_add(unsigned* p, unsigned v) { return __hip_atomic_fetch_add(p, v, __ATOMIC_RELAXED, __HIP_MEMORY_SCOPE_AGENT); }
__device__ __forceinline__ unsigned xb_xcc_id() { return (unsigned)__builtin_amdgcn_s_getreg((3 << 11) | 20) & 0xFu; }
#define XB_SPIN(cond, bar) do { unsigned _sp = 0; while (cond) { __builtin_amdgcn_s_sleep(1); \
    if ((++_sp & 255u) == 0u) { if (xb_ld(&(bar)[XB_TMO])) break; if (_sp > XB_SPIN_CAP) { atomicAdd(&(bar)[XB_TMO], 1u); break; } } } } while (0)
struct XcdBarrier { unsigned* bar; unsigned x; volatile LAS unsigned* st; };
__device__ __forceinline__ XcdBarrier xcd_barrier_post(unsigned* bar, volatile LAS unsigned* st) {
    XcdBarrier b; b.bar = bar; b.x = xb_xcc_id(); b.st = st;
    if (threadIdx.x == 0) (void)xb_add(&bar[XB_XCNT(b.x)], 1u);
    return b;
}
__device__ __forceinline__ void xcd_barrier_complete(unsigned* bar, unsigned x, unsigned& nloc, unsigned& nx) {
    const unsigned G = gridDim.x * gridDim.y * gridDim.z;
    unsigned sum, cnt, mine, sp = 0u;
    for (;;) {
        sum = 0u; cnt = 0u; mine = 0u;
#pragma unroll
        for (unsigned j = 0; j < 16; ++j) { const unsigned c = xb_ld(&bar[XB_XCNT(j)]); sum += c; cnt += (c > 0u) ? 1u : 0u; mine = (j == x) ? c : mine; }
        if (sum == G) break;
        __builtin_amdgcn_s_sleep(1);
        if ((++sp & 255u) == 0u) { if (xb_ld(&bar[XB_TMO])) break; if (sp > XB_SPIN_CAP) { atomicAdd(&bar[XB_TMO], 1u); break; } }
    }
    nloc = mine > 0u ? mine : 1u; nx = cnt > 0u ? cnt : 1u;
}
__device__ __forceinline__ void xcd_barrier(const XcdBarrier& b) {
    asm volatile("s_waitcnt vmcnt(0)" ::: "memory");
    __syncthreads();
    if (threadIdx.x == 0) {
        unsigned* bar = b.bar;
        __builtin_amdgcn_s_waitcnt(0);
        unsigned nloc = b.st[0], nx = b.st[1];
        if (nloc == 0u) { xcd_barrier_complete(bar, b.x, nloc, nx); b.st[0] = nloc; b.st[1] = nx; }
        const unsigned old = xb_add(&bar[XB_XSUB(b.x)], 1u);
        const unsigned gen = old / nloc;
        if (old + 1u == (gen + 1u) * nloc) {
            __builtin_amdgcn_fence(__ATOMIC_RELEASE, "agent");
            asm volatile("s_waitcnt vmcnt(0)" ::: "memory");
            const unsigned og = xb_add(&bar[XB_TOP], 1u);
            const unsigned tg = og / nx;
            if (og + 1u == (tg + 1u) * nx) xb_add(&bar[XB_TOPGEN], 1u);
            else XB_SPIN(xb_ld(&bar[XB_TOPGEN]) == tg, bar);
            __builtin_amdgcn_fence(__ATOMIC_ACQUIRE, "agent");
            xb_add(&bar[XB_XGEN(b.x)], 1u);
            asm volatile("s_waitcnt vmcnt(0)" ::: "memory");
        } else {
            XB_SPIN(xb_ld(&bar[XB_XGEN(b.x)]) == gen, bar);
            __builtin_amdgcn_fence(__ATOMIC_ACQUIRE, "agent");
            asm volatile("s_waitcnt vmcnt(0)" ::: "memory");
        }
    }
    __syncthreads();
}

struct Args {
    const float* x; const float* c; const int* pos; const float* norm_g; const float* mod_w; const float* mod_b;
    const float* pwi; const float* pwg; const float* pls; const float* pwo; const float* awi; const float* awo; const float* fg;
    float* out; unsigned char* ws;
    int ph_lo, ph_hi;
};
constexpr int NWAVES = 8, NTHR = 512;
constexpr int RING_BYTES = 131072, LDS_BYTES = 147456, MISC_OFF = LDS_BYTES - 256;

__device__ __forceinline__ void sincos_d(double a, float& s_out, float& c_out) {
    const double k = __builtin_rint(a * 0.6366197723675814);
    double r = __builtin_fma(-k, 1.5707963267948966, a); r = __builtin_fma(-k, 6.123233995736766e-17, r);
    const double r2 = r * r;
    double sp = -7.647163731819816e-13; sp = sp * r2 + 1.6059043836821613e-10; sp = sp * r2 - 2.505210838544172e-08; sp = sp * r2 + 2.7557319223985893e-06;
    sp = sp * r2 - 1.984126984126984e-04; sp = sp * r2 + 8.333333333333333e-03; sp = sp * r2 - 1.6666666666666666e-01; const double s = r + r * r2 * sp;
    double cp = 4.779477332387385e-14; cp = cp * r2 - 1.1470745597729725e-11; cp = cp * r2 + 2.08767569878681e-09; cp = cp * r2 - 2.755731922398589e-07;
    cp = cp * r2 + 2.48015873015873e-05; cp = cp * r2 - 1.388888888888889e-03; cp = cp * r2 + 4.1666666666666664e-02; cp = cp * r2 - 0.5; const double c = 1.0 + r2 * cp;
    const int q = (int)((long long)k & 3);
    const double ss = (q == 0) ? s : (q == 1) ? c : (q == 2) ? -s : -c;
    const double cc = (q == 0) ? c : (q == 1) ? -s : (q == 2) ? -c : s;
    s_out = (float)ss; c_out = (float)cc;
}
__device__ __forceinline__ void transpose_item(const float* W, int K, int N, bf16_t* WT, int row_off, LAS float* scr, int nblk, int item, int lane) {
    const int kb = item / nblk, nb = item % nblk, k0 = 64 * kb, n0 = 32 * nb;
    const int nn = n0 + (lane & 31);
    float tv[32];
#pragma unroll
    for (int i = 0; i < 32; ++i) { const int kk = 2 * i + (lane >> 5); tv[i] = (nn < N) ? W[(size_t)(k0 + kk) * N + nn] : 0.f; }
#pragma unroll
    for (int i = 0; i < 32; ++i) { const int kk = 2 * i + (lane >> 5); scr[kk * 33 + (lane & 31)] = tv[i]; }
    LDS_WAIT(); asm volatile("" ::: "memory");
    const int c = lane & 7;
#pragma unroll
    for (int j = 0; j < 4; ++j) { const int n = (lane >> 3) + 8 * j; const LAS float* s = scr + (8 * c) * 33 + n;
        u32x4 o; o.x = pk2(s[0 * 33], s[1 * 33]); o.y = pk2(s[2 * 33], s[3 * 33]); o.z = pk2(s[4 * 33], s[5 * 33]); o.w = pk2(s[6 * 33], s[7 * 33]);
        *(u32x4*)(WT + (size_t)(row_off + n0 + n) * K + k0 + 8 * c) = o; }
    LDS_WAIT(); asm volatile("" ::: "memory");
}
template <int VAR>
__device__ __forceinline__ void phase0(int wv, const Args& a, LAS unsigned char* lds) {
    const int tid = opaque_tid(wv), lane = tid & 63, wave = __builtin_amdgcn_readfirstlane(tid >> 6);
    const int G = gridDim.x, bx = blockIdx.x;
    unsigned char* ws = a.ws;
    if (VAR == 0 || VAR == 1)
    for (int unit = bx; unit < 256; unit += G) {
        const int layer = unit >> 6, kq = (unit >> 4) & 3, cs = unit & 15;
        const float* W = a.mod_w + ((size_t)layer * DM + 512 * kq) * 6144 + 384 * cs;
        LAS float* red = (LAS float*)lds;
        LAS float* cdl = (LAS float*)(lds + 8192);
        if (tid < 512) cdl[tid] = silu_f(a.c[512 * kq + tid]);
        if (tid < 8) cdl[512 + tid] = 0.f;
        __syncthreads();
        if (tid < 480) {
            const int kg = tid / 96, ln = tid - kg * 96;
            f32x4 acc4 = {0.f, 0.f, 0.f, 0.f};
#pragma unroll 8
            for (int i = 0; i < 103; ++i) { const int k = kg + 5 * i, kc = k < 512 ? k : 511;
                acc4 += *(const f32x4*)(W + (size_t)kc * 6144 + 4 * ln) * cdl[k]; }
            *(LAS f32x4*)(red + kg * 384 + 4 * ln) = acc4;
        }
        __syncthreads();
        if (tid < 384) { float sum = red[tid];
#pragma unroll
            for (int kg = 1; kg < 5; ++kg) sum += red[kg * 384 + tid];
            const int col = 384 * cs + tid;
            if (kq == 0) sum += a.mod_b[layer * 6144 + col];
            ((float*)(ws + WS_MOD))[(layer * 4 + kq) * 6144 + col] = sum; }
        __syncthreads();
    }
    if (VAR == 0 || VAR == 2) {
        float* cosq = (float*)(ws + WS_TAB); float* sinq = cosq + SEQ * 16; float* cosi = sinq + SEQ * 16; float* sini = cosi + SEQ * 8;
        for (int e = bx * NTHR + tid; e < SEQ * 24; e += G * NTHR) {
            const int p = e / 24, i = e - p * 24;
            const float pf = (float)a.pos[p];
            const double frac = i < 16 ? (double)i * (1.0 / 16.0) : (double)(i - 16) * (1.0 / 8.0);
            const float inv = (float)exp2(-18.931568569324174 * frac);
            const float ang = pf * inv;
            float s, c; sincos_d((double)ang, s, c);
            if (i < 16) { cosq[p * 16 + i] = c; sinq[p * 16 + i] = s; } else { cosi[p * 8 + i - 16] = c; sini[p * 8 + i - 16] = s; }
        }
    }
    if (VAR == 0 || VAR == 3) {
        LAS float* scr = (LAS float*)(lds + 16384 + wave * 8704);
        const int gw = bx * NWAVES + wave, NGW = G * NWAVES;
        constexpr int I_PI = 32 * 128, I_PG = 8 * 16, I_PO = 32 * 64, I_AI = 32 * 296, I_AO = 32 * 64;
        constexpr int NITEMS = 2 * I_PI + 8 * I_PG + 2 * I_PO + 2 * I_AI + 2 * I_AO;
        for (int it = gw; it < NITEMS; it += NGW) {
            int r = it;
            if (r < 2 * I_AI) { const int l = r / I_AI; r -= l * I_AI; transpose_item(a.awi + (size_t)l * DM * ATTN_IN, DM, ATTN_IN, (bf16_t*)(ws + WS_WAI) + (size_t)l * ATTN_INP * DM, 0, scr, 296, r, lane); continue; } r -= 2 * I_AI;
            if (r < 2 * I_PI) { const int l = r / I_PI; r -= l * I_PI; transpose_item(a.pwi + (size_t)l * DM * POOL_IN, DM, POOL_IN, (bf16_t*)(ws + WS_WPI) + (size_t)l * POOL_IN * DM, 0, scr, 128, r, lane); continue; } r -= 2 * I_PI;
            if (r < 2 * I_PO) { const int l = r / I_PO; r -= l * I_PO; transpose_item(a.pwo + (size_t)l * DM * DM, DM, DM, (bf16_t*)(ws + WS_WPO) + (size_t)l * DM * DM, 0, scr, 64, r, lane); continue; } r -= 2 * I_PO;
            if (r < 2 * I_AO) { const int l = r / I_AO; r -= l * I_AO; transpose_item(a.awo + (size_t)l * DM * DM, DM, DM, (bf16_t*)(ws + WS_WAO) + (size_t)l * DM * DM, 0, scr, 64, r, lane); continue; } r -= 2 * I_AO;
            { const int lg = r / I_PG; r -= lg * I_PG; const int l = lg >> 2, gi = lg & 3;
              transpose_item(a.pwg + (size_t)lg * 512 * 512, 512, 512, (bf16_t*)(ws + WS_WPG) + (size_t)l * DM * 512, gi * 512, scr, 16, r, lane); }
        }
    }
}

template <bool IN_BF16> __device__ __forceinline__ void phase_norm(int wv, const void* x, const float* g, const float* mod  , bf16_t* h) {
    const int tid = opaque_tid(wv), lane = tid & 63, wave = tid >> 6;
    const int gw = blockIdx.x * NWAVES + wave, NGW = gridDim.x * NWAVES;
    f32x4 av[8], sv[8];
#pragma unroll
    for (int j = 0; j < 8; ++j) { const int col = 8 * lane + 512 * (j >> 1) + 4 * (j & 1);
        const f32x4 gg = *(const f32x4*)(g + col);
        sv[j] = ((*(const f32x4*)(mod + col) + *(const f32x4*)(mod + 6144 + col)) + *(const f32x4*)(mod + 2 * 6144 + col)) + *(const f32x4*)(mod + 3 * 6144 + col);
        const f32x4 sc = ((*(const f32x4*)(mod + DM + col) + *(const f32x4*)(mod + 6144 + DM + col)) + *(const f32x4*)(mod + 2 * 6144 + DM + col)) + *(const f32x4*)(mod + 3 * 6144 + DM + col);
        av[j] = gg * (sc + 1.0f); }
    for (int row = gw; row < SEQ; row += 4 * NGW) {
        u32x4 t[4][4]; f32x4 tf[4][8];
#pragma unroll
        for (int r = 0; r < 4; ++r) { const size_t ro = (size_t)(row + r * NGW) * DM;
            if (IN_BF16) { const u32x4* xr = (const u32x4*)((const bf16_t*)x + ro) + lane;
#pragma unroll
                for (int j = 0; j < 4; ++j) t[r][j] = xr[64 * j]; }
            else { const f32x4* xr = (const f32x4*)((const float*)x + ro) + 2 * lane;
#pragma unroll
                for (int j = 0; j < 4; ++j) { tf[r][2 * j] = xr[128 * j]; tf[r][2 * j + 1] = xr[128 * j + 1]; } } }
#pragma unroll
        for (int r = 0; r < 4; ++r) {
            f32x4 v[8];
#pragma unroll
            for (int j = 0; j < 4; ++j) { if (IN_BF16) unpack8(t[r][j], v[2 * j], v[2 * j + 1]); else { v[2 * j] = tf[r][2 * j]; v[2 * j + 1] = tf[r][2 * j + 1]; } }
            float s = 0.f;
#pragma unroll
            for (int j = 0; j < 8; ++j) s += (v[j].x * v[j].x + v[j].y * v[j].y) + (v[j].z * v[j].z + v[j].w * v[j].w);
            const float rstd = 1.0f / sqrtf(wave_sum(s) * (1.f / DM) + EPS);
            u32x4* o16 = (u32x4*)(h + (size_t)(row + r * NGW) * DM) + lane;
#pragma unroll
            for (int j = 0; j < 4; ++j) o16[64 * j] = pack8(v[2 * j] * rstd * av[2 * j] + sv[2 * j], v[2 * j + 1] * rstd * av[2 * j + 1] + sv[2 * j + 1]);
        }
    }
}
__device__ __forceinline__ void phase_final(int wv, const bf16_t* x, float* y, const float* g) {
    const int tid = opaque_tid(wv), lane = tid & 63, wave = tid >> 6;
    const int gw = blockIdx.x * NWAVES + wave, NGW = gridDim.x * NWAVES;
    for (int row = gw; row < SEQ; row += 2 * NGW) {
        const int rowb = row + NGW;
        const u32x4* xr = (const u32x4*)(x + (size_t)row * DM) + lane; const u32x4* xs = (const u32x4*)(x + (size_t)rowb * DM) + lane;
        f32x4* yr = (f32x4*)(y + (size_t)row * DM) + 2 * lane; f32x4* ys = (f32x4*)(y + (size_t)rowb * DM) + 2 * lane;
        u32x4 t0[4], t1[4];
#pragma unroll
        for (int j = 0; j < 4; ++j) { t0[j] = xr[64 * j]; t1[j] = xs[64 * j]; }
        f32x4 v[8], u[8]; float s = 0.f, s2 = 0.f;
#pragma unroll
        for (int j = 0; j < 4; ++j) { unpack8(t0[j], v[2 * j], v[2 * j + 1]); unpack8(t1[j], u[2 * j], u[2 * j + 1]); }
#pragma unroll
        for (int j = 0; j < 8; ++j) { s += (v[j].x * v[j].x + v[j].y * v[j].y) + (v[j].z * v[j].z + v[j].w * v[j].w); s2 += (u[j].x * u[j].x + u[j].y * u[j].y) + (u[j].z * u[j].z + u[j].w * u[j].w); }
        const float rstd = 1.0f / sqrtf(wave_sum(s) * (1.f / DM) + EPS), rstd2 = 1.0f / sqrtf(wave_sum(s2) * (1.f / DM) + EPS);
#pragma unroll
        for (int j = 0; j < 8; ++j) { const int col = 8 * lane + 512 * (j >> 1) + 4 * (j & 1); const f32x4 gg = *(const f32x4*)(g + col);
            yr[128 * (j >> 1) + (j & 1)] = v[j] * rstd * gg; ys[128 * (j >> 1) + (j & 1)] = u[j] * rstd2 * gg; }
    }
}

template <int W, int R> __device__ __forceinline__ void pool_strip(const bf16_t* VG, bf16_t* PL, int t0, int c0) {
    u32x4 r[W + R - 1];
#pragma unroll
    for (int i = 0; i < W + R - 1; ++i) { const int t = t0 - (W - 1) + i; r[i] = *(const u32x4*)(VG + (size_t)(t < 0 ? 0 : t) * POOL_IN + c0); }
    float S[8];
#pragma unroll
    for (int e = 0; e < 8; ++e) S[e] = 0.f;
#pragma unroll
    for (int i = 0; i < W - 1; ++i) { const float wg = (t0 - (W - 1) + i >= 0) ? 1.f : 0.f;
#pragma unroll
        for (int e = 0; e < 4; ++e) { const unsigned x = r[i][e]; S[2 * e] += wg * __builtin_bit_cast(float, x << 16); S[2 * e + 1] += wg * __builtin_bit_cast(float, x & 0xffff0000u); } }
#pragma unroll
    for (int j = 0; j < R; ++j) { const int t = t0 + j;
        float v[8];
#pragma unroll
        for (int e = 0; e < 4; ++e) { const unsigned x = r[W - 1 + j][e]; v[2 * e] = __builtin_bit_cast(float, x << 16); v[2 * e + 1] = __builtin_bit_cast(float, x & 0xffff0000u); }
        const int cnt = (t + 1 < W) ? (t + 1) : W; const float ic = 1.0f / (float)cnt;
        float o[8];
#pragma unroll
        for (int e = 0; e < 8; ++e) { S[e] += v[e]; o[e] = S[e] * ic - v[e]; }
        u32x4 pw; pw.x = cvt_pk_bf16(o[0], o[1]); pw.y = cvt_pk_bf16(o[2], o[3]); pw.z = cvt_pk_bf16(o[4], o[5]); pw.w = cvt_pk_bf16(o[6], o[7]);
        *(u32x4*)(PL + (size_t)t * DM + c0) = pw;
        const float wg = (t - W + 1 >= 0) ? 1.f : 0.f;
#pragma unroll
        for (int e = 0; e < 4; ++e) { const unsigned x = r[j][e]; S[2 * e] -= wg * __builtin_bit_cast(float, x << 16); S[2 * e + 1] -= wg * __builtin_bit_cast(float, x & 0xffff0000u); } }
}
__device__ __forceinline__ void phase_pool(int wv, const bf16_t* VG, bf16_t* PL) {
    const int total = 512 * 256;
    const int tid = opaque_tid(wv);
    for (int it = blockIdx.x * NTHR + tid; it < total; it += gridDim.x * NTHR) {
        const int cg = it & 255, strip = it >> 8; const int c0 = cg * 8, t0 = strip * 16;
        const int grp = __builtin_amdgcn_readfirstlane(c0 >> 9);
        if (grp == 0) pool_strip<2, 16>(VG, PL, t0, c0); else if (grp == 1) pool_strip<4, 16>(VG, PL, t0, c0); else if (grp == 2) pool_strip<8, 16>(VG, PL, t0, c0);
        else { pool_strip<16, 8>(VG, PL, t0, c0); pool_strip<16, 8>(VG, PL, t0 + 8, c0); }
    }
}

__device__ __forceinline__ size_t sc_block_base(int qb) { return (size_t)65536 * (size_t)(qb * (qb + 1) / 2); }
__device__ __forceinline__ float fma_s(float a, float b, float c) { asm("v_fma_f32 %0, %1, %2, %0" : "+v"(c) : "v"(a), "v"(b)); return c; }
__device__ __forceinline__ float relu_i(float x) { const int b = __builtin_bit_cast(int, x); return __builtin_bit_cast(float, b > 0 ? b : 0); }
template <int VAR>
__device__ __forceinline__ void phase_scores(int wv, const bf16_t* QI, const bf16_t* KI, const float* WI, float* SC, LAS unsigned char* lds, unsigned* ctr  ) {
    const int tid = opaque_tid(wv), wid = __builtin_amdgcn_readfirstlane(tid >> 6), lane = tid & 63, r32 = lane & 31, hi = lane >> 5;
    constexpr int QROW = 2064;
    volatile LAS int* slot = (volatile LAS int*)(lds + 32 * QROW);
    for (;;) {
        __syncthreads();
        if (tid == 0) slot[0] = (int)__hip_atomic_fetch_add(ctr, 1u, __ATOMIC_RELAXED, __HIP_MEMORY_SCOPE_AGENT);
        __syncthreads();
        const int L = slot[0];
        if (L >= 1152) break;
        int kc = 0, base = 0;
        for (; kc < 8; ++kc) { const int n = 256 - 32 * kc; if (L < base + n) break; base += n; }
        const int u = 32 * kc + (L - base);
        const int q0 = 32 * u, qb = u >> 3;
        const int klim = (qb + 1) * 256;
        bf16x8 kf[2][4];
        { const int key0 = kc * 1024 + wid * 64;
#pragma unroll
            for (int b = 0; b < 2; ++b)
#pragma unroll
                for (int kk = 0; kk < 4; ++kk) kf[b][kk] = *(const bf16x8*)(KI + (size_t)(key0 + 32 * b + r32) * 64 + 16 * kk + 8 * hi); }
        {
            int t_ = tid; asm volatile("" : "+v"(t_));
            const bf16_t* src = QI + (size_t)q0 * 1024 + t_ * 8;
            const int ldst = (t_ >> 7) * QROW + (t_ & 127) * 16;
            u32x4 tq[8];
#pragma unroll
            for (int i = 0; i < 8; ++i) tq[i] = *(const u32x4*)(src + i * 4096);
            __builtin_amdgcn_sched_barrier(0);
#pragma unroll
            for (int i = 0; i < 8; ++i) *(LAS u32x4*)(lds + ldst + i * (4 * QROW)) = tq[i];
        }
        f32x4 wq[4];
#pragma unroll
        for (int i = 0; i < 4; ++i) wq[i] = *(const f32x4*)(WI + (size_t)(q0 + r32) * 16 + 4 * i);
        __syncthreads();
        for (int sl = wid; sl < 16; sl += 8) {
            const int key0 = kc * 1024 + sl * 64;
            if (key0 >= klim) continue;
            if (sl != wid) {
#pragma unroll
                for (int b = 0; b < 2; ++b)
#pragma unroll
                    for (int kk = 0; kk < 4; ++kk) kf[b][kk] = *(const bf16x8*)(KI + (size_t)(key0 + 32 * b + r32) * 64 + 16 * kk + 8 * hi); }
            f32x16 acc0 = {}, acc1 = {};
            const LAS unsigned char* qa = lds + r32 * QROW + hi * 16;
#define SC_MM(h, S0, S1) do { bf16x8 af_[4];                                                                                  \
                _Pragma("unroll") for (int kk = 0; kk < 4; ++kk) af_[kk] = *(const LAS bf16x8*)(qa + (h) * 128 + kk * 32);     \
                S0 = __builtin_amdgcn_mfma_f32_32x32x16_bf16(kf[0][0], af_[0], f32x16{}, 0, 0, 0); S1 = __builtin_amdgcn_mfma_f32_32x32x16_bf16(kf[1][0], af_[0], f32x16{}, 0, 0, 0); \
                _Pragma("unroll") for (int kk = 1; kk < 4; ++kk) { S0 = __builtin_amdgcn_mfma_f32_32x32x16_bf16(kf[0][kk], af_[kk], S0, 0, 0, 0); S1 = __builtin_amdgcn_mfma_f32_32x32x16_bf16(kf[1][kk], af_[kk], S1, 0, 0, 0); } } while (0)
#define SC_VA(h, S0, S1) do { const float w_ = wq[(h) >> 2][(h) & 3];                                                          \
                _Pragma("unroll") for (int r = 0; r < 16; ++r) { acc0[r] = fma_s(relu_i(S0[r]), w_, acc0[r]); acc1[r] = fma_s(relu_i(S1[r]), w_, acc1[r]); } } while (0)
#define SC_SB() __builtin_amdgcn_sched_barrier(0)
            f32x16 sA0, sA1, sB0, sB1;
            SC_MM(0, sA0, sA1); SC_SB();
            if (wid < 4) {
#pragma unroll
                for (int h = 0; h < 14; h += 2) {
                    SC_MM(h + 1, sB0, sB1); SC_SB(); SC_VA(h, sA0, sA1); SC_SB();
                    SC_MM(h + 2, sA0, sA1); SC_SB(); SC_VA(h + 1, sB0, sB1); SC_SB();
                }
                SC_MM(15, sB0, sB1); SC_SB(); SC_VA(14, sA0, sA1); SC_SB();
                SC_VA(15, sB0, sB1);
            } else {
                SC_MM(1, sB0, sB1); SC_SB();
#pragma unroll
                for (int h = 0; h < 14; h += 2) {
                    SC_VA(h, sA0, sA1); SC_SB(); SC_MM(h + 2, sA0, sA1); SC_SB();
                    SC_VA(h + 1, sB0, sB1); SC_SB(); SC_MM(h + 3, sB0, sB1); SC_SB();
                }
                SC_VA(14, sA0, sA1); SC_SB();
                SC_VA(15, sB0, sB1);
            }
#undef SC_SB
#undef SC_MM
#undef SC_VA
            float* out = SC + sc_block_base(qb) + (size_t)(q0 - qb * 256 + r32) * (size_t)klim + key0 + 4 * hi;
#pragma unroll
            for (int g = 0; g < 4; ++g) {
                *(f32x4*)(out + 8 * g) = (f32x4){acc0[4 * g], acc0[4 * g + 1], acc0[4 * g + 2], acc0[4 * g + 3]};
                *(f32x4*)(out + 32 + 8 * g) = (f32x4){acc1[4 * g], acc1[4 * g + 1], acc1[4 * g + 2], acc1[4 * g + 3]}; }
        }
    }
}

template <int VAR>
__device__ __forceinline__ void phase_select(int wv, const float* SC, unsigned long long* MASK, LAS unsigned char* lds) {
    const int tid = opaque_tid(wv), lane0 = tid & 63, wave = __builtin_amdgcn_readfirstlane(tid >> 6);
    LAS unsigned* hist = (LAS unsigned*)(lds + wave * 9216);
    const int gw = blockIdx.x * NWAVES + wave, NGW = gridDim.x * NWAVES;
    for (int q = gw; q < SEQ; q += NGW) {
        int lane = lane0; asm volatile("" : "+v"(lane));
        const int qb = q >> 8, klim = (qb + 1) * 256;
        const float* rowp = SC + sc_block_base(qb) + (size_t)(q - qb * 256) * (size_t)klim;
        const int ngrp = qb + 1;
        unsigned key[32][4];
#pragma unroll
        for (int g = 0; g < 8; ++g) {
            if (4 * g < ngrp) {
#pragma unroll
                for (int i = 0; i < 4; ++i) { const u32x4 v = *(const u32x4*)(rowp + 256 * (4 * g + i) + 4 * lane);
                    key[4 * g + i][0] = v.x; key[4 * g + i][1] = v.y; key[4 * g + i][2] = v.z; key[4 * g + i][3] = v.w; }
            } else {
#pragma unroll
                for (int i = 0; i < 4; ++i) { key[4 * g + i][0] = 0u; key[4 * g + i][1] = 0u; key[4 * g + i][2] = 0u; key[4 * g + i][3] = 0u; }
            }
        }
        unsigned T = 1u; unsigned need_eq = 0xffffffffu, n_eq = 0u;
        const bool radix = (q + 1 > TOPK) && (VAR != 1 && VAR != 3);
        if (VAR == 3) { unsigned x_ = 0u;
#pragma unroll
            for (int j = 0; j < 32; ++j) x_ |= key[j][0] & key[j][1] & key[j][2] & key[j][3];
            if (x_ == 0x12345u) MASK[q] = x_; continue; }
        if (radix) {
#pragma unroll
            for (int i = 0; i < 9; ++i) *(LAS u32x4*)(hist + 4 * (lane + 64 * i)) = (u32x4){0u, 0u, 0u, 0u};
        }
        __builtin_amdgcn_sched_barrier(0);
#pragma unroll
        for (int g = 0; g < 8; ++g) { if (4 * g < ngrp) {
#pragma unroll
            for (int i = 0; i < 4; ++i)
#pragma unroll
                for (int e = 0; e < 4; ++e) { const int j = 4 * g + i; const unsigned uu = key[j][e];
                    const unsigned kx = uu ^ ((unsigned)((int)uu >> 31) | 0x80000000u); key[j][e] = (256 * j + 4 * lane + e <= q) ? kx : 0u; }
            } __builtin_amdgcn_sched_barrier(0); }
        if (radix) {
            unsigned gm0 = 0u, gm1 = 0u, gm2 = 0u, gm3 = 0u;
#pragma unroll
            for (int g = 0; g < 8; ++g) if (4 * g < ngrp) {
#pragma unroll
                for (int i = 0; i < 4; ++i) { const int j = 4 * g + i; gm0 = key[j][0] > gm0 ? key[j][0] : gm0; gm1 = key[j][1] > gm1 ? key[j][1] : gm1; gm2 = key[j][2] > gm2 ? key[j][2] : gm2; gm3 = key[j][3] > gm3 ? key[j][3] : gm3; }
            }
            unsigned Pmin = gm0 < gm1 ? gm0 : gm1; { const unsigned p2 = gm2 < gm3 ? gm2 : gm3; Pmin = Pmin < p2 ? Pmin : p2; }
#pragma unroll
            for (int off = 1; off < 64; off <<= 1) { const unsigned tt = (unsigned)__builtin_amdgcn_ds_bpermute((lane ^ off) << 2, (int)Pmin); Pmin = tt < Pmin ? tt : Pmin; }
            LDS_WAIT();
#pragma unroll
            for (int g = 0; g < 8; ++g) if (4 * g < ngrp) {
#pragma unroll
                for (int i = 0; i < 4; ++i) {
#pragma unroll
                    for (int e = 0; e < 4; ++e) { const unsigned k = key[4 * g + i][e];
                        if (k >= Pmin) { const unsigned b = k >> 21; __hip_atomic_fetch_add(hist + b + ((b >> 5) << 2), 1u, __ATOMIC_RELAXED, __HIP_MEMORY_SCOPE_WORKGROUP); } }
                    __builtin_amdgcn_sched_barrier(0); }
            }
            unsigned prefix = 0u, pmask = 0u, kk = TOPK;
#pragma unroll 1
            for (int pass = 0; pass < ((VAR == 4) ? 1 : 3); ++pass) {
                const int shift = (pass == 0) ? 21 : (pass == 1) ? 10 : 0;
                const unsigned dmask = (pass == 2) ? 1023u : 2047u;
                LDS_WAIT();
                if (pass > 0) {
#pragma unroll
                    for (int g = 0; g < 8; ++g) if (4 * g < ngrp) {
#pragma unroll
                        for (int i = 0; i < 4; ++i) {
#pragma unroll
                            for (int e = 0; e < 4; ++e) { const unsigned k = key[4 * g + i][e];
                                if ((k & pmask) == prefix) { const unsigned b = (k >> shift) & dmask; __hip_atomic_fetch_add(hist + b + ((b >> 5) << 2), 1u, __ATOMIC_RELAXED, __HIP_MEMORY_SCOPE_WORKGROUP); } }
                            __builtin_amdgcn_sched_barrier(0); }
                    }
                }
                LDS_WAIT();
                if (VAR == 5) { prefix |= (0x5a5u & dmask) << shift; pmask |= dmask << shift; continue; }
                unsigned s = 0u;
#pragma unroll
                for (int i = 0; i < 8; ++i) { const u32x4 v = *(const LAS u32x4*)(hist + 36 * lane + 4 * i); s += (v.x + v.y) + (v.z + v.w); }
                unsigned suf = s;
#pragma unroll
                for (int off = 1; off < 64; off <<= 1) { const unsigned tt = (unsigned)__builtin_amdgcn_ds_bpermute(((lane + off) & 63) << 2, (int)suf); if (lane + off < 64) suf += tt; }
                const unsigned long long bal = __ballot(suf >= kk);
                const int Ls = 63 - __builtin_clzll(bal);
                const unsigned above1 = (unsigned)__builtin_amdgcn_readlane((int)(suf - s), Ls);
                const unsigned c2 = hist[36 * Ls + (lane & 31)];
                unsigned suf2 = (lane < 32) ? c2 : 0u;
#pragma unroll
                for (int off = 1; off < 32; off <<= 1) { const unsigned tt = (unsigned)__builtin_amdgcn_ds_bpermute(((lane + off) & 63) << 2, (int)suf2); if (lane + off < 32) suf2 += tt; }
                const unsigned long long bal2 = __ballot(lane < 32 && above1 + suf2 >= kk);
                const int Bs = 63 - __builtin_clzll(bal2);
                const int dsel = 32 * Ls + Bs;
                const unsigned cnt_b = (unsigned)__builtin_amdgcn_readlane((int)c2, Bs);
                const unsigned kk_new = kk - (above1 + (unsigned)__builtin_amdgcn_readlane((int)suf2, Bs) - cnt_b);
                LDS_WAIT();
#pragma unroll
                for (int i = 0; i < 9; ++i) *(LAS u32x4*)(hist + 4 * (lane + 64 * i)) = (u32x4){0u, 0u, 0u, 0u};
                const unsigned d = (unsigned)dsel; kk = kk_new; n_eq = cnt_b;
                prefix |= d << shift; pmask |= dmask << shift;
            }
            T = prefix; need_eq = kk;
        }
        if (VAR == 2 || VAR == 4 || VAR == 5) { if (T == 0x12345u) MASK[q] = T; continue; }
        const bool tie_path = (need_eq != 0xffffffffu) && (n_eq > need_eq);
        unsigned tie_seen = 0u;
        const unsigned long long lt = (lane == 0) ? 0ull : (~0ull >> (64 - lane));
        int w0lo = 0, w0hi = 0, w1lo = 0, w1hi = 0;
#pragma unroll
        for (int g = 0; g < 8; ++g) if (4 * g < ngrp) {
#pragma unroll
            for (int i = 0; i < 4; ++i) { const int j = 4 * g + i;
                unsigned long long B[4];
                if (!tie_path) {
#pragma unroll
                    for (int e = 0; e < 4; ++e) B[e] = __ballot(key[j][e] >= T);
                } else {
                    unsigned long long E[4]; unsigned before = tie_seen;
#pragma unroll
                    for (int e = 0; e < 4; ++e) { E[e] = __ballot(key[j][e] == T); before += (unsigned)__builtin_popcountll(E[e] & lt); }
                    unsigned mine = 0u;
#pragma unroll
                    for (int e = 0; e < 4; ++e) { const bool eq = (key[j][e] == T);
                        B[e] = __ballot(key[j][e] > T || (eq && (before + mine) < need_eq)); mine += eq ? 1u : 0u; }
#pragma unroll
                    for (int e = 0; e < 4; ++e) tie_seen += (unsigned)__builtin_popcountll(E[e]);
                }
#pragma unroll
                for (int k = 0; k < 4; ++k) { const int t = 4 * j + k;
                    const unsigned blo_ = (unsigned)((B[0] >> (16 * k)) & 0xffffull) | ((unsigned)((B[1] >> (16 * k)) & 0xffffull) << 16);
                    const unsigned bhi_ = (unsigned)((B[2] >> (16 * k)) & 0xffffull) | ((unsigned)((B[3] >> (16 * k)) & 0xffffull) << 16);
                    if (t < 64) asm volatile("s_nop 3\n\tv_writelane_b32 %0, %2, %4\n\tv_writelane_b32 %1, %3, %4" : "+v"(w0lo), "+v"(w0hi) : "s"(blo_), "s"(bhi_), "n"(t & 63));
                    else asm volatile("s_nop 3\n\tv_writelane_b32 %0, %2, %4\n\tv_writelane_b32 %1, %3, %4" : "+v"(w1lo), "+v"(w1hi) : "s"(blo_), "s"(bhi_), "n"(t & 63)); }
            }
        }
        const int ntile = 4 * ngrp;
        if (lane < ntile) MASK[(size_t)lane * SEQ + q] = ((unsigned long long)(unsigned)w0hi << 32) | (unsigned)w0lo;
        if (lane + 64 < ntile) MASK[(size_t)(lane + 64) * SEQ + q] = ((unsigned long long)(unsigned)w1hi << 32) | (unsigned)w1lo;
    }
}

__device__ __forceinline__ att::BlockRef attn_ref(int h, int qb, const bf16_t* Qh, const bf16_t* Kh, const bf16_t* Vh, bf16_t* O, const bf16_t* SG, const unsigned long long* MASK) {
    att::BlockRef r;
    r.Q = Qh + ((size_t)h * SEQ + (size_t)qb * 256) * HD; r.K = Kh + (size_t)h * SEQ * HD; r.V = Vh + (size_t)h * SEQ * HD;
    r.O = O + (size_t)qb * 256 * DM + h * HD; r.G = SG + (size_t)qb * 256 * DM + h * HD; r.M = MASK + qb * 256; r.P0 = qb * 256;
    return r;
}
__device__ __forceinline__ void phase_attn(int wv, const bf16_t* Qh, const bf16_t* Kh, const bf16_t* Vh, bf16_t* O, const bf16_t* SG, const unsigned long long* MASK, char* lds) {
    const int total = NHEAD * 16, stride = gridDim.x;
    int L = blockIdx.x; if (L >= total) return;
    if (gridDim.x == 256) { const int b = L; L = 16 * ((b & 7) + 8 * (b >> 7)) + ((b >> 3) & 15); }
    int pass = 0;
    att::BlockRef cur = attn_ref(L >> 4, L & 15, Qh, Kh, Vh, O, SG, MASK);
    att::Seam S;
    att::attn_prime(wv, cur, lds, S);
    for (;;) {
        const bool more_pass = pass == 0, more_item = L + stride < total, last = !more_pass && !more_item;
        int passn = pass + 1, Ln = L;
        if (!more_pass) { passn = 0; Ln = more_item ? L + stride : L; }
        const int hn = Ln >> 4, xn = Ln & 15;
        const att::BlockRef nxt = last ? cur : attn_ref(hn, passn ? 31 - xn : xn, Qh, Kh, Vh, O, SG, MASK);
        att::attn_block(wv, cur, nxt, lds, S);
        if (last) break;
        cur = nxt; pass = passn; L = Ln;
    }
}

__global__ void __launch_bounds__(NTHR, 2) trunk_fwd(Args args) {
    extern __shared__ __attribute__((aligned(16))) unsigned char lds_raw[];
    LAS unsigned char* lds = (LAS unsigned char*)lds_raw;
    volatile LAS unsigned* MISC = (volatile LAS unsigned*)(lds + MISC_OFF);
    const int wv = __builtin_amdgcn_readfirstlane((int)threadIdx.x >> 6);
    const int tid = opaque_tid(wv);
    unsigned char* ws = args.ws;
    if (tid < 32) MISC[tid] = 0u;
    __syncthreads();
    XcdBarrier bar; bar.bar = (unsigned*)(ws + WS_CTL) + 1024; bar.x = 0; bar.st = nullptr;
    if (MK_ONE_LAUNCH) bar = xcd_barrier_post((unsigned*)(ws + WS_CTL) + 1024, MISC + 8);
    const int lo = args.ph_lo, hi = args.ph_hi;
    int ph = 0;
#ifndef PHASE_MASK
#define PHASE_MASK 0xFFFF
#endif
#define IN(k) (lo <= (k) && (k) < hi)
#define PM(b) ((PHASE_MASK >> (b)) & 1)
#ifndef DUP_MASK
#define DUP_MASK 0
#endif
#ifndef SC_VAR
#define SC_VAR 0
#endif
#define DUP(b) ((DUP_MASK >> (b)) & 1)
#define REDO(b, stmt) do { if (DUP(b)) { if (MK_ONE_LAUNCH) xcd_barrier(bar); else __syncthreads(); stmt; } } while (0)
#ifndef ECHO_MASK
#define ECHO_MASK 0
#endif
#define ECHO_K 4
    unsigned long long echo_acc = 0ull, echo_prev = ECHO_MASK ? __builtin_amdgcn_s_memrealtime() : 0ull;
#define SEAM(b) do { if (IN(ph) && IN(ph + 1)) xcd_barrier(bar); ++ph; \
        if (ECHO_MASK) { const unsigned long long now_ = __builtin_amdgcn_s_memrealtime(); if ((ECHO_MASK >> (b)) & 1) echo_acc += now_ - echo_prev; echo_prev = now_; } } while (0)

    float* mod = (float*)(ws + WS_MOD);
    bf16_t* HU = (bf16_t*)(ws + WS_HU);
    const float* cosq = (const float*)(ws + WS_TAB); const float* sinq = cosq + SEQ * 16; const float* cosi = sinq + SEQ * 16; const float* sini = cosi + SEQ * 8;
    const int G = gridDim.x, bx = blockIdx.x;

    if (PM(0) && IN(ph)) { phase0<0>(wv, args, lds); REDO(0, phase0<SC_VAR>(wv, args, lds)); }
    SEAM(0);
#pragma unroll 1
    for (int layer = 0; layer < 4; ++layer) {
        const int j = layer >> 1;
        bf16_t* XB = (bf16_t*)(ws + WS_XB);
        const float* lmod = mod + layer * 4 * 6144;
        if (PM(1) && IN(ph)) { if (layer == 0) phase_norm<false>(wv, args.x, args.norm_g, lmod, HU); else phase_norm<true>(wv, XB, args.norm_g + layer * DM, lmod, HU); }
        SEAM(1);
        if ((layer & 1) == 0) {
            bf16_t* VG = (bf16_t*)(ws + WS_VG); bf16_t* PL = (bf16_t*)(ws + WS_PL);
            if (PM(2) && IN(ph)) { pg8::Gemm g{HU, (const bf16_t*)(ws + WS_WPI) + (size_t)j * POOL_IN * DM, SEQ, POOL_IN, DM, DM, DM, 0, 0};
                pg8::StaticOrder S; S.init(SEQ, POOL_IN, G, bx); pg8::EpiBf16 E{VG, POOL_IN};
                pg8::gemm_phase<pg8::EpiBf16, true>(wv, lds, g, S, E); REDO(2, (pg8::gemm_phase<pg8::EpiBf16, true>(wv, lds, g, S, E))); }
            SEAM(2);
            if (PM(3) && IN(ph)) { phase_pool(wv, VG, PL); REDO(3, phase_pool(wv, VG, PL)); }
            SEAM(3);
            if (PM(4) && IN(ph)) { pg8::Gemm g{PL, (const bf16_t*)(ws + WS_WPG) + (size_t)j * DM * 512, SEQ, DM, 512, DM, 512, 1, 512};
                pg8::StaticOrder S; S.init(SEQ, DM, G, bx); pg8::EpiPoolGrp E{HU, VG, args.pls + j * DM};
                pg8::gemm_phase<pg8::EpiPoolGrp, true>(wv, lds, g, S, E); REDO(4, (pg8::gemm_phase<pg8::EpiPoolGrp, true>(wv, lds, g, S, E))); }
            SEAM(4);
            if (PM(5) && IN(ph)) { pg8::Gemm g{HU, (const bf16_t*)(ws + WS_WPO) + (size_t)j * DM * DM, SEQ, DM, DM, DM, DM, 0, 0};
                pg8::StaticOrder S; S.init(SEQ, DM, G, bx);
                if (layer == 0) { pg8::EpiResid<false, true> E{args.x, XB, lmod + 2 * DM}; pg8::gemm_phase<pg8::EpiResid<false, true>, true>(wv, lds, g, S, E); }
                else { pg8::EpiResid<true, true> E{XB, XB, lmod + 2 * DM}; pg8::gemm_phase<pg8::EpiResid<true, true>, true>(wv, lds, g, S, E); } }
            SEAM(5);
        } else {
            bf16_t* Qh = (bf16_t*)(ws + WS_Q); bf16_t* Kh = (bf16_t*)(ws + WS_K); bf16_t* Vh = (bf16_t*)(ws + WS_V); bf16_t* SG = (bf16_t*)(ws + WS_GATE);
            bf16_t* QI = (bf16_t*)(ws + WS_QI); bf16_t* KI = (bf16_t*)(ws + WS_KI); float* WI = (float*)(ws + WS_WI);
            unsigned long long* MASK = (unsigned long long*)(ws + WS_MASK); float* SC = (float*)(ws + WS_SC);
            if (PM(6) && IN(ph)) { pg8::Gemm g{HU, (const bf16_t*)(ws + WS_WAI) + (size_t)j * ATTN_INP * DM, SEQ, ATTN_INP, DM, DM, DM, 0, 0};
                pg8::StaticOrder S; S.init(SEQ, ATTN_INP, G, bx); pg8::EpiAttnIn E{ws, args.pos};
                pg8::gemm_phase<pg8::EpiAttnIn, true>(wv, lds, g, S, E); REDO(6, (pg8::gemm_phase<pg8::EpiAttnIn, true>(wv, lds, g, S, E))); }
            SEAM(6);
            if (PM(7) && IN(ph)) { unsigned* qctr = (unsigned*)(ws + WS_CTL) + 8192 + 128 * j; phase_scores<0>(wv, QI, KI, WI, SC, lds, qctr); REDO(7, phase_scores<SC_VAR>(wv, QI, KI, WI, (float*)(ws + WS_END), lds, qctr + 64)); }
            SEAM(7);
            if (PM(8) && IN(ph)) { phase_select<0>(wv, SC, MASK, lds); REDO(8, phase_select<SC_VAR>(wv, SC, (unsigned long long*)(ws + WS_END), lds)); }
            SEAM(8);
            if (PM(9) && IN(ph)) { phase_attn(wv, Qh, Kh, Vh, HU, SG, MASK, (char*)lds_raw); REDO(9, phase_attn(wv, Qh, Kh, Vh, HU, SG, MASK, (char*)lds_raw)); }
            SEAM(9);
            if (PM(5) && IN(ph)) { pg8::Gemm g{HU, (const bf16_t*)(ws + WS_WAO) + (size_t)j * DM * DM, SEQ, DM, DM, DM, DM, 0, 0};
                pg8::StaticOrder S; S.init(SEQ, DM, G, bx);
                { pg8::EpiResid<true, true> E{XB, XB, lmod + 2 * DM}; pg8::gemm_phase<pg8::EpiResid<true, true>, true>(wv, lds, g, S, E); } }
            SEAM(5);
        }
    }
    if (PM(10) && IN(ph)) { phase_final(wv, (const bf16_t*)(ws + WS_XB), args.out, args.fg); REDO(10, phase_final(wv, (const bf16_t*)(ws + WS_XB), args.out, args.fg)); }
    if (ECHO_MASK) { if ((ECHO_MASK >> 10) & 1) echo_acc += __builtin_amdgcn_s_memrealtime() - echo_prev;
        if (bx == 0) { const unsigned long long target_ = __builtin_amdgcn_s_memrealtime() + (unsigned long long)ECHO_K * echo_acc; while (__builtin_amdgcn_s_memrealtime() < target_) __builtin_amdgcn_s_sleep(32); } }
#undef IN
#undef PM
#undef SEAM
#undef REDO
}
constexpr int N_PHASES = 1 + 2 * 5 + 2 * 6 + 1;

extern "C" void kernel_launch(void* const* d_in, const int* in_sizes, int n_in, void* d_out, int out_size, void* d_ws, size_t ws_size, hipStream_t stream) {
    static int grid = 0;
    if (grid == 0) {
        if (n_in != 13 || in_sizes[0] != SEQ * DM || out_size != SEQ * DM || ws_size < WS_END) {
            fprintf(stderr, "kernel_launch: unexpected shapes / workspace (n_in %d, in0 %d, out %d, ws %zu, need %zu)\n", n_in, n_in > 0 ? in_sizes[0] : -1, out_size, ws_size, (size_t)WS_END);
            grid = -1; return; }
        int dev = 0, cus = 0, per_cu = 0;
        if (hipGetDevice(&dev) != hipSuccess || hipDeviceGetAttribute(&cus, hipDeviceAttributeMultiprocessorCount, dev) != hipSuccess) { grid = -1; return; }
        if (hipFuncSetAttribute((const void*)trunk_fwd, hipFuncAttributeMaxDynamicSharedMemorySize, LDS_BYTES) != hipSuccess) { fprintf(stderr, "kernel_launch: hipFuncSetAttribute failed\n"); grid = -1; return; }
        if (hipOccupancyMaxActiveBlocksPerMultiprocessor(&per_cu, (const void*)trunk_fwd, NTHR, LDS_BYTES) != hipSuccess || per_cu < 1) {
            fprintf(stderr, "kernel_launch: occupancy query reports %d workgroups per CU\n", per_cu); per_cu = 1; }
        (void)hipGetLastError();
        grid = cus;
        if (grid > 256) grid = 256;
    }
    if (grid < 0) return;
    (void)hipMemsetAsync((char*)d_ws + WS_CTL, 0, CTL_ZERO_BYTES, stream);
    Args a{};
    a.x = (const float*)d_in[0]; a.c = (const float*)d_in[1]; a.pos = (const int*)d_in[2]; a.norm_g = (const float*)d_in[3];
    a.mod_w = (const float*)d_in[4]; a.mod_b = (const float*)d_in[5]; a.pwi = (const float*)d_in[6]; a.pwg = (const float*)d_in[7];
    a.pls = (const float*)d_in[8]; a.pwo = (const float*)d_in[9]; a.awi = (const float*)d_in[10]; a.awo = (const float*)d_in[11]; a.fg = (const float*)d_in[12];
    a.out = (float*)d_out; a.ws = (unsigned char*)d_ws;
#if MK_ONE_LAUNCH
    a.ph_lo = 0; a.ph_hi = N_PHASES;
    hipLaunchKernelGGL(trunk_fwd, dim3(grid), dim3(NTHR), LDS_BYTES, stream, a);
#else
    for (int p = 0; p < N_PHASES; ++p) { a.ph_lo = p; a.ph_hi = p + 1; hipLaunchKernelGGL(trunk_fwd, dim3(grid), dim3(NTHR), LDS_BYTES, stream, a); }
#endif
}
```

```cpp
#include <hip/hip_runtime.h>
#include <cstdio>
#include <cstdint>
#include <cmath>

#ifndef MK_ONE_LAUNCH
#define MK_ONE_LAUNCH 1
#endif

#define LAS __attribute__((address_space(3)))
#define GAS __attribute__((address_space(1)))
typedef unsigned short bf16_t;
typedef short bf16x8 __attribute__((ext_vector_type(8)));
typedef short s16x4 __attribute__((ext_vector_type(4)));
typedef float f32x4 __attribute__((ext_vector_type(4)));
typedef float f32x2 __attribute__((ext_vector_type(2)));
typedef float f32x16 __attribute__((ext_vector_type(16)));
typedef unsigned u32x4 __attribute__((ext_vector_type(4)));
typedef unsigned u32x2 __attribute__((ext_vector_type(2)));

constexpr int DM = 2048, SEQ = 8192, NHEAD = 16, HD = 128, IDXH = 16, IDXD = 64;
constexpr int POOL_IN = 4096, ATTN_IN = 9296, ATTN_INP = 9472  ;
constexpr int TOPK = 256;
constexpr float EPS = 1e-6f;

constexpr size_t MiB = 1u << 20;
constexpr size_t WS_CTL = 0, CTL_ZERO_BYTES = 64 * 1024;
constexpr size_t WS_MOD = 1 * MiB;
constexpr size_t WS_TAB = 2 * MiB;
constexpr size_t WS_WPI = 4 * MiB;
constexpr size_t WS_WPG = 36 * MiB;
constexpr size_t WS_WPO = 40 * MiB;
constexpr size_t WS_WAI = 56 * MiB;
constexpr size_t WS_WAO = 130 * MiB;
constexpr size_t WS_HU = 146 * MiB;
constexpr size_t WS_L = 178 * MiB;
constexpr size_t WS_VG = WS_L;
constexpr size_t WS_PL = WS_L + 64 * MiB;
constexpr size_t WS_Q = WS_L, WS_K = WS_L + 32 * MiB, WS_V = WS_L + 64 * MiB;
constexpr size_t WS_GATE = WS_L + 96 * MiB;
constexpr size_t WS_QI = WS_L + 128 * MiB;
constexpr size_t WS_KI = WS_L + 144 * MiB;
constexpr size_t WS_WI = WS_L + 145 * MiB;
constexpr size_t WS_MASK = WS_L + 146 * MiB;
constexpr size_t WS_SC = WS_L + 154 * MiB;
constexpr size_t WS_XB = WS_SC + 139 * MiB;
constexpr size_t WS_END = WS_XB + 32 * MiB;

__device__ __forceinline__ unsigned cvt_pk_bf16(float lo, float hi) { unsigned r; asm volatile("v_cvt_pk_bf16_f32 %0, %1, %2" : "=v"(r) : "v"(lo), "v"(hi)); return r; }
__device__ __forceinline__ unsigned f2bf(float f) { unsigned u = __builtin_bit_cast(unsigned, f); return (u + 0x7fffu + ((u >> 16) & 1u)) >> 16; }
__device__ __forceinline__ unsigned pk2(float lo, float hi) { return f2bf(lo) | (f2bf(hi) << 16); }
__device__ __forceinline__ float bf2f(unsigned short b) { return __builtin_bit_cast(float, (unsigned)b << 16); }
__device__ __forceinline__ float fast_sigmoid(float x) { return __builtin_amdgcn_rcpf(1.0f + __builtin_amdgcn_exp2f(-1.4426950408889634f * x)); }
__device__ __forceinline__ float silu_f(float x) { return x * fast_sigmoid(x); }
template <int X> __device__ __forceinline__ float swz_xor(float v) {
    return __builtin_bit_cast(float, __builtin_amdgcn_ds_swizzle(__builtin_bit_cast(int, v), (X << 10) | 0x1f)); }
__device__ __forceinline__ float wave_sum(float v) {
    v += swz_xor<1>(v); v += swz_xor<2>(v); v += swz_xor<4>(v); v += swz_xor<8>(v); v += swz_xor<16>(v);
    const auto rr = __builtin_amdgcn_permlane32_swap(__builtin_bit_cast(unsigned, v), __builtin_bit_cast(unsigned, v), false, false);
    const unsigned r0 = rr[0], r1 = rr[1];
    return __builtin_bit_cast(float, r0) + __builtin_bit_cast(float, r1);
}
__device__ __forceinline__ int opaque_tid(int wv) { int t; asm volatile("v_mbcnt_lo_u32_b32 %0, -1, 0\n\tv_mbcnt_hi_u32_b32 %0, -1, %0\n\tv_lshl_add_u32 %0, %1, 6, %0" : "=&v"(t) : "s"(wv)); return t; }
#define LDS_WAIT() asm volatile("s_waitcnt lgkmcnt(0)" ::: "memory")
#define VM_WAIT() asm volatile("s_waitcnt vmcnt(0)" ::: "memory")

__device__ __forceinline__ void unpack8(const u32x4 w, f32x4& a, f32x4& b) {
    const unsigned w0 = w.x, w1 = w.y, w2 = w.z, w3 = w.w;
    a = (f32x4){__builtin_bit_cast(float, w0 << 16), __builtin_bit_cast(float, w0 & 0xffff0000u), __builtin_bit_cast(float, w1 << 16), __builtin_bit_cast(float, w1 & 0xffff0000u)};
    b = (f32x4){__builtin_bit_cast(float, w2 << 16), __builtin_bit_cast(float, w2 & 0xffff0000u), __builtin_bit_cast(float, w3 << 16), __builtin_bit_cast(float, w3 & 0xffff0000u)};
}
__device__ __forceinline__ u32x4 pack8(const f32x4 a, const f32x4 b) { u32x4 w; w.x = cvt_pk_bf16(a[0], a[1]); w.y = cvt_pk_bf16(a[2], a[3]); w.z = cvt_pk_bf16(b[0], b[1]); w.w = cvt_pk_bf16(b[2], b[3]); return w; }

namespace pg8 {
constexpr int BM = 256, BK = 64, HALF = 128, HTB = HALF * BK * 2, STAGE_BYTES = 8 * HTB, NXCD = 8, WGM = 8;
__host__ __device__ __forceinline__ int lds_byte(int r, int c) { const int st = (r >> 4) * 2 + (c >> 5), rr = r & 15, cc = c & 31, ob = rr * 64 + cc * 2; return st * 1024 + (ob ^ (((ob >> 9) & 1) << 5)); }
__host__ __device__ __forceinline__ void stage_rc(int b, int& R, int& C) { const int st = b / 1024, sb = b % 1024, swz = sb ^ (((sb >> 9) & 1) << 5); R = (st >> 1) * 16 + swz / 64; C = (st & 1) * 32 + (swz % 64) / 2; }
__host__ __device__ __forceinline__ int perm32(int rho) { const int n = rho >> 4, i = rho & 15; return 8 * (i >> 2) + 4 * n + (i & 3); }

struct Unit { int pm, pn; };
struct Gemm { const bf16_t* A; const bf16_t* Bt; int M, N, K, lda, ldb, agsh, agstride; };

struct StaticOrder {
    int nM, nN, nwg, G, c;
    __host__ __device__ void init(int M, int N, int G_, int c_) { nM = M / BM; nN = N / BM; nwg = nM * nN; G = G_; c = c_; }
    __host__ __device__ bool next(int i, Unit& u) const {
        const long L = (long)i * G + c; if (L >= nwg) return false;
        int wgid = (int)L; { const int q = nwg / NXCD, r = nwg % NXCD, xcd = wgid % NXCD, off = wgid / NXCD; wgid = (xcd < r ? xcd * (q + 1) : r * (q + 1) + (xcd - r) * q) + off; }
        const int nig = WGM * nN, gid = wgid / nig, fm = gid * WGM, gsz = (nM - fm) < WGM ? (nM - fm) : WGM;
        u.pm = fm + ((wgid % nig) % gsz); u.pn = (wgid % nig) / gsz; return true;
    }
};

template <class Epi, bool ALIGN_EPI>
__device__ __forceinline__ void gemm_phase(int wv, LAS unsigned char* lds, const Gemm g, const StaticOrder& S, const Epi& E) {
    const int tid = opaque_tid(wv), wid = __builtin_amdgcn_readfirstlane(tid >> 6), lane = tid & 63, wr = wid >> 2, wc = wid & 3, fr = lane & 15, fq = lane >> 4;
    const int K = g.K, nt = K / BK;
    unsigned voffA[2], voffB[2];
#pragma unroll
    for (int i = 0; i < 2; ++i) { int R, C; stage_rc(tid * 16 + i * 8192, R, C); const int Rb = Epi::PERM ? ((R & ~31) + perm32(R & 31)) : R;
        voffA[i] = (unsigned)(R * g.lda + C) * 2u; voffB[i] = (unsigned)(Rb * g.ldb + C) * 2u; }
    const size_t kstep = (size_t)(BK * 2);
    const size_t hstepA = (size_t)HALF * g.lda * 2, hstepB = (size_t)HALF * g.ldb * 2;
    const size_t tstepA = 2 * hstepA, tstepB = 2 * hstepB;
    const unsigned ldsw = (unsigned)wid * 1024u;
    const int aoff = lds_byte(wr * 64 + fr, fq * 8), boff = lds_byte(wc * 32 + fr, fq * 8);
#define PG8_SA(b, h) (((b) * 2 + (h)) * HTB)
#define PG8_SB(b, h) ((4 + (b) * 2 + (h)) * HTB)
#define PG8_STAGE(bufoff, gbase, voff) do { _Pragma("unroll") for (int _i = 0; _i < 2; ++_i) \
        __builtin_amdgcn_global_load_lds((const unsigned*)((const char*)(gbase) + (voff)[_i]), (LAS unsigned*)(lds + (bufoff) + ldsw + _i * 8192), 16, 0, 0); } while (0)
#define PG8_LDA(dst, b, h) do { _Pragma("unroll") for (int m = 0; m < 4; ++m) _Pragma("unroll") for (int k = 0; k < 2; ++k) dst[m][k] = *(const LAS bf16x8*)(lds + PG8_SA(b, h) + aoff + m * 2048 + k * 1024); } while (0)
#define PG8_LDB(dst, b, h) do { _Pragma("unroll") for (int n = 0; n < 2; ++n) _Pragma("unroll") for (int k = 0; k < 2; ++k) dst[n][k] = *(const LAS bf16x8*)(lds + PG8_SB(b, h) + boff + n * 2048 + k * 1024); } while (0)
#define PG8_MMA(ai, bj, At, Bt) do { __builtin_amdgcn_s_setprio(1); _Pragma("unroll") for (int m = 0; m < 4; ++m) _Pragma("unroll") for (int n = 0; n < 2; ++n) _Pragma("unroll") for (int k = 0; k < 2; ++k) \
        acc[ai][bj][m][n] = __builtin_amdgcn_mfma_f32_16x16x32_bf16(Bt[n][k], At[m][k], acc[ai][bj][m][n], 0, 0, 0); __builtin_amdgcn_s_setprio(0); } while (0)
#define PG8_WAIT_V(n) asm volatile("s_waitcnt vmcnt(" #n ")" ::: "memory")
#define PG8_WAIT_L(n) asm volatile("s_waitcnt lgkmcnt(" #n ")" ::: "memory")
#define PG8_BAR __builtin_amdgcn_s_barrier()
#define PG8_SCHED __builtin_amdgcn_sched_barrier(0)
#define PG8_AOFF(u) ((size_t)(u).pm * tstepA + (size_t)(((u).pn >> g.agsh) * g.agstride) * 2)
    Unit cur, nxt; int ui = 0;
    if (!S.next(0, cur)) return;
    f32x4 acc[2][2][4][2];
#pragma unroll
    for (int a = 0; a < 2; ++a)
#pragma unroll
        for (int b = 0; b < 2; ++b)
#pragma unroll
            for (int m = 0; m < 4; ++m)
#pragma unroll
                for (int n = 0; n < 2; ++n) acc[a][b][m][n] = (f32x4){0.f, 0.f, 0.f, 0.f};
    bf16x8 At[4][2], B0[2][2], B1[2][2];
    const char* cA = (const char*)g.A + PG8_AOFF(cur); const char* cB = (const char*)g.Bt + (size_t)cur.pn * tstepB;
    PG8_STAGE(PG8_SB(0, 0), cB, voffB); PG8_STAGE(PG8_SB(0, 1), cB + hstepB, voffB); PG8_STAGE(PG8_SA(0, 0), cA, voffA); PG8_STAGE(PG8_SA(0, 1), cA + hstepA, voffA);
    if (wr == 1) PG8_BAR;
    PG8_WAIT_V(2); PG8_BAR;
    PG8_STAGE(PG8_SB(1, 0), cB + kstep, voffB); PG8_STAGE(PG8_SA(1, 0), cA + kstep, voffA); PG8_STAGE(PG8_SB(1, 1), cB + hstepB + kstep, voffB);
    PG8_WAIT_V(6); PG8_BAR;
    for (;;) {
        const bool has_next = S.next(ui + 1, nxt);
        const char* nA = has_next ? (const char*)g.A + PG8_AOFF(nxt) : cA; const char* nB = has_next ? (const char*)g.Bt + (size_t)nxt.pn * tstepB : cB;
        for (int t = 0; t < nt; t += 2) {
            const bool last = (t == nt - 2);
            const char* a1 = cA + (size_t)(t + 1) * kstep;
            const char* a2 = last ? nA : cA + (size_t)(t + 2) * kstep; const char* b2 = last ? nB : cB + (size_t)(t + 2) * kstep;
            const char* a3 = a2 + kstep; const char* b3 = b2 + kstep;
            PG8_LDB(B0, 0, 0); PG8_LDB(B1, 0, 1); PG8_SCHED; PG8_LDA(At, 0, 0); PG8_STAGE(PG8_SA(1, 1), a1 + hstepA, voffA);
            PG8_WAIT_V(8); PG8_WAIT_L(0); PG8_BAR; PG8_MMA(0, 0, At, B0); PG8_MMA(0, 1, At, B1); PG8_BAR; PG8_SCHED;
            PG8_LDA(At, 0, 1); PG8_STAGE(PG8_SB(0, 0), b2, voffB); PG8_STAGE(PG8_SB(0, 1), b2 + hstepB, voffB); PG8_STAGE(PG8_SA(0, 0), a2, voffA);
            PG8_WAIT_V(8); PG8_WAIT_L(0); PG8_BAR; PG8_MMA(1, 0, At, B0); PG8_MMA(1, 1, At, B1); PG8_BAR; PG8_SCHED;
            PG8_LDB(B0, 1, 0); PG8_LDB(B1, 1, 1); PG8_SCHED; PG8_LDA(At, 1, 0); PG8_STAGE(PG8_SA(0, 1), a2 + hstepA, voffA);
            PG8_WAIT_V(8); PG8_WAIT_L(0); PG8_BAR; PG8_MMA(0, 0, At, B0); PG8_MMA(0, 1, At, B1); PG8_BAR; PG8_SCHED;
            PG8_LDA(At, 1, 1); PG8_STAGE(PG8_SB(1, 0), b3, voffB); PG8_STAGE(PG8_SB(1, 1), b3 + hstepB, voffB); PG8_STAGE(PG8_SA(1, 0), a3, voffA);
            PG8_WAIT_V(8); PG8_WAIT_L(0); PG8_BAR; PG8_MMA(1, 0, At, B0); PG8_MMA(1, 1, At, B1); PG8_BAR; PG8_SCHED;
        }
        if constexpr (ALIGN_EPI) { if (wr == 0) PG8_BAR; }
        E(acc, cur, wr, wc, fr, fq);
        if (!has_next) break;
#pragma unroll
        for (int a = 0; a < 2; ++a)
#pragma unroll
            for (int b = 0; b < 2; ++b)
#pragma unroll
                for (int m = 0; m < 4; ++m)
#pragma unroll
                    for (int n = 0; n < 2; ++n) acc[a][b][m][n] = (f32x4){0.f, 0.f, 0.f, 0.f};
        cur = nxt; cA = nA; cB = nB; ++ui;
        if constexpr (ALIGN_EPI) { if (wr == 1) PG8_BAR; }
    }
    PG8_WAIT_V(0);
    if constexpr (!ALIGN_EPI) { if (wr == 0) PG8_BAR; }
    PG8_BAR;
#undef PG8_SA
#undef PG8_SB
#undef PG8_STAGE
#undef PG8_LDA
#undef PG8_LDB
#undef PG8_MMA
#undef PG8_WAIT_V
#undef PG8_WAIT_L
#undef PG8_BAR
#undef PG8_SCHED
#undef PG8_AOFF
}

struct EpiBf16 {
    static constexpr bool PERM = true;
    bf16_t* O; int ldc;
    __device__ __forceinline__ void operator()(const f32x4 (&acc)[2][2][4][2], const Unit& u, int wr, int wc, int fr, int fq) const {
        const int row0 = u.pm * BM + wr * 64 + fr; const int col0 = u.pn * BM + wc * 32 + 8 * fq;
#pragma unroll
        for (int ai = 0; ai < 2; ++ai)
#pragma unroll
            for (int m = 0; m < 4; ++m) { bf16_t* rowp = O + (size_t)(row0 + ai * HALF + m * 16) * ldc + col0;
#pragma unroll
                for (int bj = 0; bj < 2; ++bj) { const f32x4 v0 = acc[ai][bj][m][0], v1 = acc[ai][bj][m][1];
                    u32x4 w; w.x = cvt_pk_bf16(v0[0], v0[1]); w.y = cvt_pk_bf16(v0[2], v0[3]); w.z = cvt_pk_bf16(v1[0], v1[1]); w.w = cvt_pk_bf16(v1[2], v1[3]);
                    *(u32x4*)(rowp + bj * HALF) = w; } }
    }
};
struct EpiPoolGrp {
    static constexpr bool PERM = true;
    bf16_t* U; const bf16_t* VG; const float* ls;
    __device__ __forceinline__ void operator()(const f32x4 (&acc)[2][2][4][2], const Unit& u, int wr, int wc, int fr, int fq) const {
        const int row0 = u.pm * BM + wr * 64 + fr; const int col0 = u.pn * BM + wc * 32 + 8 * fq;
        f32x4 lv[2][2];
#pragma unroll
        for (int bj = 0; bj < 2; ++bj)
#pragma unroll
            for (int n = 0; n < 2; ++n) lv[bj][n] = *(const f32x4*)(ls + col0 + bj * HALF + 4 * n);
#pragma unroll
        for (int ai = 0; ai < 2; ++ai)
#pragma unroll
            for (int m = 0; m < 4; ++m) { const size_t row = (size_t)(row0 + ai * HALF + m * 16);
#pragma unroll
                for (int bj = 0; bj < 2; ++bj) {
                    const u32x4 gw = *(const u32x4*)(VG + row * POOL_IN + DM + col0 + bj * HALF);
                    f32x4 v0 = acc[ai][bj][m][0] * lv[bj][0], v1 = acc[ai][bj][m][1] * lv[bj][1];
                    float g[8];
#pragma unroll
                    for (int e = 0; e < 4; ++e) { g[2 * e] = __builtin_bit_cast(float, gw[e] << 16); g[2 * e + 1] = __builtin_bit_cast(float, gw[e] & 0xffff0000u); }
#pragma unroll
                    for (int e = 0; e < 4; ++e) { v0[e] *= silu_f(g[e]); v1[e] *= silu_f(g[4 + e]); }
                    u32x4 w; w.x = cvt_pk_bf16(v0[0], v0[1]); w.y = cvt_pk_bf16(v0[2], v0[3]); w.z = cvt_pk_bf16(v1[0], v1[1]); w.w = cvt_pk_bf16(v1[2], v1[3]);
                    *(u32x4*)(U + row * DM + col0 + bj * HALF) = w; } }
    }
};
template <bool IN_BF16, bool OUT_BF16> struct EpiResid {
    static constexpr bool PERM = true;
    const void* xin; void* xout; const float* gmod;
    __device__ __forceinline__ void operator()(const f32x4 (&acc)[2][2][4][2], const Unit& u, int wr, int wc, int fr, int fq) const {
        const int row0 = u.pm * BM + wr * 64 + fr; const int col0 = u.pn * BM + wc * 32 + 8 * fq;
        f32x4 gv[2][2];
#pragma unroll
        for (int bj = 0; bj < 2; ++bj)
#pragma unroll
            for (int n = 0; n < 2; ++n) { const float* gp = gmod + col0 + bj * HALF + 4 * n;
                gv[bj][n] = ((*(const f32x4*)gp + *(const f32x4*)(gp + 6144)) + *(const f32x4*)(gp + 2 * 6144)) + *(const f32x4*)(gp + 3 * 6144); }
#pragma unroll
        for (int ai = 0; ai < 2; ++ai)
#pragma unroll
            for (int m = 0; m < 4; ++m) { const size_t off = (size_t)(row0 + ai * HALF + m * 16) * DM + col0;
#pragma unroll
                for (int bj = 0; bj < 2; ++bj) {
                    f32x4 b0, b1;
                    if (IN_BF16) { const u32x4 w = *(const u32x4*)((const bf16_t*)xin + off + bj * HALF);
                        const unsigned w0 = w.x, w1 = w.y, w2 = w.z, w3 = w.w;
                        b0 = (f32x4){__builtin_bit_cast(float, w0 << 16), __builtin_bit_cast(float, w0 & 0xffff0000u), __builtin_bit_cast(float, w1 << 16), __builtin_bit_cast(float, w1 & 0xffff0000u)};
                        b1 = (f32x4){__builtin_bit_cast(float, w2 << 16), __builtin_bit_cast(float, w2 & 0xffff0000u), __builtin_bit_cast(float, w3 << 16), __builtin_bit_cast(float, w3 & 0xffff0000u)}; }
                    else { b0 = *(const f32x4*)((const float*)xin + off + bj * HALF); b1 = *(const f32x4*)((const float*)xin + off + bj * HALF + 4); }
                    const f32x4 y0 = b0 + gv[bj][0] * acc[ai][bj][m][0], y1 = b1 + gv[bj][1] * acc[ai][bj][m][1];
                    if (OUT_BF16) { u32x4 w; w.x = cvt_pk_bf16(y0[0], y0[1]); w.y = cvt_pk_bf16(y0[2], y0[3]); w.z = cvt_pk_bf16(y1[0], y1[1]); w.w = cvt_pk_bf16(y1[2], y1[3]);
                        *(u32x4*)((bf16_t*)xout + off + bj * HALF) = w; }
                    else { *(f32x4*)((float*)xout + off + bj * HALF) = y0; *(f32x4*)((float*)xout + off + bj * HALF + 4) = y1; } } }
    }
};
struct EpiAttnIn {
    static constexpr bool PERM = true;
    unsigned char* ws; const int* pos;
    __device__ __forceinline__ void operator()(const f32x4 (&acc)[2][2][4][2], const Unit& u, int wr, int wc, int fr, int fq) const {
        const int row0 = u.pm * BM + wr * 64 + fr; const int pn = u.pn;
        bf16_t* const Qh = (bf16_t*)(ws + WS_Q); bf16_t* const SG = (bf16_t*)(ws + WS_GATE); bf16_t* const QI = (bf16_t*)(ws + WS_QI); bf16_t* const KI = (bf16_t*)(ws + WS_KI); float* const WI = (float*)(ws + WS_WI);
        const float* const cosq = (const float*)(ws + WS_TAB); const float* const sinq = cosq + SEQ * 16; const float* const cosi = sinq + SEQ * 16; const float* const sini = cosi + SEQ * 8;
#pragma unroll
        for (int ai = 0; ai < 2; ++ai)
#pragma unroll
            for (int m = 0; m < 4; ++m) {
                const int row = row0 + ai * HALF + m * 16;
                if (pn < 24) {
                    bf16_t* base = Qh + (size_t)(pn >> 3) * ((size_t)SEQ * DM);
                    const bool rope = (pn < 16) && (wc == 0);
                    f32x4 cs[2] = {{1.f, 1.f, 1.f, 1.f}, {1.f, 1.f, 1.f, 1.f}}, sn[2] = {{0.f, 0.f, 0.f, 0.f}, {0.f, 0.f, 0.f, 0.f}};
                    if (rope) { const float* cp = cosq + (size_t)row * 16 + 8 * (fq & 1); const float* sp = sinq + (size_t)row * 16 + 8 * (fq & 1);
                        cs[0] = *(const f32x4*)cp; cs[1] = *(const f32x4*)(cp + 4); sn[0] = *(const f32x4*)sp; sn[1] = *(const f32x4*)(sp + 4); }
#pragma unroll
                    for (int bj = 0; bj < 2; ++bj) { const int head = 2 * (pn & 7) + bj;
                        f32x4 v[2] = {acc[ai][bj][m][0], acc[ai][bj][m][1]};
                        if (rope) {
#pragma unroll
                            for (int n = 0; n < 2; ++n) { f32x4 pr;
#pragma unroll
                                for (int e = 0; e < 4; ++e) { const float ve = v[n][e];
                                    const auto rr = __builtin_amdgcn_permlane32_swap(__builtin_bit_cast(unsigned, ve), __builtin_bit_cast(unsigned, ve), false, false);
                                    const unsigned pu = (fq < 2) ? rr[1] : rr[0]; pr[e] = __builtin_bit_cast(float, pu); }
                                v[n] = (fq < 2) ? (v[n] * cs[n] - pr * sn[n]) : (v[n] * cs[n] + pr * sn[n]); } }
                        *(u32x4*)(base + ((size_t)head * SEQ + row) * HD + 32 * wc + 8 * fq) = pack8(v[0], v[1]); }
                } else if (pn < 32) {
#pragma unroll
                    for (int bj = 0; bj < 2; ++bj) { f32x4 v0 = acc[ai][bj][m][0], v1 = acc[ai][bj][m][1];
#pragma unroll
                        for (int e = 0; e < 4; ++e) { v0[e] = silu_f(v0[e]); v1[e] = silu_f(v1[e]); }
                        *(u32x4*)(SG + (size_t)row * DM + (pn - 24) * BM + bj * HALF + 32 * wc + 8 * fq) = pack8(v0, v1); }
                } else {
                    const bool isq = pn < 36;
                    const bool rope = ((wc & 1) == 0) && (isq || wc == 0);
                    f32x4 cs[2], sn[2];
                    { const float* cp = cosi + (size_t)row * 8; const float* sp = sini + (size_t)row * 8;
                      cs[0] = *(const f32x4*)cp; cs[1] = *(const f32x4*)(cp + 4); sn[0] = *(const f32x4*)sp; sn[1] = *(const f32x4*)(sp + 4); }
#pragma unroll
                    for (int bj = 0; bj < 2; ++bj) {
                        if (!isq && bj == 1) continue;
                        f32x4 v[2] = {acc[ai][bj][m][0], acc[ai][bj][m][1]};
                        if (rope) {
#pragma unroll
                            for (int n = 0; n < 2; ++n) { f32x4 pr;
#pragma unroll
                                for (int e = 0; e < 4; ++e) pr[e] = swz_xor<16>(v[n][e]);
                                const f32x4 ro = (fq == 0) ? (v[n] * cs[n] - pr * sn[n]) : (v[n] * cs[n] + pr * sn[n]);
                                v[n] = (fq < 2) ? ro : v[n]; } }
                        const int cl = bj * HALF + 32 * wc + 8 * fq;
                        if (isq) *(u32x4*)(QI + (size_t)row * 1024 + (pn - 32) * BM + cl) = pack8(v[0], v[1]);
                        else if (cl < 64) *(u32x4*)(KI + (size_t)row * 64 + cl) = pack8(v[0], v[1]);
                        else if (cl < 80) { *(f32x4*)(WI + (size_t)row * 16 + (cl - 64)) = v[0]; *(f32x4*)(WI + (size_t)row * 16 + (cl - 64) + 4) = v[1]; }
                    }
                }
                asm volatile("" ::: "memory");
            }
    }
};
}

namespace att {
constexpr int D = 128, NW = 8, QBLK = 32, KVBLK = 64, QB = NW * QBLK;
constexpr int KROWB = 272;
constexpr int SHM_V = KVBLK * D * 2, SHM_K = KVBLK * KROWB;
constexpr int QROWB = 272;
constexpr int Q_OFF = 2 * SHM_V + 2 * SHM_K + NW * 64 * 4;
constexpr int LDS_BYTES = Q_OFF + QB * QROWB;
constexpr float SCALE = 0.08838834764831845f;
constexpr float THR = 8.f;
#define KSWZ(row, colB) ((row) * KROWB + (colB))
#define SBAR() __builtin_amdgcn_sched_barrier(0)
__device__ __forceinline__ int v_st(int k, int c) { const int kk = (k & ~0xC) | ((k & 4) << 1) | ((k & 8) >> 1); return ((kk >> 3) * 4 + (c >> 5)) * 512 + ((kk & 7) * 32 + (c & 31)) * 2; }
__device__ __forceinline__ int v_rd_base(int lane) { return ((lane & 3) << 3) | (((lane >> 2) & 3) << 6) | (((lane >> 4) & 1) << 5) | (((lane >> 5) & 1) << 8); }
constexpr int v_rd_off(int d0, int ks, int half) { return d0 * 512 + ks * 4096 + half * 2048; }
__device__ __forceinline__ int crow(int r, int hi) { return (r & 3) + 8 * (r >> 2) + 4 * hi; }
__device__ __forceinline__ unsigned cvtpk(float lo, float hi) { unsigned r; asm volatile("v_cvt_pk_bf16_f32 %0, %1, %2" : "=v"(r) : "v"(lo), "v"(hi)); return r; }
__device__ __forceinline__ bf16x8 load8(const bf16_t* p) { return *reinterpret_cast<const bf16x8*>(p); }
__device__ __forceinline__ float mask_and(float v, unsigned mlo, unsigned mhi, int r, int p) {
    const int pos = 16 * (r & 1) + 2 * (r >> 2) + 8 * p;
    const unsigned w = (r & 2) ? mhi : mlo;
    const int bits = __builtin_amdgcn_sbfe((int)w, pos, 1);
    return __builtin_bit_cast(float, __builtin_bit_cast(unsigned, v) & (unsigned)bits);
}
__device__ __forceinline__ void partialSM(f32x16& p0, f32x16& p1, float& m_reg, float& mn, float& alpha, unsigned mlo, unsigned mhi) {
    float pmax = p0[0];
#pragma unroll
    for (int r = 1; r < 16; ++r) pmax = fmaxf(pmax, p0[r]);
#pragma unroll
    for (int r = 0; r < 16; ++r) pmax = fmaxf(pmax, p1[r]);
    { auto rr = __builtin_amdgcn_permlane32_swap(__float_as_uint(pmax), __float_as_uint(pmax), false, false);
      pmax = fmaxf(__uint_as_float(rr[0]), __uint_as_float(rr[1])); }
    constexpr float C2 = 1.4426950408889634f * SCALE;
    if (__builtin_expect(__all((pmax - m_reg) * SCALE <= THR), 1)) { mn = m_reg; alpha = 1.f; }
    else { mn = fmaxf(m_reg, pmax); alpha = __builtin_amdgcn_exp2f((m_reg - mn) * C2); m_reg = mn; }
    const float mnL = -mn * C2;
#pragma unroll
    for (int r = 0; r < 16; ++r) p0[r] = fmaf(p0[r], C2, mnL);
#pragma unroll
    for (int r = 0; r < 16; ++r) p1[r] = fmaf(p1[r], C2, mnL);
#pragma unroll
    for (int r = 0; r < 16; ++r) p0[r] = mask_and(__builtin_amdgcn_exp2f(p0[r]), mlo, mhi, r, 0);
}
__device__ __forceinline__ void finishSM(f32x16& p0, f32x16& p1, float alpha, float& l_reg, bf16x8& pa0, bf16x8& pa1, bf16x8& pa2, bf16x8& pa3, unsigned mlo, unsigned mhi) {
#pragma unroll
    for (int r = 0; r < 16; ++r) p1[r] = mask_and(__builtin_amdgcn_exp2f(p1[r]), mlo, mhi, r, 1);
    float ps = 0;
#pragma unroll
    for (int r = 0; r < 16; ++r) ps += p0[r];
#pragma unroll
    for (int r = 0; r < 16; ++r) ps += p1[r];
    { auto rr = __builtin_amdgcn_permlane32_swap(__float_as_uint(ps), __float_as_uint(ps), false, false);
      ps = __uint_as_float(rr[0]) + __uint_as_float(rr[1]); }
    l_reg = l_reg * alpha + ps;
#define PK4(P, B_, OUT) do { unsigned a0 = cvtpk(P[B_+0], P[B_+1]), a1 = cvtpk(P[B_+2], P[B_+3]);                          \
        unsigned b0 = cvtpk(P[B_+4], P[B_+5]), b1 = cvtpk(P[B_+6], P[B_+7]);                                             \
        auto r0 = __builtin_amdgcn_permlane32_swap(a0, b0, false, false); auto r1 = __builtin_amdgcn_permlane32_swap(a1, b1, false, false); \
        u32x4 w = {r0[0], r1[0], r0[1], r1[1]}; OUT = *reinterpret_cast<bf16x8*>(&w); } while (0)
    PK4(p0, 0, pa0); PK4(p0, 8, pa1); PK4(p1, 0, pa2); PK4(p1, 8, pa3);
#undef PK4
}
template <int KB>
__device__ __forceinline__ void qkt(f32x16& p0, f32x16& p1, const char* K_lds, int r32, int hi, const char* qa  ) {
    p0 = f32x16{}; p1 = f32x16{};
    const char* kb = K_lds + KB * SHM_K + r32 * KROWB + hi * 16;
#pragma unroll
    for (int d0 = 0; d0 < 8; ++d0) { const char* a = kb + d0 * 32;
        bf16x8 b0 = *reinterpret_cast<const bf16x8*>(a);
        bf16x8 b1 = *reinterpret_cast<const bf16x8*>(a + 32 * KROWB);
        const bf16x8 qf = *reinterpret_cast<const bf16x8*>(qa + d0 * 32);
        p0 = __builtin_amdgcn_mfma_f32_32x32x16_bf16(b0, qf, p0, 0, 0, 0);
        p1 = __builtin_amdgcn_mfma_f32_32x32x16_bf16(b1, qf, p1, 0, 0, 0); }
}
template <int VB>
__device__ __forceinline__ void pv_tile(f32x16* o, int vb0, bf16x8 pa0, bf16x8 pa1, bf16x8 pa2, bf16x8 pa3) {
#define TRRD(dst, off) asm volatile("ds_read_b64_tr_b16 %0, %1 offset:%2" : "=&v"(dst) : "v"(vb0), "i"(off) : "memory")
#define PV_D0(d0) do { s16x4 l0, l1, l2, l3, h0, h1, h2, h3; constexpr int b_ = VB * SHM_V + v_rd_off(d0, 0, 0); \
        TRRD(l0, b_); TRRD(h0, b_ + 2048); TRRD(l1, b_ + 4096); TRRD(h1, b_ + 6144); TRRD(l2, b_ + 8192); TRRD(h2, b_ + 10240); TRRD(l3, b_ + 12288); TRRD(h3, b_ + 14336); \
        asm volatile("s_waitcnt lgkmcnt(0)" ::: "memory"); SBAR();   \
        o[d0] = __builtin_amdgcn_mfma_f32_32x32x16_bf16(pa0, (bf16x8){l0[0], l0[1], l0[2], l0[3], h0[0], h0[1], h0[2], h0[3]}, o[d0], 0, 0, 0);   \
        o[d0] = __builtin_amdgcn_mfma_f32_32x32x16_bf16(pa1, (bf16x8){l1[0], l1[1], l1[2], l1[3], h1[0], h1[1], h1[2], h1[3]}, o[d0], 0, 0, 0);   \
        o[d0] = __builtin_amdgcn_mfma_f32_32x32x16_bf16(pa2, (bf16x8){l2[0], l2[1], l2[2], l2[3], h2[0], h2[1], h2[2], h2[3]}, o[d0], 0, 0, 0);   \
        o[d0] = __builtin_amdgcn_mfma_f32_32x32x16_bf16(pa3, (bf16x8){l3[0], l3[1], l3[2], l3[3], h3[0], h3[1], h3[2], h3[3]}, o[d0], 0, 0, 0); } while (0)
    PV_D0(0); PV_D0(1); PV_D0(2); PV_D0(3);
#undef PV_D0
#undef TRRD
}
struct BlockRef { const bf16_t* Q; const bf16_t* K; const bf16_t* V; bf16_t* O; const bf16_t* G; const unsigned long long* M; int P0; };
struct Seam { bf16x8 st_v0, st_v1, st_k0, st_k1; };
#define ROW(p, k0, rr) ((p) + (size_t)((k0) + (rr)) * D + sc)
#define VMW() asm volatile("s_waitcnt vmcnt(0)" ::: "memory")
#define VMWN(n) asm volatile("s_waitcnt vmcnt(%0)" :: "i"(n) : "memory")
#define SLOAD_H(Kp, Vp, k0) do { S.st_v0 = load8(ROW(Vp, k0, sr)); S.st_v1 = load8(ROW(Vp, k0, 32 + sr));              \
                         S.st_k0 = load8(ROW(Kp, k0, sr)); S.st_k1 = load8(ROW(Kp, k0, 32 + sr)); } while (0)
#define SWRITE_HK(bf) do { *(bf16x8*)(K_lds + (bf) * SHM_K + kws) = S.st_k0; *(bf16x8*)(K_lds + (bf) * SHM_K + kws + 32 * KROWB) = S.st_k1; } while (0)
#define SWRITE_HV(bf) do { *(bf16x8*)(V_lds + (bf) * SHM_V + vst0) = S.st_v0; *(bf16x8*)(V_lds + (bf) * SHM_V + vst1) = S.st_v1; } while (0)
#define SWRITE_H(bf) do { SWRITE_HV(bf); SWRITE_HK(bf); } while (0)
__device__ __forceinline__ void attn_prime(int wv, const BlockRef& cur, char* lds, Seam& S) {
    const int tid = opaque_tid(wv);
    const int sr = tid >> 4, sc = (tid & 15) * 8, kws = KSWZ(sr, sc * 2); char* K_lds = lds + 2 * SHM_V;
    SLOAD_H(cur.K, cur.V, 0); VMW(); SWRITE_HK(0);
    __syncthreads();
}
__device__ __forceinline__ void attn_block(int wv, const BlockRef& cur, const BlockRef& nxt, char* lds, Seam& S) {
    const int tid = opaque_tid(wv), wid = __builtin_amdgcn_readfirstlane(tid >> 6), lane = tid & 63, r32 = lane & 31, hi = lane >> 5;
    const int NT = cur.P0 / KVBLK + 4;
    char* V_lds = lds; char* K_lds = lds + 2 * SHM_V;
    float* ws = (float*)(lds + 2 * SHM_V + 2 * SHM_K) + wid * 64; float* li_l = ws, * al_l = ws + 32;
    float m_reg = -1e30f, l_reg = 0; f32x16 o[4] = {};
    const int sr = tid >> 4, sc = (tid & 15) * 8, vst0 = v_st(sr, sc), vst1 = v_st(32 + sr, sc), kws = KSWZ(sr, sc * 2);
    const int vb0 = (int)(uintptr_t)V_lds + v_rd_base(lane);
    const bf16_t* Kh = cur.K; const bf16_t* Vh = cur.V;
    const unsigned long long* mp = cur.M + (wid * QBLK + r32);
#define MLOAD(lo_, hi_, t) do { const unsigned long long w_ = mp[(size_t)(t) * SEQ] >> hi; lo_ = (unsigned)w_; hi_ = (unsigned)(w_ >> 32); } while (0)
#define RESC(a) do { if (__any((a) < 1.f)) { if (hi == 0) al_l[r32] = (a); asm volatile("s_waitcnt lgkmcnt(0)" ::: "memory");              \
                     for (int d_ = 0; d_ < 4; ++d_) for (int r = 0; r < 16; ++r) o[d_][r] *= al_l[crow(r, hi)]; } } while (0)
#define KBASE(t) ((t) * KVBLK)
#define SEAM_K0() do { VMW(); SWRITE_HK(0); SBAR(); } while (0)
    f32x16 pA0, pA1, pB0, pB1; float mnA, mnB, alA, alB; bf16x8 pa0, pa1, pa2, pa3;
    unsigned mAlo, mAhi, mBlo, mBhi;
    MLOAD(mAlo, mAhi, 0);
    char* Qw_lds = lds + Q_OFF + wid * (QBLK * QROWB);
    { u32x4 tq[8];
#pragma unroll
        for (int i = 0; i < 8; ++i) tq[i] = *(const u32x4*)(cur.Q + (size_t)(wid * QBLK + 4 * i + (lane >> 4)) * D + (lane & 15) * 8);
#pragma unroll
        for (int i = 0; i < 8; ++i) *(u32x4*)(Qw_lds + (4 * i + (lane >> 4)) * QROWB + (lane & 15) * 16) = tq[i];
        asm volatile("s_waitcnt lgkmcnt(0)" ::: "memory"); }
    const char* qa = Qw_lds + r32 * QROWB + hi * 16;
    SWRITE_HV(0); SBAR();
    if (NT > 1) { SLOAD_H(Kh, Vh, KBASE(1)); }
    SBAR(); qkt<0>(pA0, pA1, K_lds, r32, hi, qa);
    partialSM(pA0, pA1, m_reg, mnA, alA, mAlo, mAhi);
    if (NT > 1) { VMW(); SWRITE_H(1); }
    __syncthreads();
#define HALF_STEP(PX0, PX1, mnX, alX, mXlo, mXhi, PY0, PY1, alY, mYlo, mYhi, t, KB, VB, SB) do {                                  \
        SBAR(); MLOAD(mXlo, mXhi, t); qkt<KB>(PX0, PX1, K_lds, r32, hi, qa);                                                  \
        finishSM(PY0, PY1, alY, l_reg, pa0, pa1, pa2, pa3, mYlo, mYhi); SBAR();                                                 \
        if ((t) + 1 < NT) { SLOAD_H(Kh, Vh, KBASE((t) + 1)); SBAR(); }                                                          \
        pv_tile<VB>(o, vb0, pa0, pa1, pa2, pa3); partialSM(PX0, PX1, m_reg, mnX, alX, mXlo, mXhi);                              \
        __syncthreads();                                                                                                      \
        if ((t) + 1 < NT) { VMW(); SWRITE_H(SB); }                                                                            \
        RESC(alX); __syncthreads(); } while (0)
    for (int t = 1; t + 1 < NT; t += 2) {
        HALF_STEP(pB0, pB1, mnB, alB, mBlo, mBhi, pA0, pA1, alA, mAlo, mAhi, t, 1, 0, 0);
        HALF_STEP(pA0, pA1, mnA, alA, mAlo, mAhi, pB0, pB1, alB, mBlo, mBhi, t + 1, 0, 1, 1);
    }
    MLOAD(mBlo, mBhi, NT - 1);
    SBAR(); qkt<1>(pB0, pB1, K_lds, r32, hi, qa); SBAR();
    SLOAD_H(nxt.K, nxt.V, 0); SBAR();
    finishSM(pA0, pA1, alA, l_reg, pa0, pa1, pa2, pa3, mAlo, mAhi); SBAR();
    pv_tile<0>(o, vb0, pa0, pa1, pa2, pa3);
    partialSM(pB0, pB1, m_reg, mnB, alB, mBlo, mBhi); __syncthreads(); RESC(alB);
    finishSM(pB0, pB1, alB, l_reg, pa0, pa1, pa2, pa3, mBlo, mBhi); SBAR(); pv_tile<1>(o, vb0, pa0, pa1, pa2, pa3);
    SBAR(); SEAM_K0();
    if (hi == 0) li_l[r32] = l_reg; asm volatile("s_waitcnt lgkmcnt(0)" ::: "memory");
    { char* ow_l = Qw_lds + r32 * 2;
#pragma unroll
      for (int r = 0; r < 16; ++r) { const int orow = crow(r, hi); const float rl = __builtin_amdgcn_rcpf(li_l[orow]);
#pragma unroll
          for (int d0 = 0; d0 < 4; ++d0) *(unsigned short*)(ow_l + orow * QROWB + d0 * 64) = (unsigned short)(cvtpk(o[d0][r] * rl, 0.f) & 0xffffu); }
      asm volatile("s_waitcnt lgkmcnt(0)" ::: "memory"); SBAR();
      bf16_t* Ow = cur.O + (size_t)(wid * QBLK + (lane >> 4)) * DM + (lane & 15) * 8; const bf16_t* Gw = cur.G + (size_t)(wid * QBLK + (lane >> 4)) * DM + (lane & 15) * 8;
      u32x4 gv[8];
#pragma unroll
      for (int i = 0; i < 8; ++i) gv[i] = *(const u32x4*)(Gw + (size_t)(4 * i) * DM);
#pragma unroll
      for (int i = 0; i < 8; ++i) { const u32x4 ov = *(const u32x4*)(Qw_lds + (4 * i + (lane >> 4)) * QROWB + (lane & 15) * 16);
          f32x4 a0, a1, g0, g1; unpack8(ov, a0, a1); unpack8(gv[i], g0, g1);
          *(u32x4*)(Ow + (size_t)(4 * i) * DM) = pack8(a0 * g0, a1 * g1); }
      asm volatile("s_waitcnt lgkmcnt(0)" ::: "memory"); }
    __syncthreads();
#undef MLOAD
#undef RESC
#undef KBASE
#undef SEAM_K0
#undef HALF_STEP
}
#undef ROW
#undef VMW
#undef VMWN
#undef SLOAD_H
#undef SWRITE_HK
#undef SWRITE_HV
#undef SWRITE_H
#undef KSWZ
#undef SBAR
}

#define XB_TMO      128
#define XB_XCNT(j)  (256  + 64 * (j))
#define XB_XSUB(j)  (1280 + 64 * (j))
#define XB_XGEN(j)  (2304 + 64 * (j))
#define XB_TOP      3328
#define XB_TOPGEN   3392
#define XCD_BAR_WORDS 3456
#define XB_SPIN_CAP (1u << 22)
__device__ __forceinline__ unsigned xb_ld(unsigned* p)              { return __hip_atomic_load(p, __ATOMIC_RELAXED, __HIP_MEMORY_SCOPE_AGENT); }
__device__ __forceinline__ unsigned xb_add(unsigned* p, unsigned v) { return __hip_atomic_fetch_add(p, v, __ATOMIC_RELAXED, __HIP_MEMORY_SCOPE_AGENT); }
__device__ __forceinline__ unsigned xb_xcc_id() { return (unsigned)__builtin_amdgcn_s_getreg((3 << 11) | 20) & 0xFu; }
#define XB_SPIN(cond, bar) do { unsigned _sp = 0; while (cond) { __builtin_amdgcn_s_sleep(1); \
    if ((++_sp & 255u) == 0u) { if (xb_ld(&(bar)[XB_TMO])) break; if (_sp > XB_SPIN_CAP) { atomicAdd(&(bar)[XB_TMO], 1u); break; } } } } while (0)
struct XcdBarrier { unsigned* bar; unsigned x; volatile LAS unsigned* st; };
__device__ __forceinline__ XcdBarrier xcd_barrier_post(unsigned* bar, volatile LAS unsigned* st) {
    XcdBarrier b; b.bar = bar; b.x = xb_xcc_id(); b.st = st;
    if (threadIdx.x == 0) (void)xb_add(&bar[XB_XCNT(b.x)], 1u);
    return b;
}
__device__ __forceinline__ void xcd_barrier_complete(unsigned* bar, unsigned x, unsigned& nloc, unsigned& nx) {
    const unsigned G = gridDim.x * gridDim.y * gridDim.z;
    unsigned sum, cnt, mine, sp = 0u;
    for (;;) {
        sum = 0u; cnt = 0u; mine = 0u;
#pragma unroll
        for (unsigned j = 0; j < 16; ++j) { const unsigned c = xb_ld(&bar[XB_XCNT(j)]); sum += c; cnt += (c > 0u) ? 1u : 0u; mine = (j == x) ? c : mine; }
        if (sum == G) break;
        __builtin_amdgcn_s_sleep(1);
        if ((++sp & 255u) == 0u) { if (xb_ld(&bar[XB_TMO])) break; if (sp > XB_SPIN_CAP) { atomicAdd(&bar[XB_TMO], 1u); break; } }
    }
    nloc = mine > 0u ? mine : 1u; nx = cnt > 0u ? cnt : 1u;
}
__device__ __forceinline__ void xcd_barrier(const XcdBarrier& b) {
    asm volatile("s_waitcnt vmcnt(0)" ::: "memory");
    __syncthreads();
    if (threadIdx.x == 0) {
        unsigned* bar = b.bar;
        __builtin_amdgcn_s_waitcnt(0);
        unsigned nloc = b.st[0], nx = b.st[1];
        if (nloc == 0u) { xcd_barrier_complete(bar, b.x, nloc, nx); b.st[0] = nloc; b.st[1] = nx; }
        const unsigned old = xb_add(&bar[XB_XSUB(b.x)], 1u);
        const unsigned gen = old / nloc;
        if (old + 1u == (gen + 1u) * nloc) {
            __builtin_amdgcn_fence(__ATOMIC_RELEASE, "agent");
            asm volatile("s_waitcnt vmcnt(0)" ::: "memory");
            const unsigned og = xb_add(&bar[XB_TOP], 1u);
            const unsigned tg = og / nx;
            if (og + 1u == (tg + 1u) * nx) xb_add(&bar[XB_TOPGEN], 1u);
            else XB_SPIN(xb_ld(&bar[XB_TOPGEN]) == tg, bar);
            __builtin_amdgcn_fence(__ATOMIC_ACQUIRE, "agent");
            xb_add(&bar[XB_XGEN(b.x)], 1u);
            asm volatile("s_waitcnt vmcnt(0)" ::: "memory");
        } else {
            XB_SPIN(xb_ld(&bar[XB_XGEN(b.x)]) == gen, bar);
            __builtin_amdgcn_fence(__ATOMIC_ACQUIRE, "agent");
            asm volatile("s_waitcnt vmcnt(0)" ::: "memory");
        }
    }
    __syncthreads();
}

struct Args {
    const float* x; const float* c; const int* pos; const float* norm_g; const float* mod_w; const float* mod_b;
    const float* pwi; const float* pwg; const float* pls; const float* pwo; const float* awi; const float* awo; const float* fg;
    float* out; unsigned char* ws;
    int ph_lo, ph_hi;
};
constexpr int NWAVES = 8, NTHR = 512;
constexpr int RING_BYTES = 131072, LDS_BYTES = 147456, MISC_OFF = LDS_BYTES - 256;

__device__ __forceinline__ void sincos_d(double a, float& s_out, float& c_out) {
    const double k = __builtin_rint(a * 0.6366197723675814);
    double r = __builtin_fma(-k, 1.5707963267948966, a); r = __builtin_fma(-k, 6.123233995736766e-17, r);
    const double r2 = r * r;
    double sp = -7.647163731819816e-13; sp = sp * r2 + 1.6059043836821613e-10; sp = sp * r2 - 2.505210838544172e-08; sp = sp * r2 + 2.7557319223985893e-06;
    sp = sp * r2 - 1.984126984126984e-04; sp = sp * r2 + 8.333333333333333e-03; sp = sp * r2 - 1.6666666666666666e-01; const double s = r + r * r2 * sp;
    double cp = 4.779477332387385e-14; cp = cp * r2 - 1.1470745597729725e-11; cp = cp * r2 + 2.08767569878681e-09; cp = cp * r2 - 2.755731922398589e-07;
    cp = cp * r2 + 2.48015873015873e-05; cp = cp * r2 - 1.388888888888889e-03; cp = cp * r2 + 4.1666666666666664e-02; cp = cp * r2 - 0.5; const double c = 1.0 + r2 * cp;
    const int q = (int)((long long)k & 3);
    const double ss = (q == 0) ? s : (q == 1) ? c : (q == 2) ? -s : -c;
    const double cc = (q == 0) ? c : (q == 1) ? -s : (q == 2) ? -c : s;
    s_out = (float)ss; c_out = (float)cc;
}
__device__ __forceinline__ void transpose_item(const float* W, int K, int N, bf16_t* WT, int row_off, LAS float* scr, int nblk, int item, int lane) {
    const int kb = item / nblk, nb = item % nblk, k0 = 64 * kb, n0 = 32 * nb;
    const int nn = n0 + (lane & 31);
    float tv[32];
#pragma unroll
    for (int i = 0; i < 32; ++i) { const int kk = 2 * i + (lane >> 5); tv[i] = (nn < N) ? W[(size_t)(k0 + kk) * N + nn] : 0.f; }
#pragma unroll
    for (int i = 0; i < 32; ++i) { const int kk = 2 * i + (lane >> 5); scr[kk * 33 + (lane & 31)] = tv[i]; }
    LDS_WAIT(); asm volatile("" ::: "memory");
    const int c = lane & 7;
#pragma unroll
    for (int j = 0; j < 4; ++j) { const int n = (lane >> 3) + 8 * j; const LAS float* s = scr + (8 * c) * 33 + n;
        u32x4 o; o.x = pk2(s[0 * 33], s[1 * 33]); o.y = pk2(s[2 * 33], s[3 * 33]); o.z = pk2(s[4 * 33], s[5 * 33]); o.w = pk2(s[6 * 33], s[7 * 33]);
        *(u32x4*)(WT + (size_t)(row_off + n0 + n) * K + k0 + 8 * c) = o; }
    LDS_WAIT(); asm volatile("" ::: "memory");
}
template <int VAR>
__device__ __forceinline__ void phase0(int wv, const Args& a, LAS unsigned char* lds) {
    const int tid = opaque_tid(wv), lane = tid & 63, wave = __builtin_amdgcn_readfirstlane(tid >> 6);
    const int G = gridDim.x, bx = blockIdx.x;
    unsigned char* ws = a.ws;
    if (VAR == 0 || VAR == 1)
    for (int unit = bx; unit < 256; unit += G) {
        const int layer = unit >> 6, kq = (unit >> 4) & 3, cs = unit & 15;
        const float* W = a.mod_w + ((size_t)layer * DM + 512 * kq) * 6144 + 384 * cs;
        LAS float* red = (LAS float*)lds;
        LAS float* cdl = (LAS float*)(lds + 8192);
        if (tid < 512) cdl[tid] = silu_f(a.c[512 * kq + tid]);
        if (tid < 8) cdl[512 + tid] = 0.f;
        __syncthreads();
        if (tid < 480) {
            const int kg = tid / 96, ln = tid - kg * 96;
            f32x4 acc4 = {0.f, 0.f, 0.f, 0.f};
#pragma unroll 8
            for (int i = 0; i < 103; ++i) { const int k = kg + 5 * i, kc = k < 512 ? k : 511;
                acc4 += *(const f32x4*)(W + (size_t)kc * 6144 + 4 * ln) * cdl[k]; }
            *(LAS f32x4*)(red + kg * 384 + 4 * ln) = acc4;
        }
        __syncthreads();
        if (tid < 384) { float sum = red[tid];
#pragma unroll
            for (int kg = 1; kg < 5; ++kg) sum += red[kg * 384 + tid];
            const int col = 384 * cs + tid;
            if (kq == 0) sum += a.mod_b[layer * 6144 + col];
            ((float*)(ws + WS_MOD))[(layer * 4 + kq) * 6144 + col] = sum; }
        __syncthreads();
    }
    if (VAR == 0 || VAR == 2) {
        float* cosq = (float*)(ws + WS_TAB); float* sinq = cosq + SEQ * 16; float* cosi = sinq + SEQ * 16; float* sini = cosi + SEQ * 8;
        for (int e = bx * NTHR + tid; e < SEQ * 24; e += G * NTHR) {
            const int p = e / 24, i = e - p * 24;
            const float pf = (float)a.pos[p];
            const double frac = i < 16 ? (double)i * (1.0 / 16.0) : (double)(i - 16) * (1.0 / 8.0);
            const float inv = (float)exp2(-18.931568569324174 * frac);
            const float ang = pf * inv;
            float s, c; sincos_d((double)ang, s, c);
            if (i < 16) { cosq[p * 16 + i] = c; sinq[p * 16 + i] = s; } else { cosi[p * 8 + i - 16] = c; sini[p * 8 + i - 16] = s; }
        }
    }
    if (VAR == 0 || VAR == 3) {
        LAS float* scr = (LAS float*)(lds + 16384 + wave * 8704);
        const int gw = bx * NWAVES + wave, NGW = G * NWAVES;
        constexpr int I_PI = 32 * 128, I_PG = 8 * 16, I_PO = 32 * 64, I_AI = 32 * 296, I_AO = 32 * 64;
        constexpr int NITEMS = 2 * I_PI + 8 * I_PG + 2 * I_PO + 2 * I_AI + 2 * I_AO;
        for (int it = gw; it < NITEMS; it += NGW) {
            int r = it;
            if (r < 2 * I_AI) { const int l = r / I_AI; r -= l * I_AI; transpose_item(a.awi + (size_t)l * DM * ATTN_IN, DM, ATTN_IN, (bf16_t*)(ws + WS_WAI) + (size_t)l * ATTN_INP * DM, 0, scr, 296, r, lane); continue; } r -= 2 * I_AI;
            if (r < 2 * I_PI) { const int l = r / I_PI; r -= l * I_PI; transpose_item(a.pwi + (size_t)l * DM * POOL_IN, DM, POOL_IN, (bf16_t*)(ws + WS_WPI) + (size_t)l * POOL_IN * DM, 0, scr, 128, r, lane); continue; } r -= 2 * I_PI;
            if (r < 2 * I_PO) { const int l = r / I_PO; r -= l * I_PO; transpose_item(a.pwo + (size_t)l * DM * DM, DM, DM, (bf16_t*)(ws + WS_WPO) + (size_t)l * DM * DM, 0, scr, 64, r, lane); continue; } r -= 2 * I_PO;
            if (r < 2 * I_AO) { const int l = r / I_AO; r -= l * I_AO; transpose_item(a.awo + (size_t)l * DM * DM, DM, DM, (bf16_t*)(ws + WS_WAO) + (size_t)l * DM * DM, 0, scr, 64, r, lane); continue; } r -= 2 * I_AO;
            { const int lg = r / I_PG; r -= lg * I_PG; const int l = lg >> 2, gi = lg & 3;
              transpose_item(a.pwg + (size_t)lg * 512 * 512, 512, 512, (bf16_t*)(ws + WS_WPG) + (size_t)l * DM * 512, gi * 512, scr, 16, r, lane); }
        }
    }
}

template <bool IN_BF16> __device__ __forceinline__ void phase_norm(int wv, const void* x, const float* g, const float* mod  , bf16_t* h) {
    const int tid = opaque_tid(wv), lane = tid & 63, wave = tid >> 6;
    const int gw = blockIdx.x * NWAVES + wave, NGW = gridDim.x * NWAVES;
    f32x4 av[8], sv[8];
#pragma unroll
    for (int j = 0; j < 8; ++j) { const int col = 8 * lane + 512 * (j >> 1) + 4 * (j & 1);
        const f32x4 gg = *(const f32x4*)(g + col);
        sv[j] = ((*(const f32x4*)(mod + col) + *(const f32x4*)(mod + 6144 + col)) + *(const f32x4*)(mod + 2 * 6144 + col)) + *(const f32x4*)(mod + 3 * 6144 + col);
        const f32x4 sc = ((*(const f32x4*)(mod + DM + col) + *(const f32x4*)(mod + 6144 + DM + col)) + *(const f32x4*)(mod + 2 * 6144 + DM + col)) + *(const f32x4*)(mod + 3 * 6144 + DM + col);
        av[j] = gg * (sc + 1.0f); }
    for (int row = gw; row < SEQ; row += 4 * NGW) {
        u32x4 t[4][4]; f32x4 tf[4][8];
#pragma unroll
        for (int r = 0; r < 4; ++r) { const size_t ro = (size_t)(row + r * NGW) * DM;
            if (IN_BF16) { const u32x4* xr = (const u32x4*)((const bf16_t*)x + ro) + lane;
#pragma unroll
                for (int j = 0; j < 4; ++j) t[r][j] = xr[64 * j]; }
            else { const f32x4* xr = (const f32x4*)((const float*)x + ro) + 2 * lane;
#pragma unroll
                for (int j = 0; j < 4; ++j) { tf[r][2 * j] = xr[128 * j]; tf[r][2 * j + 1] = xr[128 * j + 1]; } } }
#pragma unroll
        for (int r = 0; r < 4; ++r) {
            f32x4 v[8];
#pragma unroll
            for (int j = 0; j < 4; ++j) { if (IN_BF16) unpack8(t[r][j], v[2 * j], v[2 * j + 1]); else { v[2 * j] = tf[r][2 * j]; v[2 * j + 1] = tf[r][2 * j + 1]; } }
            float s = 0.f;
#pragma unroll
            for (int j = 0; j < 8; ++j) s += (v[j].x * v[j].x + v[j].y * v[j].y) + (v[j].z * v[j].z + v[j].w * v[j].w);
            const float rstd = 1.0f / sqrtf(wave_sum(s) * (1.f / DM) + EPS);
            u32x4* o16 = (u32x4*)(h + (size_t)(row + r * NGW) * DM) + lane;
#pragma unroll
            for (int j = 0; j < 4; ++j) o16[64 * j] = pack8(v[2 * j] * rstd * av[2 * j] + sv[2 * j], v[2 * j + 1] * rstd * av[2 * j + 1] + sv[2 * j + 1]);
        }
    }
}
__device__ __forceinline__ void phase_final(int wv, const bf16_t* x, float* y, const float* g) {
    const int tid = opaque_tid(wv), lane = tid & 63, wave = tid >> 6;
    const int gw = blockIdx.x * NWAVES + wave, NGW = gridDim.x * NWAVES;
    for (int row = gw; row < SEQ; row += 2 * NGW) {
        const int rowb = row + NGW;
        const u32x4* xr = (const u32x4*)(x + (size_t)row * DM) + lane; const u32x4* xs = (const u32x4*)(x + (size_t)rowb * DM) + lane;
        f32x4* yr = (f32x4*)(y + (size_t)row * DM) + 2 * lane; f32x4* ys = (f32x4*)(y + (size_t)rowb * DM) + 2 * lane;
        u32x4 t0[4], t1[4];
#pragma unroll
        for (int j = 0; j < 4; ++j) { t0[j] = xr[64 * j]; t1[j] = xs[64 * j]; }
        f32x4 v[8], u[8]; float s = 0.f, s2 = 0.f;
#pragma unroll
        for (int j = 0; j < 4; ++j) { unpack8(t0[j], v[2 * j], v[2 * j + 1]); unpack8(t1[j], u[2 * j], u[2 * j + 1]); }
#pragma unroll
        for (int j = 0; j < 8; ++j) { s += (v[j].x * v[j].x + v[j].y * v[j].y) + (v[j].z * v[j].z + v[j].w * v[j].w); s2 += (u[j].x * u[j].x + u[j].y * u[j].y) + (u[j].z * u[j].z + u[j].w * u[j].w); }
        const float rstd = 1.0f / sqrtf(wave_sum(s) * (1.f / DM) + EPS), rstd2 = 1.0f / sqrtf(wave_sum(s2) * (1.f / DM) + EPS);
#pragma unroll
        for (int j = 0; j < 8; ++j) { const int col = 8 * lane + 512 * (j >> 1) + 4 * (j & 1); const f32x4 gg = *(const f32x4*)(g + col);
            yr[128 * (j >> 1) + (j & 1)] = v[j] * rstd * gg; ys[128 * (j >> 1) + (j & 1)] = u[j] * rstd2 * gg; }
    }
}

template <int W, int R> __device__ __forceinline__ void pool_strip(const bf16_t* VG, bf16_t* PL, int t0, int c0) {
    u32x4 r[W + R - 1];
#pragma unroll
    for (int i = 0; i < W + R - 1; ++i) { const int t = t0 - (W - 1) + i; r[i] = *(const u32x4*)(VG + (size_t)(t < 0 ? 0 : t) * POOL_IN + c0); }
    float S[8];
#pragma unroll
    for (int e = 0; e < 8; ++e) S[e] = 0.f;
#pragma unroll
    for (int i = 0; i < W - 1; ++i) { const float wg = (t0 - (W - 1) + i >= 0) ? 1.f : 0.f;
#pragma unroll
        for (int e = 0; e < 4; ++e) { const unsigned x = r[i][e]; S[2 * e] += wg * __builtin_bit_cast(float, x << 16); S[2 * e + 1] += wg * __builtin_bit_cast(float, x & 0xffff0000u); } }
#pragma unroll
    for (int j = 0; j < R; ++j) { const int t = t0 + j;
        float v[8];
#pragma unroll
        for (int e = 0; e < 4; ++e) { const unsigned x = r[W - 1 + j][e]; v[2 * e] = __builtin_bit_cast(float, x << 16); v[2 * e + 1] = __builtin_bit_cast(float, x & 0xffff0000u); }
        const int cnt = (t + 1 < W) ? (t + 1) : W; const float ic = 1.0f / (float)cnt;
        float o[8];
#pragma unroll
        for (int e = 0; e < 8; ++e) { S[e] += v[e]; o[e] = S[e] * ic - v[e]; }
        u32x4 pw; pw.x = cvt_pk_bf16(o[0], o[1]); pw.y = cvt_pk_bf16(o[2], o[3]); pw.z = cvt_pk_bf16(o[4], o[5]); pw.w = cvt_pk_bf16(o[6], o[7]);
        *(u32x4*)(PL + (size_t)t * DM + c0) = pw;
        const float wg = (t - W + 1 >= 0) ? 1.f : 0.f;
#pragma unroll
        for (int e = 0; e < 4; ++e) { const unsigned x = r[j][e]; S[2 * e] -= wg * __builtin_bit_cast(float, x << 16); S[2 * e + 1] -= wg * __builtin_bit_cast(float, x & 0xffff0000u); } }
}
__device__ __forceinline__ void phase_pool(int wv, const bf16_t* VG, bf16_t* PL) {
    const int total = 512 * 256;
    const int tid = opaque_tid(wv);
    for (int it = blockIdx.x * NTHR + tid; it < total; it += gridDim.x * NTHR) {
        const int cg = it & 255, strip = it >> 8; const int c0 = cg * 8, t0 = strip * 16;
        const int grp = __builtin_amdgcn_readfirstlane(c0 >> 9);
        if (grp == 0) pool_strip<2, 16>(VG, PL, t0, c0); else if (grp == 1) pool_strip<4, 16>(VG, PL, t0, c0); else if (grp == 2) pool_strip<8, 16>(VG, PL, t0, c0);
        else { pool_strip<16, 8>(VG, PL, t0, c0); pool_strip<16, 8>(VG, PL, t0 + 8, c0); }
    }
}

__device__ __forceinline__ size_t sc_block_base(int qb) { return (size_t)65536 * (size_t)(qb * (qb + 1) / 2); }
__device__ __forceinline__ float fma_s(float a, float b, float c) { asm("v_fma_f32 %0, %1, %2, %0" : "+v"(c) : "v"(a), "v"(b)); return c; }
__device__ __forceinline__ float relu_i(float x) { const int b = __builtin_bit_cast(int, x); return __builtin_bit_cast(float, b > 0 ? b : 0); }
template <int VAR>
__device__ __forceinline__ void phase_scores(int wv, const bf16_t* QI, const bf16_t* KI, const float* WI, float* SC, LAS unsigned char* lds, unsigned* ctr  ) {
    const int tid = opaque_tid(wv), wid = __builtin_amdgcn_readfirstlane(tid >> 6), lane = tid & 63, r32 = lane & 31, hi = lane >> 5;
    constexpr int QROW = 2064;
    volatile LAS int* slot = (volatile LAS int*)(lds + 32 * QROW);
    for (;;) {
        __syncthreads();
        if (tid == 0) slot[0] = (int)__hip_atomic_fetch_add(ctr, 1u, __ATOMIC_RELAXED, __HIP_MEMORY_SCOPE_AGENT);
        __syncthreads();
        const int L = slot[0];
        if (L >= 1152) break;
        int kc = 0, base = 0;
        for (; kc < 8; ++kc) { const int n = 256 - 32 * kc; if (L < base + n) break; base += n; }
        const int u = 32 * kc + (L - base);
        const int q0 = 32 * u, qb = u >> 3;
        const int klim = (qb + 1) * 256;
        bf16x8 kf[2][4];
        { const int key0 = kc * 1024 + wid * 64;
#pragma unroll
            for (int b = 0; b < 2; ++b)
#pragma unroll
                for (int kk = 0; kk < 4; ++kk) kf[b][kk] = *(const bf16x8*)(KI + (size_t)(key0 + 32 * b + r32) * 64 + 16 * kk + 8 * hi); }
        {
            int t_ = tid; asm volatile("" : "+v"(t_));
            const bf16_t* src = QI + (size_t)q0 * 1024 + t_ * 8;
            const int ldst = (t_ >> 7) * QROW + (t_ & 127) * 16;
            u32x4 tq[8];
#pragma unroll
            for (int i = 0; i < 8; ++i) tq[i] = *(const u32x4*)(src + i * 4096);
            __builtin_amdgcn_sched_barrier(0);
#pragma unroll
            for (int i = 0; i < 8; ++i) *(LAS u32x4*)(lds + ldst + i * (4 * QROW)) = tq[i];
        }
        f32x4 wq[4];
#pragma unroll
        for (int i = 0; i < 4; ++i) wq[i] = *(const f32x4*)(WI + (size_t)(q0 + r32) * 16 + 4 * i);
        __syncthreads();
        for (int sl = wid; sl < 16; sl += 8) {
            const int key0 = kc * 1024 + sl * 64;
            if (key0 >= klim) continue;
            if (sl != wid) {
#pragma unroll
                for (int b = 0; b < 2; ++b)
#pragma unroll
                    for (int kk = 0; kk < 4; ++kk) kf[b][kk] = *(const bf16x8*)(KI + (size_t)(key0 + 32 * b + r32) * 64 + 16 * kk + 8 * hi); }
            f32x16 acc0 = {}, acc1 = {};
            const LAS unsigned char* qa = lds + r32 * QROW + hi * 16;
#define SC_MM(h, S0, S1) do { bf16x8 af_[4];                                                                                  \
                _Pragma("unroll") for (int kk = 0; kk < 4; ++kk) af_[kk] = *(const LAS bf16x8*)(qa + (h) * 128 + kk * 32);     \
                S0 = __builtin_amdgcn_mfma_f32_32x32x16_bf16(kf[0][0], af_[0], f32x16{}, 0, 0, 0); S1 = __builtin_amdgcn_mfma_f32_32x32x16_bf16(kf[1][0], af_[0], f32x16{}, 0, 0, 0); \
                _Pragma("unroll") for (int kk = 1; kk < 4; ++kk) { S0 = __builtin_amdgcn_mfma_f32_32x32x16_bf16(kf[0][kk], af_[kk], S0, 0, 0, 0); S1 = __builtin_amdgcn_mfma_f32_32x32x16_bf16(kf[1][kk], af_[kk], S1, 0, 0, 0); } } while (0)
#define SC_VA(h, S0, S1) do { const float w_ = wq[(h) >> 2][(h) & 3];                                                          \
                _Pragma("unroll") for (int r = 0; r < 16; ++r) { acc0[r] = fma_s(relu_i(S0[r]), w_, acc0[r]); acc1[r] = fma_s(relu_i(S1[r]), w_, acc1[r]); } } while (0)
#define SC_SB() __builtin_amdgcn_sched_barrier(0)
            f32x16 sA0, sA1, sB0, sB1;
            SC_MM(0, sA0, sA1); SC_SB();
            if (wid < 4) {
#pragma unroll
                for (int h = 0; h < 14; h += 2) {
                    SC_MM(h + 1, sB0, sB1); SC_SB(); SC_VA(h, sA0, sA1); SC_SB();
                    SC_MM(h + 2, sA0, sA1); SC_SB(); SC_VA(h + 1, sB0, sB1); SC_SB();
                }
                SC_MM(15, sB0, sB1); SC_SB(); SC_VA(14, sA0, sA1); SC_SB();
                SC_VA(15, sB0, sB1);
            } else {
                SC_MM(1, sB0, sB1); SC_SB();
#pragma unroll
                for (int h = 0; h < 14; h += 2) {
                    SC_VA(h, sA0, sA1); SC_SB(); SC_MM(h + 2, sA0, sA1); SC_SB();
                    SC_VA(h + 1, sB0, sB1); SC_SB(); SC_MM(h + 3, sB0, sB1); SC_SB();
                }
                SC_VA(14, sA0, sA1); SC_SB();
                SC_VA(15, sB0, sB1);
            }
#undef SC_SB
#undef SC_MM
#undef SC_VA
            float* out = SC + sc_block_base(qb) + (size_t)(q0 - qb * 256 + r32) * (size_t)klim + key0 + 4 * hi;
#pragma unroll
            for (int g = 0; g < 4; ++g) {
                *(f32x4*)(out + 8 * g) = (f32x4){acc0[4 * g], acc0[4 * g + 1], acc0[4 * g + 2], acc0[4 * g + 3]};
                *(f32x4*)(out + 32 + 8 * g) = (f32x4){acc1[4 * g], acc1[4 * g + 1], acc1[4 * g + 2], acc1[4 * g + 3]}; }
        }
    }
}

template <int VAR>
__device__ __forceinline__ void phase_select(int wv, const float* SC, unsigned long long* MASK, LAS unsigned char* lds) {
    const int tid = opaque_tid(wv), lane0 = tid & 63, wave = __builtin_amdgcn_readfirstlane(tid >> 6);
    LAS unsigned* hist = (LAS unsigned*)(lds + wave * 9216);
    const int gw = blockIdx.x * NWAVES + wave, NGW = gridDim.x * NWAVES;
    for (int q = gw; q < SEQ; q += NGW) {
        int lane = lane0; asm volatile("" : "+v"(lane));
        const int qb = q >> 8, klim = (qb + 1) * 256;
        const float* rowp = SC + sc_block_base(qb) + (size_t)(q - qb * 256) * (size_t)klim;
        const int ngrp = qb + 1;
        unsigned key[32][4];
#pragma unroll
        for (int g = 0; g < 8; ++g) {
            if (4 * g < ngrp) {
#pragma unroll
                for (int i = 0; i < 4; ++i) { const u32x4 v = *(const u32x4*)(rowp + 256 * (4 * g + i) + 4 * lane);
                    key[4 * g + i][0] = v.x; key[4 * g + i][1] = v.y; key[4 * g + i][2] = v.z; key[4 * g + i][3] = v.w; }
            } else {
#pragma unroll
                for (int i = 0; i < 4; ++i) { key[4 * g + i][0] = 0u; key[4 * g + i][1] = 0u; key[4 * g + i][2] = 0u; key[4 * g + i][3] = 0u; }
            }
        }
        unsigned T = 1u; unsigned need_eq = 0xffffffffu, n_eq = 0u;
        const bool radix = (q + 1 > TOPK) && (VAR != 1 && VAR != 3);
        if (VAR == 3) { unsigned x_ = 0u;
#pragma unroll
            for (int j = 0; j < 32; ++j) x_ |= key[j][0] & key[j][1] & key[j][2] & key[j][3];
            if (x_ == 0x12345u) MASK[q] = x_; continue; }
        if (radix) {
#pragma unroll
            for (int i = 0; i < 9; ++i) *(LAS u32x4*)(hist + 4 * (lane + 64 * i)) = (u32x4){0u, 0u, 0u, 0u};
        }
        __builtin_amdgcn_sched_barrier(0);
#pragma unroll
        for (int g = 0; g < 8; ++g) { if (4 * g < ngrp) {
#pragma unroll
            for (int i = 0; i < 4; ++i)
#pragma unroll
                for (int e = 0; e < 4; ++e) { const int j = 4 * g + i; const unsigned uu = key[j][e];
                    const unsigned kx = uu ^ ((unsigned)((int)uu >> 31) | 0x80000000u); key[j][e] = (256 * j + 4 * lane + e <= q) ? kx : 0u; }
            } __builtin_amdgcn_sched_barrier(0); }
        if (radix) {
            unsigned gm0 = 0u, gm1 = 0u, gm2 = 0u, gm3 = 0u;
#pragma unroll
            for (int g = 0; g < 8; ++g) if (4 * g < ngrp) {
#pragma unroll
                for (int i = 0; i < 4; ++i) { const int j = 4 * g + i; gm0 = key[j][0] > gm0 ? key[j][0] : gm0; gm1 = key[j][1] > gm1 ? key[j][1] : gm1; gm2 = key[j][2] > gm2 ? key[j][2] : gm2; gm3 = key[j][3] > gm3 ? key[j][3] : gm3; }
            }
            unsigned Pmin = gm0 < gm1 ? gm0 : gm1; { const unsigned p2 = gm2 < gm3 ? gm2 : gm3; Pmin = Pmin < p2 ? Pmin : p2; }
#pragma unroll
            for (int off = 1; off < 64; off <<= 1) { const unsigned tt = (unsigned)__builtin_amdgcn_ds_bpermute((lane ^ off) << 2, (int)Pmin); Pmin = tt < Pmin ? tt : Pmin; }
            LDS_WAIT();
#pragma unroll
            for (int g = 0; g < 8; ++g) if (4 * g < ngrp) {
#pragma unroll
                for (int i = 0; i < 4; ++i) {
#pragma unroll
                    for (int e = 0; e < 4; ++e) { const unsigned k = key[4 * g + i][e];
                        if (k >= Pmin) { const unsigned b = k >> 21; __hip_atomic_fetch_add(hist + b + ((b >> 5) << 2), 1u, __ATOMIC_RELAXED, __HIP_MEMORY_SCOPE_WORKGROUP); } }
                    __builtin_amdgcn_sched_barrier(0); }
            }
            unsigned prefix = 0u, pmask = 0u, kk = TOPK;
#pragma unroll 1
            for (int pass = 0; pass < ((VAR == 4) ? 1 : 3); ++pass) {
                const int shift = (pass == 0) ? 21 : (pass == 1) ? 10 : 0;
                const unsigned dmask = (pass == 2) ? 1023u : 2047u;
                LDS_WAIT();
                if (pass > 0) {
#pragma unroll
                    for (int g = 0; g < 8; ++g) if (4 * g < ngrp) {
#pragma unroll
                        for (int i = 0; i < 4; ++i) {
#pragma unroll
                            for (int e = 0; e < 4; ++e) { const unsigned k = key[4 * g + i][e];
                                if ((k & pmask) == prefix) { const unsigned b = (k >> shift) & dmask; __hip_atomic_fetch_add(hist + b + ((b >> 5) << 2), 1u, __ATOMIC_RELAXED, __HIP_MEMORY_SCOPE_WORKGROUP); } }
                            __builtin_amdgcn_sched_barrier(0); }
                    }
                }
                LDS_WAIT();
                if (VAR == 5) { prefix |= (0x5a5u & dmask) << shift; pmask |= dmask << shift; continue; }
                unsigned s = 0u;
#pragma unroll
                for (int i = 0; i < 8; ++i) { const u32x4 v = *(const LAS u32x4*)(hist + 36 * lane + 4 * i); s += (v.x + v.y) + (v.z + v.w); }
                unsigned suf = s;
#pragma unroll
                for (int off = 1; off < 64; off <<= 1) { const unsigned tt = (unsigned)__builtin_amdgcn_ds_bpermute(((lane + off) & 63) << 2, (int)suf); if (lane + off < 64) suf += tt; }
                const unsigned long long bal = __ballot(suf >= kk);
                const int Ls = 63 - __builtin_clzll(bal);
                const unsigned above1 = (unsigned)__builtin_amdgcn_readlane((int)(suf - s), Ls);
                const unsigned c2 = hist[36 * Ls + (lane & 31)];
                unsigned suf2 = (lane < 32) ? c2 : 0u;
#pragma unroll
                for (int off = 1; off < 32; off <<= 1) { const unsigned tt = (unsigned)__builtin_amdgcn_ds_bpermute(((lane + off) & 63) << 2, (int)suf2); if (lane + off < 32) suf2 += tt; }
                const unsigned long long bal2 = __ballot(lane < 32 && above1 + suf2 >= kk);
                const int Bs = 63 - __builtin_clzll(bal2);
                const int dsel = 32 * Ls + Bs;
                const unsigned cnt_b = (unsigned)__builtin_amdgcn_readlane((int)c2, Bs);
                const unsigned kk_new = kk - (above1 + (unsigned)__builtin_amdgcn_readlane((int)suf2, Bs) - cnt_b);
                LDS_WAIT();
#pragma unroll
                for (int i = 0; i < 9; ++i) *(LAS u32x4*)(hist + 4 * (lane + 64 * i)) = (u32x4){0u, 0u, 0u, 0u};
                const unsigned d = (unsigned)dsel; kk = kk_new; n_eq = cnt_b;
                prefix |= d << shift; pmask |= dmask << shift;
            }
            T = prefix; need_eq = kk;
        }
        if (VAR == 2 || VAR == 4 || VAR == 5) { if (T == 0x12345u) MASK[q] = T; continue; }
        const bool tie_path = (need_eq != 0xffffffffu) && (n_eq > need_eq);
        unsigned tie_seen = 0u;
        const unsigned long long lt = (lane == 0) ? 0ull : (~0ull >> (64 - lane));
        int w0lo = 0, w0hi = 0, w1lo = 0, w1hi = 0;
#pragma unroll
        for (int g = 0; g < 8; ++g) if (4 * g < ngrp) {
#pragma unroll
            for (int i = 0; i < 4; ++i) { const int j = 4 * g + i;
                unsigned long long B[4];
                if (!tie_path) {
#pragma unroll
                    for (int e = 0; e < 4; ++e) B[e] = __ballot(key[j][e] >= T);
                } else {
                    unsigned long long E[4]; unsigned before = tie_seen;
#pragma unroll
                    for (int e = 0; e < 4; ++e) { E[e] = __ballot(key[j][e] == T); before += (unsigned)__builtin_popcountll(E[e] & lt); }
                    unsigned mine = 0u;
#pragma unroll
                    for (int e = 0; e < 4; ++e) { const bool eq = (key[j][e] == T);
                        B[e] = __ballot(key[j][e] > T || (eq && (before + mine) < need_eq)); mine += eq ? 1u : 0u; }
#pragma unroll
                    for (int e = 0; e < 4; ++e) tie_seen += (unsigned)__builtin_popcountll(E[e]);
                }
#pragma unroll
                for (int k = 0; k < 4; ++k) { const int t = 4 * j + k;
                    const unsigned blo_ = (unsigned)((B[0] >> (16 * k)) & 0xffffull) | ((unsigned)((B[1] >> (16 * k)) & 0xffffull) << 16);
                    const unsigned bhi_ = (unsigned)((B[2] >> (16 * k)) & 0xffffull) | ((unsigned)((B[3] >> (16 * k)) & 0xffffull) << 16);
                    if (t < 64) asm volatile("s_nop 3\n\tv_writelane_b32 %0, %2, %4\n\tv_writelane_b32 %1, %3, %4" : "+v"(w0lo), "+v"(w0hi) : "s"(blo_), "s"(bhi_), "n"(t & 63));
                    else asm volatile("s_nop 3\n\tv_writelane_b32 %0, %2, %4\n\tv_writelane_b32 %1, %3, %4" : "+v"(w1lo), "+v"(w1hi) : "s"(blo_), "s"(bhi_), "n"(t & 63)); }
            }
        }
        const int ntile = 4 * ngrp;
        if (lane < ntile) MASK[(size_t)lane * SEQ + q] = ((unsigned long long)(unsigned)w0hi << 32) | (unsigned)w0lo;
        if (lane + 64 < ntile) MASK[(size_t)(lane + 64) * SEQ + q] = ((unsigned long long)(unsigned)w1hi << 32) | (unsigned)w1lo;
    }
}

__device__ __forceinline__ att::BlockRef attn_ref(int h, int qb, const bf16_t* Qh, const bf16_t* Kh, const bf16_t* Vh, bf16_t* O, const bf16_t* SG, const unsigned long long* MASK) {
    att::BlockRef r;
    r.Q = Qh + ((size_t)h * SEQ + (size_t)qb * 256) * HD; r.K = Kh + (size_t)h * SEQ * HD; r.V = Vh + (size_t)h * SEQ * HD;
    r.O = O + (size_t)qb * 256 * DM + h * HD; r.G = SG + (size_t)qb * 256 * DM + h * HD; r.M = MASK + qb * 256; r.P0 = qb * 256;
    return r;
}
__device__ __forceinline__ void phase_attn(int wv, const bf16_t* Qh, const bf16_t* Kh, const bf16_t* Vh, bf16_t* O, const bf16_t* SG, const unsigned long long* MASK, char* lds) {
    const int total = NHEAD * 16, stride = gridDim.x;
    int L = blockIdx.x; if (L >= total) return;
    if (gridDim.x == 256) { const int b = L; L = 16 * ((b & 7) + 8 * (b >> 7)) + ((b >> 3) & 15); }
    int pass = 0;
    att::BlockRef cur = attn_ref(L >> 4, L & 15, Qh, Kh, Vh, O, SG, MASK);
    att::Seam S;
    att::attn_prime(wv, cur, lds, S);
    for (;;) {
        const bool more_pass = pass == 0, more_item = L + stride < total, last = !more_pass && !more_item;
        int passn = pass + 1, Ln = L;
        if (!more_pass) { passn = 0; Ln = more_item ? L + stride : L; }
        const int hn = Ln >> 4, xn = Ln & 15;
        const att::BlockRef nxt = last ? cur : attn_ref(hn, passn ? 31 - xn : xn, Qh, Kh, Vh, O, SG, MASK);
        att::attn_block(wv, cur, nxt, lds, S);
        if (last) break;
        cur = nxt; pass = passn; L = Ln;
    }
}

__global__ void __launch_bounds__(NTHR, 2) trunk_fwd(Args args) {
    extern __shared__ __attribute__((aligned(16))) unsigned char lds_raw[];
    LAS unsigned char* lds = (LAS unsigned char*)lds_raw;
    volatile LAS unsigned* MISC = (volatile LAS unsigned*)(lds + MISC_OFF);
    const int wv = __builtin_amdgcn_readfirstlane((int)threadIdx.x >> 6);
    const int tid = opaque_tid(wv);
    unsigned char* ws = args.ws;
    if (tid < 32) MISC[tid] = 0u;
    __syncthreads();
    XcdBarrier bar; bar.bar = (unsigned*)(ws + WS_CTL) + 1024; bar.x = 0; bar.st = nullptr;
    if (MK_ONE_LAUNCH) bar = xcd_barrier_post((unsigned*)(ws + WS_CTL) + 1024, MISC + 8);
    const int lo = args.ph_lo, hi = args.ph_hi;
    int ph = 0;
#ifndef PHASE_MASK
#define PHASE_MASK 0xFFFF
#endif
#define IN(k) (lo <= (k) && (k) < hi)
#define PM(b) ((PHASE_MASK >> (b)) & 1)
#ifndef DUP_MASK
#define DUP_MASK 0
#endif
#ifndef SC_VAR
#define SC_VAR 0
#endif
#define DUP(b) ((DUP_MASK >> (b)) & 1)
#define REDO(b, stmt) do { if (DUP(b)) { if (MK_ONE_LAUNCH) xcd_barrier(bar); else __syncthreads(); stmt; } } while (0)
#ifndef ECHO_MASK
#define ECHO_MASK 0
#endif
#define ECHO_K 4
    unsigned long long echo_acc = 0ull, echo_prev = ECHO_MASK ? __builtin_amdgcn_s_memrealtime() : 0ull;
#define SEAM(b) do { if (IN(ph) && IN(ph + 1)) xcd_barrier(bar); ++ph; \
        if (ECHO_MASK) { const unsigned long long now_ = __builtin_amdgcn_s_memrealtime(); if ((ECHO_MASK >> (b)) & 1) echo_acc += now_ - echo_prev; echo_prev = now_; } } while (0)

    float* mod = (float*)(ws + WS_MOD);
    bf16_t* HU = (bf16_t*)(ws + WS_HU);
    const float* cosq = (const float*)(ws + WS_TAB); const float* sinq = cosq + SEQ * 16; const float* cosi = sinq + SEQ * 16; const float* sini = cosi + SEQ * 8;
    const int G = gridDim.x, bx = blockIdx.x;

    if (PM(0) && IN(ph)) { phase0<0>(wv, args, lds); REDO(0, phase0<SC_VAR>(wv, args, lds)); }
    SEAM(0);
#pragma unroll 1
    for (int layer = 0; layer < 4; ++layer) {
        const int j = layer >> 1;
        bf16_t* XB = (bf16_t*)(ws + WS_XB);
        const float* lmod = mod + layer * 4 * 6144;
        if (PM(1) && IN(ph)) { if (layer == 0) phase_norm<false>(wv, args.x, args.norm_g, lmod, HU); else phase_norm<true>(wv, XB, args.norm_g + layer * DM, lmod, HU); }
        SEAM(1);
        if ((layer & 1) == 0) {
            bf16_t* VG = (bf16_t*)(ws + WS_VG); bf16_t* PL = (bf16_t*)(ws + WS_PL);
            if (PM(2) && IN(ph)) { pg8::Gemm g{HU, (const bf16_t*)(ws + WS_WPI) + (size_t)j * POOL_IN * DM, SEQ, POOL_IN, DM, DM, DM, 0, 0};
                pg8::StaticOrder S; S.init(SEQ, POOL_IN, G, bx); pg8::EpiBf16 E{VG, POOL_IN};
                pg8::gemm_phase<pg8::EpiBf16, true>(wv, lds, g, S, E); REDO(2, (pg8::gemm_phase<pg8::EpiBf16, true>(wv, lds, g, S, E))); }
            SEAM(2);
            if (PM(3) && IN(ph)) { phase_pool(wv, VG, PL); REDO(3, phase_pool(wv, VG, PL)); }
            SEAM(3);
            if (PM(4) && IN(ph)) { pg8::Gemm g{PL, (const bf16_t*)(ws + WS_WPG) + (size_t)j * DM * 512, SEQ, DM, 512, DM, 512, 1, 512};
                pg8::StaticOrder S; S.init(SEQ, DM, G, bx); pg8::EpiPoolGrp E{HU, VG, args.pls + j * DM};
                pg8::gemm_phase<pg8::EpiPoolGrp, true>(wv, lds, g, S, E); REDO(4, (pg8::gemm_phase<pg8::EpiPoolGrp, true>(wv, lds, g, S, E))); }
            SEAM(4);
            if (PM(5) && IN(ph)) { pg8::Gemm g{HU, (const bf16_t*)(ws + WS_WPO) + (size_t)j * DM * DM, SEQ, DM, DM, DM, DM, 0, 0};
                pg8::StaticOrder S; S.init(SEQ, DM, G, bx);
                if (layer == 0) { pg8::EpiResid<false, true> E{args.x, XB, lmod + 2 * DM}; pg8::gemm_phase<pg8::EpiResid<false, true>, true>(wv, lds, g, S, E); }
                else { pg8::EpiResid<true, true> E{XB, XB, lmod + 2 * DM}; pg8::gemm_phase<pg8::EpiResid<true, true>, true>(wv, lds, g, S, E); } }
            SEAM(5);
        } else {
            bf16_t* Qh = (bf16_t*)(ws + WS_Q); bf16_t* Kh = (bf16_t*)(ws + WS_K); bf16_t* Vh = (bf16_t*)(ws + WS_V); bf16_t* SG = (bf16_t*)(ws + WS_GATE);
            bf16_t* QI = (bf16_t*)(ws + WS_QI); bf16_t* KI = (bf16_t*)(ws + WS_KI); float* WI = (float*)(ws + WS_WI);
            unsigned long long* MASK = (unsigned long long*)(ws + WS_MASK); float* SC = (float*)(ws + WS_SC);
            if (PM(6) && IN(ph)) { pg8::Gemm g{HU, (const bf16_t*)(ws + WS_WAI) + (size_t)j * ATTN_INP * DM, SEQ, ATTN_INP, DM, DM, DM, 0, 0};
                pg8::StaticOrder S; S.init(SEQ, ATTN_INP, G, bx); pg8::EpiAttnIn E{ws, args.pos};
                pg8::gemm_phase<pg8::EpiAttnIn, true>(wv, lds, g, S, E); REDO(6, (pg8::gemm_phase<pg8::EpiAttnIn, true>(wv, lds, g, S, E))); }
            SEAM(6);
            if (PM(7) && IN(ph)) { unsigned* qctr = (unsigned*)(ws + WS_CTL) + 8192 + 128 * j; phase_scores<0>(wv, QI, KI, WI, SC, lds, qctr); REDO(7, phase_scores<SC_VAR>(wv, QI, KI, WI, (float*)(ws + WS_END), lds, qctr + 64)); }
            SEAM(7);
            if (PM(8) && IN(ph)) { phase_select<0>(wv, SC, MASK, lds); REDO(8, phase_select<SC_VAR>(wv, SC, (unsigned long long*)(ws + WS_END), lds)); }
            SEAM(8);
            if (PM(9) && IN(ph)) { phase_attn(wv, Qh, Kh, Vh, HU, SG, MASK, (char*)lds_raw); REDO(9, phase_attn(wv, Qh, Kh, Vh, HU, SG, MASK, (char*)lds_raw)); }
            SEAM(9);
            if (PM(5) && IN(ph)) { pg8::Gemm g{HU, (const bf16_t*)(ws + WS_WAO) + (size_t)j * DM * DM, SEQ, DM, DM, DM, DM, 0, 0};
                pg8::StaticOrder S; S.init(SEQ, DM, G, bx);
                { pg8::EpiResid<true, true> E{XB, XB, lmod + 2 * DM}; pg8::gemm_phase<pg8::EpiResid<true, true>, true>(wv, lds, g, S, E); } }
            SEAM(5);
        }
    }
    if (PM(10) && IN(ph)) { phase_final(wv, (const bf16_t*)(ws + WS_XB), args.out, args.fg); REDO(10, phase_final(wv, (const bf16_t*)(ws + WS_XB), args.out, args.fg)); }
    if (ECHO_MASK) { if ((ECHO_MASK >> 10) & 1) echo_acc += __builtin_amdgcn_s_memrealtime() - echo_prev;
        if (bx == 0) { const unsigned long long target_ = __builtin_amdgcn_s_memrealtime() + (unsigned long long)ECHO_K * echo_acc; while (__builtin_amdgcn_s_memrealtime() < target_) __builtin_amdgcn_s_sleep(32); } }
#undef IN
#undef PM
#undef SEAM
#undef REDO
}
constexpr int N_PHASES = 1 + 2 * 5 + 2 * 6 + 1;

extern "C" void kernel_launch(void* const* d_in, const int* in_sizes, int n_in, void* d_out, int out_size, void* d_ws, size_t ws_size, hipStream_t stream) {
    static int grid = 0;
    if (grid == 0) {
        if (n_in != 13 || in_sizes[0] != SEQ * DM || out_size != SEQ * DM || ws_size < WS_END) {
            fprintf(stderr, "kernel_launch: unexpected shapes / workspace (n_in %d, in0 %d, out %d, ws %zu, need %zu)\n", n_in, n_in > 0 ? in_sizes[0] : -1, out_size, ws_size, (size_t)WS_END);
            grid = -1; return; }
        int dev = 0, cus = 0, per_cu = 0;
        if (hipGetDevice(&dev) != hipSuccess || hipDeviceGetAttribute(&cus, hipDeviceAttributeMultiprocessorCount, dev) != hipSuccess) { grid = -1; return; }
        if (hipFuncSetAttribute((const void*)trunk_fwd, hipFuncAttributeMaxDynamicSharedMemorySize, LDS_BYTES) != hipSuccess) { fprintf(stderr, "kernel_launch: hipFuncSetAttribute failed\n"); grid = -1; return; }
        if (hipOccupancyMaxActiveBlocksPerMultiprocessor(&per_cu, (const void*)trunk_fwd, NTHR, LDS_BYTES) != hipSuccess || per_cu < 1) {
            fprintf(stderr, "kernel_launch: occupancy query reports %d workgroups per CU\n", per_cu); per_cu = 1; }
        (void)hipGetLastError();
        grid = cus;
        if (grid > 256) grid = 256;
    }
    if (grid < 0) return;
    (void)hipMemsetAsync((char*)d_ws + WS_CTL, 0, CTL_ZERO_BYTES, stream);
    Args a{};
    a.x = (const float*)d_in[0]; a.c = (const float*)d_in[1]; a.pos = (const int*)d_in[2]; a.norm_g = (const float*)d_in[3];
    a.mod_w = (const float*)d_in[4]; a.mod_b = (const float*)d_in[5]; a.pwi = (const float*)d_in[6]; a.pwg = (const float*)d_in[7];
    a.pls = (const float*)d_in[8]; a.pwo = (const float*)d_in[9]; a.awi = (const float*)d_in[10]; a.awo = (const float*)d_in[11]; a.fg = (const float*)d_in[12];
    a.out = (float*)d_out; a.ws = (unsigned char*)d_ws;
#if MK_ONE_LAUNCH
    a.ph_lo = 0; a.ph_hi = N_PHASES;
    hipLaunchKernelGGL(trunk_fwd, dim3(grid), dim3(NTHR), LDS_BYTES, stream, a);
#else
    for (int p = 0; p < N_PHASES; ++p) { a.ph_lo = p; a.ph_hi = p + 1; hipLaunchKernelGGL(trunk_fwd, dim3(grid), dim3(NTHR), LDS_BYTES, stream, a); }
#endif
}
```

```cpp
#include <hip/hip_runtime.h>
#include <cstdio>
#include <cstdint>
#include <cmath>

#ifndef MK_ONE_LAUNCH
#define MK_ONE_LAUNCH 1
#endif

#define LAS __attribute__((address_space(3)))
#define GAS __attribute__((address_space(1)))
typedef unsigned short bf16_t;
typedef short bf16x8 __attribute__((ext_vector_type(8)));
typedef short s16x4 __attribute__((ext_vector_type(4)));
typedef float f32x4 __attribute__((ext_vector_type(4)));
typedef float f32x2 __attribute__((ext_vector_type(2)));
typedef float f32x16 __attribute__((ext_vector_type(16)));
typedef unsigned u32x4 __attribute__((ext_vector_type(4)));
typedef unsigned u32x2 __attribute__((ext_vector_type(2)));

constexpr int DM = 2048, SEQ = 8192, NHEAD = 16, HD = 128, IDXH = 16, IDXD = 64;
constexpr int POOL_IN = 4096, ATTN_IN = 9296, ATTN_INP = 9472  ;
constexpr int TOPK = 256;
constexpr float EPS = 1e-6f;

constexpr size_t MiB = 1u << 20;
constexpr size_t WS_CTL = 0, CTL_ZERO_BYTES = 64 * 1024;
constexpr size_t WS_MOD = 1 * MiB;
constexpr size_t WS_TAB = 2 * MiB;
constexpr size_t WS_WPI = 4 * MiB;
constexpr size_t WS_WPG = 36 * MiB;
constexpr size_t WS_WPO = 40 * MiB;
constexpr size_t WS_WAI = 56 * MiB;
constexpr size_t WS_WAO = 130 * MiB;
constexpr size_t WS_HU = 146 * MiB;
constexpr size_t WS_L = 178 * MiB;
constexpr size_t WS_VG = WS_L;
constexpr size_t WS_PL = WS_L + 64 * MiB;
constexpr size_t WS_Q = WS_L, WS_K = WS_L + 32 * MiB, WS_V = WS_L + 64 * MiB;
constexpr size_t WS_GATE = WS_L + 96 * MiB;
constexpr size_t WS_QI = WS_L + 128 * MiB;
constexpr size_t WS_KI = WS_L + 144 * MiB;
constexpr size_t WS_WI = WS_L + 145 * MiB;
constexpr size_t WS_MASK = WS_L + 146 * MiB;
constexpr size_t WS_SC = WS_L + 154 * MiB;
constexpr size_t WS_XB = WS_SC + 139 * MiB;
constexpr size_t WS_END = WS_XB + 32 * MiB;

__device__ __forceinline__ unsigned cvt_pk_bf16(float lo, float hi) { unsigned r; asm volatile("v_cvt_pk_bf16_f32 %0, %1, %2" : "=v"(r) : "v"(lo), "v"(hi)); return r; }
__device__ __forceinline__ unsigned f2bf(float f) { unsigned u = __builtin_bit_cast(unsigned, f); return (u + 0x7fffu + ((u >> 16) & 1u)) >> 16; }
__device__ __forceinline__ unsigned pk2(float lo, float hi) { return f2bf(lo) | (f2bf(hi) << 16); }
__device__ __forceinline__ float bf2f(unsigned short b) { return __builtin_bit_cast(float, (unsigned)b << 16); }
__device__ __forceinline__ float fast_sigmoid(float x) { return __builtin_amdgcn_rcpf(1.0f + __builtin_amdgcn_exp2f(-1.4426950408889634f * x)); }
__device__ __forceinline__ float silu_f(float x) { return x * fast_sigmoid(x); }
template <int X> __device__ __forceinline__ float swz_xor(float v) {
    return __builtin_bit_cast(float, __builtin_amdgcn_ds_swizzle(__builtin_bit_cast(int, v), (X << 10) | 0x1f)); }
__device__ __forceinline__ float wave_sum(float v) {
    v += swz_xor<1>(v); v += swz_xor<2>(v); v += swz_xor<4>(v); v += swz_xor<8>(v); v += swz_xor<16>(v);
    const auto rr = __builtin_amdgcn_permlane32_swap(__builtin_bit_cast(unsigned, v), __builtin_bit_cast(unsigned, v), false, false);
    const unsigned r0 = rr[0], r1 = rr[1];
    return __builtin_bit_cast(float, r0) + __builtin_bit_cast(float, r1);
}
__device__ __forceinline__ int opaque_tid(int wv) { int t; asm volatile("v_mbcnt_lo_u32_b32 %0, -1, 0\n\tv_mbcnt_hi_u32_b32 %0, -1, %0\n\tv_lshl_add_u32 %0, %1, 6, %0" : "=&v"(t) : "s"(wv)); return t; }
#define LDS_WAIT() asm volatile("s_waitcnt lgkmcnt(0)" ::: "memory")
#define VM_WAIT() asm volatile("s_waitcnt vmcnt(0)" ::: "memory")

__device__ __forceinline__ void unpack8(const u32x4 w, f32x4& a, f32x4& b) {
    const unsigned w0 = w.x, w1 = w.y, w2 = w.z, w3 = w.w;
    a = (f32x4){__builtin_bit_cast(float, w0 << 16), __builtin_bit_cast(float, w0 & 0xffff0000u), __builtin_bit_cast(float, w1 << 16), __builtin_bit_cast(float, w1 & 0xffff0000u)};
    b = (f32x4){__builtin_bit_cast(float, w2 << 16), __builtin_bit_cast(float, w2 & 0xffff0000u), __builtin_bit_cast(float, w3 << 16), __builtin_bit_cast(float, w3 & 0xffff0000u)};
}
__device__ __forceinline__ u32x4 pack8(const f32x4 a, const f32x4 b) { u32x4 w; w.x = cvt_pk_bf16(a[0], a[1]); w.y = cvt_pk_bf16(a[2], a[3]); w.z = cvt_pk_bf16(b[0], b[1]); w.w = cvt_pk_bf16(b[2], b[3]); return w; }

namespace pg8 {
constexpr int BM = 256, BK = 64, HALF = 128, HTB = HALF * BK * 2, STAGE_BYTES = 8 * HTB, NXCD = 8, WGM = 8;
__host__ __device__ __forceinline__ int lds_byte(int r, int c) { const int st = (r >> 4) * 2 + (c >> 5), rr = r & 15, cc = c & 31, ob = rr * 64 + cc * 2; return st * 1024 + (ob ^ (((ob >> 9) & 1) << 5)); }
__host__ __device__ __forceinline__ void stage_rc(int b, int& R, int& C) { const int st = b / 1024, sb = b % 1024, swz = sb ^ (((sb >> 9) & 1) << 5); R = (st >> 1) * 16 + swz / 64; C = (st & 1) * 32 + (swz % 64) / 2; }
__host__ __device__ __forceinline__ int perm32(int rho) { const int n = rho >> 4, i = rho & 15; return 8 * (i >> 2) + 4 * n + (i & 3); }

struct Unit { int pm, pn; };
struct Gemm { const bf16_t* A; const bf16_t* Bt; int M, N, K, lda, ldb, agsh, agstride; };

struct StaticOrder {
    int nM, nN, nwg, G, c;
    __host__ __device__ void init(int M, int N, int G_, int c_) { nM = M / BM; nN = N / BM; nwg = nM * nN; G = G_; c = c_; }
    __host__ __device__ bool next(int i, Unit& u) const {
        const long L = (long)i * G + c; if (L >= nwg) return false;
        int wgid = (int)L; { const int q = nwg / NXCD, r = nwg % NXCD, xcd = wgid % NXCD, off = wgid / NXCD; wgid = (xcd < r ? xcd * (q + 1) : r * (q + 1) + (xcd - r) * q) + off; }
        const int nig = WGM * nN, gid = wgid / nig, fm = gid * WGM, gsz = (nM - fm) < WGM ? (nM - fm) : WGM;
        u.pm = fm + ((wgid % nig) % gsz); u.pn = (wgid % nig) / gsz; return true;
    }
};

template <class Epi, bool ALIGN_EPI>
__device__ __forceinline__ void gemm_phase(int wv, LAS unsigned char* lds, const Gemm g, const StaticOrder& S, const Epi& E) {
    const int tid = opaque_tid(wv), wid = __builtin_amdgcn_readfirstlane(tid >> 6), lane = tid & 63, wr = wid >> 2, wc = wid & 3, fr = lane & 15, fq = lane >> 4;
    const int K = g.K, nt = K / BK;
    unsigned voffA[2], voffB[2];
#pragma unroll
    for (int i = 0; i < 2; ++i) { int R, C; stage_rc(tid * 16 + i * 8192, R, C); const int Rb = Epi::PERM ? ((R & ~31) + perm32(R & 31)) : R;
        voffA[i] = (unsigned)(R * g.lda + C) * 2u; voffB[i] = (unsigned)(Rb * g.ldb + C) * 2u; }
    const size_t kstep = (size_t)(BK * 2);
    const size_t hstepA = (size_t)HALF * g.lda * 2, hstepB = (size_t)HALF * g.ldb * 2;
    const size_t tstepA = 2 * hstepA, tstepB = 2 * hstepB;
    const unsigned ldsw = (unsigned)wid * 1024u;
    const int aoff = lds_byte(wr * 64 + fr, fq * 8), boff = lds_byte(wc * 32 + fr, fq * 8);
#define PG8_SA(b, h) (((b) * 2 + (h)) * HTB)
#define PG8_SB(b, h) ((4 + (b) * 2 + (h)) * HTB)
#define PG8_STAGE(bufoff, gbase, voff) do { _Pragma("unroll") for (int _i = 0; _i < 2; ++_i) \
        __builtin_amdgcn_global_load_lds((const unsigned*)((const char*)(gbase) + (voff)[_i]), (LAS unsigned*)(lds + (bufoff) + ldsw + _i * 8192), 16, 0, 0); } while (0)
#define PG8_LDA(dst, b, h) do { _Pragma("unroll") for (int m = 0; m < 4; ++m) _Pragma("unroll") for (int k = 0; k < 2; ++k) dst[m][k] = *(const LAS bf16x8*)(lds + PG8_SA(b, h) + aoff + m * 2048 + k * 1024); } while (0)
#define PG8_LDB(dst, b, h) do { _Pragma("unroll") for (int n = 0; n < 2; ++n) _Pragma("unroll") for (int k = 0; k < 2; ++k) dst[n][k] = *(const LAS bf16x8*)(lds + PG8_SB(b, h) + boff + n * 2048 + k * 1024); } while (0)
#define PG8_MMA(ai, bj, At, Bt) do { __builtin_amdgcn_s_setprio(1); _Pragma("unroll") for (int m = 0; m < 4; ++m) _Pragma("unroll") for (int n = 0; n < 2; ++n) _Pragma("unroll") for (int k = 0; k < 2; ++k) \
        acc[ai][bj][m][n] = __builtin_amdgcn_mfma_f32_16x16x32_bf16(Bt[n][k], At[m][k], acc[ai][bj][m][n], 0, 0, 0); __builtin_amdgcn_s_setprio(0); } while (0)
#define PG8_WAIT_V(n) asm volatile("s_waitcnt vmcnt(" #n ")" ::: "memory")
#define PG8_WAIT_L(n) asm volatile("s_waitcnt lgkmcnt(" #n ")" ::: "memory")
#define PG8_BAR __builtin_amdgcn_s_barrier()
#define PG8_SCHED __builtin_amdgcn_sched_barrier(0)
#define PG8_AOFF(u) ((size_t)(u).pm * tstepA + (size_t)(((u).pn >> g.agsh) * g.agstride) * 2)
    Unit cur, nxt; int ui = 0;
    if (!S.next(0, cur)) return;
    f32x4 acc[2][2][4][2];
#pragma unroll
    for (int a = 0; a < 2; ++a)
#pragma unroll
        for (int b = 0; b < 2; ++b)
#pragma unroll
            for (int m = 0; m < 4; ++m)
#pragma unroll
                for (int n = 0; n < 2; ++n) acc[a][b][m][n] = (f32x4){0.f, 0.f, 0.f, 0.f};
    bf16x8 At[4][2], B0[2][2], B1[2][2];
    const char* cA = (const char*)g.A + PG8_AOFF(cur); const char* cB = (const char*)g.Bt + (size_t)cur.pn * tstepB;
    PG8_STAGE(PG8_SB(0, 0), cB, voffB); PG8_STAGE(PG8_SB(0, 1), cB + hstepB, voffB); PG8_STAGE(PG8_SA(0, 0), cA, voffA); PG8_STAGE(PG8_SA(0, 1), cA + hstepA, voffA);
    if (wr == 1) PG8_BAR;
    PG8_WAIT_V(2); PG8_BAR;
    PG8_STAGE(PG8_SB(1, 0), cB + kstep, voffB); PG8_STAGE(PG8_SA(1, 0), cA + kstep, voffA); PG8_STAGE(PG8_SB(1, 1), cB + hstepB + kstep, voffB);
    PG8_WAIT_V(6); PG8_BAR;
    for (;;) {
        const bool has_next = S.next(ui + 1, nxt);
        const char* nA = has_next ? (const char*)g.A + PG8_AOFF(nxt) : cA; const char* nB = has_next ? (const char*)g.Bt + (size_t)nxt.pn * tstepB : cB;
        for (int t = 0; t < nt; t += 2) {
            const bool last = (t == nt - 2);
            const char* a1 = cA + (size_t)(t + 1) * kstep;
            const char* a2 = last ? nA : cA + (size_t)(t + 2) * kstep; const char* b2 = last ? nB : cB + (size_t)(t + 2) * kstep;
            const char* a3 = a2 + kstep; const char* b3 = b2 + kstep;
            PG8_LDB(B0, 0, 0); PG8_LDB(B1, 0, 1); PG8_SCHED; PG8_LDA(At, 0, 0); PG8_STAGE(PG8_SA(1, 1), a1 + hstepA, voffA);
            PG8_WAIT_V(8); PG8_WAIT_L(0); PG8_BAR; PG8_MMA(0, 0, At, B0); PG8_MMA(0, 1, At, B1); PG8_BAR; PG8_SCHED;
            PG8_LDA(At, 0, 1); PG8_STAGE(PG8_SB(0, 0), b2, voffB); PG8_STAGE(PG8_SB(0, 1), b2 + hstepB, voffB); PG8_STAGE(PG8_SA(0, 0), a2, voffA);
            PG8_WAIT_V(8); PG8_WAIT_L(0); PG8_BAR; PG8_MMA(1, 0, At, B0); PG8_MMA(1, 1, At, B1); PG8_BAR; PG8_SCHED;
            PG8_LDB(B0, 1, 0); PG8_LDB(B1, 1, 1); PG8_SCHED; PG8_LDA(At, 1, 0); PG8_STAGE(PG8_SA(0, 1), a2 + hstepA, voffA);
            PG8_WAIT_V(8); PG8_WAIT_L(0); PG8_BAR; PG8_MMA(0, 0, At, B0); PG8_MMA(0, 1, At, B1); PG8_BAR; PG8_SCHED;
            PG8_LDA(At, 1, 1); PG8_STAGE(PG8_SB(1, 0), b3, voffB); PG8_STAGE(PG8_SB(1, 1), b3 + hstepB, voffB); PG8_STAGE(PG8_SA(1, 0), a3, voffA);
            PG8_WAIT_V(8); PG8_WAIT_L(0); PG8_BAR; PG8_MMA(1, 0, At, B0); PG8_MMA(1, 1, At, B1); PG8_BAR; PG8_SCHED;
        }
        if constexpr (ALIGN_EPI) { if (wr == 0) PG8_BAR; }
        E(acc, cur, wr, wc, fr, fq);
        if (!has_next) break;
#pragma unroll
        for (int a = 0; a < 2; ++a)
#pragma unroll
            for (int b = 0; b < 2; ++b)
#pragma unroll
                for (int m = 0; m < 4; ++m)
#pragma unroll
                    for (int n = 0; n < 2; ++n) acc[a][b][m][n] = (f32x4){0.f, 0.f, 0.f, 0.f};
        cur = nxt; cA = nA; cB = nB; ++ui;
        if constexpr (ALIGN_EPI) { if (wr == 1) PG8_BAR; }
    }
    PG8_WAIT_V(0);
    if constexpr (!ALIGN_EPI) { if (wr == 0) PG8_BAR; }
    PG8_BAR;
#undef PG8_SA
#undef PG8_SB
#undef PG8_STAGE
#undef PG8_LDA
#undef PG8_LDB
#undef PG8_MMA
#undef PG8_WAIT_V
#undef PG8_WAIT_L
#undef PG8_BAR
#undef PG8_SCHED
#undef PG8_AOFF
}

struct EpiBf16 {
    static constexpr bool PERM = true;
    bf16_t* O; int ldc;
    __device__ __forceinline__ void operator()(const f32x4 (&acc)[2][2][4][2], const Unit& u, int wr, int wc, int fr, int fq) const {
        const int row0 = u.pm * BM + wr * 64 + fr; const int col0 = u.pn * BM + wc * 32 + 8 * fq;
#pragma unroll
        for (int ai = 0; ai < 2; ++ai)
#pragma unroll
            for (int m = 0; m < 4; ++m) { bf16_t* rowp = O + (size_t)(row0 + ai * HALF + m * 16) * ldc + col0;
#pragma unroll
                for (int bj = 0; bj < 2; ++bj) { const f32x4 v0 = acc[ai][bj][m][0], v1 = acc[ai][bj][m][1];
                    u32x4 w; w.x = cvt_pk_bf16(v0[0], v0[1]); w.y = cvt_pk_bf16(v0[2], v0[3]); w.z = cvt_pk_bf16(v1[0], v1[1]); w.w = cvt_pk_bf16(v1[2], v1[3]);
                    *(u32x4*)(rowp + bj * HALF) = w; } }
    }
};
struct EpiPoolGrp {
    static constexpr bool PERM = true;
    bf16_t* U; const bf16_t* VG; const float* ls;
    __device__ __forceinline__ void operator()(const f32x4 (&acc)[2][2][4][2], const Unit& u, int wr, int wc, int fr, int fq) const {
        const int row0 = u.pm * BM + wr * 64 + fr; const int col0 = u.pn * BM + wc * 32 + 8 * fq;
        f32x4 lv[2][2];
#pragma unroll
        for (int bj = 0; bj < 2; ++bj)
#pragma unroll
            for (int n = 0; n < 2; ++n) lv[bj][n] = *(const f32x4*)(ls + col0 + bj * HALF + 4 * n);
#pragma unroll
        for (int ai = 0; ai < 2; ++ai) {
            u32x4 gw[4][2];
#pragma unroll
            for (int m = 0; m < 4; ++m)
#pragma unroll
                for (int bj = 0; bj < 2; ++bj) gw[m][bj] = *(const u32x4*)(VG + (size_t)(row0 + ai * HALF + m * 16) * POOL_IN + DM + col0 + bj * HALF);
            __builtin_amdgcn_sched_barrier(0);
#pragma unroll
            for (int m = 0; m < 4; ++m) { const size_t row = (size_t)(row0 + ai * HALF + m * 16);
#pragma unroll
                for (int bj = 0; bj < 2; ++bj) {
                    f32x4 v0 = acc[ai][bj][m][0] * lv[bj][0], v1 = acc[ai][bj][m][1] * lv[bj][1];
                    f32x4 g0, g1; unpack8(gw[m][bj], g0, g1);
#pragma unroll
                    for (int e = 0; e < 4; ++e) { v0[e] *= silu_f(g0[e]); v1[e] *= silu_f(g1[e]); }
                    *(u32x4*)(U + row * DM + col0 + bj * HALF) = pack8(v0, v1); } }
            __builtin_amdgcn_sched_barrier(0); }
    }
};
template <bool IN_BF16, bool OUT_BF16> struct EpiResid {
    static constexpr bool PERM = true;
    const void* xin; void* xout; const float* gmod;
    __device__ __forceinline__ void operator()(const f32x4 (&acc)[2][2][4][2], const Unit& u, int wr, int wc, int fr, int fq) const {
        const int row0 = u.pm * BM + wr * 64 + fr; const int col0 = u.pn * BM + wc * 32 + 8 * fq;
        f32x4 gv[2][2];
#pragma unroll
        for (int bj = 0; bj < 2; ++bj)
#pragma unroll
            for (int n = 0; n < 2; ++n) { const float* gp = gmod + col0 + bj * HALF + 4 * n;
                gv[bj][n] = ((*(const f32x4*)gp + *(const f32x4*)(gp + 6144)) + *(const f32x4*)(gp + 2 * 6144)) + *(const f32x4*)(gp + 3 * 6144); }
#pragma unroll
        for (int ai = 0; ai < 2; ++ai)
#pragma unroll
          for (int mh = 0; mh < (IN_BF16 ? 1 : 2); ++mh) {
            constexpr int MB = IN_BF16 ? 4 : 2;
            u32x4 rw[MB][2]; f32x4 rf[MB][2][2];
#pragma unroll
            for (int mm = 0; mm < MB; ++mm)
#pragma unroll
                for (int bj = 0; bj < 2; ++bj) { const size_t off = (size_t)(row0 + ai * HALF + (mh * MB + mm) * 16) * DM + col0 + bj * HALF;
                    if (IN_BF16) rw[mm][bj] = *(const u32x4*)((const bf16_t*)xin + off);
                    else { rf[mm][bj][0] = *(const f32x4*)((const float*)xin + off); rf[mm][bj][1] = *(const f32x4*)((const float*)xin + off + 4); } }
            __builtin_amdgcn_sched_barrier(0);
#pragma unroll
            for (int mm = 0; mm < MB; ++mm)
#pragma unroll
                for (int bj = 0; bj < 2; ++bj) { const int m = mh * MB + mm; const size_t off = (size_t)(row0 + ai * HALF + m * 16) * DM + col0 + bj * HALF;
                    f32x4 b0, b1;
                    if (IN_BF16) unpack8(rw[mm][bj], b0, b1); else { b0 = rf[mm][bj][0]; b1 = rf[mm][bj][1]; }
                    const f32x4 y0 = b0 + gv[bj][0] * acc[ai][bj][m][0], y1 = b1 + gv[bj][1] * acc[ai][bj][m][1];
                    if (OUT_BF16) *(u32x4*)((bf16_t*)xout + off) = pack8(y0, y1);
                    else { *(f32x4*)((float*)xout + off) = y0; *(f32x4*)((float*)xout + off + 4) = y1; } }
            __builtin_amdgcn_sched_barrier(0); }
    }
};
struct EpiAttnIn {
    static constexpr bool PERM = true;
    unsigned char* ws; const int* pos;
    __device__ __forceinline__ void operator()(const f32x4 (&acc)[2][2][4][2], const Unit& u, int wr, int wc, int fr, int fq) const {
        const int row0 = u.pm * BM + wr * 64 + fr; const int pn = u.pn;
        bf16_t* const Qh = (bf16_t*)(ws + WS_Q); bf16_t* const SG = (bf16_t*)(ws + WS_GATE); bf16_t* const QI = (bf16_t*)(ws + WS_QI); bf16_t* const KI = (bf16_t*)(ws + WS_KI); float* const WI = (float*)(ws + WS_WI);
        const float* const cosq = (const float*)(ws + WS_TAB); const float* const sinq = cosq + SEQ * 16; const float* const cosi = sinq + SEQ * 16; const float* const sini = cosi + SEQ * 8;
#pragma unroll
        for (int ai = 0; ai < 2; ++ai)
#pragma unroll
            for (int m = 0; m < 4; ++m) {
                const int row = row0 + ai * HALF + m * 16;
                if (pn < 24) {
                    bf16_t* base = Qh + (size_t)(pn >> 3) * ((size_t)SEQ * DM);
                    const bool rope = (pn < 16) && (wc == 0);
                    f32x4 cs[2] = {{1.f, 1.f, 1.f, 1.f}, {1.f, 1.f, 1.f, 1.f}}, sn[2] = {{0.f, 0.f, 0.f, 0.f}, {0.f, 0.f, 0.f, 0.f}};
                    if (rope) { const float* cp = cosq + (size_t)row * 16 + 8 * (fq & 1); const float* sp = sinq + (size_t)row * 16 + 8 * (fq & 1);
                        cs[0] = *(const f32x4*)cp; cs[1] = *(const f32x4*)(cp + 4); sn[0] = *(const f32x4*)sp; sn[1] = *(const f32x4*)(sp + 4); }
#pragma unroll
                    for (int bj = 0; bj < 2; ++bj) { const int head = 2 * (pn & 7) + bj;
                        f32x4 v[2] = {acc[ai][bj][m][0], acc[ai][bj][m][1]};
                        if (rope) {
#pragma unroll
                            for (int n = 0; n < 2; ++n) { f32x4 pr;
#pragma unroll
                                for (int e = 0; e < 4; ++e) { const float ve = v[n][e];
                                    const auto rr = __builtin_amdgcn_permlane32_swap(__builtin_bit_cast(unsigned, ve), __builtin_bit_cast(unsigned, ve), false, false);
                                    const unsigned pu = (fq < 2) ? rr[1] : rr[0]; pr[e] = __builtin_bit_cast(float, pu); }
                                v[n] = (fq < 2) ? (v[n] * cs[n] - pr * sn[n]) : (v[n] * cs[n] + pr * sn[n]); } }
                        *(u32x4*)(base + ((size_t)head * SEQ + row) * HD + 32 * wc + 8 * fq) = pack8(v[0], v[1]); }
                } else if (pn < 32) {
#pragma unroll
                    for (int bj = 0; bj < 2; ++bj) { f32x4 v0 = acc[ai][bj][m][0], v1 = acc[ai][bj][m][1];
#pragma unroll
                        for (int e = 0; e < 4; ++e) { v0[e] = silu_f(v0[e]); v1[e] = silu_f(v1[e]); }
                        *(u32x4*)(SG + (size_t)row * DM + (pn - 24) * BM + bj * HALF + 32 * wc + 8 * fq) = pack8(v0, v1); }
                } else {
                    const bool isq = pn < 36;
                    const bool rope = ((wc & 1) == 0) && (isq || wc == 0);
                    f32x4 cs[2], sn[2];
                    { const float* cp = cosi + (size_t)row * 8; const float* sp = sini + (size_t)row * 8;
                      cs[0] = *(const f32x4*)cp; cs[1] = *(const f32x4*)(cp + 4); sn[0] = *(const f32x4*)sp; sn[1] = *(const f32x4*)(sp + 4); }
#pragma unroll
                    for (int bj = 0; bj < 2; ++bj) {
                        if (!isq && bj == 1) continue;
                        f32x4 v[2] = {acc[ai][bj][m][0], acc[ai][bj][m][1]};
                        if (rope) {
#pragma unroll
                            for (int n = 0; n < 2; ++n) { f32x4 pr;
#pragma unroll
                                for (int e = 0; e < 4; ++e) pr[e] = swz_xor<16>(v[n][e]);
                                const f32x4 ro = (fq == 0) ? (v[n] * cs[n] - pr * sn[n]) : (v[n] * cs[n] + pr * sn[n]);
                                v[n] = (fq < 2) ? ro : v[n]; } }
                        const int cl = bj * HALF + 32 * wc + 8 * fq;
                        if (isq) *(u32x4*)(QI + (size_t)row * 1024 + (pn - 32) * BM + cl) = pack8(v[0], v[1]);
                        else if (cl < 64) *(u32x4*)(KI + (size_t)row * 64 + cl) = pack8(v[0], v[1]);
                        else if (cl < 80) { *(f32x4*)(WI + (size_t)row * 16 + (cl - 64)) = v[0]; *(f32x4*)(WI + (size_t)row * 16 + (cl - 64) + 4) = v[1]; }
                    }
                }
                asm volatile("" ::: "memory");
            }
    }
};
}

namespace att {
constexpr int D = 128, NW = 8, QBLK = 32, KVBLK = 64, QB = NW * QBLK;
constexpr int KROWB = 272;
constexpr int SHM_V = KVBLK * D * 2, SHM_K = KVBLK * KROWB;
constexpr int QROWB = 272;
constexpr int Q_OFF = 2 * SHM_V + 2 * SHM_K + NW * 64 * 4;
constexpr int LDS_BYTES = Q_OFF + QB * QROWB;
constexpr float SCALE = 0.08838834764831845f;
constexpr float THR = 8.f;
#define KSWZ(row, colB) ((row) * KROWB + (colB))
#define SBAR() __builtin_amdgcn_sched_barrier(0)
__device__ __forceinline__ int v_st(int k, int c) { const int kk = (k & ~0xC) | ((k & 4) << 1) | ((k & 8) >> 1); return ((kk >> 3) * 4 + (c >> 5)) * 512 + ((kk & 7) * 32 + (c & 31)) * 2; }
__device__ __forceinline__ int v_rd_base(int lane) { return ((lane & 3) << 3) | (((lane >> 2) & 3) << 6) | (((lane >> 4) & 1) << 5) | (((lane >> 5) & 1) << 8); }
constexpr int v_rd_off(int d0, int ks, int half) { return d0 * 512 + ks * 4096 + half * 2048; }
__device__ __forceinline__ int crow(int r, int hi) { return (r & 3) + 8 * (r >> 2) + 4 * hi; }
__device__ __forceinline__ unsigned cvtpk(float lo, float hi) { unsigned r; asm volatile("v_cvt_pk_bf16_f32 %0, %1, %2" : "=v"(r) : "v"(lo), "v"(hi)); return r; }
__device__ __forceinline__ bf16x8 load8(const bf16_t* p) { return *reinterpret_cast<const bf16x8*>(p); }
__device__ __forceinline__ float mask_and(float v, unsigned mlo, unsigned mhi, int r, int p) {
    const int pos = 16 * (r & 1) + 2 * (r >> 2) + 8 * p;
    const unsigned w = (r & 2) ? mhi : mlo;
    const int bits = __builtin_amdgcn_sbfe((int)w, pos, 1);
    return __builtin_bit_cast(float, __builtin_bit_cast(unsigned, v) & (unsigned)bits);
}
__device__ __forceinline__ void partialSM(f32x16& p0, f32x16& p1, float& m_reg, float& mn, float& alpha, unsigned mlo, unsigned mhi) {
    float pmax = p0[0];
#pragma unroll
    for (int r = 1; r < 16; ++r) pmax = fmaxf(pmax, p0[r]);
#pragma unroll
    for (int r = 0; r < 16; ++r) pmax = fmaxf(pmax, p1[r]);
    { auto rr = __builtin_amdgcn_permlane32_swap(__float_as_uint(pmax), __float_as_uint(pmax), false, false);
      pmax = fmaxf(__uint_as_float(rr[0]), __uint_as_float(rr[1])); }
    constexpr float C2 = 1.4426950408889634f * SCALE;
    if (__builtin_expect(__all((pmax - m_reg) * SCALE <= THR), 1)) { mn = m_reg; alpha = 1.f; }
    else { mn = fmaxf(m_reg, pmax); alpha = __builtin_amdgcn_exp2f((m_reg - mn) * C2); m_reg = mn; }
    const float mnL = -mn * C2;
#pragma unroll
    for (int r = 0; r < 16; ++r) p0[r] = fmaf(p0[r], C2, mnL);
#pragma unroll
    for (int r = 0; r < 16; ++r) p1[r] = fmaf(p1[r], C2, mnL);
#pragma unroll
    for (int r = 0; r < 16; ++r) p0[r] = mask_and(__builtin_amdgcn_exp2f(p0[r]), mlo, mhi, r, 0);
}
__device__ __forceinline__ void finishSM(f32x16& p0, f32x16& p1, float alpha, float& l_reg, bf16x8& pa0, bf16x8& pa1, bf16x8& pa2, bf16x8& pa3, unsigned mlo, unsigned mhi) {
#pragma unroll
    for (int r = 0; r < 16; ++r) p1[r] = mask_and(__builtin_amdgcn_exp2f(p1[r]), mlo, mhi, r, 1);
    float ps = 0;
#pragma unroll
    for (int r = 0; r < 16; ++r) ps += p0[r];
#pragma unroll
    for (int r = 0; r < 16; ++r) ps += p1[r];
    { auto rr = __builtin_amdgcn_permlane32_swap(__float_as_uint(ps), __float_as_uint(ps), false, false);
      ps = __uint_as_float(rr[0]) + __uint_as_float(rr[1]); }
    l_reg = l_reg * alpha + ps;
#define PK4(P, B_, OUT) do { unsigned a0 = cvtpk(P[B_+0], P[B_+1]), a1 = cvtpk(P[B_+2], P[B_+3]);                          \
        unsigned b0 = cvtpk(P[B_+4], P[B_+5]), b1 = cvtpk(P[B_+6], P[B_+7]);                                             \
        auto r0 = __builtin_amdgcn_permlane32_swap(a0, b0, false, false); auto r1 = __builtin_amdgcn_permlane32_swap(a1, b1, false, false); \
        u32x4 w = {r0[0], r1[0], r0[1], r1[1]}; OUT = *reinterpret_cast<bf16x8*>(&w); } while (0)
    PK4(p0, 0, pa0); PK4(p0, 8, pa1); PK4(p1, 0, pa2); PK4(p1, 8, pa3);
#undef PK4
}
template <int KB>
__device__ __forceinline__ void qkt(f32x16& p0, f32x16& p1, const char* K_lds, int r32, int hi, const char* qa  ) {
    p0 = f32x16{}; p1 = f32x16{};
    const char* kb = K_lds + KB * SHM_K + r32 * KROWB + hi * 16;
#pragma unroll
    for (int d0 = 0; d0 < 8; ++d0) { const char* a = kb + d0 * 32;
        bf16x8 b0 = *reinterpret_cast<const bf16x8*>(a);
        bf16x8 b1 = *reinterpret_cast<const bf16x8*>(a + 32 * KROWB);
        const bf16x8 qf = *reinterpret_cast<const bf16x8*>(qa + d0 * 32);
        p0 = __builtin_amdgcn_mfma_f32_32x32x16_bf16(b0, qf, p0, 0, 0, 0);
        p1 = __builtin_amdgcn_mfma_f32_32x32x16_bf16(b1, qf, p1, 0, 0, 0); }
}
template <int VB>
__device__ __forceinline__ void pv_tile(f32x16* o, int vb0, bf16x8 pa0, bf16x8 pa1, bf16x8 pa2, bf16x8 pa3) {
#define TRRD(dst, off) asm volatile("ds_read_b64_tr_b16 %0, %1 offset:%2" : "=&v"(dst) : "v"(vb0), "i"(off) : "memory")
#define PV_D0(d0) do { s16x4 l0, l1, l2, l3, h0, h1, h2, h3; constexpr int b_ = VB * SHM_V + v_rd_off(d0, 0, 0); \
        TRRD(l0, b_); TRRD(h0, b_ + 2048); TRRD(l1, b_ + 4096); TRRD(h1, b_ + 6144); TRRD(l2, b_ + 8192); TRRD(h2, b_ + 10240); TRRD(l3, b_ + 12288); TRRD(h3, b_ + 14336); \
        asm volatile("s_waitcnt lgkmcnt(0)" ::: "memory"); SBAR();   \
        o[d0] = __builtin_amdgcn_mfma_f32_32x32x16_bf16(pa0, (bf16x8){l0[0], l0[1], l0[2], l0[3], h0[0], h0[1], h0[2], h0[3]}, o[d0], 0, 0, 0);   \
        o[d0] = __builtin_amdgcn_mfma_f32_32x32x16_bf16(pa1, (bf16x8){l1[0], l1[1], l1[2], l1[3], h1[0], h1[1], h1[2], h1[3]}, o[d0], 0, 0, 0);   \
        o[d0] = __builtin_amdgcn_mfma_f32_32x32x16_bf16(pa2, (bf16x8){l2[0], l2[1], l2[2], l2[3], h2[0], h2[1], h2[2], h2[3]}, o[d0], 0, 0, 0);   \
        o[d0] = __builtin_amdgcn_mfma_f32_32x32x16_bf16(pa3, (bf16x8){l3[0], l3[1], l3[2], l3[3], h3[0], h3[1], h3[2], h3[3]}, o[d0], 0, 0, 0); } while (0)
    PV_D0(0); PV_D0(1); PV_D0(2); PV_D0(3);
#undef PV_D0
#undef TRRD
}
struct BlockRef { const bf16_t* Q; const bf16_t* K; const bf16_t* V; bf16_t* O; const bf16_t* G; const unsigned long long* M; int P0; };
struct Seam { bf16x8 st_v0, st_v1, st_k0, st_k1; };
#define ROW(p, k0, rr) ((p) + (size_t)((k0) + (rr)) * D + sc)
#define VMW() asm volatile("s_waitcnt vmcnt(0)" ::: "memory")
#define VMWN(n) asm volatile("s_waitcnt vmcnt(%0)" :: "i"(n) : "memory")
#define SLOAD_H(Kp, Vp, k0) do { S.st_v0 = load8(ROW(Vp, k0, sr)); S.st_v1 = load8(ROW(Vp, k0, 32 + sr));              \
                         S.st_k0 = load8(ROW(Kp, k0, sr)); S.st_k1 = load8(ROW(Kp, k0, 32 + sr)); } while (0)
#define SWRITE_HK(bf) do { *(bf16x8*)(K_lds + (bf) * SHM_K + kws) = S.st_k0; *(bf16x8*)(K_lds + (bf) * SHM_K + kws + 32 * KROWB) = S.st_k1; } while (0)
#define SWRITE_HV(bf) do { *(bf16x8*)(V_lds + (bf) * SHM_V + vst0) = S.st_v0; *(bf16x8*)(V_lds + (bf) * SHM_V + vst1) = S.st_v1; } while (0)
#define SWRITE_H(bf) do { SWRITE_HV(bf); SWRITE_HK(bf); } while (0)
__device__ __forceinline__ void attn_prime(int wv, const BlockRef& cur, char* lds, Seam& S) {
    const int tid = opaque_tid(wv);
    const int sr = tid >> 4, sc = (tid & 15) * 8, kws = KSWZ(sr, sc * 2); char* K_lds = lds + 2 * SHM_V;
    SLOAD_H(cur.K, cur.V, 0); VMW(); SWRITE_HK(0);
    __syncthreads();
}
__device__ __forceinline__ void attn_block(int wv, const BlockRef& cur, const BlockRef& nxt, char* lds, Seam& S) {
    const int tid = opaque_tid(wv), wid = __builtin_amdgcn_readfirstlane(tid >> 6), lane = tid & 63, r32 = lane & 31, hi = lane >> 5;
    const int NT = cur.P0 / KVBLK + 4;
    char* V_lds = lds; char* K_lds = lds + 2 * SHM_V;
    float* ws = (float*)(lds + 2 * SHM_V + 2 * SHM_K) + wid * 64; float* li_l = ws, * al_l = ws + 32;
    float m_reg = -1e30f, l_reg = 0; f32x16 o[4] = {};
    const int sr = tid >> 4, sc = (tid & 15) * 8, vst0 = v_st(sr, sc), vst1 = v_st(32 + sr, sc), kws = KSWZ(sr, sc * 2);
    const int vb0 = (int)(uintptr_t)V_lds + v_rd_base(lane);
    const bf16_t* Kh = cur.K; const bf16_t* Vh = cur.V;
    const unsigned long long* mp = cur.M + (wid * QBLK + r32);
#define MLOAD(lo_, hi_, t) do { const unsigned long long w_ = mp[(size_t)(t) * SEQ] >> hi; lo_ = (unsigned)w_; hi_ = (unsigned)(w_ >> 32); } while (0)
#define RESC(a) do { if (__any((a) < 1.f)) { if (hi == 0) al_l[r32] = (a); asm volatile("s_waitcnt lgkmcnt(0)" ::: "memory");              \
                     for (int d_ = 0; d_ < 4; ++d_) for (int r = 0; r < 16; ++r) o[d_][r] *= al_l[crow(r, hi)]; } } while (0)
#define KBASE(t) ((t) * KVBLK)
#define SEAM_K0() do { VMW(); SWRITE_HK(0); SBAR(); } while (0)
    f32x16 pA0, pA1, pB0, pB1; float mnA, mnB, alA, alB; bf16x8 pa0, pa1, pa2, pa3;
    unsigned mAlo, mAhi, mBlo, mBhi;
    MLOAD(mAlo, mAhi, 0);
    char* Qw_lds = lds + Q_OFF + wid * (QBLK * QROWB);
    { u32x4 tq[8];
#pragma unroll
        for (int i = 0; i < 8; ++i) tq[i] = *(const u32x4*)(cur.Q + (size_t)(wid * QBLK + 4 * i + (lane >> 4)) * D + (lane & 15) * 8);
#pragma unroll
        for (int i = 0; i < 8; ++i) *(u32x4*)(Qw_lds + (4 * i + (lane >> 4)) * QROWB + (lane & 15) * 16) = tq[i];
        asm volatile("s_waitcnt lgkmcnt(0)" ::: "memory"); }
    const char* qa = Qw_lds + r32 * QROWB + hi * 16;
    SWRITE_HV(0); SBAR();
    if (NT > 1) { SLOAD_H(Kh, Vh, KBASE(1)); }
    SBAR(); qkt<0>(pA0, pA1, K_lds, r32, hi, qa);
    partialSM(pA0, pA1, m_reg, mnA, alA, mAlo, mAhi);
    if (NT > 1) { VMW(); SWRITE_H(1); }
    __syncthreads();
#define HALF_STEP(PX0, PX1, mnX, alX, mXlo, mXhi, PY0, PY1, alY, mYlo, mYhi, t, KB, VB, SB) do {                                  \
        SBAR(); MLOAD(mXlo, mXhi, t); qkt<KB>(PX0, PX1, K_lds, r32, hi, qa);                                                  \
        finishSM(PY0, PY1, alY, l_reg, pa0, pa1, pa2, pa3, mYlo, mYhi); SBAR();                                                 \
        if ((t) + 1 < NT) { SLOAD_H(Kh, Vh, KBASE((t) + 1)); SBAR(); }                                                          \
        pv_tile<VB>(o, vb0, pa0, pa1, pa2, pa3); partialSM(PX0, PX1, m_reg, mnX, alX, mXlo, mXhi);                              \
        __syncthreads();                                                                                                      \
        if ((t) + 1 < NT) { VMW(); SWRITE_H(SB); }                                                                            \
        RESC(alX); __syncthreads(); } while (0)
    for (int t = 1; t + 1 < NT; t += 2) {
        HALF_STEP(pB0, pB1, mnB, alB, mBlo, mBhi, pA0, pA1, alA, mAlo, mAhi, t, 1, 0, 0);
        HALF_STEP(pA0, pA1, mnA, alA, mAlo, mAhi, pB0, pB1, alB, mBlo, mBhi, t + 1, 0, 1, 1);
    }
    MLOAD(mBlo, mBhi, NT - 1);
    SBAR(); qkt<1>(pB0, pB1, K_lds, r32, hi, qa); SBAR();
    SLOAD_H(nxt.K, nxt.V, 0); SBAR();
    finishSM(pA0, pA1, alA, l_reg, pa0, pa1, pa2, pa3, mAlo, mAhi); SBAR();
    pv_tile<0>(o, vb0, pa0, pa1, pa2, pa3);
    partialSM(pB0, pB1, m_reg, mnB, alB, mBlo, mBhi); __syncthreads(); RESC(alB);
    finishSM(pB0, pB1, alB, l_reg, pa0, pa1, pa2, pa3, mBlo, mBhi); SBAR(); pv_tile<1>(o, vb0, pa0, pa1, pa2, pa3);
    SBAR(); SEAM_K0();
    if (hi == 0) li_l[r32] = l_reg; asm volatile("s_waitcnt lgkmcnt(0)" ::: "memory");
    { char* ow_l = Qw_lds + r32 * 2;
#pragma unroll
      for (int r = 0; r < 16; ++r) { const int orow = crow(r, hi); const float rl = __builtin_amdgcn_rcpf(li_l[orow]);
#pragma unroll
          for (int d0 = 0; d0 < 4; ++d0) *(unsigned short*)(ow_l + orow * QROWB + d0 * 64) = (unsigned short)(cvtpk(o[d0][r] * rl, 0.f) & 0xffffu); }
      asm volatile("s_waitcnt lgkmcnt(0)" ::: "memory"); SBAR();
      bf16_t* Ow = cur.O + (size_t)(wid * QBLK + (lane >> 4)) * DM + (lane & 15) * 8; const bf16_t* Gw = cur.G + (size_t)(wid * QBLK + (lane >> 4)) * DM + (lane & 15) * 8;
      u32x4 gv[8];
#pragma unroll
      for (int i = 0; i < 8; ++i) gv[i] = *(const u32x4*)(Gw + (size_t)(4 * i) * DM);
#pragma unroll
      for (int i = 0; i < 8; ++i) { const u32x4 ov = *(const u32x4*)(Qw_lds + (4 * i + (lane >> 4)) * QROWB + (lane & 15) * 16);
          f32x4 a0, a1, g0, g1; unpack8(ov, a0, a1); unpack8(gv[i], g0, g1);
          *(u32x4*)(Ow + (size_t)(4 * i) * DM) = pack8(a0 * g0, a1 * g1); }
      asm volatile("s_waitcnt lgkmcnt(0)" ::: "memory"); }
    __syncthreads();
#undef MLOAD
#undef RESC
#undef KBASE
#undef SEAM_K0
#undef HALF_STEP
}
#undef ROW
#undef VMW
#undef VMWN
#undef SLOAD_H
#undef SWRITE_HK
#undef SWRITE_HV
#undef SWRITE_H
#undef KSWZ
#undef SBAR
}

#define XB_TMO      128
#define XB_XCNT(j)  (256  + 64 * (j))
#define XB_XSUB(j)  (1280 + 64 * (j))
#define XB_XGEN(j)  (2304 + 64 * (j))
#define XB_TOP      3328
#define XB_TOPGEN   3392
#define XCD_BAR_WORDS 3456
#define XB_SPIN_CAP (1u << 22)
__device__ __forceinline__ unsigned xb_ld(unsigned* p)              { return __hip_atomic_load(p, __ATOMIC_RELAXED, __HIP_MEMORY_SCOPE_AGENT); }
__device__ __forceinline__ unsigned xb_add(unsigned* p, unsigned v) { return __hip_atomic_fetch_add(p, v, __ATOMIC_RELAXED, __HIP_MEMORY_SCOPE_AGENT); }
__device__ __forceinline__ unsigned xb_xcc_id() { return (unsigned)__builtin_amdgcn_s_getreg((3 << 11) | 20) & 0xFu; }
#define XB_SPIN(cond, bar) do { unsigned _sp = 0; while (cond) { __builtin_amdgcn_s_sleep(1); \
    if ((++_sp & 255u) == 0u) { if (xb_ld(&(bar)[XB_TMO])) break; if (_sp > XB_SPIN_CAP) { atomicAdd(&(bar)[XB_TMO], 1u); break; } } } } while (0)
struct XcdBarrier { unsigned* bar; unsigned x; volatile LAS unsigned* st; };
__device__ __forceinline__ XcdBarrier xcd_barrier_post(unsigned* bar, volatile LAS unsigned* st) {
    XcdBarrier b; b.bar = bar; b.x = xb_xcc_id(); b.st = st;
    if (threadIdx.x == 0) (void)xb_add(&bar[XB_XCNT(b.x)], 1u);
    return b;
}
__device__ __forceinline__ void xcd_barrier_complete(unsigned* bar, unsigned x, unsigned& nloc, unsigned& nx) {
    const unsigned G = gridDim.x * gridDim.y * gridDim.z;
    unsigned sum, cnt, mine, sp = 0u;
    for (;;) {
        sum = 0u; cnt = 0u; mine = 0u;
        unsigned cj[16];
#pragma unroll
        for (unsigned j = 0; j < 16; ++j) cj[j] = xb_ld(&bar[XB_XCNT(j)]);
        __builtin_amdgcn_sched_barrier(0);
#pragma unroll
        for (unsigned j = 0; j < 16; ++j) { const unsigned c = cj[j]; sum += c; cnt += (c > 0u) ? 1u : 0u; mine = (j == x) ? c : mine; }
        if (sum == G) break;
        __builtin_amdgcn_s_sleep(1);
        if ((++sp & 255u) == 0u) { if (xb_ld(&bar[XB_TMO])) break; if (sp > XB_SPIN_CAP) { atomicAdd(&bar[XB_TMO], 1u); break; } }
    }
    nloc = mine > 0u ? mine : 1u; nx = cnt > 0u ? cnt : 1u;
}
__device__ __forceinline__ void xcd_barrier(const XcdBarrier& b) {
    asm volatile("s_waitcnt vmcnt(0)" ::: "memory");
    __syncthreads();
    if (threadIdx.x == 0) {
        unsigned* bar = b.bar;
        __builtin_amdgcn_s_waitcnt(0);
        unsigned nloc = b.st[0], nx = b.st[1];
        if (nloc == 0u) { xcd_barrier_complete(bar, b.x, nloc, nx); b.st[0] = nloc; b.st[1] = nx; }
        const unsigned old = xb_add(&bar[XB_XSUB(b.x)], 1u);
        const unsigned gen = old / nloc;
        if (old + 1u == (gen + 1u) * nloc) {
            __builtin_amdgcn_fence(__ATOMIC_RELEASE, "agent");
            asm volatile("s_waitcnt vmcnt(0)" ::: "memory");
            const unsigned og = xb_add(&bar[XB_TOP], 1u);
            const unsigned tg = og / nx;
            if (og + 1u == (tg + 1u) * nx) xb_add(&bar[XB_TOPGEN], 1u);
            else XB_SPIN(xb_ld(&bar[XB_TOPGEN]) == tg, bar);
            __builtin_amdgcn_fence(__ATOMIC_ACQUIRE, "agent");
            xb_add(&bar[XB_XGEN(b.x)], 1u);
            asm volatile("s_waitcnt vmcnt(0)" ::: "memory");
        } else {
            XB_SPIN(xb_ld(&bar[XB_XGEN(b.x)]) == gen, bar);
            __builtin_amdgcn_fence(__ATOMIC_ACQUIRE, "agent");
            asm volatile("s_waitcnt vmcnt(0)" ::: "memory");
        }
    }
    __syncthreads();
}

struct Args {
    const float* x; const float* c; const int* pos; const float* norm_g; const float* mod_w; const float* mod_b;
    const float* pwi; const float* pwg; const float* pls; const float* pwo; const float* awi; const float* awo; const float* fg;
    float* out; unsigned char* ws;
    int ph_lo, ph_hi;
};
constexpr int NWAVES = 8, NTHR = 512;
constexpr int RING_BYTES = 131072, LDS_BYTES = 147456, MISC_OFF = LDS_BYTES - 256;

__device__ __forceinline__ void sincos_d(double a, float& s_out, float& c_out) {
    const double k = __builtin_rint(a * 0.6366197723675814);
    double r = __builtin_fma(-k, 1.5707963267948966, a); r = __builtin_fma(-k, 6.123233995736766e-17, r);
    const double r2 = r * r;
    double sp = -7.647163731819816e-13; sp = sp * r2 + 1.6059043836821613e-10; sp = sp * r2 - 2.505210838544172e-08; sp = sp * r2 + 2.7557319223985893e-06;
    sp = sp * r2 - 1.984126984126984e-04; sp = sp * r2 + 8.333333333333333e-03; sp = sp * r2 - 1.6666666666666666e-01; const double s = r + r * r2 * sp;
    double cp = 4.779477332387385e-14; cp = cp * r2 - 1.1470745597729725e-11; cp = cp * r2 + 2.08767569878681e-09; cp = cp * r2 - 2.755731922398589e-07;
    cp = cp * r2 + 2.48015873015873e-05; cp = cp * r2 - 1.388888888888889e-03; cp = cp * r2 + 4.1666666666666664e-02; cp = cp * r2 - 0.5; const double c = 1.0 + r2 * cp;
    const int q = (int)((long long)k & 3);
    const double ss = (q == 0) ? s : (q == 1) ? c : (q == 2) ? -s : -c;
    const double cc = (q == 0) ? c : (q == 1) ? -s : (q == 2) ? -c : s;
    s_out = (float)ss; c_out = (float)cc;
}
__device__ __forceinline__ void transpose_item(const float* W, int K, int N, bf16_t* WT, int row_off, LAS float* scr, int nblk, int item, int lane) {
    const int kb = item / nblk, nb = item % nblk, k0 = 64 * kb, n0 = 32 * nb;
    const int nn = n0 + (lane & 31);
    float tv[32];
#pragma unroll
    for (int i = 0; i < 32; ++i) { const int kk = 2 * i + (lane >> 5); tv[i] = (nn < N) ? W[(size_t)(k0 + kk) * N + nn] : 0.f; }
#pragma unroll
    for (int i = 0; i < 32; ++i) { const int kk = 2 * i + (lane >> 5); scr[kk * 33 + (lane & 31)] = tv[i]; }
    LDS_WAIT(); asm volatile("" ::: "memory");
    const int c = lane & 7;
#pragma unroll
    for (int j = 0; j < 4; ++j) { const int n = (lane >> 3) + 8 * j; const LAS float* s = scr + (8 * c) * 33 + n;
        u32x4 o; o.x = pk2(s[0 * 33], s[1 * 33]); o.y = pk2(s[2 * 33], s[3 * 33]); o.z = pk2(s[4 * 33], s[5 * 33]); o.w = pk2(s[6 * 33], s[7 * 33]);
        *(u32x4*)(WT + (size_t)(row_off + n0 + n) * K + k0 + 8 * c) = o; }
    LDS_WAIT(); asm volatile("" ::: "memory");
}
template <int VAR>
__device__ __forceinline__ void phase0(int wv, const Args& a, LAS unsigned char* lds) {
    const int tid = opaque_tid(wv), lane = tid & 63, wave = __builtin_amdgcn_readfirstlane(tid >> 6);
    const int G = gridDim.x, bx = blockIdx.x;
    unsigned char* ws = a.ws;
    if (VAR == 0 || VAR == 1)
    for (int unit = bx; unit < 256; unit += G) {
        const int layer = unit >> 6, kq = (unit >> 4) & 3, cs = unit & 15;
        const float* W = a.mod_w + ((size_t)layer * DM + 512 * kq) * 6144 + 384 * cs;
        LAS float* red = (LAS float*)lds;
        LAS float* cdl = (LAS float*)(lds + 8192);
        if (tid < 512) cdl[tid] = silu_f(a.c[512 * kq + tid]);
        if (tid < 8) cdl[512 + tid] = 0.f;
        __syncthreads();
        if (tid < 480) {
            const int kg = tid / 96, ln = tid - kg * 96;
            f32x4 acc4 = {0.f, 0.f, 0.f, 0.f};
#pragma unroll 8
            for (int i = 0; i < 103; ++i) { const int k = kg + 5 * i, kc = k < 512 ? k : 511;
                acc4 += *(const f32x4*)(W + (size_t)kc * 6144 + 4 * ln) * cdl[k]; }
            *(LAS f32x4*)(red + kg * 384 + 4 * ln) = acc4;
        }
        __syncthreads();
        if (tid < 384) { float sum = red[tid];
#pragma unroll
            for (int kg = 1; kg < 5; ++kg) sum += red[kg * 384 + tid];
            const int col = 384 * cs + tid;
            if (kq == 0) sum += a.mod_b[layer * 6144 + col];
            ((float*)(ws + WS_MOD))[(layer * 4 + kq) * 6144 + col] = sum; }
        __syncthreads();
    }
    if (VAR == 0 || VAR == 2) {
        float* cosq = (float*)(ws + WS_TAB); float* sinq = cosq + SEQ * 16; float* cosi = sinq + SEQ * 16; float* sini = cosi + SEQ * 8;
        for (int e = bx * NTHR + tid; e < SEQ * 24; e += G * NTHR) {
            const int p = e / 24, i = e - p * 24;
            const float pf = (float)a.pos[p];
            const double frac = i < 16 ? (double)i * (1.0 / 16.0) : (double)(i - 16) * (1.0 / 8.0);
            const float inv = (float)exp2(-18.931568569324174 * frac);
            const float ang = pf * inv;
            float s, c; sincos_d((double)ang, s, c);
            if (i < 16) { cosq[p * 16 + i] = c; sinq[p * 16 + i] = s; } else { cosi[p * 8 + i - 16] = c; sini[p * 8 + i - 16] = s; }
        }
    }
    if (VAR == 0 || VAR == 3) {
        LAS float* scr = (LAS float*)(lds + 16384 + wave * 8704);
        const int gw = bx * NWAVES + wave, NGW = G * NWAVES;
        constexpr int I_PI = 32 * 128, I_PG = 8 * 16, I_PO = 32 * 64, I_AI = 32 * 296, I_AO = 32 * 64;
        constexpr int NITEMS = 2 * I_PI + 8 * I_PG + 2 * I_PO + 2 * I_AI + 2 * I_AO;
        for (int it = gw; it < NITEMS; it += NGW) {
            int r = it;
            if (r < 2 * I_AI) { const int l = r / I_AI; r -= l * I_AI; transpose_item(a.awi + (size_t)l * DM * ATTN_IN, DM, ATTN_IN, (bf16_t*)(ws + WS_WAI) + (size_t)l * ATTN_INP * DM, 0, scr, 296, r, lane); continue; } r -= 2 * I_AI;
            if (r < 2 * I_PI) { const int l = r / I_PI; r -= l * I_PI; transpose_item(a.pwi + (size_t)l * DM * POOL_IN, DM, POOL_IN, (bf16_t*)(ws + WS_WPI) + (size_t)l * POOL_IN * DM, 0, scr, 128, r, lane); continue; } r -= 2 * I_PI;
            if (r < 2 * I_PO) { const int l = r / I_PO; r -= l * I_PO; transpose_item(a.pwo + (size_t)l * DM * DM, DM, DM, (bf16_t*)(ws + WS_WPO) + (size_t)l * DM * DM, 0, scr, 64, r, lane); continue; } r -= 2 * I_PO;
            if (r < 2 * I_AO) { const int l = r / I_AO; r -= l * I_AO; transpose_item(a.awo + (size_t)l * DM * DM, DM, DM, (bf16_t*)(ws + WS_WAO) + (size_t)l * DM * DM, 0, scr, 64, r, lane); continue; } r -= 2 * I_AO;
            { const int lg = r / I_PG; r -= lg * I_PG; const int l = lg >> 2, gi = lg & 3;
              transpose_item(a.pwg + (size_t)lg * 512 * 512, 512, 512, (bf16_t*)(ws + WS_WPG) + (size_t)l * DM * 512, gi * 512, scr, 16, r, lane); }
        }
    }
}

template <bool IN_BF16> __device__ __forceinline__ void phase_norm(int wv, const void* x, const float* g, const float* mod  , bf16_t* h, unsigned char* lds) {
    const int tid = opaque_tid(wv), lane = tid & 63, wave = tid >> 6;
    const int gw = blockIdx.x * NWAVES + wave, NGW = gridDim.x * NWAVES;
    u32x4 t[4][4]; f32x4 tf[4][8];
#define NORM_LOAD(row_) do {                                                                                                  \
        _Pragma("unroll") for (int r = 0; r < 4; ++r) { const size_t ro = (size_t)((row_) + r * NGW) * DM;                   \
            if (IN_BF16) { const u32x4* xr = (const u32x4*)((const bf16_t*)x + ro) + lane;                                   \
                _Pragma("unroll") for (int j = 0; j < 4; ++j) t[r][j] = xr[64 * j]; }                                        \
            else { const f32x4* xr = (const f32x4*)((const float*)x + ro) + 2 * lane;                                        \
                _Pragma("unroll") for (int j = 0; j < 4; ++j) { tf[r][2 * j] = xr[128 * j]; tf[r][2 * j + 1] = xr[128 * j + 1]; } } } } while (0)
    float* la = (float*)lds; float* lsft = la + DM;
    { const int col = 4 * tid;
      const f32x4 gg = *(const f32x4*)(g + col);
      const f32x4 p0 = *(const f32x4*)(mod + col), p1 = *(const f32x4*)(mod + 6144 + col), p2 = *(const f32x4*)(mod + 2 * 6144 + col), p3 = *(const f32x4*)(mod + 3 * 6144 + col);
      const f32x4 q0 = *(const f32x4*)(mod + DM + col), q1 = *(const f32x4*)(mod + 6144 + DM + col), q2 = *(const f32x4*)(mod + 2 * 6144 + DM + col), q3 = *(const f32x4*)(mod + 3 * 6144 + DM + col);
      int row = gw; if (row < SEQ) NORM_LOAD(row);
      const f32x4 sh = ((p0 + p1) + p2) + p3, sc = ((q0 + q1) + q2) + q3;
      *(f32x4*)(la + col) = gg * (sc + 1.0f); *(f32x4*)(lsft + col) = sh; }
    __syncthreads();
    f32x4 av[8], sv[8];
#pragma unroll
    for (int j = 0; j < 8; ++j) { const int col = 8 * lane + 512 * (j >> 1) + 4 * (j & 1); av[j] = *(const f32x4*)(la + col); sv[j] = *(const f32x4*)(lsft + col); }
    for (int row = gw; row < SEQ; ) {
#pragma unroll
        for (int r = 0; r < 4; ++r) {
            f32x4 v[8];
#pragma unroll
            for (int j = 0; j < 4; ++j) { if (IN_BF16) unpack8(t[r][j], v[2 * j], v[2 * j + 1]); else { v[2 * j] = tf[r][2 * j]; v[2 * j + 1] = tf[r][2 * j + 1]; } }
            float s = 0.f;
#pragma unroll
            for (int j = 0; j < 8; ++j) s += (v[j].x * v[j].x + v[j].y * v[j].y) + (v[j].z * v[j].z + v[j].w * v[j].w);
            const float rstd = 1.0f / sqrtf(wave_sum(s) * (1.f / DM) + EPS);
            u32x4* o16 = (u32x4*)(h + (size_t)(row + r * NGW) * DM) + lane;
#pragma unroll
            for (int j = 0; j < 4; ++j) o16[64 * j] = pack8(v[2 * j] * rstd * av[2 * j] + sv[2 * j], v[2 * j + 1] * rstd * av[2 * j + 1] + sv[2 * j + 1]);
        }
        row += 4 * NGW; if (row >= SEQ) break;
        NORM_LOAD(row);
    }
#undef NORM_LOAD
}
__device__ __forceinline__ void phase_final(int wv, const bf16_t* x, float* y, const float* g) {
    const int tid = opaque_tid(wv), lane = tid & 63, wave = tid >> 6;
    const int gw = blockIdx.x * NWAVES + wave, NGW = gridDim.x * NWAVES;
    for (int row = gw; row < SEQ; row += 2 * NGW) {
        const int rowb = row + NGW;
        const u32x4* xr = (const u32x4*)(x + (size_t)row * DM) + lane; const u32x4* xs = (const u32x4*)(x + (size_t)rowb * DM) + lane;
        f32x4* yr = (f32x4*)(y + (size_t)row * DM) + 2 * lane; f32x4* ys = (f32x4*)(y + (size_t)rowb * DM) + 2 * lane;
        u32x4 t0[4], t1[4];
#pragma unroll
        for (int j = 0; j < 4; ++j) { t0[j] = xr[64 * j]; t1[j] = xs[64 * j]; }
        f32x4 v[8], u[8]; float s = 0.f, s2 = 0.f;
#pragma unroll
        for (int j = 0; j < 4; ++j) { unpack8(t0[j], v[2 * j], v[2 * j + 1]); unpack8(t1[j], u[2 * j], u[2 * j + 1]); }
#pragma unroll
        for (int j = 0; j < 8; ++j) { s += (v[j].x * v[j].x + v[j].y * v[j].y) + (v[j].z * v[j].z + v[j].w * v[j].w); s2 += (u[j].x * u[j].x + u[j].y * u[j].y) + (u[j].z * u[j].z + u[j].w * u[j].w); }
        const float rstd = 1.0f / sqrtf(wave_sum(s) * (1.f / DM) + EPS), rstd2 = 1.0f / sqrtf(wave_sum(s2) * (1.f / DM) + EPS);
#pragma unroll
        for (int j = 0; j < 8; ++j) { const int col = 8 * lane + 512 * (j >> 1) + 4 * (j & 1); const f32x4 gg = *(const f32x4*)(g + col);
            yr[128 * (j >> 1) + (j & 1)] = v[j] * rstd * gg; ys[128 * (j >> 1) + (j & 1)] = u[j] * rstd2 * gg; }
    }
}

template <int W, int R> __device__ __forceinline__ void pool_strip(const bf16_t* VG, bf16_t* PL, int t0, int c0) {
    u32x4 r[W + R - 1];
#pragma unroll
    for (int i = 0; i < W + R - 1; ++i) { const int t = t0 - (W - 1) + i; r[i] = *(const u32x4*)(VG + (size_t)(t < 0 ? 0 : t) * POOL_IN + c0); }
    float S[8];
#pragma unroll
    for (int e = 0; e < 8; ++e) S[e] = 0.f;
#pragma unroll
    for (int i = 0; i < W - 1; ++i) { const float wg = (t0 - (W - 1) + i >= 0) ? 1.f : 0.f;
#pragma unroll
        for (int e = 0; e < 4; ++e) { const unsigned x = r[i][e]; S[2 * e] += wg * __builtin_bit_cast(float, x << 16); S[2 * e + 1] += wg * __builtin_bit_cast(float, x & 0xffff0000u); } }
#pragma unroll
    for (int j = 0; j < R; ++j) { const int t = t0 + j;
        float v[8];
#pragma unroll
        for (int e = 0; e < 4; ++e) { const unsigned x = r[W - 1 + j][e]; v[2 * e] = __builtin_bit_cast(float, x << 16); v[2 * e + 1] = __builtin_bit_cast(float, x & 0xffff0000u); }
        const int cnt = (t + 1 < W) ? (t + 1) : W; const float ic = 1.0f / (float)cnt;
        float o[8];
#pragma unroll
        for (int e = 0; e < 8; ++e) { S[e] += v[e]; o[e] = S[e] * ic - v[e]; }
        u32x4 pw; pw.x = cvt_pk_bf16(o[0], o[1]); pw.y = cvt_pk_bf16(o[2], o[3]); pw.z = cvt_pk_bf16(o[4], o[5]); pw.w = cvt_pk_bf16(o[6], o[7]);
        *(u32x4*)(PL + (size_t)t * DM + c0) = pw;
        const float wg = (t - W + 1 >= 0) ? 1.f : 0.f;
#pragma unroll
        for (int e = 0; e < 4; ++e) { const unsigned x = r[j][e]; S[2 * e] -= wg * __builtin_bit_cast(float, x << 16); S[2 * e + 1] -= wg * __builtin_bit_cast(float, x & 0xffff0000u); } }
}
__device__ __forceinline__ void phase_pool(int wv, const bf16_t* VG, bf16_t* PL) {
    const int total = 512 * 256;
    const int tid = opaque_tid(wv);
    for (int it = blockIdx.x * NTHR + tid; it < total; it += gridDim.x * NTHR) {
        const int cg = it & 255, strip = it >> 8; const int c0 = cg * 8, t0 = strip * 16;
        const int grp = __builtin_amdgcn_readfirstlane(c0 >> 9);
        if (grp == 0) pool_strip<2, 16>(VG, PL, t0, c0); else if (grp == 1) pool_strip<4, 16>(VG, PL, t0, c0); else if (grp == 2) pool_strip<8, 16>(VG, PL, t0, c0);
        else { pool_strip<16, 8>(VG, PL, t0, c0); pool_strip<16, 8>(VG, PL, t0 + 8, c0); }
    }
}

__device__ __forceinline__ size_t sc_block_base(int qb) { return (size_t)65536 * (size_t)(qb * (qb + 1) / 2); }
__device__ __forceinline__ float fma_s(float a, float b, float c) { asm("v_fma_f32 %0, %1, %2, %0" : "+v"(c) : "v"(a), "v"(b)); return c; }
__device__ __forceinline__ float relu_i(float x) { const int b = __builtin_bit_cast(int, x); return __builtin_bit_cast(float, b > 0 ? b : 0); }
template <int VAR>
__device__ __forceinline__ void phase_scores(int wv, const bf16_t* QI, const bf16_t* KI, const float* WI, float* SC, LAS unsigned char* lds, unsigned* ctr  ) {
    const int tid = opaque_tid(wv), wid = __builtin_amdgcn_readfirstlane(tid >> 6), lane = tid & 63, r32 = lane & 31, hi = lane >> 5;
    constexpr int QROW = 2064;
    volatile LAS int* slot = (volatile LAS int*)(lds + 32 * QROW);
    for (;;) {
        __syncthreads();
        if (tid == 0) slot[0] = (int)__hip_atomic_fetch_add(ctr, 1u, __ATOMIC_RELAXED, __HIP_MEMORY_SCOPE_AGENT);
        __syncthreads();
        const int L = slot[0];
        if (L >= 1152) break;
        int kc = 0, base = 0;
        for (; kc < 8; ++kc) { const int n = 256 - 32 * kc; if (L < base + n) break; base += n; }
        const int u = 32 * kc + (L - base);
        const int q0 = 32 * u, qb = u >> 3;
        const int klim = (qb + 1) * 256;
        bf16x8 kf[2][4];
        { const int key0 = kc * 1024 + wid * 64;
#pragma unroll
            for (int b = 0; b < 2; ++b)
#pragma unroll
                for (int kk = 0; kk < 4; ++kk) kf[b][kk] = *(const bf16x8*)(KI + (size_t)(key0 + 32 * b + r32) * 64 + 16 * kk + 8 * hi); }
        {
            int t_ = tid; asm volatile("" : "+v"(t_));
            const bf16_t* src = QI + (size_t)q0 * 1024 + t_ * 8;
            const int ldst = (t_ >> 7) * QROW + (t_ & 127) * 16;
            u32x4 tq[8];
#pragma unroll
            for (int i = 0; i < 8; ++i) tq[i] = *(const u32x4*)(src + i * 4096);
            __builtin_amdgcn_sched_barrier(0);
#pragma unroll
            for (int i = 0; i < 8; ++i) *(LAS u32x4*)(lds + ldst + i * (4 * QROW)) = tq[i];
        }
        f32x4 wq[4];
#pragma unroll
        for (int i = 0; i < 4; ++i) wq[i] = *(const f32x4*)(WI + (size_t)(q0 + r32) * 16 + 4 * i);
        __syncthreads();
        for (int sl = wid; sl < 16; sl += 8) {
            const int key0 = kc * 1024 + sl * 64;
            if (key0 >= klim) continue;
            if (sl != wid) {
#pragma unroll
                for (int b = 0; b < 2; ++b)
#pragma unroll
                    for (int kk = 0; kk < 4; ++kk) kf[b][kk] = *(const bf16x8*)(KI + (size_t)(key0 + 32 * b + r32) * 64 + 16 * kk + 8 * hi); }
            f32x16 acc0 = {}, acc1 = {};
            const LAS unsigned char* qa = lds + r32 * QROW + hi * 16;
#define SC_MM(h, S0, S1) do { bf16x8 af_[4];                                                                                  \
                _Pragma("unroll") for (int kk = 0; kk < 4; ++kk) af_[kk] = *(const LAS bf16x8*)(qa + (h) * 128 + kk * 32);     \
                S0 = __builtin_amdgcn_mfma_f32_32x32x16_bf16(kf[0][0], af_[0], f32x16{}, 0, 0, 0); S1 = __builtin_amdgcn_mfma_f32_32x32x16_bf16(kf[1][0], af_[0], f32x16{}, 0, 0, 0); \
                _Pragma("unroll") for (int kk = 1; kk < 4; ++kk) { S0 = __builtin_amdgcn_mfma_f32_32x32x16_bf16(kf[0][kk], af_[kk], S0, 0, 0, 0); S1 = __builtin_amdgcn_mfma_f32_32x32x16_bf16(kf[1][kk], af_[kk], S1, 0, 0, 0); } } while (0)
#define SC_VA(h, S0, S1) do { const float w_ = wq[(h) >> 2][(h) & 3];                                                          \
                _Pragma("unroll") for (int r = 0; r < 16; ++r) { acc0[r] = fma_s(relu_i(S0[r]), w_, acc0[r]); acc1[r] = fma_s(relu_i(S1[r]), w_, acc1[r]); } } while (0)
#define SC_SB() __builtin_amdgcn_sched_barrier(0)
            f32x16 sA0, sA1, sB0, sB1;
            SC_MM(0, sA0, sA1); SC_SB();
            if (wid < 4) {
#pragma unroll
                for (int h = 0; h < 14; h += 2) {
                    SC_MM(h + 1, sB0, sB1); SC_SB(); SC_VA(h, sA0, sA1); SC_SB();
                    SC_MM(h + 2, sA0, sA1); SC_SB(); SC_VA(h + 1, sB0, sB1); SC_SB();
                }
                SC_MM(15, sB0, sB1); SC_SB(); SC_VA(14, sA0, sA1); SC_SB();
                SC_VA(15, sB0, sB1);
            } else {
                SC_MM(1, sB0, sB1); SC_SB();
#pragma unroll
                for (int h = 0; h < 14; h += 2) {
                    SC_VA(h, sA0, sA1); SC_SB(); SC_MM(h + 2, sA0, sA1); SC_SB();
                    SC_VA(h + 1, sB0, sB1); SC_SB(); SC_MM(h + 3, sB0, sB1); SC_SB();
                }
                SC_VA(14, sA0, sA1); SC_SB();
                SC_VA(15, sB0, sB1);
            }
#undef SC_SB
#undef SC_MM
#undef SC_VA
            float* out = SC + sc_block_base(qb) + (size_t)(q0 - qb * 256 + r32) * (size_t)klim + key0 + 4 * hi;
#pragma unroll
            for (int g = 0; g < 4; ++g) {
                *(f32x4*)(out + 8 * g) = (f32x4){acc0[4 * g], acc0[4 * g + 1], acc0[4 * g + 2], acc0[4 * g + 3]};
                *(f32x4*)(out + 32 + 8 * g) = (f32x4){acc1[4 * g], acc1[4 * g + 1], acc1[4 * g + 2], acc1[4 * g + 3]}; }
        }
    }
}

template <int VAR>
__device__ __forceinline__ void phase_select(int wv, const float* SC, unsigned long long* MASK, LAS unsigned char* lds) {
    const int tid = opaque_tid(wv), lane0 = tid & 63, wave = __builtin_amdgcn_readfirstlane(tid >> 6);
    LAS unsigned* hist = (LAS unsigned*)(lds + wave * 9216);
    const int gw = blockIdx.x * NWAVES + wave, NGW = gridDim.x * NWAVES;
    for (int q = gw; q < SEQ; q += NGW) {
        int lane = lane0; asm volatile("" : "+v"(lane));
        const int qb = q >> 8, klim = (qb + 1) * 256;
        const float* rowp = SC + sc_block_base(qb) + (size_t)(q - qb * 256) * (size_t)klim;
        const int ngrp = qb + 1;
        unsigned key[32][4];
#pragma unroll
        for (int g = 0; g < 8; ++g) {
            if (4 * g < ngrp) {
#pragma unroll
                for (int i = 0; i < 4; ++i) { const u32x4 v = *(const u32x4*)(rowp + 256 * (4 * g + i) + 4 * lane);
                    key[4 * g + i][0] = v.x; key[4 * g + i][1] = v.y; key[4 * g + i][2] = v.z; key[4 * g + i][3] = v.w; }
            } else {
#pragma unroll
                for (int i = 0; i < 4; ++i) { key[4 * g + i][0] = 0u; key[4 * g + i][1] = 0u; key[4 * g + i][2] = 0u; key[4 * g + i][3] = 0u; }
            }
        }
        unsigned T = 1u; unsigned need_eq = 0xffffffffu, n_eq = 0u;
        const bool radix = (q + 1 > TOPK) && (VAR != 1 && VAR != 3);
        if (VAR == 3) { unsigned x_ = 0u;
#pragma unroll
            for (int j = 0; j < 32; ++j) x_ |= key[j][0] & key[j][1] & key[j][2] & key[j][3];
            if (x_ == 0x12345u) MASK[q] = x_; continue; }
        if (radix) {
#pragma unroll
            for (int i = 0; i < 9; ++i) *(LAS u32x4*)(hist + 4 * (lane + 64 * i)) = (u32x4){0u, 0u, 0u, 0u};
        }
        __builtin_amdgcn_sched_barrier(0);
#pragma unroll
        for (int g = 0; g < 8; ++g) { if (4 * g < ngrp) {
#pragma unroll
            for (int i = 0; i < 4; ++i)
#pragma unroll
                for (int e = 0; e < 4; ++e) { const int j = 4 * g + i; const unsigned uu = key[j][e];
                    const unsigned kx = uu ^ ((unsigned)((int)uu >> 31) | 0x80000000u); key[j][e] = (256 * j + 4 * lane + e <= q) ? kx : 0u; }
            } __builtin_amdgcn_sched_barrier(0); }
        if (radix) {
            unsigned gm0 = 0u, gm1 = 0u, gm2 = 0u, gm3 = 0u;
#pragma unroll
            for (int g = 0; g < 8; ++g) if (4 * g < ngrp) {
#pragma unroll
                for (int i = 0; i < 4; ++i) { const int j = 4 * g + i; gm0 = key[j][0] > gm0 ? key[j][0] : gm0; gm1 = key[j][1] > gm1 ? key[j][1] : gm1; gm2 = key[j][2] > gm2 ? key[j][2] : gm2; gm3 = key[j][3] > gm3 ? key[j][3] : gm3; }
            }
            unsigned Pmin = gm0 < gm1 ? gm0 : gm1; { const unsigned p2 = gm2 < gm3 ? gm2 : gm3; Pmin = Pmin < p2 ? Pmin : p2; }
#pragma unroll
            for (int off = 1; off < 64; off <<= 1) { const unsigned tt = (unsigned)__builtin_amdgcn_ds_bpermute((lane ^ off) << 2, (int)Pmin); Pmin = tt < Pmin ? tt : Pmin; }
            LDS_WAIT();
#pragma unroll
            for (int g = 0; g < 8; ++g) if (4 * g < ngrp) {
#pragma unroll
                for (int i = 0; i < 4; ++i) {
#pragma unroll
                    for (int e = 0; e < 4; ++e) { const unsigned k = key[4 * g + i][e];
                        if (k >= Pmin) { const unsigned b = k >> 21; __hip_atomic_fetch_add(hist + b + ((b >> 5) << 2), 1u, __ATOMIC_RELAXED, __HIP_MEMORY_SCOPE_WORKGROUP); } }
                    __builtin_amdgcn_sched_barrier(0); }
            }
            unsigned prefix = 0u, pmask = 0u, kk = TOPK;
#pragma unroll 1
            for (int pass = 0; pass < ((VAR == 4) ? 1 : 3); ++pass) {
                const int shift = (pass == 0) ? 21 : (pass == 1) ? 10 : 0;
                const unsigned dmask = (pass == 2) ? 1023u : 2047u;
                LDS_WAIT();
                if (pass > 0) {
#pragma unroll
                    for (int g = 0; g < 8; ++g) if (4 * g < ngrp) {
#pragma unroll
                        for (int i = 0; i < 4; ++i) {
#pragma unroll
                            for (int e = 0; e < 4; ++e) { const unsigned k = key[4 * g + i][e];
                                if ((k & pmask) == prefix) { const unsigned b = (k >> shift) & dmask; __hip_atomic_fetch_add(hist + b + ((b >> 5) << 2), 1u, __ATOMIC_RELAXED, __HIP_MEMORY_SCOPE_WORKGROUP); } }
                            __builtin_amdgcn_sched_barrier(0); }
                    }
                }
                LDS_WAIT();
                if (VAR == 5) { prefix |= (0x5a5u & dmask) << shift; pmask |= dmask << shift; continue; }
                unsigned s = 0u;
#pragma unroll
                for (int i = 0; i < 8; ++i) { const u32x4 v = *(const LAS u32x4*)(hist + 36 * lane + 4 * i); s += (v.x + v.y) + (v.z + v.w); }
                unsigned suf = s;
#pragma unroll
                for (int off = 1; off < 64; off <<= 1) { const unsigned tt = (unsigned)__builtin_amdgcn_ds_bpermute(((lane + off) & 63) << 2, (int)suf); if (lane + off < 64) suf += tt; }
                const unsigned long long bal = __ballot(suf >= kk);
                const int Ls = 63 - __builtin_clzll(bal);
                const unsigned above1 = (unsigned)__builtin_amdgcn_readlane((int)(suf - s), Ls);
                const unsigned c2 = hist[36 * Ls + (lane & 31)];
                unsigned suf2 = (lane < 32) ? c2 : 0u;
#pragma unroll
                for (int off = 1; off < 32; off <<= 1) { const unsigned tt = (unsigned)__builtin_amdgcn_ds_bpermute(((lane + off) & 63) << 2, (int)suf2); if (lane + off < 32) suf2 += tt; }
                const unsigned long long bal2 = __ballot(lane < 32 && above1 + suf2 >= kk);
                const int Bs = 63 - __builtin_clzll(bal2);
                const int dsel = 32 * Ls + Bs;
                const unsigned cnt_b = (unsigned)__builtin_amdgcn_readlane((int)c2, Bs);
                const unsigned kk_new = kk - (above1 + (unsigned)__builtin_amdgcn_readlane((int)suf2, Bs) - cnt_b);
                LDS_WAIT();
#pragma unroll
                for (int i = 0; i < 9; ++i) *(LAS u32x4*)(hist + 4 * (lane + 64 * i)) = (u32x4){0u, 0u, 0u, 0u};
                const unsigned d = (unsigned)dsel; kk = kk_new; n_eq = cnt_b;
                prefix |= d << shift; pmask |= dmask << shift;
            }
            T = prefix; need_eq = kk;
        }
        if (VAR == 2 || VAR == 4 || VAR == 5) { if (T == 0x12345u) MASK[q] = T; continue; }
        const bool tie_path = (need_eq != 0xffffffffu) && (n_eq > need_eq);
        unsigned tie_seen = 0u;
        const unsigned long long lt = (lane == 0) ? 0ull : (~0ull >> (64 - lane));
        int w0lo = 0, w0hi = 0, w1lo = 0, w1hi = 0;
#pragma unroll
        for (int g = 0; g < 8; ++g) if (4 * g < ngrp) {
#pragma unroll
            for (int i = 0; i < 4; ++i) { const int j = 4 * g + i;
                unsigned long long B[4];
                if (!tie_path) {
#pragma unroll
                    for (int e = 0; e < 4; ++e) B[e] = __ballot(key[j][e] >= T);
                } else {
                    unsigned long long E[4]; unsigned before = tie_seen;
#pragma unroll
                    for (int e = 0; e < 4; ++e) { E[e] = __ballot(key[j][e] == T); before += (unsigned)__builtin_popcountll(E[e] & lt); }
                    unsigned mine = 0u;
#pragma unroll
                    for (int e = 0; e < 4; ++e) { const bool eq = (key[j][e] == T);
                        B[e] = __ballot(key[j][e] > T || (eq && (before + mine) < need_eq)); mine += eq ? 1u : 0u; }
#pragma unroll
                    for (int e = 0; e < 4; ++e) tie_seen += (unsigned)__builtin_popcountll(E[e]);
                }
#pragma unroll
                for (int k = 0; k < 4; ++k) { const int t = 4 * j + k;
                    const unsigned blo_ = (unsigned)((B[0] >> (16 * k)) & 0xffffull) | ((unsigned)((B[1] >> (16 * k)) & 0xffffull) << 16);
                    const unsigned bhi_ = (unsigned)((B[2] >> (16 * k)) & 0xffffull) | ((unsigned)((B[3] >> (16 * k)) & 0xffffull) << 16);
                    if (t < 64) asm volatile("s_nop 3\n\tv_writelane_b32 %0, %2, %4\n\tv_writelane_b32 %1, %3, %4" : "+v"(w0lo), "+v"(w0hi) : "s"(blo_), "s"(bhi_), "n"(t & 63));
                    else asm volatile("s_nop 3\n\tv_writelane_b32 %0, %2, %4\n\tv_writelane_b32 %1, %3, %4" : "+v"(w1lo), "+v"(w1hi) : "s"(blo_), "s"(bhi_), "n"(t & 63)); }
            }
        }
        const int ntile = 4 * ngrp;
        if (lane < ntile) MASK[(size_t)lane * SEQ + q] = ((unsigned long long)(unsigned)w0hi << 32) | (unsigned)w0lo;
        if (lane + 64 < ntile) MASK[(size_t)(lane + 64) * SEQ + q] = ((unsigned long long)(unsigned)w1hi << 32) | (unsigned)w1lo;
    }
}

__device__ __forceinline__ att::BlockRef attn_ref(int h, int qb, const bf16_t* Qh, const bf16_t* Kh, const bf16_t* Vh, bf16_t* O, const bf16_t* SG, const unsigned long long* MASK) {
    att::BlockRef r;
    r.Q = Qh + ((size_t)h * SEQ + (size_t)qb * 256) * HD; r.K = Kh + (size_t)h * SEQ * HD; r.V = Vh + (size_t)h * SEQ * HD;
    r.O = O + (size_t)qb * 256 * DM + h * HD; r.G = SG + (size_t)qb * 256 * DM + h * HD; r.M = MASK + qb * 256; r.P0 = qb * 256;
    return r;
}
__device__ __forceinline__ void phase_attn(int wv, const bf16_t* Qh, const bf16_t* Kh, const bf16_t* Vh, bf16_t* O, const bf16_t* SG, const unsigned long long* MASK, char* lds) {
    const int total = NHEAD * 16, stride = gridDim.x;
    int L = blockIdx.x; if (L >= total) return;
    if (gridDim.x == 256) { const int b = L; L = 16 * ((b & 7) + 8 * (b >> 7)) + ((b >> 3) & 15); }
    int pass = 0;
    att::BlockRef cur = attn_ref(L >> 4, L & 15, Qh, Kh, Vh, O, SG, MASK);
    att::Seam S;
    att::attn_prime(wv, cur, lds, S);
    for (;;) {
        const bool more_pass = pass == 0, more_item = L + stride < total, last = !more_pass && !more_item;
        int passn = pass + 1, Ln = L;
        if (!more_pass) { passn = 0; Ln = more_item ? L + stride : L; }
        const int hn = Ln >> 4, xn = Ln & 15;
        const att::BlockRef nxt = last ? cur : attn_ref(hn, passn ? 31 - xn : xn, Qh, Kh, Vh, O, SG, MASK);
        att::attn_block(wv, cur, nxt, lds, S);
        if (last) break;
        cur = nxt; pass = passn; L = Ln;
    }
}

__global__ void __launch_bounds__(NTHR, 2) trunk_fwd(Args args) {
    extern __shared__ __attribute__((aligned(16))) unsigned char lds_raw[];
    LAS unsigned char* lds = (LAS unsigned char*)lds_raw;
    volatile LAS unsigned* MISC = (volatile LAS unsigned*)(lds + MISC_OFF);
    const int wv = __builtin_amdgcn_readfirstlane((int)threadIdx.x >> 6);
    const int tid = opaque_tid(wv);
    unsigned char* ws = args.ws;
    if (tid < 32) MISC[tid] = 0u;
    __syncthreads();
    XcdBarrier bar; bar.bar = (unsigned*)(ws + WS_CTL) + 1024; bar.x = 0; bar.st = nullptr;
    if (MK_ONE_LAUNCH) bar = xcd_barrier_post((unsigned*)(ws + WS_CTL) + 1024, MISC + 8);
    const int lo = args.ph_lo, hi = args.ph_hi;
    int ph = 0;
#ifndef PHASE_MASK
#define PHASE_MASK 0xFFFF
#endif
#define IN(k) (lo <= (k) && (k) < hi)
#define PM(b) ((PHASE_MASK >> (b)) & 1)
#ifndef DUP_MASK
#define DUP_MASK 0
#endif
#ifndef SC_VAR
#define SC_VAR 0
#endif
#define DUP(b) ((DUP_MASK >> (b)) & 1)
#define REDO(b, stmt) do { if (DUP(b)) { if (MK_ONE_LAUNCH) xcd_barrier(bar); else __syncthreads(); stmt; } } while (0)
#ifndef ECHO_MASK
#define ECHO_MASK 0
#endif
#define ECHO_K 4
    unsigned long long echo_acc = 0ull, echo_prev = ECHO_MASK ? __builtin_amdgcn_s_memrealtime() : 0ull;
#define SEAM(b) do { if (IN(ph) && IN(ph + 1)) xcd_barrier(bar); ++ph; \
        if (ECHO_MASK) { const unsigned long long now_ = __builtin_amdgcn_s_memrealtime(); if ((ECHO_MASK >> (b)) & 1) echo_acc += now_ - echo_prev; echo_prev = now_; } } while (0)

    float* mod = (float*)(ws + WS_MOD);
    bf16_t* HU = (bf16_t*)(ws + WS_HU);
    const float* cosq = (const float*)(ws + WS_TAB); const float* sinq = cosq + SEQ * 16; const float* cosi = sinq + SEQ * 16; const float* sini = cosi + SEQ * 8;
    const int G = gridDim.x, bx = blockIdx.x;

    if (PM(0) && IN(ph)) { phase0<0>(wv, args, lds); REDO(0, phase0<SC_VAR>(wv, args, lds)); }
    SEAM(0);
#pragma unroll 1
    for (int layer = 0; layer < 4; ++layer) {
        const int j = layer >> 1;
        bf16_t* XB = (bf16_t*)(ws + WS_XB);
        const float* lmod = mod + layer * 4 * 6144;
        if (PM(1) && IN(ph)) { if (layer == 0) phase_norm<false>(wv, args.x, args.norm_g, lmod, HU, lds_raw); else phase_norm<true>(wv, XB, args.norm_g + layer * DM, lmod, HU, lds_raw); }
        SEAM(1);
        if ((layer & 1) == 0) {
            bf16_t* VG = (bf16_t*)(ws + WS_VG); bf16_t* PL = (bf16_t*)(ws + WS_PL);
            if (PM(2) && IN(ph)) { pg8::Gemm g{HU, (const bf16_t*)(ws + WS_WPI) + (size_t)j * POOL_IN * DM, SEQ, POOL_IN, DM, DM, DM, 0, 0};
                pg8::StaticOrder S; S.init(SEQ, POOL_IN, G, bx); pg8::EpiBf16 E{VG, POOL_IN};
                pg8::gemm_phase<pg8::EpiBf16, true>(wv, lds, g, S, E); REDO(2, (pg8::gemm_phase<pg8::EpiBf16, true>(wv, lds, g, S, E))); }
            SEAM(2);
            if (PM(3) && IN(ph)) { phase_pool(wv, VG, PL); REDO(3, phase_pool(wv, VG, PL)); }
            SEAM(3);
            if (PM(4) && IN(ph)) { pg8::Gemm g{PL, (const bf16_t*)(ws + WS_WPG) + (size_t)j * DM * 512, SEQ, DM, 512, DM, 512, 1, 512};
                pg8::StaticOrder S; S.init(SEQ, DM, G, bx); pg8::EpiPoolGrp E{HU, VG, args.pls + j * DM};
                pg8::gemm_phase<pg8::EpiPoolGrp, true>(wv, lds, g, S, E); REDO(4, (pg8::gemm_phase<pg8::EpiPoolGrp, true>(wv, lds, g, S, E))); }
            SEAM(4);
            if (PM(5) && IN(ph)) { pg8::Gemm g{HU, (const bf16_t*)(ws + WS_WPO) + (size_t)j * DM * DM, SEQ, DM, DM, DM, DM, 0, 0};
                pg8::StaticOrder S; S.init(SEQ, DM, G, bx);
                if (layer == 0) { pg8::EpiResid<false, true> E{args.x, XB, lmod + 2 * DM}; pg8::gemm_phase<pg8::EpiResid<false, true>, true>(wv, lds, g, S, E); }
                else { pg8::EpiResid<true, true> E{XB, XB, lmod + 2 * DM}; pg8::gemm_phase<pg8::EpiResid<true, true>, true>(wv, lds, g, S, E); } }
            SEAM(5);
        } else {
            bf16_t* Qh = (bf16_t*)(ws + WS_Q); bf16_t* Kh = (bf16_t*)(ws + WS_K); bf16_t* Vh = (bf16_t*)(ws + WS_V); bf16_t* SG = (bf16_t*)(ws + WS_GATE);
            bf16_t* QI = (bf16_t*)(ws + WS_QI); bf16_t* KI = (bf16_t*)(ws + WS_KI); float* WI = (float*)(ws + WS_WI);
            unsigned long long* MASK = (unsigned long long*)(ws + WS_MASK); float* SC = (float*)(ws + WS_SC);
            if (PM(6) && IN(ph)) { pg8::Gemm g{HU, (const bf16_t*)(ws + WS_WAI) + (size_t)j * ATTN_INP * DM, SEQ, ATTN_INP, DM, DM, DM, 0, 0};
                pg8::StaticOrder S; S.init(SEQ, ATTN_INP, G, bx); pg8::EpiAttnIn E{ws, args.pos};
                pg8::gemm_phase<pg8::EpiAttnIn, true>(wv, lds, g, S, E); REDO(6, (pg8::gemm_phase<pg8::EpiAttnIn, true>(wv, lds, g, S, E))); }
            SEAM(6);
            if (PM(7) && IN(ph)) { unsigned* qctr = (unsigned*)(ws + WS_CTL) + 8192 + 128 * j; phase_scores<0>(wv, QI, KI, WI, SC, lds, qctr); REDO(7, phase_scores<SC_VAR>(wv, QI, KI, WI, (float*)(ws + WS_END), lds, qctr + 64)); }
            SEAM(7);
            if (PM(8) && IN(ph)) { phase_select<0>(wv, SC, MASK, lds); REDO(8, phase_select<SC_VAR>(wv, SC, (unsigned long long*)(ws + WS_END), lds)); }
            SEAM(8);
            if (PM(9) && IN(ph)) { phase_attn(wv, Qh, Kh, Vh, HU, SG, MASK, (char*)lds_raw); REDO(9, phase_attn(wv, Qh, Kh, Vh, HU, SG, MASK, (char*)lds_raw)); }
            SEAM(9);
            if (PM(5) && IN(ph)) { pg8::Gemm g{HU, (const bf16_t*)(ws + WS_WAO) + (size_t)j * DM * DM, SEQ, DM, DM, DM, DM, 0, 0};
                pg8::StaticOrder S; S.init(SEQ, DM, G, bx);
                { pg8::EpiResid<true, true> E{XB, XB, lmod + 2 * DM}; pg8::gemm_phase<pg8::EpiResid<true, true>, true>(wv, lds, g, S, E); } }
            SEAM(5);
        }
    }
    if (PM(10) && IN(ph)) { phase_final(wv, (const bf16_t*)(ws + WS_XB), args.out, args.fg); REDO(10, phase_final(wv, (const bf16_t*)(ws + WS_XB), args.out, args.fg)); }
    if (ECHO_MASK) { if ((ECHO_MASK >> 10) & 1) echo_acc += __builtin_amdgcn_s_memrealtime() - echo_prev;
        if (bx == 0) { const unsigned long long target_ = __builtin_amdgcn_s_memrealtime() + (unsigned long long)ECHO_K * echo_acc; while (__builtin_amdgcn_s_memrealtime() < target_) __builtin_amdgcn_s_sleep(32); } }
#undef IN
#undef PM
#undef SEAM
#undef REDO
}
constexpr int N_PHASES = 1 + 2 * 5 + 2 * 6 + 1;

extern "C" void kernel_launch(void* const* d_in, const int* in_sizes, int n_in, void* d_out, int out_size, void* d_ws, size_t ws_size, hipStream_t stream) {
    static int grid = 0;
    if (grid == 0) {
        if (n_in != 13 || in_sizes[0] != SEQ * DM || out_size != SEQ * DM || ws_size < WS_END) {
            fprintf(stderr, "kernel_launch: unexpected shapes / workspace (n_in %d, in0 %d, out %d, ws %zu, need %zu)\n", n_in, n_in > 0 ? in_sizes[0] : -1, out_size, ws_size, (size_t)WS_END);
            grid = -1; return; }
        int dev = 0, cus = 0, per_cu = 0;
        if (hipGetDevice(&dev) != hipSuccess || hipDeviceGetAttribute(&cus, hipDeviceAttributeMultiprocessorCount, dev) != hipSuccess) { grid = -1; return; }
        if (hipFuncSetAttribute((const void*)trunk_fwd, hipFuncAttributeMaxDynamicSharedMemorySize, LDS_BYTES) != hipSuccess) { fprintf(stderr, "kernel_launch: hipFuncSetAttribute failed\n"); grid = -1; return; }
        if (hipOccupancyMaxActiveBlocksPerMultiprocessor(&per_cu, (const void*)trunk_fwd, NTHR, LDS_BYTES) != hipSuccess || per_cu < 1) {
            fprintf(stderr, "kernel_launch: occupancy query reports %d workgroups per CU\n", per_cu); per_cu = 1; }
        (void)hipGetLastError();
        grid = cus;
        if (grid > 256) grid = 256;
    }
    if (grid < 0) return;
    (void)hipMemsetAsync((char*)d_ws + WS_CTL, 0, CTL_ZERO_BYTES, stream);
    Args a{};
    a.x = (const float*)d_in[0]; a.c = (const float*)d_in[1]; a.pos = (const int*)d_in[2]; a.norm_g = (const float*)d_in[3];
    a.mod_w = (const float*)d_in[4]; a.mod_b = (const float*)d_in[5]; a.pwi = (const float*)d_in[6]; a.pwg = (const float*)d_in[7];
    a.pls = (const float*)d_in[8]; a.pwo = (const float*)d_in[9]; a.awi = (const float*)d_in[10]; a.awo = (const float*)d_in[11]; a.fg = (const float*)d_in[12];
    a.out = (float*)d_out; a.ws = (unsigned char*)d_ws;
#if MK_ONE_LAUNCH
    a.ph_lo = 0; a.ph_hi = N_PHASES;
    hipLaunchKernelGGL(trunk_fwd, dim3(grid), dim3(NTHR), LDS_BYTES, stream, a);
#else
    for (int p = 0; p < N_PHASES; ++p) { a.ph_lo = p; a.ph_hi = p + 1; hipLaunchKernelGGL(trunk_fwd, dim3(grid), dim3(NTHR), LDS_BYTES, stream, a); }
#endif
}
```

```cpp
#include <hip/hip_runtime.h>
#include <cstdio>
#include <cstdint>
#include <cmath>

#ifndef MK_ONE_LAUNCH
#define MK_ONE_LAUNCH 1
#endif

#define LAS __attribute__((address_space(3)))
#define GAS __attribute__((address_space(1)))
typedef unsigned short bf16_t;
typedef short bf16x8 __attribute__((ext_vector_type(8)));
typedef short s16x4 __attribute__((ext_vector_type(4)));
typedef float f32x4 __attribute__((ext_vector_type(4)));
typedef float f32x2 __attribute__((ext_vector_type(2)));
typedef float f32x16 __attribute__((ext_vector_type(16)));
typedef unsigned u32x4 __attribute__((ext_vector_type(4)));
typedef unsigned u32x2 __attribute__((ext_vector_type(2)));

constexpr int DM = 2048, SEQ = 8192, NHEAD = 16, HD = 128, IDXH = 16, IDXD = 64;
constexpr int POOL_IN = 4096, ATTN_IN = 9296, ATTN_INP = 9472  ;
constexpr int TOPK = 256;
constexpr float EPS = 1e-6f;

constexpr size_t MiB = 1u << 20;
constexpr size_t WS_CTL = 0, CTL_ZERO_BYTES = 64 * 1024;
constexpr size_t WS_MOD = 1 * MiB;
constexpr size_t WS_TAB = 2 * MiB;
constexpr size_t WS_WPI = 4 * MiB;
constexpr size_t WS_WPG = 36 * MiB;
constexpr size_t WS_WPO = 40 * MiB;
constexpr size_t WS_WAI = 56 * MiB;
constexpr size_t WS_WAO = 130 * MiB;
constexpr size_t WS_HU = 146 * MiB;
constexpr size_t WS_L = 178 * MiB;
constexpr size_t WS_VG = WS_L;
constexpr size_t WS_PL = WS_L + 64 * MiB;
constexpr size_t WS_Q = WS_L, WS_K = WS_L + 32 * MiB, WS_V = WS_L + 64 * MiB;
constexpr size_t WS_GATE = WS_L + 96 * MiB;
constexpr size_t WS_QI = WS_L + 128 * MiB;
constexpr size_t WS_KI = WS_L + 144 * MiB;
constexpr size_t WS_WI = WS_L + 145 * MiB;
constexpr size_t WS_MASK = WS_L + 146 * MiB;
constexpr size_t WS_SC = WS_L + 154 * MiB;
constexpr size_t WS_XB = WS_SC + 139 * MiB;
constexpr size_t WS_END = WS_XB + 32 * MiB;

__device__ __forceinline__ unsigned cvt_pk_bf16(float lo, float hi) { unsigned r; asm volatile("v_cvt_pk_bf16_f32 %0, %1, %2" : "=v"(r) : "v"(lo), "v"(hi)); return r; }
__device__ __forceinline__ unsigned f2bf(float f) { unsigned u = __builtin_bit_cast(unsigned, f); return (u + 0x7fffu + ((u >> 16) & 1u)) >> 16; }
__device__ __forceinline__ unsigned pk2(float lo, float hi) { return f2bf(lo) | (f2bf(hi) << 16); }
__device__ __forceinline__ float bf2f(unsigned short b) { return __builtin_bit_cast(float, (unsigned)b << 16); }
__device__ __forceinline__ float fast_sigmoid(float x) { return __builtin_amdgcn_rcpf(1.0f + __builtin_amdgcn_exp2f(-1.4426950408889634f * x)); }
__device__ __forceinline__ float silu_f(float x) { return x * fast_sigmoid(x); }
template <int X> __device__ __forceinline__ float swz_xor(float v) {
    return __builtin_bit_cast(float, __builtin_amdgcn_ds_swizzle(__builtin_bit_cast(int, v), (X << 10) | 0x1f)); }
__device__ __forceinline__ float wave_sum(float v) {
    v += swz_xor<1>(v); v += swz_xor<2>(v); v += swz_xor<4>(v); v += swz_xor<8>(v); v += swz_xor<16>(v);
    const auto rr = __builtin_amdgcn_permlane32_swap(__builtin_bit_cast(unsigned, v), __builtin_bit_cast(unsigned, v), false, false);
    const unsigned r0 = rr[0], r1 = rr[1];
    return __builtin_bit_cast(float, r0) + __builtin_bit_cast(float, r1);
}
__device__ __forceinline__ int opaque_tid(int wv) { int t; asm volatile("v_mbcnt_lo_u32_b32 %0, -1, 0\n\tv_mbcnt_hi_u32_b32 %0, -1, %0\n\tv_lshl_add_u32 %0, %1, 6, %0" : "=&v"(t) : "s"(wv)); return t; }
#define LDS_WAIT() asm volatile("s_waitcnt lgkmcnt(0)" ::: "memory")
#define VM_WAIT() asm volatile("s_waitcnt vmcnt(0)" ::: "memory")

__device__ __forceinline__ void unpack8(const u32x4 w, f32x4& a, f32x4& b) {
    const unsigned w0 = w.x, w1 = w.y, w2 = w.z, w3 = w.w;
    a = (f32x4){__builtin_bit_cast(float, w0 << 16), __builtin_bit_cast(float, w0 & 0xffff0000u), __builtin_bit_cast(float, w1 << 16), __builtin_bit_cast(float, w1 & 0xffff0000u)};
    b = (f32x4){__builtin_bit_cast(float, w2 << 16), __builtin_bit_cast(float, w2 & 0xffff0000u), __builtin_bit_cast(float, w3 << 16), __builtin_bit_cast(float, w3 & 0xffff0000u)};
}
__device__ __forceinline__ u32x4 pack8(const f32x4 a, const f32x4 b) { u32x4 w; w.x = cvt_pk_bf16(a[0], a[1]); w.y = cvt_pk_bf16(a[2], a[3]); w.z = cvt_pk_bf16(b[0], b[1]); w.w = cvt_pk_bf16(b[2], b[3]); return w; }

constexpr float ATT_QSCALE = 0.08838834764831845f * 1.4426950408889634f;
namespace pg8 {
constexpr int BM = 256, BK = 64, HALF = 128, HTB = HALF * BK * 2, STAGE_BYTES = 8 * HTB, NXCD = 8, WGM = 8;
__host__ __device__ __forceinline__ int lds_byte(int r, int c) { const int st = (r >> 4) * 2 + (c >> 5), rr = r & 15, cc = c & 31, ob = rr * 64 + cc * 2; return st * 1024 + (ob ^ (((ob >> 9) & 1) << 5)); }
__host__ __device__ __forceinline__ void stage_rc(int b, int& R, int& C) { const int st = b / 1024, sb = b % 1024, swz = sb ^ (((sb >> 9) & 1) << 5); R = (st >> 1) * 16 + swz / 64; C = (st & 1) * 32 + (swz % 64) / 2; }
__host__ __device__ __forceinline__ int perm32(int rho) { const int n = rho >> 4, i = rho & 15; return 8 * (i >> 2) + 4 * n + (i & 3); }

struct Unit { int pm, pn; };
struct Gemm { const bf16_t* A; const bf16_t* Bt; int M, N, K, lda, ldb, agsh, agstride; };

struct StaticOrder {
    int nM, nN, nwg, G, c;
    __host__ __device__ void init(int M, int N, int G_, int c_) { nM = M / BM; nN = N / BM; nwg = nM * nN; G = G_; c = c_; }
    __host__ __device__ bool next(int i, Unit& u) const {
        const long L = (long)i * G + c; if (L >= nwg) return false;
        int wgid = (int)L; { const int q = nwg / NXCD, r = nwg % NXCD, xcd = wgid % NXCD, off = wgid / NXCD; wgid = (xcd < r ? xcd * (q + 1) : r * (q + 1) + (xcd - r) * q) + off; }
        const int nig = WGM * nN, gid = wgid / nig, fm = gid * WGM, gsz = (nM - fm) < WGM ? (nM - fm) : WGM;
        u.pm = fm + ((wgid % nig) % gsz); u.pn = (wgid % nig) / gsz; return true;
    }
};

template <class Epi, bool ALIGN_EPI>
__device__ __forceinline__ void gemm_phase(int wv, LAS unsigned char* lds, const Gemm g, const StaticOrder& S, const Epi& E) {
    const int tid = opaque_tid(wv), wid = __builtin_amdgcn_readfirstlane(tid >> 6), lane = tid & 63, wr = wid >> 2, wc = wid & 3, fr = lane & 15, fq = lane >> 4;
    const int K = g.K, nt = K / BK;
    unsigned voffA[2], voffB[2];
#pragma unroll
    for (int i = 0; i < 2; ++i) { int R, C; stage_rc(tid * 16 + i * 8192, R, C); const int Rb = Epi::PERM ? ((R & ~31) + perm32(R & 31)) : R;
        voffA[i] = (unsigned)(R * g.lda + C) * 2u; voffB[i] = (unsigned)(Rb * g.ldb + C) * 2u; }
    const size_t kstep = (size_t)(BK * 2);
    const size_t hstepA = (size_t)HALF * g.lda * 2, hstepB = (size_t)HALF * g.ldb * 2;
    const size_t tstepA = 2 * hstepA, tstepB = 2 * hstepB;
    const unsigned ldsw = (unsigned)wid * 1024u;
    const int aoff = lds_byte(wr * 64 + fr, fq * 8), boff = lds_byte(wc * 32 + fr, fq * 8);
#define PG8_SA(b, h) (((b) * 2 + (h)) * HTB)
#define PG8_SB(b, h) ((4 + (b) * 2 + (h)) * HTB)
#define PG8_STAGE(bufoff, gbase, voff) do { _Pragma("unroll") for (int _i = 0; _i < 2; ++_i) \
        __builtin_amdgcn_global_load_lds((const unsigned*)((const char*)(gbase) + (voff)[_i]), (LAS unsigned*)(lds + (bufoff) + ldsw + _i * 8192), 16, 0, 0); } while (0)
#define PG8_LDA(dst, b, h) do { _Pragma("unroll") for (int m = 0; m < 4; ++m) _Pragma("unroll") for (int k = 0; k < 2; ++k) dst[m][k] = *(const LAS bf16x8*)(lds + PG8_SA(b, h) + aoff + m * 2048 + k * 1024); } while (0)
#define PG8_LDB(dst, b, h) do { _Pragma("unroll") for (int n = 0; n < 2; ++n) _Pragma("unroll") for (int k = 0; k < 2; ++k) dst[n][k] = *(const LAS bf16x8*)(lds + PG8_SB(b, h) + boff + n * 2048 + k * 1024); } while (0)
#define PG8_MMA(ai, bj, At, Bt) do { __builtin_amdgcn_s_setprio(1); _Pragma("unroll") for (int m = 0; m < 4; ++m) _Pragma("unroll") for (int n = 0; n < 2; ++n) _Pragma("unroll") for (int k = 0; k < 2; ++k) \
        acc[ai][bj][m][n] = __builtin_amdgcn_mfma_f32_16x16x32_bf16(Bt[n][k], At[m][k], acc[ai][bj][m][n], 0, 0, 0); __builtin_amdgcn_s_setprio(0); } while (0)
#define PG8_WAIT_V(n) asm volatile("s_waitcnt vmcnt(" #n ")" ::: "memory")
#define PG8_WAIT_L(n) asm volatile("s_waitcnt lgkmcnt(" #n ")" ::: "memory")
#define PG8_BAR __builtin_amdgcn_s_barrier()
#define PG8_SCHED __builtin_amdgcn_sched_barrier(0)
#define PG8_AOFF(u) ((size_t)(u).pm * tstepA + (size_t)(((u).pn >> g.agsh) * g.agstride) * 2)
    Unit cur, nxt; int ui = 0;
    if (!S.next(0, cur)) return;
    f32x4 acc[2][2][4][2];
#pragma unroll
    for (int a = 0; a < 2; ++a)
#pragma unroll
        for (int b = 0; b < 2; ++b)
#pragma unroll
            for (int m = 0; m < 4; ++m)
#pragma unroll
                for (int n = 0; n < 2; ++n) acc[a][b][m][n] = (f32x4){0.f, 0.f, 0.f, 0.f};
    bf16x8 At[4][2], B0[2][2], B1[2][2];
    const char* cA = (const char*)g.A + PG8_AOFF(cur); const char* cB = (const char*)g.Bt + (size_t)cur.pn * tstepB;
    PG8_STAGE(PG8_SB(0, 0), cB, voffB); PG8_STAGE(PG8_SB(0, 1), cB + hstepB, voffB); PG8_STAGE(PG8_SA(0, 0), cA, voffA); PG8_STAGE(PG8_SA(0, 1), cA + hstepA, voffA);
    if (wr == 1) PG8_BAR;
    PG8_WAIT_V(2); PG8_BAR;
    PG8_STAGE(PG8_SB(1, 0), cB + kstep, voffB); PG8_STAGE(PG8_SA(1, 0), cA + kstep, voffA); PG8_STAGE(PG8_SB(1, 1), cB + hstepB + kstep, voffB);
    PG8_WAIT_V(6); PG8_BAR;
    for (;;) {
        const bool has_next = S.next(ui + 1, nxt);
        const char* nA = has_next ? (const char*)g.A + PG8_AOFF(nxt) : cA; const char* nB = has_next ? (const char*)g.Bt + (size_t)nxt.pn * tstepB : cB;
        for (int t = 0; t < nt; t += 2) {
            const bool last = (t == nt - 2);
            const char* a1 = cA + (size_t)(t + 1) * kstep;
            const char* a2 = last ? nA : cA + (size_t)(t + 2) * kstep; const char* b2 = last ? nB : cB + (size_t)(t + 2) * kstep;
            const char* a3 = a2 + kstep; const char* b3 = b2 + kstep;
            PG8_LDB(B0, 0, 0); PG8_LDB(B1, 0, 1); PG8_SCHED; PG8_LDA(At, 0, 0); PG8_STAGE(PG8_SA(1, 1), a1 + hstepA, voffA);
            PG8_WAIT_V(8); PG8_WAIT_L(0); PG8_BAR; PG8_MMA(0, 0, At, B0); PG8_MMA(0, 1, At, B1); PG8_BAR; PG8_SCHED;
            PG8_LDA(At, 0, 1); PG8_STAGE(PG8_SB(0, 0), b2, voffB); PG8_STAGE(PG8_SB(0, 1), b2 + hstepB, voffB); PG8_STAGE(PG8_SA(0, 0), a2, voffA);
            PG8_WAIT_V(8); PG8_WAIT_L(0); PG8_BAR; PG8_MMA(1, 0, At, B0); PG8_MMA(1, 1, At, B1); PG8_BAR; PG8_SCHED;
            PG8_LDB(B0, 1, 0); PG8_LDB(B1, 1, 1); PG8_SCHED; PG8_LDA(At, 1, 0); PG8_STAGE(PG8_SA(0, 1), a2 + hstepA, voffA);
            PG8_WAIT_V(8); PG8_WAIT_L(0); PG8_BAR; PG8_MMA(0, 0, At, B0); PG8_MMA(0, 1, At, B1); PG8_BAR; PG8_SCHED;
            PG8_LDA(At, 1, 1); PG8_STAGE(PG8_SB(1, 0), b3, voffB); PG8_STAGE(PG8_SB(1, 1), b3 + hstepB, voffB); PG8_STAGE(PG8_SA(1, 0), a3, voffA);
            PG8_WAIT_V(8); PG8_WAIT_L(0); PG8_BAR; PG8_MMA(1, 0, At, B0); PG8_MMA(1, 1, At, B1); PG8_BAR; PG8_SCHED;
        }
        if constexpr (ALIGN_EPI) { if (wr == 0) PG8_BAR; }
        E(acc, cur, wr, wc, fr, fq);
        if (!has_next) break;
#pragma unroll
        for (int a = 0; a < 2; ++a)
#pragma unroll
            for (int b = 0; b < 2; ++b)
#pragma unroll
                for (int m = 0; m < 4; ++m)
#pragma unroll
                    for (int n = 0; n < 2; ++n) acc[a][b][m][n] = (f32x4){0.f, 0.f, 0.f, 0.f};
        cur = nxt; cA = nA; cB = nB; ++ui;
        if constexpr (ALIGN_EPI) { if (wr == 1) PG8_BAR; }
    }
    PG8_WAIT_V(0);
    if constexpr (!ALIGN_EPI) { if (wr == 0) PG8_BAR; }
    PG8_BAR;
#undef PG8_SA
#undef PG8_SB
#undef PG8_STAGE
#undef PG8_LDA
#undef PG8_LDB
#undef PG8_MMA
#undef PG8_WAIT_V
#undef PG8_WAIT_L
#undef PG8_BAR
#undef PG8_SCHED
#undef PG8_AOFF
}

struct EpiBf16 {
    static constexpr bool PERM = true;
    bf16_t* O; int ldc;
    __device__ __forceinline__ void operator()(const f32x4 (&acc)[2][2][4][2], const Unit& u, int wr, int wc, int fr, int fq) const {
        const int row0 = u.pm * BM + wr * 64 + fr; const int col0 = u.pn * BM + wc * 32 + 8 * fq;
#pragma unroll
        for (int ai = 0; ai < 2; ++ai)
#pragma unroll
            for (int m = 0; m < 4; ++m) { bf16_t* rowp = O + (size_t)(row0 + ai * HALF + m * 16) * ldc + col0;
#pragma unroll
                for (int bj = 0; bj < 2; ++bj) { const f32x4 v0 = acc[ai][bj][m][0], v1 = acc[ai][bj][m][1];
                    u32x4 w; w.x = cvt_pk_bf16(v0[0], v0[1]); w.y = cvt_pk_bf16(v0[2], v0[3]); w.z = cvt_pk_bf16(v1[0], v1[1]); w.w = cvt_pk_bf16(v1[2], v1[3]);
                    *(u32x4*)(rowp + bj * HALF) = w; } }
    }
};
struct EpiPoolGrp {
    static constexpr bool PERM = true;
    bf16_t* U; const bf16_t* VG; const float* ls;
    __device__ __forceinline__ void operator()(const f32x4 (&acc)[2][2][4][2], const Unit& u, int wr, int wc, int fr, int fq) const {
        const int row0 = u.pm * BM + wr * 64 + fr; const int col0 = u.pn * BM + wc * 32 + 8 * fq;
        f32x4 lv[2][2];
#pragma unroll
        for (int bj = 0; bj < 2; ++bj)
#pragma unroll
            for (int n = 0; n < 2; ++n) lv[bj][n] = *(const f32x4*)(ls + col0 + bj * HALF + 4 * n);
#pragma unroll
        for (int ai = 0; ai < 2; ++ai) {
            u32x4 gw[4][2];
#pragma unroll
            for (int m = 0; m < 4; ++m)
#pragma unroll
                for (int bj = 0; bj < 2; ++bj) gw[m][bj] = *(const u32x4*)(VG + (size_t)(row0 + ai * HALF + m * 16) * POOL_IN + DM + col0 + bj * HALF);
            __builtin_amdgcn_sched_barrier(0);
#pragma unroll
            for (int m = 0; m < 4; ++m) { const size_t row = (size_t)(row0 + ai * HALF + m * 16);
#pragma unroll
                for (int bj = 0; bj < 2; ++bj) {
                    f32x4 v0 = acc[ai][bj][m][0] * lv[bj][0], v1 = acc[ai][bj][m][1] * lv[bj][1];
                    f32x4 g0, g1; unpack8(gw[m][bj], g0, g1);
#pragma unroll
                    for (int e = 0; e < 4; ++e) { v0[e] *= silu_f(g0[e]); v1[e] *= silu_f(g1[e]); }
                    *(u32x4*)(U + row * DM + col0 + bj * HALF) = pack8(v0, v1); } }
            __builtin_amdgcn_sched_barrier(0); }
    }
};
template <bool IN_BF16, bool OUT_BF16> struct EpiResid {
    static constexpr bool PERM = true;
    const void* xin; void* xout; const float* gmod;
    __device__ __forceinline__ void operator()(const f32x4 (&acc)[2][2][4][2], const Unit& u, int wr, int wc, int fr, int fq) const {
        const int row0 = u.pm * BM + wr * 64 + fr; const int col0 = u.pn * BM + wc * 32 + 8 * fq;
        f32x4 gv[2][2];
#pragma unroll
        for (int bj = 0; bj < 2; ++bj)
#pragma unroll
            for (int n = 0; n < 2; ++n) gv[bj][n] = *(const f32x4*)(gmod + col0 + bj * HALF + 4 * n);
#pragma unroll
        for (int ai = 0; ai < 2; ++ai)
#pragma unroll
          for (int mh = 0; mh < (IN_BF16 ? 1 : 2); ++mh) {
            constexpr int MB = IN_BF16 ? 4 : 2;
            u32x4 rw[MB][2]; f32x4 rf[MB][2][2];
#pragma unroll
            for (int mm = 0; mm < MB; ++mm)
#pragma unroll
                for (int bj = 0; bj < 2; ++bj) { const size_t off = (size_t)(row0 + ai * HALF + (mh * MB + mm) * 16) * DM + col0 + bj * HALF;
                    if (IN_BF16) rw[mm][bj] = *(const u32x4*)((const bf16_t*)xin + off);
                    else { rf[mm][bj][0] = *(const f32x4*)((const float*)xin + off); rf[mm][bj][1] = *(const f32x4*)((const float*)xin + off + 4); } }
            __builtin_amdgcn_sched_barrier(0);
#pragma unroll
            for (int mm = 0; mm < MB; ++mm)
#pragma unroll
                for (int bj = 0; bj < 2; ++bj) { const int m = mh * MB + mm; const size_t off = (size_t)(row0 + ai * HALF + m * 16) * DM + col0 + bj * HALF;
                    f32x4 b0, b1;
                    if (IN_BF16) unpack8(rw[mm][bj], b0, b1); else { b0 = rf[mm][bj][0]; b1 = rf[mm][bj][1]; }
                    const f32x4 y0 = b0 + gv[bj][0] * acc[ai][bj][m][0], y1 = b1 + gv[bj][1] * acc[ai][bj][m][1];
                    if (OUT_BF16) *(u32x4*)((bf16_t*)xout + off) = pack8(y0, y1);
                    else { *(f32x4*)((float*)xout + off) = y0; *(f32x4*)((float*)xout + off + 4) = y1; } }
            __builtin_amdgcn_sched_barrier(0); }
    }
};
struct EpiAttnIn {
    static constexpr bool PERM = true;
    unsigned char* ws; const int* pos;
    __device__ __forceinline__ void operator()(const f32x4 (&acc)[2][2][4][2], const Unit& u, int wr, int wc, int fr, int fq) const {
        const int row0 = u.pm * BM + wr * 64 + fr; const int pn = u.pn;
        bf16_t* const Qh = (bf16_t*)(ws + WS_Q); bf16_t* const SG = (bf16_t*)(ws + WS_GATE); bf16_t* const QI = (bf16_t*)(ws + WS_QI); bf16_t* const KI = (bf16_t*)(ws + WS_KI); float* const WI = (float*)(ws + WS_WI);
        const float* const cosq = (const float*)(ws + WS_TAB); const float* const sinq = cosq + SEQ * 16; const float* const cosi = sinq + SEQ * 16; const float* const sini = cosi + SEQ * 8;
#pragma unroll
        for (int ai = 0; ai < 2; ++ai)
#pragma unroll
            for (int m = 0; m < 4; ++m) {
                const int row = row0 + ai * HALF + m * 16;
                if (pn < 24) {
                    bf16_t* base = Qh + (size_t)(pn >> 3) * ((size_t)SEQ * DM);
                    const bool rope = (pn < 16) && (wc == 0);
                    f32x4 cs[2] = {{1.f, 1.f, 1.f, 1.f}, {1.f, 1.f, 1.f, 1.f}}, sn[2] = {{0.f, 0.f, 0.f, 0.f}, {0.f, 0.f, 0.f, 0.f}};
                    if (rope) { const float* cp = cosq + (size_t)row * 16 + 8 * (fq & 1); const float* sp = sinq + (size_t)row * 16 + 8 * (fq & 1);
                        cs[0] = *(const f32x4*)cp; cs[1] = *(const f32x4*)(cp + 4); sn[0] = *(const f32x4*)sp; sn[1] = *(const f32x4*)(sp + 4); }
#pragma unroll
                    for (int bj = 0; bj < 2; ++bj) { const int head = 2 * (pn & 7) + bj;
                        f32x4 v[2] = {acc[ai][bj][m][0], acc[ai][bj][m][1]};
                        if (pn < 8) { v[0] *= ATT_QSCALE; v[1] *= ATT_QSCALE; }
                        if (rope) {
#pragma unroll
                            for (int n = 0; n < 2; ++n) { f32x4 pr;
#pragma unroll
                                for (int e = 0; e < 4; ++e) { const float ve = v[n][e];
                                    const auto rr = __builtin_amdgcn_permlane32_swap(__builtin_bit_cast(unsigned, ve), __builtin_bit_cast(unsigned, ve), false, false);
                                    const unsigned pu = (fq < 2) ? rr[1] : rr[0]; pr[e] = __builtin_bit_cast(float, pu); }
                                v[n] = (fq < 2) ? (v[n] * cs[n] - pr * sn[n]) : (v[n] * cs[n] + pr * sn[n]); } }
                        *(u32x4*)(base + ((size_t)head * SEQ + row) * HD + 32 * wc + 8 * fq) = pack8(v[0], v[1]); }
                } else if (pn < 32) {
#pragma unroll
                    for (int bj = 0; bj < 2; ++bj) { f32x4 v0 = acc[ai][bj][m][0], v1 = acc[ai][bj][m][1];
#pragma unroll
                        for (int e = 0; e < 4; ++e) { v0[e] = silu_f(v0[e]); v1[e] = silu_f(v1[e]); }
                        *(u32x4*)(SG + (size_t)row * DM + (pn - 24) * BM + bj * HALF + 32 * wc + 8 * fq) = pack8(v0, v1); }
                } else {
                    const bool isq = pn < 36;
                    const bool rope = ((wc & 1) == 0) && (isq || wc == 0);
                    f32x4 cs[2], sn[2];
                    { const float* cp = cosi + (size_t)row * 8; const float* sp = sini + (size_t)row * 8;
                      cs[0] = *(const f32x4*)cp; cs[1] = *(const f32x4*)(cp + 4); sn[0] = *(const f32x4*)sp; sn[1] = *(const f32x4*)(sp + 4); }
#pragma unroll
                    for (int bj = 0; bj < 2; ++bj) {
                        if (!isq && bj == 1) continue;
                        f32x4 v[2] = {acc[ai][bj][m][0], acc[ai][bj][m][1]};
                        if (rope) {
#pragma unroll
                            for (int n = 0; n < 2; ++n) { f32x4 pr;
#pragma unroll
                                for (int e = 0; e < 4; ++e) pr[e] = swz_xor<16>(v[n][e]);
                                const f32x4 ro = (fq == 0) ? (v[n] * cs[n] - pr * sn[n]) : (v[n] * cs[n] + pr * sn[n]);
                                v[n] = (fq < 2) ? ro : v[n]; } }
                        const int cl = bj * HALF + 32 * wc + 8 * fq;
                        if (isq) *(u32x4*)(QI + (size_t)row * 1024 + (pn - 32) * BM + cl) = pack8(v[0], v[1]);
                        else if (cl < 64) *(u32x4*)(KI + (size_t)row * 64 + cl) = pack8(v[0], v[1]);
                        else if (cl < 80) { *(f32x4*)(WI + (size_t)row * 16 + (cl - 64)) = v[0]; *(f32x4*)(WI + (size_t)row * 16 + (cl - 64) + 4) = v[1]; }
                    }
                }
                asm volatile("" ::: "memory");
            }
    }
};
}

namespace att {
constexpr int D = 128, NW = 8, QBLK = 32, KVBLK = 64, QB = NW * QBLK;
constexpr int KROWB = 272;
constexpr int SHM_V = KVBLK * D * 2, SHM_K = KVBLK * KROWB;
constexpr int QROWB = 272;
constexpr int Q_OFF = 2 * SHM_V + 2 * SHM_K + NW * 64 * 4;
constexpr int LDS_BYTES = Q_OFF + QB * QROWB;
constexpr float SCALE = 0.08838834764831845f;
constexpr float THR = 8.f;
#define KSWZ(row, colB) ((row) * KROWB + (colB))
#define SBAR() __builtin_amdgcn_sched_barrier(0)
__device__ __forceinline__ int v_st(int k, int c) { const int kk = (k & ~0xC) | ((k & 4) << 1) | ((k & 8) >> 1); return ((kk >> 3) * 4 + (c >> 5)) * 512 + ((kk & 7) * 32 + (c & 31)) * 2; }
__device__ __forceinline__ int v_rd_base(int lane) { return ((lane & 3) << 3) | (((lane >> 2) & 3) << 6) | (((lane >> 4) & 1) << 5) | (((lane >> 5) & 1) << 8); }
constexpr int v_rd_off(int d0, int ks, int half) { return d0 * 512 + ks * 4096 + half * 2048; }
__device__ __forceinline__ int crow(int r, int hi) { return (r & 3) + 8 * (r >> 2) + 4 * hi; }
__device__ __forceinline__ unsigned cvtpk(float lo, float hi) { unsigned r; asm volatile("v_cvt_pk_bf16_f32 %0, %1, %2" : "=v"(r) : "v"(lo), "v"(hi)); return r; }
__device__ __forceinline__ bf16x8 load8(const bf16_t* p) { return *reinterpret_cast<const bf16x8*>(p); }
__device__ __forceinline__ float mask_and(float v, unsigned mlo, unsigned mhi, int r, int p) {
    const int pos = 16 * (r & 1) + 2 * (r >> 2) + 8 * p;
    const unsigned w = (r & 2) ? mhi : mlo;
    int bits; asm("v_bfe_i32 %0, %1, %2, 1" : "=v"(bits) : "v"(w), "n"(pos));
    return __builtin_bit_cast(float, __builtin_bit_cast(unsigned, v) & (unsigned)bits);
}
constexpr float THR2 = 8.f * 1.4426950408889634f;
__device__ __forceinline__ void partialSM(f32x16& p0, f32x16& p1, float& m_reg, float& alpha, unsigned mlo_r, unsigned mhi_r, int hi) {
    float pmax = p0[0];
#pragma unroll
    for (int r = 1; r < 16; ++r) pmax = fmaxf(pmax, p0[r]);
#pragma unroll
    for (int r = 0; r < 16; ++r) pmax = fmaxf(pmax, p1[r]);
    { auto rr = __builtin_amdgcn_permlane32_swap(__float_as_uint(pmax), __float_as_uint(pmax), false, false);
      pmax = fmaxf(__uint_as_float(rr[0]), __uint_as_float(rr[1])); }
    float mn;
    if (__builtin_expect(__all(pmax - m_reg <= THR2), 1)) { mn = m_reg; alpha = 1.f; }
    else { mn = fmaxf(m_reg, pmax); alpha = __builtin_amdgcn_exp2f(m_reg - mn); m_reg = mn; }
    const f32x2 nm = {-mn, -mn};
#pragma unroll
    for (int r = 0; r < 16; r += 2) { const f32x2 a = (f32x2){p0[r], p0[r + 1]} + nm, b = (f32x2){p1[r], p1[r + 1]} + nm; p0[r] = a.x; p0[r + 1] = a.y; p1[r] = b.x; p1[r + 1] = b.y; }
    const unsigned mlo = hi ? ((mlo_r >> 1) | (mhi_r << 31)) : mlo_r, mhi = mhi_r >> hi;
#pragma unroll
    for (int r = 0; r < 16; ++r) p0[r] = mask_and(__builtin_amdgcn_exp2f(p0[r]), mlo, mhi, r, 0);
}
__device__ __forceinline__ void finishSM(f32x16& p0, f32x16& p1, float alpha, float& l_reg, bf16x8& pa0, bf16x8& pa1, bf16x8& pa2, bf16x8& pa3, unsigned mlo_r, unsigned mhi_r, int hi) {
    const unsigned mlo = hi ? ((mlo_r >> 1) | (mhi_r << 31)) : mlo_r, mhi = mhi_r >> hi;
#pragma unroll
    for (int r = 0; r < 16; ++r) p1[r] = mask_and(__builtin_amdgcn_exp2f(p1[r]), mlo, mhi, r, 1);
    f32x2 ps2 = {p0[0], p0[1]};
#pragma unroll
    for (int r = 2; r < 16; r += 2) ps2 += (f32x2){p0[r], p0[r + 1]};
#pragma unroll
    for (int r = 0; r < 16; r += 2) ps2 += (f32x2){p1[r], p1[r + 1]};
    float ps = ps2.x + ps2.y;
    { auto rr = __builtin_amdgcn_permlane32_swap(__float_as_uint(ps), __float_as_uint(ps), false, false);
      ps = __uint_as_float(rr[0]) + __uint_as_float(rr[1]); }
    l_reg = l_reg * alpha + ps;
#define PK4(P, B_, OUT) do { unsigned a0 = cvtpk(P[B_+0], P[B_+1]), a1 = cvtpk(P[B_+2], P[B_+3]);                          \
        unsigned b0 = cvtpk(P[B_+4], P[B_+5]), b1 = cvtpk(P[B_+6], P[B_+7]);                                             \
        auto r0 = __builtin_amdgcn_permlane32_swap(a0, b0, false, false); auto r1 = __builtin_amdgcn_permlane32_swap(a1, b1, false, false); \
        u32x4 w = {r0[0], r1[0], r0[1], r1[1]}; OUT = *reinterpret_cast<bf16x8*>(&w); } while (0)
    PK4(p0, 0, pa0); PK4(p0, 8, pa1); PK4(p1, 0, pa2); PK4(p1, 8, pa3);
#undef PK4
}
template <int KB>
__device__ __forceinline__ void qkt(f32x16& p0, f32x16& p1, int ka  , int qa  ) {
    const f32x16 zero16 = {};
    bf16x8 A0, B0, Q0, A1, B1, Q1;
#define LDSRD128(dst, addr, off) asm volatile("ds_read_b128 %0, %1 offset:%2" : "=&v"(dst) : "v"(addr), "i"(off) : "memory")
#define LGKM(n) asm volatile("s_waitcnt lgkmcnt(%0)" :: "i"(n) : "memory")
#define QK_LD(i, A, B, Q) do { LDSRD128(A, ka, KB * SHM_K + (i) * 32); LDSRD128(B, ka, KB * SHM_K + (i) * 32 + 32 * KROWB); LDSRD128(Q, qa, (i) * 32); } while (0)
#define QK_MM(A, B, Q) do { p0 = __builtin_amdgcn_mfma_f32_32x32x16_bf16(A, Q, p0, 0, 0, 0); p1 = __builtin_amdgcn_mfma_f32_32x32x16_bf16(B, Q, p1, 0, 0, 0); } while (0)
    QK_LD(0, A0, B0, Q0); QK_LD(1, A1, B1, Q1);
    LGKM(3); SBAR();
    p0 = __builtin_amdgcn_mfma_f32_32x32x16_bf16(A0, Q0, zero16, 0, 0, 0); p1 = __builtin_amdgcn_mfma_f32_32x32x16_bf16(B0, Q0, zero16, 0, 0, 0);
    SBAR(); QK_LD(2, A0, B0, Q0);
    LGKM(3); SBAR(); QK_MM(A1, B1, Q1); SBAR(); QK_LD(3, A1, B1, Q1);
    LGKM(3); SBAR(); QK_MM(A0, B0, Q0); SBAR(); QK_LD(4, A0, B0, Q0);
    LGKM(3); SBAR(); QK_MM(A1, B1, Q1); SBAR(); QK_LD(5, A1, B1, Q1);
    LGKM(3); SBAR(); QK_MM(A0, B0, Q0); SBAR(); QK_LD(6, A0, B0, Q0);
    LGKM(3); SBAR(); QK_MM(A1, B1, Q1); SBAR(); QK_LD(7, A1, B1, Q1);
    LGKM(3); SBAR(); QK_MM(A0, B0, Q0); SBAR();
    LGKM(0); SBAR(); QK_MM(A1, B1, Q1); SBAR();
#undef QK_LD
#undef QK_MM
}
template <int VB>
__device__ __forceinline__ void pv_tile(f32x16* o, int vb0, bf16x8 pa0, bf16x8 pa1, bf16x8 pa2, bf16x8 pa3) {
#define TRRD(dst, off) asm volatile("ds_read_b64_tr_b16 %0, %1 offset:%2" : "=&v"(dst) : "v"(vb0), "i"(off) : "memory")
#define PV_D0(d0) do { s16x4 l0, l1, l2, l3, h0, h1, h2, h3; constexpr int b_ = VB * SHM_V + v_rd_off(d0, 0, 0); \
        TRRD(l0, b_); TRRD(h0, b_ + 2048); TRRD(l1, b_ + 4096); TRRD(h1, b_ + 6144); TRRD(l2, b_ + 8192); TRRD(h2, b_ + 10240); TRRD(l3, b_ + 12288); TRRD(h3, b_ + 14336); \
        asm volatile("s_waitcnt lgkmcnt(0)" ::: "memory"); SBAR();   \
        o[d0] = __builtin_amdgcn_mfma_f32_32x32x16_bf16(pa0, (bf16x8){l0[0], l0[1], l0[2], l0[3], h0[0], h0[1], h0[2], h0[3]}, o[d0], 0, 0, 0);   \
        o[d0] = __builtin_amdgcn_mfma_f32_32x32x16_bf16(pa1, (bf16x8){l1[0], l1[1], l1[2], l1[3], h1[0], h1[1], h1[2], h1[3]}, o[d0], 0, 0, 0);   \
        o[d0] = __builtin_amdgcn_mfma_f32_32x32x16_bf16(pa2, (bf16x8){l2[0], l2[1], l2[2], l2[3], h2[0], h2[1], h2[2], h2[3]}, o[d0], 0, 0, 0);   \
        o[d0] = __builtin_amdgcn_mfma_f32_32x32x16_bf16(pa3, (bf16x8){l3[0], l3[1], l3[2], l3[3], h3[0], h3[1], h3[2], h3[3]}, o[d0], 0, 0, 0); } while (0)
    PV_D0(0); PV_D0(1); PV_D0(2); PV_D0(3);
#undef PV_D0
#undef TRRD
}
struct BlockRef { const bf16_t* Q; const bf16_t* K; const bf16_t* V; bf16_t* O; const bf16_t* G; const unsigned long long* M; int P0; };
struct Seam { bf16x8 a_v0, a_v1, a_k0, a_k1, b_v0, b_v1, b_k0, b_k1; };
#define ROW(p, k0, rr) ((p) + (size_t)((k0) + (rr)) * D + sc)
#define VMW() asm volatile("s_waitcnt vmcnt(0)" ::: "memory")
#define VMWN(n) asm volatile("s_waitcnt vmcnt(%0)" :: "i"(n) : "memory")
#define SLD(X, Kp, Vp) do { S.X##_v0 = load8(ROW(Vp, 0, sr)); S.X##_v1 = load8(ROW(Vp, 0, 32 + sr)); S.X##_k0 = load8(ROW(Kp, 0, sr)); S.X##_k1 = load8(ROW(Kp, 0, 32 + sr)); } while (0)
#define SWK(X, bf) do { *(bf16x8*)(K_lds + (bf) * SHM_K + kws) = S.X##_k0; *(bf16x8*)(K_lds + (bf) * SHM_K + kws + 32 * KROWB) = S.X##_k1; } while (0)
#define SWV(X, bf) do { *(bf16x8*)(V_lds + (bf) * SHM_V + vst0) = S.X##_v0; *(bf16x8*)(V_lds + (bf) * SHM_V + vst1) = S.X##_v1; } while (0)
__device__ __forceinline__ void attn_prime(int wv, const BlockRef& cur, char* lds, Seam& S) {
    const int tid = opaque_tid(wv);
    const int sr = tid >> 4, sc = (tid & 15) * 8, kws = KSWZ(sr, sc * 2); char* K_lds = lds + 2 * SHM_V;
    SLD(a, cur.K, cur.V); SBAR(); SWK(a, 0); SBAR(); SLD(b, cur.K + (size_t)KVBLK * D, cur.V + (size_t)KVBLK * D);
    __syncthreads();
}
__device__ __forceinline__ void attn_block(int wv, const BlockRef& cur, const BlockRef& nxt, char* lds, Seam& S) {
    const int tid = opaque_tid(wv), wid = __builtin_amdgcn_readfirstlane(tid >> 6), lane = tid & 63, r32 = lane & 31, hi = lane >> 5;
    const int NT = cur.P0 / KVBLK + 4;
    char* V_lds = lds; char* K_lds = lds + 2 * SHM_V;
    float* ws = (float*)(lds + 2 * SHM_V + 2 * SHM_K) + wid * 64; float* li_l = ws, * al_l = ws + 32;
    float m_reg = -1e30f, l_reg = 0; f32x16 o[4] = {};
    const int sr = tid >> 4, sc = (tid & 15) * 8, vst0 = v_st(sr, sc), vst1 = v_st(32 + sr, sc), kws = KSWZ(sr, sc * 2);
    const int vb0 = (int)(uintptr_t)V_lds + v_rd_base(lane);
    const bf16_t* Kh = cur.K; const bf16_t* Vh = cur.V;
    const unsigned long long* mp = cur.M + (wid * QBLK + r32);
#define MLOAD(lo_, hi_, t) do { const unsigned long long w_ = mp[(size_t)(t) * SEQ]; lo_ = (unsigned)w_; hi_ = (unsigned)(w_ >> 32); } while (0)
#define RESC(a) do { if (__any((a) < 1.f)) { if (hi == 0) al_l[r32] = (a); asm volatile("s_waitcnt lgkmcnt(0)" ::: "memory");              \
                     for (int d_ = 0; d_ < 4; ++d_) for (int r = 0; r < 16; ++r) o[d_][r] *= al_l[crow(r, hi)]; } } while (0)
#define KBASE(t) ((size_t)(t) * KVBLK * D)
    f32x16 pA0, pA1, pB0, pB1; float alA, alB; bf16x8 pa0, pa1, pa2, pa3;
    unsigned mAlo, mAhi, mBlo, mBhi;
    MLOAD(mAlo, mAhi, 0);
    char* Qw_lds = lds + Q_OFF + wid * (QBLK * QROWB);
    { u32x4 tq[8];
#pragma unroll
        for (int i = 0; i < 8; ++i) tq[i] = *(const u32x4*)(cur.Q + (size_t)(wid * QBLK + 4 * i + (lane >> 4)) * D + (lane & 15) * 8);
#pragma unroll
        for (int i = 0; i < 8; ++i) *(u32x4*)(Qw_lds + (4 * i + (lane >> 4)) * QROWB + (lane & 15) * 16) = tq[i];
        asm volatile("s_waitcnt lgkmcnt(0)" ::: "memory"); }
    const int qal = (int)(uintptr_t)Qw_lds + r32 * QROWB + hi * 16, ka = (int)(uintptr_t)K_lds + r32 * KROWB + hi * 16;
    SWV(a, 0); SBAR();
    SLD(a, Kh + KBASE(2), Vh + KBASE(2));
    SBAR(); qkt<0>(pA0, pA1, ka, qal);
    partialSM(pA0, pA1, m_reg, alA, mAlo, mAhi, hi);
    SWV(b, 1); SWK(b, 1);
    __syncthreads();
#define HALF_STEP(PX0, PX1, mnX, alX, mXlo, mXhi, PY0, PY1, alY, mYlo, mYhi, t, KB, VB, SB, SL, SW, KP, VP) do {                   \
        SBAR(); MLOAD(mXlo, mXhi, t); qkt<KB>(PX0, PX1, ka, qal);                                                             \
        finishSM(PY0, PY1, alY, l_reg, pa0, pa1, pa2, pa3, mYlo, mYhi, hi); SBAR();                                               \
        SLD(SL, KP, VP); SBAR();                                                                                              \
        pv_tile<VB>(o, vb0, pa0, pa1, pa2, pa3); partialSM(PX0, PX1, m_reg, alX, mXlo, mXhi, hi);                                 \
        __syncthreads();                                                                                                      \
        SWV(SW, SB); SWK(SW, SB);                                                                                             \
        RESC(alX); __syncthreads(); } while (0)
    for (int t = 1; t + 1 < NT; t += 2) {
        const bool inr = t + 3 < NT;
        const bf16_t* kp2 = inr ? Kh + KBASE(t + 3) : nxt.K; const bf16_t* vp2 = inr ? Vh + KBASE(t + 3) : nxt.V;
        HALF_STEP(pB0, pB1, mnB, alB, mBlo, mBhi, pA0, pA1, alA, mAlo, mAhi, t, 1, 0, 0, b, a, Kh + KBASE(t + 2), Vh + KBASE(t + 2));
        HALF_STEP(pA0, pA1, mnA, alA, mAlo, mAhi, pB0, pB1, alB, mBlo, mBhi, t + 1, 0, 1, 1, a, b, kp2, vp2);
    }
    MLOAD(mBlo, mBhi, NT - 1);
    SBAR(); qkt<1>(pB0, pB1, ka, qal); SBAR();
    SLD(b, nxt.K + KBASE(1), nxt.V + KBASE(1)); SBAR();
    finishSM(pA0, pA1, alA, l_reg, pa0, pa1, pa2, pa3, mAlo, mAhi, hi); SBAR();
    pv_tile<0>(o, vb0, pa0, pa1, pa2, pa3);
    partialSM(pB0, pB1, m_reg, alB, mBlo, mBhi, hi); __syncthreads(); RESC(alB);
    finishSM(pB0, pB1, alB, l_reg, pa0, pa1, pa2, pa3, mBlo, mBhi, hi); SBAR(); pv_tile<1>(o, vb0, pa0, pa1, pa2, pa3);
    SBAR(); SWK(a, 0); SBAR();
    if (hi == 0) li_l[r32] = l_reg; asm volatile("s_waitcnt lgkmcnt(0)" ::: "memory");
    { char* ow_l = Qw_lds + r32 * 2;
#pragma unroll
      for (int r = 0; r < 16; ++r) { const int orow = crow(r, hi); const float rl = __builtin_amdgcn_rcpf(li_l[orow]);
#pragma unroll
          for (int d0 = 0; d0 < 4; ++d0) *(unsigned short*)(ow_l + orow * QROWB + d0 * 64) = (unsigned short)(cvtpk(o[d0][r] * rl, 0.f) & 0xffffu); }
      asm volatile("s_waitcnt lgkmcnt(0)" ::: "memory"); SBAR();
      bf16_t* Ow = cur.O + (size_t)(wid * QBLK + (lane >> 4)) * DM + (lane & 15) * 8; const bf16_t* Gw = cur.G + (size_t)(wid * QBLK + (lane >> 4)) * DM + (lane & 15) * 8;
      u32x4 gv[8];
#pragma unroll
      for (int i = 0; i < 8; ++i) gv[i] = *(const u32x4*)(Gw + (size_t)(4 * i) * DM);
#pragma unroll
      for (int i = 0; i < 8; ++i) { const u32x4 ov = *(const u32x4*)(Qw_lds + (4 * i + (lane >> 4)) * QROWB + (lane & 15) * 16);
          f32x4 a0, a1, g0, g1; unpack8(ov, a0, a1); unpack8(gv[i], g0, g1);
          *(u32x4*)(Ow + (size_t)(4 * i) * DM) = pack8(a0 * g0, a1 * g1); }
      asm volatile("s_waitcnt lgkmcnt(0)" ::: "memory"); }
    __syncthreads();
#undef MLOAD
#undef RESC
#undef KBASE
#undef HALF_STEP
}
#undef ROW
#undef VMW
#undef VMWN
#undef SLD
#undef SWK
#undef SWV
#undef KSWZ
#undef SBAR
}

#define XB_TMO      128
#define XB_XCNT(j)  (256  + 64 * (j))
#define XB_XSUB(j)  (1280 + 64 * (j))
#define XB_XGEN(j)  (2304 + 64 * (j))
#define XB_TOP      3328
#define XB_TOPGEN   3392
#define XCD_BAR_WORDS 3456
#define XB_SPIN_CAP (1u << 22)
__device__ __forceinline__ unsigned xb_ld(unsigned* p)              { return __hip_atomic_load(p, __ATOMIC_RELAXED, __HIP_MEMORY_SCOPE_AGENT); }
__device__ __forceinline__ unsigned xb_add(unsigned* p, unsigned v) { return __hip_atomic_fetch_add(p, v, __ATOMIC_RELAXED, __HIP_MEMORY_SCOPE_AGENT); }
__device__ __forceinline__ unsigned xb_xcc_id() { return (unsigned)__builtin_amdgcn_s_getreg((3 << 11) | 20) & 0xFu; }
#define XB_SPIN(cond, bar) do { unsigned _sp = 0; while (cond) { __builtin_amdgcn_s_sleep(1); \
    if ((++_sp & 255u) == 0u) { if (xb_ld(&(bar)[XB_TMO])) break; if (_sp > XB_SPIN_CAP) { atomicAdd(&(bar)[XB_TMO], 1u); break; } } } } while (0)
struct XcdBarrier { unsigned* bar; unsigned x; volatile LAS unsigned* st; };
__device__ __forceinline__ XcdBarrier xcd_barrier_post(unsigned* bar, volatile LAS unsigned* st) {
    XcdBarrier b; b.bar = bar; b.x = xb_xcc_id(); b.st = st;
    if (threadIdx.x == 0) (void)xb_add(&bar[XB_XCNT(b.x)], 1u);
    return b;
}
__device__ __forceinline__ void xcd_barrier_complete(unsigned* bar, unsigned x, unsigned& nloc, unsigned& nx) {
    const unsigned G = gridDim.x * gridDim.y * gridDim.z;
    unsigned sum, cnt, mine, sp = 0u;
    for (;;) {
        sum = 0u; cnt = 0u; mine = 0u;
        unsigned cj[16];
#pragma unroll
        for (unsigned j = 0; j < 16; ++j) cj[j] = xb_ld(&bar[XB_XCNT(j)]);
        __builtin_amdgcn_sched_barrier(0);
#pragma unroll
        for (unsigned j = 0; j < 16; ++j) { const unsigned c = cj[j]; sum += c; cnt += (c > 0u) ? 1u : 0u; mine = (j == x) ? c : mine; }
        if (sum == G) break;
        __builtin_amdgcn_s_sleep(1);
        if ((++sp & 255u) == 0u) { if (xb_ld(&bar[XB_TMO])) break; if (sp > XB_SPIN_CAP) { atomicAdd(&bar[XB_TMO], 1u); break; } }
    }
    nloc = mine > 0u ? mine : 1u; nx = cnt > 0u ? cnt : 1u;
}
__device__ __forceinline__ void xcd_barrier(const XcdBarrier& b) {
    asm volatile("s_waitcnt vmcnt(0)" ::: "memory");
    __syncthreads();
    if (threadIdx.x == 0) {
        unsigned* bar = b.bar;
        __builtin_amdgcn_s_waitcnt(0);
        unsigned nloc = b.st[0], nx = b.st[1];
        if (nloc == 0u) { xcd_barrier_complete(bar, b.x, nloc, nx); b.st[0] = nloc; b.st[1] = nx; }
        const unsigned old = xb_add(&bar[XB_XSUB(b.x)], 1u);
        const unsigned gen = old / nloc;
        if (old + 1u == (gen + 1u) * nloc) {
            __builtin_amdgcn_fence(__ATOMIC_RELEASE, "agent");
            asm volatile("s_waitcnt vmcnt(0)" ::: "memory");
            const unsigned og = xb_add(&bar[XB_TOP], 1u);
            const unsigned tg = og / nx;
            if (og + 1u == (tg + 1u) * nx) xb_add(&bar[XB_TOPGEN], 1u);
            else XB_SPIN(xb_ld(&bar[XB_TOPGEN]) == tg, bar);
            __builtin_amdgcn_fence(__ATOMIC_ACQUIRE, "agent");
            xb_add(&bar[XB_XGEN(b.x)], 1u);
            asm volatile("s_waitcnt vmcnt(0)" ::: "memory");
        } else {
            XB_SPIN(xb_ld(&bar[XB_XGEN(b.x)]) == gen, bar);
            __builtin_amdgcn_fence(__ATOMIC_ACQUIRE, "agent");
            asm volatile("s_waitcnt vmcnt(0)" ::: "memory");
        }
    }
    __syncthreads();
}

struct Args {
    const float* x; const float* c; const int* pos; const float* norm_g; const float* mod_w; const float* mod_b;
    const float* pwi; const float* pwg; const float* pls; const float* pwo; const float* awi; const float* awo; const float* fg;
    float* out; unsigned char* ws;
    int ph_lo, ph_hi;
};
constexpr int NWAVES = 8, NTHR = 512;
constexpr int RING_BYTES = 131072, LDS_BYTES = 147456, MISC_OFF = LDS_BYTES - 256;

__device__ __forceinline__ void sincos_d(double a, float& s_out, float& c_out) {
    const double k = __builtin_rint(a * 0.6366197723675814);
    double r = __builtin_fma(-k, 1.5707963267948966, a); r = __builtin_fma(-k, 6.123233995736766e-17, r);
    const double r2 = r * r;
    double sp = -7.647163731819816e-13; sp = sp * r2 + 1.6059043836821613e-10; sp = sp * r2 - 2.505210838544172e-08; sp = sp * r2 + 2.7557319223985893e-06;
    sp = sp * r2 - 1.984126984126984e-04; sp = sp * r2 + 8.333333333333333e-03; sp = sp * r2 - 1.6666666666666666e-01; const double s = r + r * r2 * sp;
    double cp = 4.779477332387385e-14; cp = cp * r2 - 1.1470745597729725e-11; cp = cp * r2 + 2.08767569878681e-09; cp = cp * r2 - 2.755731922398589e-07;
    cp = cp * r2 + 2.48015873015873e-05; cp = cp * r2 - 1.388888888888889e-03; cp = cp * r2 + 4.1666666666666664e-02; cp = cp * r2 - 0.5; const double c = 1.0 + r2 * cp;
    const int q = (int)((long long)k & 3);
    const double ss = (q == 0) ? s : (q == 1) ? c : (q == 2) ? -s : -c;
    const double cc = (q == 0) ? c : (q == 1) ? -s : (q == 2) ? -c : s;
    s_out = (float)ss; c_out = (float)cc;
}
__device__ __forceinline__ void transpose_item(const float* W, int K, int N, bf16_t* WT, int row_off, LAS float* scr, int nblk, int item, int lane) {
    const int kb = item / nblk, nb = item % nblk, k0 = 64 * kb, n0 = 32 * nb;
    const int nn = n0 + (lane & 31);
    float tv[32];
#pragma unroll
    for (int i = 0; i < 32; ++i) { const int kk = 2 * i + (lane >> 5); tv[i] = (nn < N) ? W[(size_t)(k0 + kk) * N + nn] : 0.f; }
#pragma unroll
    for (int i = 0; i < 32; ++i) { const int kk = 2 * i + (lane >> 5); scr[kk * 33 + (lane & 31)] = tv[i]; }
    LDS_WAIT(); asm volatile("" ::: "memory");
    const int c = lane & 7;
#pragma unroll
    for (int j = 0; j < 4; ++j) { const int n = (lane >> 3) + 8 * j; const LAS float* s = scr + (8 * c) * 33 + n;
        u32x4 o; o.x = pk2(s[0 * 33], s[1 * 33]); o.y = pk2(s[2 * 33], s[3 * 33]); o.z = pk2(s[4 * 33], s[5 * 33]); o.w = pk2(s[6 * 33], s[7 * 33]);
        *(u32x4*)(WT + (size_t)(row_off + n0 + n) * K + k0 + 8 * c) = o; }
    LDS_WAIT(); asm volatile("" ::: "memory");
}
template <int VAR>
__device__ __forceinline__ void phase0(int wv, const Args& a, LAS unsigned char* lds) {
    const int tid = opaque_tid(wv), lane = tid & 63, wave = __builtin_amdgcn_readfirstlane(tid >> 6);
    const int G = gridDim.x, bx = blockIdx.x;
    unsigned char* ws = a.ws;
    if (VAR == 0 || VAR == 1)
    for (int unit = bx; unit < 256; unit += G) {
        const int layer = unit >> 6, kq = (unit >> 4) & 3, cs = unit & 15;
        const float* W = a.mod_w + ((size_t)layer * DM + 512 * kq) * 6144 + 384 * cs;
        LAS float* red = (LAS float*)lds;
        LAS float* cdl = (LAS float*)(lds + 8192);
        if (tid < 512) cdl[tid] = silu_f(a.c[512 * kq + tid]);
        if (tid < 8) cdl[512 + tid] = 0.f;
        __syncthreads();
        if (tid < 480) {
            const int kg = tid / 96, ln = tid - kg * 96;
            f32x4 acc4 = {0.f, 0.f, 0.f, 0.f};
#pragma unroll 8
            for (int i = 0; i < 103; ++i) { const int k = kg + 5 * i, kc = k < 512 ? k : 511;
                acc4 += *(const f32x4*)(W + (size_t)kc * 6144 + 4 * ln) * cdl[k]; }
            *(LAS f32x4*)(red + kg * 384 + 4 * ln) = acc4;
        }
        __syncthreads();
        if (tid < 384) { float sum = red[tid];
#pragma unroll
            for (int kg = 1; kg < 5; ++kg) sum += red[kg * 384 + tid];
            const int col = 384 * cs + tid;
            if (kq == 0) sum += a.mod_b[layer * 6144 + col];
            ((float*)(ws + WS_MOD))[(layer * 4 + kq) * 6144 + col] = sum; }
        __syncthreads();
    }
    if (VAR == 0 || VAR == 2) {
        float* cosq = (float*)(ws + WS_TAB); float* sinq = cosq + SEQ * 16; float* cosi = sinq + SEQ * 16; float* sini = cosi + SEQ * 8;
        for (int e = bx * NTHR + tid; e < SEQ * 24; e += G * NTHR) {
            const int p = e / 24, i = e - p * 24;
            const float pf = (float)a.pos[p];
            const double frac = i < 16 ? (double)i * (1.0 / 16.0) : (double)(i - 16) * (1.0 / 8.0);
            const float inv = (float)exp2(-18.931568569324174 * frac);
            const float ang = pf * inv;
            float s, c; sincos_d((double)ang, s, c);
            if (i < 16) { cosq[p * 16 + i] = c; sinq[p * 16 + i] = s; } else { cosi[p * 8 + i - 16] = c; sini[p * 8 + i - 16] = s; }
        }
    }
    if (VAR == 0 || VAR == 3) {
        LAS float* scr = (LAS float*)(lds + 16384 + wave * 8704);
        const int gw = bx * NWAVES + wave, NGW = G * NWAVES;
        constexpr int I_PI = 32 * 128, I_PG = 8 * 16, I_PO = 32 * 64, I_AI = 32 * 296, I_AO = 32 * 64;
        constexpr int NITEMS = 2 * I_PI + 8 * I_PG + 2 * I_PO + 2 * I_AI + 2 * I_AO;
        for (int it = gw; it < NITEMS; it += NGW) {
            int r = it;
            if (r < 2 * I_AI) { const int l = r / I_AI; r -= l * I_AI; transpose_item(a.awi + (size_t)l * DM * ATTN_IN, DM, ATTN_IN, (bf16_t*)(ws + WS_WAI) + (size_t)l * ATTN_INP * DM, 0, scr, 296, r, lane); continue; } r -= 2 * I_AI;
            if (r < 2 * I_PI) { const int l = r / I_PI; r -= l * I_PI; transpose_item(a.pwi + (size_t)l * DM * POOL_IN, DM, POOL_IN, (bf16_t*)(ws + WS_WPI) + (size_t)l * POOL_IN * DM, 0, scr, 128, r, lane); continue; } r -= 2 * I_PI;
            if (r < 2 * I_PO) { const int l = r / I_PO; r -= l * I_PO; transpose_item(a.pwo + (size_t)l * DM * DM, DM, DM, (bf16_t*)(ws + WS_WPO) + (size_t)l * DM * DM, 0, scr, 64, r, lane); continue; } r -= 2 * I_PO;
            if (r < 2 * I_AO) { const int l = r / I_AO; r -= l * I_AO; transpose_item(a.awo + (size_t)l * DM * DM, DM, DM, (bf16_t*)(ws + WS_WAO) + (size_t)l * DM * DM, 0, scr, 64, r, lane); continue; } r -= 2 * I_AO;
            { const int lg = r / I_PG; r -= lg * I_PG; const int l = lg >> 2, gi = lg & 3;
              transpose_item(a.pwg + (size_t)lg * 512 * 512, 512, 512, (bf16_t*)(ws + WS_WPG) + (size_t)l * DM * 512, gi * 512, scr, 16, r, lane); }
        }
    }
}

template <bool IN_BF16> __device__ __forceinline__ void phase_norm(int wv, const void* x, const float* g, const float* mod  , bf16_t* h, unsigned char* lds, float* gsum  ) {
    const int tid = opaque_tid(wv), lane = tid & 63, wave = tid >> 6;
    const int gw = blockIdx.x * NWAVES + wave, NGW = gridDim.x * NWAVES;
    u32x4 t[4][4]; f32x4 tf[4][8];
#define NORM_LOAD(row_) do {                                                                                                  \
        _Pragma("unroll") for (int r = 0; r < 4; ++r) { const size_t ro = (size_t)((row_) + r * NGW) * DM;                   \
            if (IN_BF16) { const u32x4* xr = (const u32x4*)((const bf16_t*)x + ro) + lane;                                   \
                _Pragma("unroll") for (int j = 0; j < 4; ++j) t[r][j] = xr[64 * j]; }                                        \
            else { const f32x4* xr = (const f32x4*)((const float*)x + ro) + 2 * lane;                                        \
                _Pragma("unroll") for (int j = 0; j < 4; ++j) { tf[r][2 * j] = xr[128 * j]; tf[r][2 * j + 1] = xr[128 * j + 1]; } } } } while (0)
    float* la = (float*)lds; float* lsft = la + DM;
    { const int col = 4 * tid;
      const f32x4 gg = *(const f32x4*)(g + col);
      const f32x4 p0 = *(const f32x4*)(mod + col), p1 = *(const f32x4*)(mod + 6144 + col), p2 = *(const f32x4*)(mod + 2 * 6144 + col), p3 = *(const f32x4*)(mod + 3 * 6144 + col);
      const f32x4 q0 = *(const f32x4*)(mod + DM + col), q1 = *(const f32x4*)(mod + 6144 + DM + col), q2 = *(const f32x4*)(mod + 2 * 6144 + DM + col), q3 = *(const f32x4*)(mod + 3 * 6144 + DM + col);
      f32x4 r0, r1, r2, r3;
      if (blockIdx.x == 0) { r0 = *(const f32x4*)(mod + 2 * DM + col); r1 = *(const f32x4*)(mod + 6144 + 2 * DM + col); r2 = *(const f32x4*)(mod + 2 * 6144 + 2 * DM + col); r3 = *(const f32x4*)(mod + 3 * 6144 + 2 * DM + col); }
      int row = gw; if (row < SEQ) NORM_LOAD(row);
      const f32x4 sh = ((p0 + p1) + p2) + p3, sc = ((q0 + q1) + q2) + q3;
      *(f32x4*)(la + col) = gg * (sc + 1.0f); *(f32x4*)(lsft + col) = sh;
      if (blockIdx.x == 0) *(f32x4*)(gsum + col) = ((r0 + r1) + r2) + r3; }
    __syncthreads();
    f32x4 av[8], sv[8];
#pragma unroll
    for (int j = 0; j < 8; ++j) { const int col = 8 * lane + 512 * (j >> 1) + 4 * (j & 1); av[j] = *(const f32x4*)(la + col); sv[j] = *(const f32x4*)(lsft + col); }
    for (int row = gw; row < SEQ; ) {
#pragma unroll
        for (int r = 0; r < 4; ++r) {
            f32x4 v[8];
#pragma unroll
            for (int j = 0; j < 4; ++j) { if (IN_BF16) unpack8(t[r][j], v[2 * j], v[2 * j + 1]); else { v[2 * j] = tf[r][2 * j]; v[2 * j + 1] = tf[r][2 * j + 1]; } }
            float s = 0.f;
#pragma unroll
            for (int j = 0; j < 8; ++j) s += (v[j].x * v[j].x + v[j].y * v[j].y) + (v[j].z * v[j].z + v[j].w * v[j].w);
            const float rstd = 1.0f / sqrtf(wave_sum(s) * (1.f / DM) + EPS);
            u32x4* o16 = (u32x4*)(h + (size_t)(row + r * NGW) * DM) + lane;
#pragma unroll
            for (int j = 0; j < 4; ++j) o16[64 * j] = pack8(v[2 * j] * rstd * av[2 * j] + sv[2 * j], v[2 * j + 1] * rstd * av[2 * j + 1] + sv[2 * j + 1]);
        }
        row += 4 * NGW; if (row >= SEQ) break;
        NORM_LOAD(row);
    }
#undef NORM_LOAD
}
__device__ __forceinline__ void phase_final(int wv, const bf16_t* x, float* y, const float* g) {
    const int tid = opaque_tid(wv), lane = tid & 63, wave = tid >> 6;
    const int gw = blockIdx.x * NWAVES + wave, NGW = gridDim.x * NWAVES;
    f32x4 gg[8];
#pragma unroll
    for (int j = 0; j < 8; ++j) gg[j] = *(const f32x4*)(g + 8 * lane + 512 * (j >> 1) + 4 * (j & 1));
    for (int row = gw; row < SEQ; row += 4 * NGW) {
        u32x4 t[4][4];
#pragma unroll
        for (int r = 0; r < 4; ++r) { const u32x4* xr = (const u32x4*)(x + (size_t)(row + r * NGW) * DM) + lane;
#pragma unroll
            for (int j = 0; j < 4; ++j) t[r][j] = xr[64 * j]; }
#pragma unroll
        for (int r = 0; r < 4; ++r) {
            f32x4 v[8]; float s = 0.f;
#pragma unroll
            for (int j = 0; j < 4; ++j) unpack8(t[r][j], v[2 * j], v[2 * j + 1]);
#pragma unroll
            for (int j = 0; j < 8; ++j) s += (v[j].x * v[j].x + v[j].y * v[j].y) + (v[j].z * v[j].z + v[j].w * v[j].w);
            const float rstd = 1.0f / sqrtf(wave_sum(s) * (1.f / DM) + EPS);
            f32x4* yr = (f32x4*)(y + (size_t)(row + r * NGW) * DM) + 2 * lane;
#pragma unroll
            for (int j = 0; j < 8; ++j) yr[128 * (j >> 1) + (j & 1)] = v[j] * rstd * gg[j];
        }
    }
}

template <int W, int R> __device__ __forceinline__ void pool_strip(const bf16_t* VG, bf16_t* PL, int t0, int c0) {
    u32x4 r[W + R - 1];
#pragma unroll
    for (int i = 0; i < W + R - 1; ++i) { const int t = t0 - (W - 1) + i; r[i] = *(const u32x4*)(VG + (size_t)(t < 0 ? 0 : t) * POOL_IN + c0); }
    float S[8];
#pragma unroll
    for (int e = 0; e < 8; ++e) S[e] = 0.f;
#pragma unroll
    for (int i = 0; i < W - 1; ++i) { const float wg = (t0 - (W - 1) + i >= 0) ? 1.f : 0.f;
#pragma unroll
        for (int e = 0; e < 4; ++e) { const unsigned x = r[i][e]; S[2 * e] += wg * __builtin_bit_cast(float, x << 16); S[2 * e + 1] += wg * __builtin_bit_cast(float, x & 0xffff0000u); } }
#pragma unroll
    for (int j = 0; j < R; ++j) { const int t = t0 + j;
        float v[8];
#pragma unroll
        for (int e = 0; e < 4; ++e) { const unsigned x = r[W - 1 + j][e]; v[2 * e] = __builtin_bit_cast(float, x << 16); v[2 * e + 1] = __builtin_bit_cast(float, x & 0xffff0000u); }
        const int cnt = (t + 1 < W) ? (t + 1) : W; const float ic = 1.0f / (float)cnt;
        float o[8];
#pragma unroll
        for (int e = 0; e < 8; ++e) { S[e] += v[e]; o[e] = S[e] * ic - v[e]; }
        u32x4 pw; pw.x = cvt_pk_bf16(o[0], o[1]); pw.y = cvt_pk_bf16(o[2], o[3]); pw.z = cvt_pk_bf16(o[4], o[5]); pw.w = cvt_pk_bf16(o[6], o[7]);
        *(u32x4*)(PL + (size_t)t * DM + c0) = pw;
        const float wg = (t - W + 1 >= 0) ? 1.f : 0.f;
#pragma unroll
        for (int e = 0; e < 4; ++e) { const unsigned x = r[j][e]; S[2 * e] -= wg * __builtin_bit_cast(float, x << 16); S[2 * e + 1] -= wg * __builtin_bit_cast(float, x & 0xffff0000u); } }
}
__device__ __forceinline__ void phase_pool(int wv, const bf16_t* VG, bf16_t* PL) {
    const int total = 512 * 256;
    const int tid = opaque_tid(wv);
    for (int it = blockIdx.x * NTHR + tid; it < total; it += gridDim.x * NTHR) {
        const int cg = it & 255, strip = it >> 8; const int c0 = cg * 8, t0 = strip * 16;
        const int grp = __builtin_amdgcn_readfirstlane(c0 >> 9);
        if (grp == 0) pool_strip<2, 16>(VG, PL, t0, c0); else if (grp == 1) pool_strip<4, 16>(VG, PL, t0, c0); else if (grp == 2) pool_strip<8, 16>(VG, PL, t0, c0);
        else { pool_strip<16, 8>(VG, PL, t0, c0); pool_strip<16, 8>(VG, PL, t0 + 8, c0); }
    }
}

__device__ __forceinline__ size_t sc_block_base(int qb) { return (size_t)65536 * (size_t)(qb * (qb + 1) / 2); }
__device__ __forceinline__ float fma_s(float a, float b, float c) { asm("v_fma_f32 %0, %1, %2, %0" : "+v"(c) : "v"(a), "v"(b)); return c; }
__device__ __forceinline__ float relu_i(float x) { const int b = __builtin_bit_cast(int, x); return __builtin_bit_cast(float, b > 0 ? b : 0); }
template <int VAR>
__device__ __forceinline__ void phase_scores(int wv, const bf16_t* QI, const bf16_t* KI, const float* WI, float* SC, LAS unsigned char* lds, unsigned* ctr  ) {
    const int tid = opaque_tid(wv), wid = __builtin_amdgcn_readfirstlane(tid >> 6), lane = tid & 63, r32 = lane & 31, hi = lane >> 5;
    constexpr int QROW = 2064;
    volatile LAS int* slot = (volatile LAS int*)(lds + 32 * QROW);
    for (;;) {
        __syncthreads();
        if (tid == 0) slot[0] = (int)__hip_atomic_fetch_add(ctr, 1u, __ATOMIC_RELAXED, __HIP_MEMORY_SCOPE_AGENT);
        __syncthreads();
        const int L = slot[0];
        if (L >= 1152) break;
        int kc = 0, base = 0;
        for (; kc < 8; ++kc) { const int n = 256 - 32 * kc; if (L < base + n) break; base += n; }
        const int u = 32 * kc + (L - base);
        const int q0 = 32 * u, qb = u >> 3;
        const int klim = (qb + 1) * 256;
        bf16x8 kf[2][4];
        { const int key0 = kc * 1024 + wid * 64;
#pragma unroll
            for (int b = 0; b < 2; ++b)
#pragma unroll
                for (int kk = 0; kk < 4; ++kk) kf[b][kk] = *(const bf16x8*)(KI + (size_t)(key0 + 32 * b + r32) * 64 + 16 * kk + 8 * hi); }
        {
            int t_ = tid; asm volatile("" : "+v"(t_));
            const bf16_t* src = QI + (size_t)q0 * 1024 + t_ * 8;
            const int ldst = (t_ >> 7) * QROW + (t_ & 127) * 16;
            u32x4 tq[8];
#pragma unroll
            for (int i = 0; i < 8; ++i) tq[i] = *(const u32x4*)(src + i * 4096);
            __builtin_amdgcn_sched_barrier(0);
#pragma unroll
            for (int i = 0; i < 8; ++i) *(LAS u32x4*)(lds + ldst + i * (4 * QROW)) = tq[i];
        }
        f32x4 wq[4];
#pragma unroll
        for (int i = 0; i < 4; ++i) wq[i] = *(const f32x4*)(WI + (size_t)(q0 + r32) * 16 + 4 * i);
        __syncthreads();
        for (int sl = wid; sl < 16; sl += 8) {
            const int key0 = kc * 1024 + sl * 64;
            if (key0 >= klim) continue;
            if (sl != wid) {
#pragma unroll
                for (int b = 0; b < 2; ++b)
#pragma unroll
                    for (int kk = 0; kk < 4; ++kk) kf[b][kk] = *(const bf16x8*)(KI + (size_t)(key0 + 32 * b + r32) * 64 + 16 * kk + 8 * hi); }
            f32x16 acc0 = {}, acc1 = {};
            const LAS unsigned char* qa = lds + r32 * QROW + hi * 16;
#define SC_MM(h, S0, S1) do { bf16x8 af_[4];                                                                                  \
                _Pragma("unroll") for (int kk = 0; kk < 4; ++kk) af_[kk] = *(const LAS bf16x8*)(qa + (h) * 128 + kk * 32);     \
                S0 = __builtin_amdgcn_mfma_f32_32x32x16_bf16(kf[0][0], af_[0], f32x16{}, 0, 0, 0); S1 = __builtin_amdgcn_mfma_f32_32x32x16_bf16(kf[1][0], af_[0], f32x16{}, 0, 0, 0); \
                _Pragma("unroll") for (int kk = 1; kk < 4; ++kk) { S0 = __builtin_amdgcn_mfma_f32_32x32x16_bf16(kf[0][kk], af_[kk], S0, 0, 0, 0); S1 = __builtin_amdgcn_mfma_f32_32x32x16_bf16(kf[1][kk], af_[kk], S1, 0, 0, 0); } } while (0)
#define SC_VA(h, S0, S1) do { const float w_ = wq[(h) >> 2][(h) & 3];                                                          \
                _Pragma("unroll") for (int r = 0; r < 16; ++r) { acc0[r] = fma_s(relu_i(S0[r]), w_, acc0[r]); acc1[r] = fma_s(relu_i(S1[r]), w_, acc1[r]); } } while (0)
#define SC_SB() __builtin_amdgcn_sched_barrier(0)
            f32x16 sA0, sA1, sB0, sB1;
            SC_MM(0, sA0, sA1); SC_SB();
            if (wid < 4) {
#pragma unroll
                for (int h = 0; h < 14; h += 2) {
                    SC_MM(h + 1, sB0, sB1); SC_SB(); SC_VA(h, sA0, sA1); SC_SB();
                    SC_MM(h + 2, sA0, sA1); SC_SB(); SC_VA(h + 1, sB0, sB1); SC_SB();
                }
                SC_MM(15, sB0, sB1); SC_SB(); SC_VA(14, sA0, sA1); SC_SB();
                SC_VA(15, sB0, sB1);
            } else {
                SC_MM(1, sB0, sB1); SC_SB();
#pragma unroll
                for (int h = 0; h < 14; h += 2) {
                    SC_VA(h, sA0, sA1); SC_SB(); SC_MM(h + 2, sA0, sA1); SC_SB();
                    SC_VA(h + 1, sB0, sB1); SC_SB(); SC_MM(h + 3, sB0, sB1); SC_SB();
                }
                SC_VA(14, sA0, sA1); SC_SB();
                SC_VA(15, sB0, sB1);
            }
#undef SC_SB
#undef SC_MM
#undef SC_VA
            float* out = SC + sc_block_base(qb) + (size_t)(q0 - qb * 256 + r32) * (size_t)klim + key0 + 4 * hi;
#pragma unroll
            for (int g = 0; g < 4; ++g) {
                *(f32x4*)(out + 8 * g) = (f32x4){acc0[4 * g], acc0[4 * g + 1], acc0[4 * g + 2], acc0[4 * g + 3]};
                *(f32x4*)(out + 32 + 8 * g) = (f32x4){acc1[4 * g], acc1[4 * g + 1], acc1[4 * g + 2], acc1[4 * g + 3]}; }
        }
    }
}

template <int VAR>
__device__ __forceinline__ void phase_select(int wv, const float* SC, unsigned long long* MASK, LAS unsigned char* lds) {
    const int tid = opaque_tid(wv), lane0 = tid & 63, wave = __builtin_amdgcn_readfirstlane(tid >> 6);
    LAS unsigned* hist = (LAS unsigned*)(lds + wave * 9216);
    const int gw = blockIdx.x * NWAVES + wave, NGW = gridDim.x * NWAVES;
    for (int q = gw; q < SEQ; q += NGW) {
        int lane = lane0; asm volatile("" : "+v"(lane));
        const int qb = q >> 8, klim = (qb + 1) * 256;
        const float* rowp = SC + sc_block_base(qb) + (size_t)(q - qb * 256) * (size_t)klim;
        const int ngrp = qb + 1;
        unsigned key[32][4];
#pragma unroll
        for (int g = 0; g < 8; ++g) {
            if (4 * g < ngrp) {
#pragma unroll
                for (int i = 0; i < 4; ++i) { const u32x4 v = *(const u32x4*)(rowp + 256 * (4 * g + i) + 4 * lane);
                    key[4 * g + i][0] = v.x; key[4 * g + i][1] = v.y; key[4 * g + i][2] = v.z; key[4 * g + i][3] = v.w; }
            } else {
#pragma unroll
                for (int i = 0; i < 4; ++i) { key[4 * g + i][0] = 0u; key[4 * g + i][1] = 0u; key[4 * g + i][2] = 0u; key[4 * g + i][3] = 0u; }
            }
        }
        unsigned T = 1u; unsigned need_eq = 0xffffffffu, n_eq = 0u;
        const bool radix = (q + 1 > TOPK) && (VAR != 1 && VAR != 3);
        if (VAR == 3) { unsigned x_ = 0u;
#pragma unroll
            for (int j = 0; j < 32; ++j) x_ |= key[j][0] & key[j][1] & key[j][2] & key[j][3];
            if (x_ == 0x12345u) MASK[q] = x_; continue; }
        if (radix) {
#pragma unroll
            for (int i = 0; i < 9; ++i) *(LAS u32x4*)(hist + 4 * (lane + 64 * i)) = (u32x4){0u, 0u, 0u, 0u};
        }
        __builtin_amdgcn_sched_barrier(0);
#pragma unroll
        for (int g = 0; g < 8; ++g) { if (4 * g < ngrp) {
#pragma unroll
            for (int i = 0; i < 4; ++i)
#pragma unroll
                for (int e = 0; e < 4; ++e) { const int j = 4 * g + i; const unsigned uu = key[j][e];
                    const unsigned kx = uu ^ ((unsigned)((int)uu >> 31) | 0x80000000u); key[j][e] = (256 * j + 4 * lane + e <= q) ? kx : 0u; }
            } __builtin_amdgcn_sched_barrier(0); }
        if (radix) {
            unsigned gm0 = 0u, gm1 = 0u, gm2 = 0u, gm3 = 0u;
#pragma unroll
            for (int g = 0; g < 8; ++g) if (4 * g < ngrp) {
#pragma unroll
                for (int i = 0; i < 4; ++i) { const int j = 4 * g + i; gm0 = key[j][0] > gm0 ? key[j][0] : gm0; gm1 = key[j][1] > gm1 ? key[j][1] : gm1; gm2 = key[j][2] > gm2 ? key[j][2] : gm2; gm3 = key[j][3] > gm3 ? key[j][3] : gm3; }
            }
            unsigned Pmin = gm0 < gm1 ? gm0 : gm1; { const unsigned p2 = gm2 < gm3 ? gm2 : gm3; Pmin = Pmin < p2 ? Pmin : p2; }
#pragma unroll
            for (int off = 1; off < 64; off <<= 1) { const unsigned tt = (unsigned)__builtin_amdgcn_ds_bpermute((lane ^ off) << 2, (int)Pmin); Pmin = tt < Pmin ? tt : Pmin; }
            LDS_WAIT();
#pragma unroll
            for (int g = 0; g < 8; ++g) if (4 * g < ngrp) {
#pragma unroll
                for (int i = 0; i < 4; ++i) {
#pragma unroll
                    for (int e = 0; e < 4; ++e) { const unsigned k = key[4 * g + i][e];
                        if (k >= Pmin) { const unsigned b = k >> 21; __hip_atomic_fetch_add(hist + b + ((b >> 5) << 2), 1u, __ATOMIC_RELAXED, __HIP_MEMORY_SCOPE_WORKGROUP); } }
                    __builtin_amdgcn_sched_barrier(0); }
            }
            unsigned prefix = 0u, pmask = 0u, kk = TOPK;
#pragma unroll 1
            for (int pass = 0; pass < ((VAR == 4) ? 1 : 3); ++pass) {
                const int shift = (pass == 0) ? 21 : (pass == 1) ? 10 : 0;
                const unsigned dmask = (pass == 2) ? 1023u : 2047u;
                LDS_WAIT();
                if (pass > 0) {
#pragma unroll
                    for (int g = 0; g < 8; ++g) if (4 * g < ngrp) {
#pragma unroll
                        for (int i = 0; i < 4; ++i) {
#pragma unroll
                            for (int e = 0; e < 4; ++e) { const unsigned k = key[4 * g + i][e];
                                if ((k & pmask) == prefix) { const unsigned b = (k >> shift) & dmask; __hip_atomic_fetch_add(hist + b + ((b >> 5) << 2), 1u, __ATOMIC_RELAXED, __HIP_MEMORY_SCOPE_WORKGROUP); } }
                            __builtin_amdgcn_sched_barrier(0); }
                    }
                }
                LDS_WAIT();
                if (VAR == 5) { prefix |= (0x5a5u & dmask) << shift; pmask |= dmask << shift; continue; }
                unsigned s = 0u;
#pragma unroll
                for (int i = 0; i < 8; ++i) { const u32x4 v = *(const LAS u32x4*)(hist + 36 * lane + 4 * i); s += (v.x + v.y) + (v.z + v.w); }
                unsigned suf = s;
#pragma unroll
                for (int off = 1; off < 64; off <<= 1) { const unsigned tt = (unsigned)__builtin_amdgcn_ds_bpermute(((lane + off) & 63) << 2, (int)suf); if (lane + off < 64) suf += tt; }
                const unsigned long long bal = __ballot(suf >= kk);
                const int Ls = 63 - __builtin_clzll(bal);
                const unsigned above1 = (unsigned)__builtin_amdgcn_readlane((int)(suf - s), Ls);
                const unsigned c2 = hist[36 * Ls + (lane & 31)];
                unsigned suf2 = (lane < 32) ? c2 : 0u;
#pragma unroll
                for (int off = 1; off < 32; off <<= 1) { const unsigned tt = (unsigned)__builtin_amdgcn_ds_bpermute(((lane + off) & 63) << 2, (int)suf2); if (lane + off < 32) suf2 += tt; }
                const unsigned long long bal2 = __ballot(lane < 32 && above1 + suf2 >= kk);
                const int Bs = 63 - __builtin_clzll(bal2);
                const int dsel = 32 * Ls + Bs;
                const unsigned cnt_b = (unsigned)__builtin_amdgcn_readlane((int)c2, Bs);
                const unsigned kk_new = kk - (above1 + (unsigned)__builtin_amdgcn_readlane((int)suf2, Bs) - cnt_b);
                LDS_WAIT();
#pragma unroll
                for (int i = 0; i < 9; ++i) *(LAS u32x4*)(hist + 4 * (lane + 64 * i)) = (u32x4){0u, 0u, 0u, 0u};
                const unsigned d = (unsigned)dsel; kk = kk_new; n_eq = cnt_b;
                prefix |= d << shift; pmask |= dmask << shift;
            }
            T = prefix; need_eq = kk;
        }
        if (VAR == 2 || VAR == 4 || VAR == 5) { if (T == 0x12345u) MASK[q] = T; continue; }
        const bool tie_path = (need_eq != 0xffffffffu) && (n_eq > need_eq);
        unsigned tie_seen = 0u;
        const unsigned long long lt = (lane == 0) ? 0ull : (~0ull >> (64 - lane));
        int w0lo = 0, w0hi = 0, w1lo = 0, w1hi = 0;
#pragma unroll
        for (int g = 0; g < 8; ++g) if (4 * g < ngrp) {
#pragma unroll
            for (int i = 0; i < 4; ++i) { const int j = 4 * g + i;
                unsigned long long B[4];
                if (!tie_path) {
#pragma unroll
                    for (int e = 0; e < 4; ++e) B[e] = __ballot(key[j][e] >= T);
                } else {
                    unsigned long long E[4]; unsigned before = tie_seen;
#pragma unroll
                    for (int e = 0; e < 4; ++e) { E[e] = __ballot(key[j][e] == T); before += (unsigned)__builtin_popcountll(E[e] & lt); }
                    unsigned mine = 0u;
#pragma unroll
                    for (int e = 0; e < 4; ++e) { const bool eq = (key[j][e] == T);
                        B[e] = __ballot(key[j][e] > T || (eq && (before + mine) < need_eq)); mine += eq ? 1u : 0u; }
#pragma unroll
                    for (int e = 0; e < 4; ++e) tie_seen += (unsigned)__builtin_popcountll(E[e]);
                }
#pragma unroll
                for (int k = 0; k < 4; ++k) { const int t = 4 * j + k;
                    const unsigned blo_ = (unsigned)((B[0] >> (16 * k)) & 0xffffull) | ((unsigned)((B[1] >> (16 * k)) & 0xffffull) << 16);
                    const unsigned bhi_ = (unsigned)((B[2] >> (16 * k)) & 0xffffull) | ((unsigned)((B[3] >> (16 * k)) & 0xffffull) << 16);
                    if (t < 64) asm volatile("s_nop 3\n\tv_writelane_b32 %0, %2, %4\n\tv_writelane_b32 %1, %3, %4" : "+v"(w0lo), "+v"(w0hi) : "s"(blo_), "s"(bhi_), "n"(t & 63));
                    else asm volatile("s_nop 3\n\tv_writelane_b32 %0, %2, %4\n\tv_writelane_b32 %1, %3, %4" : "+v"(w1lo), "+v"(w1hi) : "s"(blo_), "s"(bhi_), "n"(t & 63)); }
            }
        }
        const int ntile = 4 * ngrp;
        if (lane < ntile) MASK[(size_t)lane * SEQ + q] = ((unsigned long long)(unsigned)w0hi << 32) | (unsigned)w0lo;
        if (lane + 64 < ntile) MASK[(size_t)(lane + 64) * SEQ + q] = ((unsigned long long)(unsigned)w1hi << 32) | (unsigned)w1lo;
    }
}

__device__ __forceinline__ att::BlockRef attn_ref(int h, int qb, const bf16_t* Qh, const bf16_t* Kh, const bf16_t* Vh, bf16_t* O, const bf16_t* SG, const unsigned long long* MASK) {
    att::BlockRef r;
    r.Q = Qh + ((size_t)h * SEQ + (size_t)qb * 256) * HD; r.K = Kh + (size_t)h * SEQ * HD; r.V = Vh + (size_t)h * SEQ * HD;
    r.O = O + (size_t)qb * 256 * DM + h * HD; r.G = SG + (size_t)qb * 256 * DM + h * HD; r.M = MASK + qb * 256; r.P0 = qb * 256;
    return r;
}
__device__ __forceinline__ void phase_attn(int wv, const bf16_t* Qh, const bf16_t* Kh, const bf16_t* Vh, bf16_t* O, const bf16_t* SG, const unsigned long long* MASK, char* lds) {
    const int total = NHEAD * 16, stride = gridDim.x;
    int L = blockIdx.x; if (L >= total) return;
    if (gridDim.x == 256) { const int b = L; L = 16 * ((b & 7) + 8 * (b >> 7)) + ((b >> 3) & 15); }
    int pass = 0;
    att::BlockRef cur = attn_ref(L >> 4, L & 15, Qh, Kh, Vh, O, SG, MASK);
    att::Seam S;
    att::attn_prime(wv, cur, lds, S);
    for (;;) {
        const bool more_pass = pass == 0, more_item = L + stride < total, last = !more_pass && !more_item;
        int passn = pass + 1, Ln = L;
        if (!more_pass) { passn = 0; Ln = more_item ? L + stride : L; }
        const int hn = Ln >> 4, xn = Ln & 15;
        const att::BlockRef nxt = last ? cur : attn_ref(hn, passn ? 31 - xn : xn, Qh, Kh, Vh, O, SG, MASK);
        att::attn_block(wv, cur, nxt, lds, S);
        if (last) break;
        cur = nxt; pass = passn; L = Ln;
    }
}

__global__ void __launch_bounds__(NTHR, 2) trunk_fwd(Args args) {
    extern __shared__ __attribute__((aligned(16))) unsigned char lds_raw[];
    LAS unsigned char* lds = (LAS unsigned char*)lds_raw;
    volatile LAS unsigned* MISC = (volatile LAS unsigned*)(lds + MISC_OFF);
    const int wv = __builtin_amdgcn_readfirstlane((int)threadIdx.x >> 6);
    const int tid = opaque_tid(wv);
    unsigned char* ws = args.ws;
    if (tid < 32) MISC[tid] = 0u;
    __syncthreads();
    XcdBarrier bar; bar.bar = (unsigned*)(ws + WS_CTL) + 1024; bar.x = 0; bar.st = nullptr;
    if (MK_ONE_LAUNCH) bar = xcd_barrier_post((unsigned*)(ws + WS_CTL) + 1024, MISC + 8);
    const int lo = args.ph_lo, hi = args.ph_hi;
    int ph = 0;
#ifndef PHASE_MASK
#define PHASE_MASK 0xFFFF
#endif
#define IN(k) (lo <= (k) && (k) < hi)
#define PM(b) ((PHASE_MASK >> (b)) & 1)
#ifndef DUP_MASK
#define DUP_MASK 0
#endif
#ifndef SC_VAR
#define SC_VAR 0
#endif
#define DUP(b) ((DUP_MASK >> (b)) & 1)
#define REDO(b, stmt) do { if (DUP(b)) { if (MK_ONE_LAUNCH) xcd_barrier(bar); else __syncthreads(); stmt; } } while (0)
#ifndef ECHO_MASK
#define ECHO_MASK 0
#endif
#define ECHO_K 4
    unsigned long long echo_acc = 0ull, echo_prev = ECHO_MASK ? __builtin_amdgcn_s_memrealtime() : 0ull;
#define SEAM(b) do { if (IN(ph) && IN(ph + 1)) xcd_barrier(bar); ++ph; \
        if (ECHO_MASK) { const unsigned long long now_ = __builtin_amdgcn_s_memrealtime(); if ((ECHO_MASK >> (b)) & 1) echo_acc += now_ - echo_prev; echo_prev = now_; } } while (0)

    float* mod = (float*)(ws + WS_MOD);
    bf16_t* HU = (bf16_t*)(ws + WS_HU);
    const float* cosq = (const float*)(ws + WS_TAB); const float* sinq = cosq + SEQ * 16; const float* cosi = sinq + SEQ * 16; const float* sini = cosi + SEQ * 8;
    const int G = gridDim.x, bx = blockIdx.x;

    if (PM(0) && IN(ph)) { phase0<0>(wv, args, lds); REDO(0, phase0<SC_VAR>(wv, args, lds)); }
    SEAM(0);
#pragma unroll 1
    for (int layer = 0; layer < 4; ++layer) {
        const int j = layer >> 1;
        bf16_t* XB = (bf16_t*)(ws + WS_XB);
        float* lgs = (float*)mod + 16 * 6144 + layer * DM;
        const float* lmod = mod + layer * 4 * 6144;
        if (PM(1) && IN(ph)) { if (layer == 0) phase_norm<false>(wv, args.x, args.norm_g, lmod, HU, lds_raw, lgs); else phase_norm<true>(wv, XB, args.norm_g + layer * DM, lmod, HU, lds_raw, lgs); }
        SEAM(1);
        if ((layer & 1) == 0) {
            bf16_t* VG = (bf16_t*)(ws + WS_VG); bf16_t* PL = (bf16_t*)(ws + WS_PL);
            if (PM(2) && IN(ph)) { pg8::Gemm g{HU, (const bf16_t*)(ws + WS_WPI) + (size_t)j * POOL_IN * DM, SEQ, POOL_IN, DM, DM, DM, 0, 0};
                pg8::StaticOrder S; S.init(SEQ, POOL_IN, G, bx); pg8::EpiBf16 E{VG, POOL_IN};
                pg8::gemm_phase<pg8::EpiBf16, true>(wv, lds, g, S, E); REDO(2, (pg8::gemm_phase<pg8::EpiBf16, true>(wv, lds, g, S, E))); }
            SEAM(2);
            if (PM(3) && IN(ph)) { phase_pool(wv, VG, PL); REDO(3, phase_pool(wv, VG, PL)); }
            SEAM(3);
            if (PM(4) && IN(ph)) { pg8::Gemm g{PL, (const bf16_t*)(ws + WS_WPG) + (size_t)j * DM * 512, SEQ, DM, 512, DM, 512, 1, 512};
                pg8::StaticOrder S; S.init(SEQ, DM, G, bx); pg8::EpiPoolGrp E{HU, VG, args.pls + j * DM};
                pg8::gemm_phase<pg8::EpiPoolGrp, true>(wv, lds, g, S, E); REDO(4, (pg8::gemm_phase<pg8::EpiPoolGrp, true>(wv, lds, g, S, E))); }
            SEAM(4);
            if (PM(5) && IN(ph)) { pg8::Gemm g{HU, (const bf16_t*)(ws + WS_WPO) + (size_t)j * DM * DM, SEQ, DM, DM, DM, DM, 0, 0};
                pg8::StaticOrder S; S.init(SEQ, DM, G, bx);
                if (layer == 0) { pg8::EpiResid<false, true> E{args.x, XB, lgs}; pg8::gemm_phase<pg8::EpiResid<false, true>, true>(wv, lds, g, S, E); }
                else { pg8::EpiResid<true, true> E{XB, XB, lgs}; pg8::gemm_phase<pg8::EpiResid<true, true>, true>(wv, lds, g, S, E); } }
            SEAM(5);
        } else {
            bf16_t* Qh = (bf16_t*)(ws + WS_Q); bf16_t* Kh = (bf16_t*)(ws + WS_K); bf16_t* Vh = (bf16_t*)(ws + WS_V); bf16_t* SG = (bf16_t*)(ws + WS_GATE);
            bf16_t* QI = (bf16_t*)(ws + WS_QI); bf16_t* KI = (bf16_t*)(ws + WS_KI); float* WI = (float*)(ws + WS_WI);
            unsigned long long* MASK = (unsigned long long*)(ws + WS_MASK); float* SC = (float*)(ws + WS_SC);
            if (PM(6) && IN(ph)) { pg8::Gemm g{HU, (const bf16_t*)(ws + WS_WAI) + (size_t)j * ATTN_INP * DM, SEQ, ATTN_INP, DM, DM, DM, 0, 0};
                pg8::StaticOrder S; S.init(SEQ, ATTN_INP, G, bx); pg8::EpiAttnIn E{ws, args.pos};
                pg8::gemm_phase<pg8::EpiAttnIn, true>(wv, lds, g, S, E); REDO(6, (pg8::gemm_phase<pg8::EpiAttnIn, true>(wv, lds, g, S, E))); }
            SEAM(6);
            if (PM(7) && IN(ph)) { unsigned* qctr = (unsigned*)(ws + WS_CTL) + 8192 + 128 * j; phase_scores<0>(wv, QI, KI, WI, SC, lds, qctr); REDO(7, phase_scores<SC_VAR>(wv, QI, KI, WI, (float*)(ws + WS_END), lds, qctr + 64)); }
            SEAM(7);
            if (PM(8) && IN(ph)) { phase_select<0>(wv, SC, MASK, lds); REDO(8, phase_select<SC_VAR>(wv, SC, (unsigned long long*)(ws + WS_END), lds)); }
            SEAM(8);
            if (PM(9) && IN(ph)) { phase_attn(wv, Qh, Kh, Vh, HU, SG, MASK, (char*)lds_raw); REDO(9, phase_attn(wv, Qh, Kh, Vh, HU, SG, MASK, (char*)lds_raw)); }
            SEAM(9);
            if (PM(5) && IN(ph)) { pg8::Gemm g{HU, (const bf16_t*)(ws + WS_WAO) + (size_t)j * DM * DM, SEQ, DM, DM, DM, DM, 0, 0};
                pg8::StaticOrder S; S.init(SEQ, DM, G, bx);
                { pg8::EpiResid<true, true> E{XB, XB, lgs}; pg8::gemm_phase<pg8::EpiResid<true, true>, true>(wv, lds, g, S, E); } }
            SEAM(5);
        }
    }
    if (PM(10) && IN(ph)) { phase_final(wv, (const bf16_t*)(ws + WS_XB), args.out, args.fg); REDO(10, phase_final(wv, (const bf16_t*)(ws + WS_XB), args.out, args.fg)); }
    if (ECHO_MASK) { if ((ECHO_MASK >> 10) & 1) echo_acc += __builtin_amdgcn_s_memrealtime() - echo_prev;
        if (bx == 0) { const unsigned long long target_ = __builtin_amdgcn_s_memrealtime() + (unsigned long long)ECHO_K * echo_acc; while (__builtin_amdgcn_s_memrealtime() < target_) __builtin_amdgcn_s_sleep(32); } }
#undef IN
#undef PM
#undef SEAM
#undef REDO
}
constexpr int N_PHASES = 1 + 2 * 5 + 2 * 6 + 1;

extern "C" void kernel_launch(void* const* d_in, const int* in_sizes, int n_in, void* d_out, int out_size, void* d_ws, size_t ws_size, hipStream_t stream) {
    static int grid = 0;
    if (grid == 0) {
        if (n_in != 13 || in_sizes[0] != SEQ * DM || out_size != SEQ * DM || ws_size < WS_END) {
            fprintf(stderr, "kernel_launch: unexpected shapes / workspace (n_in %d, in0 %d, out %d, ws %zu, need %zu)\n", n_in, n_in > 0 ? in_sizes[0] : -1, out_size, ws_size, (size_t)WS_END);
            grid = -1; return; }
        int dev = 0, cus = 0, per_cu = 0;
        if (hipGetDevice(&dev) != hipSuccess || hipDeviceGetAttribute(&cus, hipDeviceAttributeMultiprocessorCount, dev) != hipSuccess) { grid = -1; return; }
        if (hipFuncSetAttribute((const void*)trunk_fwd, hipFuncAttributeMaxDynamicSharedMemorySize, LDS_BYTES) != hipSuccess) { fprintf(stderr, "kernel_launch: hipFuncSetAttribute failed\n"); grid = -1; return; }
        if (hipOccupancyMaxActiveBlocksPerMultiprocessor(&per_cu, (const void*)trunk_fwd, NTHR, LDS_BYTES) != hipSuccess || per_cu < 1) {
            fprintf(stderr, "kernel_launch: occupancy query reports %d workgroups per CU\n", per_cu); per_cu = 1; }
        (void)hipGetLastError();
        grid = cus;
        if (grid > 256) grid = 256;
    }
    if (grid < 0) return;
    (void)hipMemsetAsync((char*)d_ws + WS_CTL, 0, CTL_ZERO_BYTES, stream);
    Args a{};
    a.x = (const float*)d_in[0]; a.c = (const float*)d_in[1]; a.pos = (const int*)d_in[2]; a.norm_g = (const float*)d_in[3];
    a.mod_w = (const float*)d_in[4]; a.mod_b = (const float*)d_in[5]; a.pwi = (const float*)d_in[6]; a.pwg = (const float*)d_in[7];
    a.pls = (const float*)d_in[8]; a.pwo = (const float*)d_in[9]; a.awi = (const float*)d_in[10]; a.awo = (const float*)d_in[11]; a.fg = (const float*)d_in[12];
    a.out = (float*)d_out; a.ws = (unsigned char*)d_ws;
#if MK_ONE_LAUNCH
    a.ph_lo = 0; a.ph_hi = N_PHASES;
    hipLaunchKernelGGL(trunk_fwd, dim3(grid), dim3(NTHR), LDS_BYTES, stream, a);
#else
    for (int p = 0; p < N_PHASES; ++p) { a.ph_lo = p; a.ph_hi = p + 1; hipLaunchKernelGGL(trunk_fwd, dim3(grid), dim3(NTHR), LDS_BYTES, stream, a); }
#endif
}
```

```cpp
#include <hip/hip_runtime.h>
#include <cstdio>
#include <cstdint>
#include <cmath>

#ifndef MK_ONE_LAUNCH
#define MK_ONE_LAUNCH 1
#endif

#define LAS __attribute__((address_space(3)))
#define GAS __attribute__((address_space(1)))
typedef unsigned short bf16_t;
typedef short bf16x8 __attribute__((ext_vector_type(8)));
typedef short s16x4 __attribute__((ext_vector_type(4)));
typedef float f32x4 __attribute__((ext_vector_type(4)));
typedef float f32x2 __attribute__((ext_vector_type(2)));
typedef float f32x16 __attribute__((ext_vector_type(16)));
typedef unsigned u32x4 __attribute__((ext_vector_type(4)));
typedef unsigned u32x2 __attribute__((ext_vector_type(2)));

constexpr int DM = 2048, SEQ = 8192, NHEAD = 16, HD = 128, IDXH = 16, IDXD = 64;
constexpr int POOL_IN = 4096, ATTN_IN = 9296, ATTN_INP = 9472  ;
constexpr int TOPK = 256;
constexpr float EPS = 1e-6f;

constexpr size_t MiB = 1u << 20;
constexpr size_t WS_CTL = 0, CTL_ZERO_BYTES = 64 * 1024;
constexpr size_t WS_MOD = 1 * MiB;
constexpr size_t WS_TAB = 2 * MiB;
constexpr size_t WS_WPI = 4 * MiB;
constexpr size_t WS_WPG = 36 * MiB;
constexpr size_t WS_WPO = 40 * MiB;
constexpr size_t WS_WAI = 56 * MiB;
constexpr size_t WS_WAO = 130 * MiB;
constexpr size_t WS_HU = 146 * MiB;
constexpr size_t WS_L = 178 * MiB;
constexpr size_t WS_VG = WS_L;
constexpr size_t WS_PL = WS_L + 64 * MiB;
constexpr size_t WS_Q = WS_L, WS_K = WS_L + 32 * MiB, WS_V = WS_L + 64 * MiB;
constexpr size_t WS_GATE = WS_L + 96 * MiB;
constexpr size_t WS_QI = WS_L + 128 * MiB;
constexpr size_t WS_KI = WS_L + 144 * MiB;
constexpr size_t WS_WI = WS_L + 145 * MiB;
constexpr size_t WS_MASK = WS_L + 146 * MiB;
constexpr size_t WS_SC = WS_L + 154 * MiB;
constexpr size_t WS_XB = WS_SC + 139 * MiB;
constexpr size_t WS_END = WS_XB + 32 * MiB;

__device__ __forceinline__ unsigned cvt_pk_bf16(float lo, float hi) { unsigned r; asm volatile("v_cvt_pk_bf16_f32 %0, %1, %2" : "=v"(r) : "v"(lo), "v"(hi)); return r; }
__device__ __forceinline__ unsigned f2bf(float f) { unsigned u = __builtin_bit_cast(unsigned, f); return (u + 0x7fffu + ((u >> 16) & 1u)) >> 16; }
__device__ __forceinline__ unsigned pk2(float lo, float hi) { return f2bf(lo) | (f2bf(hi) << 16); }
__device__ __forceinline__ float bf2f(unsigned short b) { return __builtin_bit_cast(float, (unsigned)b << 16); }
__device__ __forceinline__ float fast_sigmoid(float x) { return __builtin_amdgcn_rcpf(1.0f + __builtin_amdgcn_exp2f(-1.4426950408889634f * x)); }
__device__ __forceinline__ float silu_f(float x) { return x * fast_sigmoid(x); }
template <int X> __device__ __forceinline__ float swz_xor(float v) {
    return __builtin_bit_cast(float, __builtin_amdgcn_ds_swizzle(__builtin_bit_cast(int, v), (X << 10) | 0x1f)); }
__device__ __forceinline__ float wave_sum(float v) {
    v += swz_xor<1>(v); v += swz_xor<2>(v); v += swz_xor<4>(v); v += swz_xor<8>(v); v += swz_xor<16>(v);
    const auto rr = __builtin_amdgcn_permlane32_swap(__builtin_bit_cast(unsigned, v), __builtin_bit_cast(unsigned, v), false, false);
    const unsigned r0 = rr[0], r1 = rr[1];
    return __builtin_bit_cast(float, r0) + __builtin_bit_cast(float, r1);
}
__device__ __forceinline__ int opaque_tid(int wv) { int t; asm volatile("v_mbcnt_lo_u32_b32 %0, -1, 0\n\tv_mbcnt_hi_u32_b32 %0, -1, %0\n\tv_lshl_add_u32 %0, %1, 6, %0" : "=&v"(t) : "s"(wv)); return t; }
#define LDS_WAIT() asm volatile("s_waitcnt lgkmcnt(0)" ::: "memory")
#define VM_WAIT() asm volatile("s_waitcnt vmcnt(0)" ::: "memory")

__device__ __forceinline__ void unpack8(const u32x4 w, f32x4& a, f32x4& b) {
    const unsigned w0 = w.x, w1 = w.y, w2 = w.z, w3 = w.w;
    a = (f32x4){__builtin_bit_cast(float, w0 << 16), __builtin_bit_cast(float, w0 & 0xffff0000u), __builtin_bit_cast(float, w1 << 16), __builtin_bit_cast(float, w1 & 0xffff0000u)};
    b = (f32x4){__builtin_bit_cast(float, w2 << 16), __builtin_bit_cast(float, w2 & 0xffff0000u), __builtin_bit_cast(float, w3 << 16), __builtin_bit_cast(float, w3 & 0xffff0000u)};
}
__device__ __forceinline__ u32x4 pack8(const f32x4 a, const f32x4 b) { u32x4 w; w.x = cvt_pk_bf16(a[0], a[1]); w.y = cvt_pk_bf16(a[2], a[3]); w.z = cvt_pk_bf16(b[0], b[1]); w.w = cvt_pk_bf16(b[2], b[3]); return w; }

constexpr float ATT_QSCALE = 0.08838834764831845f * 1.4426950408889634f;
namespace pg8 {
constexpr int BM = 256, BK = 64, HALF = 128, HTB = HALF * BK * 2, STAGE_BYTES = 8 * HTB, NXCD = 8, WGM = 8;
__host__ __device__ __forceinline__ int lds_byte(int r, int c) { const int st = (r >> 4) * 2 + (c >> 5), rr = r & 15, cc = c & 31, ob = rr * 64 + cc * 2; return st * 1024 + (ob ^ (((ob >> 9) & 1) << 5)); }
__host__ __device__ __forceinline__ void stage_rc(int b, int& R, int& C) { const int st = b / 1024, sb = b % 1024, swz = sb ^ (((sb >> 9) & 1) << 5); R = (st >> 1) * 16 + swz / 64; C = (st & 1) * 32 + (swz % 64) / 2; }
__host__ __device__ __forceinline__ int perm32(int rho) { const int n = rho >> 4, i = rho & 15; return 8 * (i >> 2) + 4 * n + (i & 3); }

struct Unit { int pm, pn; };
struct Gemm { const bf16_t* A; const bf16_t* Bt; int M, N, K, lda, ldb, agsh, agstride; };

struct StaticOrder {
    int nM, nN, nwg, G, c;
    __host__ __device__ void init(int M, int N, int G_, int c_) { nM = M / BM; nN = N / BM; nwg = nM * nN; G = G_; c = c_; }
    __host__ __device__ bool next(int i, Unit& u) const {
        const long L = (long)i * G + c; if (L >= nwg) return false;
        int wgid = (int)L; { const int q = nwg / NXCD, r = nwg % NXCD, xcd = wgid % NXCD, off = wgid / NXCD; wgid = (xcd < r ? xcd * (q + 1) : r * (q + 1) + (xcd - r) * q) + off; }
        const int nig = WGM * nN, gid = wgid / nig, fm = gid * WGM, gsz = (nM - fm) < WGM ? (nM - fm) : WGM;
        u.pm = fm + ((wgid % nig) % gsz); u.pn = (wgid % nig) / gsz; return true;
    }
};

template <class Epi, bool ALIGN_EPI>
__device__ __forceinline__ void gemm_phase(int wv, LAS unsigned char* lds, const Gemm g, const StaticOrder& S, const Epi& E) {
    const int tid = opaque_tid(wv), wid = __builtin_amdgcn_readfirstlane(tid >> 6), lane = tid & 63, wr = wid >> 2, wc = wid & 3, fr = lane & 15, fq = lane >> 4;
    const int K = g.K, nt = K / BK;
    unsigned voffA[2], voffB[2];
#pragma unroll
    for (int i = 0; i < 2; ++i) { int R, C; stage_rc(tid * 16 + i * 8192, R, C); const int Rb = Epi::PERM ? ((R & ~31) + perm32(R & 31)) : R;
        voffA[i] = (unsigned)(R * g.lda + C) * 2u; voffB[i] = (unsigned)(Rb * g.ldb + C) * 2u; }
    const size_t kstep = (size_t)(BK * 2);
    const size_t hstepA = (size_t)HALF * g.lda * 2, hstepB = (size_t)HALF * g.ldb * 2;
    const size_t tstepA = 2 * hstepA, tstepB = 2 * hstepB;
    const unsigned ldsw = (unsigned)wid * 1024u;
    const int aoff = lds_byte(wr * 64 + fr, fq * 8), boff = lds_byte(wc * 32 + fr, fq * 8);
#define PG8_SA(b, h) (((b) * 2 + (h)) * HTB)
#define PG8_SB(b, h) ((4 + (b) * 2 + (h)) * HTB)
#define PG8_STAGE(bufoff, gbase, voff) do { _Pragma("unroll") for (int _i = 0; _i < 2; ++_i) \
        __builtin_amdgcn_global_load_lds((const unsigned*)((const char*)(gbase) + (voff)[_i]), (LAS unsigned*)(lds + (bufoff) + ldsw + _i * 8192), 16, 0, 0); } while (0)
#define PG8_LDA(dst, b, h) do { _Pragma("unroll") for (int m = 0; m < 4; ++m) _Pragma("unroll") for (int k = 0; k < 2; ++k) dst[m][k] = *(const LAS bf16x8*)(lds + PG8_SA(b, h) + aoff + m * 2048 + k * 1024); } while (0)
#define PG8_LDB(dst, b, h) do { _Pragma("unroll") for (int n = 0; n < 2; ++n) _Pragma("unroll") for (int k = 0; k < 2; ++k) dst[n][k] = *(const LAS bf16x8*)(lds + PG8_SB(b, h) + boff + n * 2048 + k * 1024); } while (0)
#define PG8_MMA(ai, bj, At, Bt) do { __builtin_amdgcn_s_setprio(1); _Pragma("unroll") for (int m = 0; m < 4; ++m) _Pragma("unroll") for (int n = 0; n < 2; ++n) _Pragma("unroll") for (int k = 0; k < 2; ++k) \
        acc[ai][bj][m][n] = __builtin_amdgcn_mfma_f32_16x16x32_bf16(Bt[n][k], At[m][k], acc[ai][bj][m][n], 0, 0, 0); __builtin_amdgcn_s_setprio(0); } while (0)
#define PG8_WAIT_V(n) asm volatile("s_waitcnt vmcnt(" #n ")" ::: "memory")
#define PG8_WAIT_L(n) asm volatile("s_waitcnt lgkmcnt(" #n ")" ::: "memory")
#define PG8_BAR __builtin_amdgcn_s_barrier()
#define PG8_SCHED __builtin_amdgcn_sched_barrier(0)
#define PG8_AOFF(u) ((size_t)(u).pm * tstepA + (size_t)(((u).pn >> g.agsh) * g.agstride) * 2)
    Unit cur, nxt; int ui = 0;
    if (!S.next(0, cur)) return;
    f32x4 acc[2][2][4][2];
#pragma unroll
    for (int a = 0; a < 2; ++a)
#pragma unroll
        for (int b = 0; b < 2; ++b)
#pragma unroll
            for (int m = 0; m < 4; ++m)
#pragma unroll
                for (int n = 0; n < 2; ++n) acc[a][b][m][n] = (f32x4){0.f, 0.f, 0.f, 0.f};
    bf16x8 At[4][2], B0[2][2], B1[2][2];
    const char* cA = (const char*)g.A + PG8_AOFF(cur); const char* cB = (const char*)g.Bt + (size_t)cur.pn * tstepB;
    PG8_STAGE(PG8_SB(0, 0), cB, voffB); PG8_STAGE(PG8_SB(0, 1), cB + hstepB, voffB); PG8_STAGE(PG8_SA(0, 0), cA, voffA); PG8_STAGE(PG8_SA(0, 1), cA + hstepA, voffA);
    if (wr == 1) PG8_BAR;
    PG8_WAIT_V(2); PG8_BAR;
    PG8_STAGE(PG8_SB(1, 0), cB + kstep, voffB); PG8_STAGE(PG8_SA(1, 0), cA + kstep, voffA); PG8_STAGE(PG8_SB(1, 1), cB + hstepB + kstep, voffB);
    PG8_WAIT_V(6); PG8_BAR;
    for (;;) {
        const bool has_next = S.next(ui + 1, nxt);
        const char* nA = has_next ? (const char*)g.A + PG8_AOFF(nxt) : cA; const char* nB = has_next ? (const char*)g.Bt + (size_t)nxt.pn * tstepB : cB;
        for (int t = 0; t < nt; t += 2) {
            const bool last = (t == nt - 2);
            const char* a1 = cA + (size_t)(t + 1) * kstep;
            const char* a2 = last ? nA : cA + (size_t)(t + 2) * kstep; const char* b2 = last ? nB : cB + (size_t)(t + 2) * kstep;
            const char* a3 = a2 + kstep; const char* b3 = b2 + kstep;
            PG8_LDB(B0, 0, 0); PG8_LDB(B1, 0, 1); PG8_SCHED; PG8_LDA(At, 0, 0); PG8_STAGE(PG8_SA(1, 1), a1 + hstepA, voffA);
            PG8_WAIT_V(8); PG8_WAIT_L(0); PG8_BAR; PG8_MMA(0, 0, At, B0); PG8_MMA(0, 1, At, B1); PG8_BAR; PG8_SCHED;
            PG8_LDA(At, 0, 1); PG8_STAGE(PG8_SB(0, 0), b2, voffB); PG8_STAGE(PG8_SB(0, 1), b2 + hstepB, voffB); PG8_STAGE(PG8_SA(0, 0), a2, voffA);
            PG8_WAIT_V(8); PG8_WAIT_L(0); PG8_BAR; PG8_MMA(1, 0, At, B0); PG8_MMA(1, 1, At, B1); PG8_BAR; PG8_SCHED;
            PG8_LDB(B0, 1, 0); PG8_LDB(B1, 1, 1); PG8_SCHED; PG8_LDA(At, 1, 0); PG8_STAGE(PG8_SA(0, 1), a2 + hstepA, voffA);
            PG8_WAIT_V(8); PG8_WAIT_L(0); PG8_BAR; PG8_MMA(0, 0, At, B0); PG8_MMA(0, 1, At, B1); PG8_BAR; PG8_SCHED;
            PG8_LDA(At, 1, 1); PG8_STAGE(PG8_SB(1, 0), b3, voffB); PG8_STAGE(PG8_SB(1, 1), b3 + hstepB, voffB); PG8_STAGE(PG8_SA(1, 0), a3, voffA);
            PG8_WAIT_V(8); PG8_WAIT_L(0); PG8_BAR; PG8_MMA(1, 0, At, B0); PG8_MMA(1, 1, At, B1); PG8_BAR; PG8_SCHED;
        }
        if constexpr (ALIGN_EPI) { if (wr == 0) PG8_BAR; }
        E(acc, cur, wr, wc, fr, fq);
        if (!has_next) break;
#pragma unroll
        for (int a = 0; a < 2; ++a)
#pragma unroll
            for (int b = 0; b < 2; ++b)
#pragma unroll
                for (int m = 0; m < 4; ++m)
#pragma unroll
                    for (int n = 0; n < 2; ++n) acc[a][b][m][n] = (f32x4){0.f, 0.f, 0.f, 0.f};
        cur = nxt; cA = nA; cB = nB; ++ui;
        if constexpr (ALIGN_EPI) { if (wr == 1) PG8_BAR; }
    }
    PG8_WAIT_V(0);
    if constexpr (!ALIGN_EPI) { if (wr == 0) PG8_BAR; }
    PG8_BAR;
#undef PG8_SA
#undef PG8_SB
#undef PG8_STAGE
#undef PG8_LDA
#undef PG8_LDB
#undef PG8_MMA
#undef PG8_WAIT_V
#undef PG8_WAIT_L
#undef PG8_BAR
#undef PG8_SCHED
#undef PG8_AOFF
}

struct EpiBf16 {
    static constexpr bool PERM = true;
    bf16_t* O; int ldc;
    __device__ __forceinline__ void operator()(const f32x4 (&acc)[2][2][4][2], const Unit& u, int wr, int wc, int fr, int fq) const {
        const int row0 = u.pm * BM + wr * 64 + fr; const int col0 = u.pn * BM + wc * 32 + 8 * fq;
#pragma unroll
        for (int ai = 0; ai < 2; ++ai)
#pragma unroll
            for (int m = 0; m < 4; ++m) { bf16_t* rowp = O + (size_t)(row0 + ai * HALF + m * 16) * ldc + col0;
#pragma unroll
                for (int bj = 0; bj < 2; ++bj) { const f32x4 v0 = acc[ai][bj][m][0], v1 = acc[ai][bj][m][1];
                    u32x4 w; w.x = cvt_pk_bf16(v0[0], v0[1]); w.y = cvt_pk_bf16(v0[2], v0[3]); w.z = cvt_pk_bf16(v1[0], v1[1]); w.w = cvt_pk_bf16(v1[2], v1[3]);
                    *(u32x4*)(rowp + bj * HALF) = w; } }
    }
};
struct EpiPoolGrp {
    static constexpr bool PERM = true;
    bf16_t* U; const bf16_t* VG; const float* ls;
    __device__ __forceinline__ void operator()(const f32x4 (&acc)[2][2][4][2], const Unit& u, int wr, int wc, int fr, int fq) const {
        const int row0 = u.pm * BM + wr * 64 + fr; const int col0 = u.pn * BM + wc * 32 + 8 * fq;
        f32x4 lv[2][2];
#pragma unroll
        for (int bj = 0; bj < 2; ++bj)
#pragma unroll
            for (int n = 0; n < 2; ++n) lv[bj][n] = *(const f32x4*)(ls + col0 + bj * HALF + 4 * n);
#pragma unroll
        for (int ai = 0; ai < 2; ++ai) {
            u32x4 gw[4][2];
#pragma unroll
            for (int m = 0; m < 4; ++m)
#pragma unroll
                for (int bj = 0; bj < 2; ++bj) gw[m][bj] = *(const u32x4*)(VG + (size_t)(row0 + ai * HALF + m * 16) * POOL_IN + DM + col0 + bj * HALF);
            __builtin_amdgcn_sched_barrier(0);
#pragma unroll
            for (int m = 0; m < 4; ++m) { const size_t row = (size_t)(row0 + ai * HALF + m * 16);
#pragma unroll
                for (int bj = 0; bj < 2; ++bj) {
                    f32x4 v0 = acc[ai][bj][m][0] * lv[bj][0], v1 = acc[ai][bj][m][1] * lv[bj][1];
                    f32x4 g0, g1; unpack8(gw[m][bj], g0, g1);
#pragma unroll
                    for (int e = 0; e < 4; ++e) { v0[e] *= silu_f(g0[e]); v1[e] *= silu_f(g1[e]); }
                    *(u32x4*)(U + row * DM + col0 + bj * HALF) = pack8(v0, v1); } }
            __builtin_amdgcn_sched_barrier(0); }
    }
};
template <bool IN_BF16, bool OUT_BF16> struct EpiResid {
    static constexpr bool PERM = true;
    const void* xin; void* xout; const float* gmod;
    __device__ __forceinline__ void operator()(const f32x4 (&acc)[2][2][4][2], const Unit& u, int wr, int wc, int fr, int fq) const {
        const int row0 = u.pm * BM + wr * 64 + fr; const int col0 = u.pn * BM + wc * 32 + 8 * fq;
        f32x4 gv[2][2];
#pragma unroll
        for (int bj = 0; bj < 2; ++bj)
#pragma unroll
            for (int n = 0; n < 2; ++n) gv[bj][n] = *(const f32x4*)(gmod + col0 + bj * HALF + 4 * n);
#pragma unroll
        for (int ai = 0; ai < 2; ++ai)
#pragma unroll
          for (int mh = 0; mh < (IN_BF16 ? 1 : 2); ++mh) {
            constexpr int MB = IN_BF16 ? 4 : 2;
            u32x4 rw[MB][2]; f32x4 rf[MB][2][2];
#pragma unroll
            for (int mm = 0; mm < MB; ++mm)
#pragma unroll
                for (int bj = 0; bj < 2; ++bj) { const size_t off = (size_t)(row0 + ai * HALF + (mh * MB + mm) * 16) * DM + col0 + bj * HALF;
                    if (IN_BF16) rw[mm][bj] = *(const u32x4*)((const bf16_t*)xin + off);
                    else { rf[mm][bj][0] = *(const f32x4*)((const float*)xin + off); rf[mm][bj][1] = *(const f32x4*)((const float*)xin + off + 4); } }
            __builtin_amdgcn_sched_barrier(0);
#pragma unroll
            for (int mm = 0; mm < MB; ++mm)
#pragma unroll
                for (int bj = 0; bj < 2; ++bj) { const int m = mh * MB + mm; const size_t off = (size_t)(row0 + ai * HALF + m * 16) * DM + col0 + bj * HALF;
                    f32x4 b0, b1;
                    if (IN_BF16) unpack8(rw[mm][bj], b0, b1); else { b0 = rf[mm][bj][0]; b1 = rf[mm][bj][1]; }
                    const f32x4 y0 = b0 + gv[bj][0] * acc[ai][bj][m][0], y1 = b1 + gv[bj][1] * acc[ai][bj][m][1];
                    if (OUT_BF16) *(u32x4*)((bf16_t*)xout + off) = pack8(y0, y1);
                    else { *(f32x4*)((float*)xout + off) = y0; *(f32x4*)((float*)xout + off + 4) = y1; } }
            __builtin_amdgcn_sched_barrier(0); }
    }
};
struct EpiAttnIn {
    static constexpr bool PERM = true;
    unsigned char* ws; const int* pos;
    __device__ __forceinline__ void operator()(const f32x4 (&acc)[2][2][4][2], const Unit& u, int wr, int wc, int fr, int fq) const {
        const int row0 = u.pm * BM + wr * 64 + fr; const int pn = u.pn;
        bf16_t* const Qh = (bf16_t*)(ws + WS_Q); bf16_t* const SG = (bf16_t*)(ws + WS_GATE); bf16_t* const QI = (bf16_t*)(ws + WS_QI); bf16_t* const KI = (bf16_t*)(ws + WS_KI); float* const WI = (float*)(ws + WS_WI);
        const float* const cosq = (const float*)(ws + WS_TAB); const float* const sinq = cosq + SEQ * 16; const float* const cosi = sinq + SEQ * 16; const float* const sini = cosi + SEQ * 8;
#pragma unroll
        for (int ai = 0; ai < 2; ++ai)
#pragma unroll
            for (int m = 0; m < 4; ++m) {
                const int row = row0 + ai * HALF + m * 16;
                if (pn < 24) {
                    bf16_t* base = Qh + (size_t)(pn >> 3) * ((size_t)SEQ * DM);
                    const bool rope = (pn < 16) && (wc == 0);
                    f32x4 cs[2] = {{1.f, 1.f, 1.f, 1.f}, {1.f, 1.f, 1.f, 1.f}}, sn[2] = {{0.f, 0.f, 0.f, 0.f}, {0.f, 0.f, 0.f, 0.f}};
                    if (rope) { const float* cp = cosq + (size_t)row * 16 + 8 * (fq & 1); const float* sp = sinq + (size_t)row * 16 + 8 * (fq & 1);
                        cs[0] = *(const f32x4*)cp; cs[1] = *(const f32x4*)(cp + 4); sn[0] = *(const f32x4*)sp; sn[1] = *(const f32x4*)(sp + 4); }
#pragma unroll
                    for (int bj = 0; bj < 2; ++bj) { const int head = 2 * (pn & 7) + bj;
                        f32x4 v[2] = {acc[ai][bj][m][0], acc[ai][bj][m][1]};
                        if (pn < 8) { v[0] *= ATT_QSCALE; v[1] *= ATT_QSCALE; }
                        if (rope) {
#pragma unroll
                            for (int n = 0; n < 2; ++n) { f32x4 pr;
#pragma unroll
                                for (int e = 0; e < 4; ++e) { const float ve = v[n][e];
                                    const auto rr = __builtin_amdgcn_permlane32_swap(__builtin_bit_cast(unsigned, ve), __builtin_bit_cast(unsigned, ve), false, false);
                                    const unsigned pu = (fq < 2) ? rr[1] : rr[0]; pr[e] = __builtin_bit_cast(float, pu); }
                                v[n] = (fq < 2) ? (v[n] * cs[n] - pr * sn[n]) : (v[n] * cs[n] + pr * sn[n]); } }
                        *(u32x4*)(base + ((size_t)head * SEQ + row) * HD + 32 * wc + 8 * fq) = pack8(v[0], v[1]); }
                } else if (pn < 32) {
#pragma unroll
                    for (int bj = 0; bj < 2; ++bj) { f32x4 v0 = acc[ai][bj][m][0], v1 = acc[ai][bj][m][1];
#pragma unroll
                        for (int e = 0; e < 4; ++e) { v0[e] = silu_f(v0[e]); v1[e] = silu_f(v1[e]); }
                        *(u32x4*)(SG + (size_t)row * DM + (pn - 24) * BM + bj * HALF + 32 * wc + 8 * fq) = pack8(v0, v1); }
                } else {
                    const bool isq = pn < 36;
                    const bool rope = ((wc & 1) == 0) && (isq || wc == 0);
                    f32x4 cs[2], sn[2];
                    { const float* cp = cosi + (size_t)row * 8; const float* sp = sini + (size_t)row * 8;
                      cs[0] = *(const f32x4*)cp; cs[1] = *(const f32x4*)(cp + 4); sn[0] = *(const f32x4*)sp; sn[1] = *(const f32x4*)(sp + 4); }
#pragma unroll
                    for (int bj = 0; bj < 2; ++bj) {
                        if (!isq && bj == 1) continue;
                        f32x4 v[2] = {acc[ai][bj][m][0], acc[ai][bj][m][1]};
                        if (rope) {
#pragma unroll
                            for (int n = 0; n < 2; ++n) { f32x4 pr;
#pragma unroll
                                for (int e = 0; e < 4; ++e) pr[e] = swz_xor<16>(v[n][e]);
                                const f32x4 ro = (fq == 0) ? (v[n] * cs[n] - pr * sn[n]) : (v[n] * cs[n] + pr * sn[n]);
                                v[n] = (fq < 2) ? ro : v[n]; } }
                        const int cl = bj * HALF + 32 * wc + 8 * fq;
                        if (isq) *(u32x4*)(QI + (size_t)row * 1024 + (pn - 32) * BM + cl) = pack8(v[0], v[1]);
                        else if (cl < 64) *(u32x4*)(KI + (size_t)row * 64 + cl) = pack8(v[0], v[1]);
                        else if (cl < 80) { *(f32x4*)(WI + (size_t)row * 16 + (cl - 64)) = v[0]; *(f32x4*)(WI + (size_t)row * 16 + (cl - 64) + 4) = v[1]; }
                    }
                }
                asm volatile("" ::: "memory");
            }
    }
};
}

namespace att {
constexpr int D = 128, NW = 8, QBLK = 32, KVBLK = 64, QB = NW * QBLK;
constexpr int KROWB = 272;
constexpr int SHM_V = KVBLK * D * 2, SHM_K = KVBLK * KROWB;
constexpr int QROWB = 272;
constexpr int Q_OFF = 2 * SHM_V + 2 * SHM_K + NW * 64 * 4;
constexpr int LDS_BYTES = Q_OFF + QB * QROWB;
constexpr float SCALE = 0.08838834764831845f;
constexpr float THR = 8.f;
#define KSWZ(row, colB) ((row) * KROWB + (colB))
#define SBAR() __builtin_amdgcn_sched_barrier(0)
__device__ __forceinline__ int v_st(int k, int c) { const int kk = (k & ~0xC) | ((k & 4) << 1) | ((k & 8) >> 1); return ((kk >> 3) * 4 + (c >> 5)) * 512 + ((kk & 7) * 32 + (c & 31)) * 2; }
__device__ __forceinline__ int v_rd_base(int lane) { return ((lane & 3) << 3) | (((lane >> 2) & 3) << 6) | (((lane >> 4) & 1) << 5) | (((lane >> 5) & 1) << 8); }
constexpr int v_rd_off(int d0, int ks, int half) { return d0 * 512 + ks * 4096 + half * 2048; }
__device__ __forceinline__ int crow(int r, int hi) { return (r & 3) + 8 * (r >> 2) + 4 * hi; }
__device__ __forceinline__ unsigned cvtpk(float lo, float hi) { unsigned r; asm volatile("v_cvt_pk_bf16_f32 %0, %1, %2" : "=v"(r) : "v"(lo), "v"(hi)); return r; }
__device__ __forceinline__ bf16x8 load8(const bf16_t* p) { return *reinterpret_cast<const bf16x8*>(p); }
__device__ __forceinline__ float mask_and(float v, unsigned mlo, unsigned mhi, int r, int p) {
    const int pos = 16 * (r & 1) + 2 * (r >> 2) + 8 * p;
    const unsigned w = (r & 2) ? mhi : mlo;
    int bits; asm("v_bfe_i32 %0, %1, %2, 1" : "=v"(bits) : "v"(w), "n"(pos));
    return __builtin_bit_cast(float, __builtin_bit_cast(unsigned, v) & (unsigned)bits);
}
constexpr float THR2 = 8.f * 1.4426950408889634f;
__device__ __forceinline__ void partialSM(f32x16& p0, f32x16& p1, float& m_reg, float& alpha, unsigned mlo_r, unsigned mhi_r, int hi) {
    float pmax = p0[0];
#pragma unroll
    for (int r = 1; r < 16; ++r) pmax = fmaxf(pmax, p0[r]);
#pragma unroll
    for (int r = 0; r < 16; ++r) pmax = fmaxf(pmax, p1[r]);
    { auto rr = __builtin_amdgcn_permlane32_swap(__float_as_uint(pmax), __float_as_uint(pmax), false, false);
      pmax = fmaxf(__uint_as_float(rr[0]), __uint_as_float(rr[1])); }
    float mn;
    if (__builtin_expect(__all(pmax - m_reg <= THR2), 1)) { mn = m_reg; alpha = 1.f; }
    else { mn = fmaxf(m_reg, pmax); alpha = __builtin_amdgcn_exp2f(m_reg - mn); m_reg = mn; }
    const f32x2 nm = {-mn, -mn};
#pragma unroll
    for (int r = 0; r < 16; r += 2) { const f32x2 a = (f32x2){p0[r], p0[r + 1]} + nm, b = (f32x2){p1[r], p1[r + 1]} + nm; p0[r] = a.x; p0[r + 1] = a.y; p1[r] = b.x; p1[r + 1] = b.y; }
    const unsigned mlo = hi ? ((mlo_r >> 1) | (mhi_r << 31)) : mlo_r, mhi = mhi_r >> hi;
#pragma unroll
    for (int r = 0; r < 16; ++r) p0[r] = mask_and(__builtin_amdgcn_exp2f(p0[r]), mlo, mhi, r, 0);
}
__device__ __forceinline__ void finishSM(f32x16& p0, f32x16& p1, float alpha, float& l_reg, bf16x8& pa0, bf16x8& pa1, bf16x8& pa2, bf16x8& pa3, unsigned mlo_r, unsigned mhi_r, int hi) {
    const unsigned mlo = hi ? ((mlo_r >> 1) | (mhi_r << 31)) : mlo_r, mhi = mhi_r >> hi;
#pragma unroll
    for (int r = 0; r < 16; ++r) p1[r] = mask_and(__builtin_amdgcn_exp2f(p1[r]), mlo, mhi, r, 1);
    f32x2 ps2 = {p0[0], p0[1]};
#pragma unroll
    for (int r = 2; r < 16; r += 2) ps2 += (f32x2){p0[r], p0[r + 1]};
#pragma unroll
    for (int r = 0; r < 16; r += 2) ps2 += (f32x2){p1[r], p1[r + 1]};
    float ps = ps2.x + ps2.y;
    { auto rr = __builtin_amdgcn_permlane32_swap(__float_as_uint(ps), __float_as_uint(ps), false, false);
      ps = __uint_as_float(rr[0]) + __uint_as_float(rr[1]); }
    l_reg = l_reg * alpha + ps;
#define PK4(P, B_, OUT) do { unsigned a0 = cvtpk(P[B_+0], P[B_+1]), a1 = cvtpk(P[B_+2], P[B_+3]);                          \
        unsigned b0 = cvtpk(P[B_+4], P[B_+5]), b1 = cvtpk(P[B_+6], P[B_+7]);                                             \
        auto r0 = __builtin_amdgcn_permlane32_swap(a0, b0, false, false); auto r1 = __builtin_amdgcn_permlane32_swap(a1, b1, false, false); \
        u32x4 w = {r0[0], r1[0], r0[1], r1[1]}; OUT = *reinterpret_cast<bf16x8*>(&w); } while (0)
    PK4(p0, 0, pa0); PK4(p0, 8, pa1); PK4(p1, 0, pa2); PK4(p1, 8, pa3);
#undef PK4
}
template <int KB>
__device__ __forceinline__ void qkt(f32x16& p0, f32x16& p1, int ka  , int qa  ) {
    const f32x16 zero16 = {};
    bf16x8 A0, B0, Q0, A1, B1, Q1;
#define LDSRD128(dst, addr, off) asm volatile("ds_read_b128 %0, %1 offset:%2" : "=&v"(dst) : "v"(addr), "i"(off) : "memory")
#define LGKM(n) asm volatile("s_waitcnt lgkmcnt(%0)" :: "i"(n) : "memory")
#define QK_LD(i, A, B, Q) do { LDSRD128(A, ka, KB * SHM_K + (i) * 32); LDSRD128(B, ka, KB * SHM_K + (i) * 32 + 32 * KROWB); LDSRD128(Q, qa, (i) * 32); } while (0)
#define QK_MM(A, B, Q) do { p0 = __builtin_amdgcn_mfma_f32_32x32x16_bf16(A, Q, p0, 0, 0, 0); p1 = __builtin_amdgcn_mfma_f32_32x32x16_bf16(B, Q, p1, 0, 0, 0); } while (0)
    QK_LD(0, A0, B0, Q0); QK_LD(1, A1, B1, Q1);
    LGKM(3); SBAR();
    p0 = __builtin_amdgcn_mfma_f32_32x32x16_bf16(A0, Q0, zero16, 0, 0, 0); p1 = __builtin_amdgcn_mfma_f32_32x32x16_bf16(B0, Q0, zero16, 0, 0, 0);
    SBAR(); QK_LD(2, A0, B0, Q0);
    LGKM(3); SBAR(); QK_MM(A1, B1, Q1); SBAR(); QK_LD(3, A1, B1, Q1);
    LGKM(3); SBAR(); QK_MM(A0, B0, Q0); SBAR(); QK_LD(4, A0, B0, Q0);
    LGKM(3); SBAR(); QK_MM(A1, B1, Q1); SBAR(); QK_LD(5, A1, B1, Q1);
    LGKM(3); SBAR(); QK_MM(A0, B0, Q0); SBAR(); QK_LD(6, A0, B0, Q0);
    LGKM(3); SBAR(); QK_MM(A1, B1, Q1); SBAR(); QK_LD(7, A1, B1, Q1);
    LGKM(3); SBAR(); QK_MM(A0, B0, Q0); SBAR();
    LGKM(0); SBAR(); QK_MM(A1, B1, Q1); SBAR();
#undef QK_LD
#undef QK_MM
}
template <int VB>
__device__ __forceinline__ void pv_tile(f32x16* o, int vb0, bf16x8 pa0, bf16x8 pa1, bf16x8 pa2, bf16x8 pa3) {
#define TRRD(dst, off) asm volatile("ds_read_b64_tr_b16 %0, %1 offset:%2" : "=&v"(dst) : "v"(vb0), "i"(off) : "memory")
#define PV_D0(d0) do { s16x4 l0, l1, l2, l3, h0, h1, h2, h3; constexpr int b_ = VB * SHM_V + v_rd_off(d0, 0, 0); \
        TRRD(l0, b_); TRRD(h0, b_ + 2048); TRRD(l1, b_ + 4096); TRRD(h1, b_ + 6144); TRRD(l2, b_ + 8192); TRRD(h2, b_ + 10240); TRRD(l3, b_ + 12288); TRRD(h3, b_ + 14336); \
        asm volatile("s_waitcnt lgkmcnt(0)" ::: "memory"); SBAR();   \
        o[d0] = __builtin_amdgcn_mfma_f32_32x32x16_bf16(pa0, (bf16x8){l0[0], l0[1], l0[2], l0[3], h0[0], h0[1], h0[2], h0[3]}, o[d0], 0, 0, 0);   \
        o[d0] = __builtin_amdgcn_mfma_f32_32x32x16_bf16(pa1, (bf16x8){l1[0], l1[1], l1[2], l1[3], h1[0], h1[1], h1[2], h1[3]}, o[d0], 0, 0, 0);   \
        o[d0] = __builtin_amdgcn_mfma_f32_32x32x16_bf16(pa2, (bf16x8){l2[0], l2[1], l2[2], l2[3], h2[0], h2[1], h2[2], h2[3]}, o[d0], 0, 0, 0);   \
        o[d0] = __builtin_amdgcn_mfma_f32_32x32x16_bf16(pa3, (bf16x8){l3[0], l3[1], l3[2], l3[3], h3[0], h3[1], h3[2], h3[3]}, o[d0], 0, 0, 0); } while (0)
    PV_D0(0); PV_D0(1); PV_D0(2); PV_D0(3);
#undef PV_D0
#undef TRRD
}
template <int KB>
__device__ __forceinline__ void qkt_fsm(f32x16& p0, f32x16& p1, int ka, int qa,
                                        f32x16& y0, f32x16& y1, float alpha, float& l_reg, bf16x8& pa0, bf16x8& pa1, bf16x8& pa2, bf16x8& pa3, unsigned mlo_r, unsigned mhi_r, int hi) {
    const unsigned mlo = hi ? ((mlo_r >> 1) | (mhi_r << 31)) : mlo_r, mhi = mhi_r >> hi;
    const f32x16 zero16 = {};
    f32x2 sa = {0.f, 0.f}, sb = {0.f, 0.f};
    bf16x8 A0, B0, Q0, A1, B1, Q1;
#define QK_LD(i, A, B, Q) do { LDSRD128(A, ka, KB * SHM_K + (i) * 32); LDSRD128(B, ka, KB * SHM_K + (i) * 32 + 32 * KROWB); LDSRD128(Q, qa, (i) * 32); } while (0)
    QK_LD(0, A0, B0, Q0); QK_LD(1, A1, B1, Q1);
    LGKM(3); SBAR(); p0 = __builtin_amdgcn_mfma_f32_32x32x16_bf16(A0, Q0, zero16, 0, 0, 0); SBAR(); y1[0] = mask_and(__builtin_amdgcn_exp2f(y1[0]), mlo, mhi, 0, 1); sa += (f32x2){y0[0], y0[1]}; sa += (f32x2){y0[2], y0[3]}; SBAR();
    p1 = __builtin_amdgcn_mfma_f32_32x32x16_bf16(B0, Q0, zero16, 0, 0, 0); SBAR(); QK_LD(2, A0, B0, Q0); y1[1] = mask_and(__builtin_amdgcn_exp2f(y1[1]), mlo, mhi, 1, 1); sa += (f32x2){y0[4], y0[5]}; sa += (f32x2){y0[6], y0[7]}; SBAR();
    LGKM(3); SBAR(); p0 = __builtin_amdgcn_mfma_f32_32x32x16_bf16(A1, Q1, p0, 0, 0, 0); SBAR(); y1[2] = mask_and(__builtin_amdgcn_exp2f(y1[2]), mlo, mhi, 2, 1); sa += (f32x2){y0[8], y0[9]}; sa += (f32x2){y0[10], y0[11]}; SBAR();
    p1 = __builtin_amdgcn_mfma_f32_32x32x16_bf16(B1, Q1, p1, 0, 0, 0); SBAR(); QK_LD(3, A1, B1, Q1); y1[3] = mask_and(__builtin_amdgcn_exp2f(y1[3]), mlo, mhi, 3, 1); sa += (f32x2){y0[12], y0[13]}; sa += (f32x2){y0[14], y0[15]}; SBAR();
    LGKM(3); SBAR(); p0 = __builtin_amdgcn_mfma_f32_32x32x16_bf16(A0, Q0, p0, 0, 0, 0); SBAR(); y1[4] = mask_and(__builtin_amdgcn_exp2f(y1[4]), mlo, mhi, 4, 1); const unsigned a0_p = cvtpk(y0[0+0], y0[0+1]), b0_p = cvtpk(y0[0+4], y0[0+5]); const auto r0_p = __builtin_amdgcn_permlane32_swap(a0_p, b0_p, false, false); SBAR();
    p1 = __builtin_amdgcn_mfma_f32_32x32x16_bf16(B0, Q0, p1, 0, 0, 0); SBAR(); QK_LD(4, A0, B0, Q0); y1[5] = mask_and(__builtin_amdgcn_exp2f(y1[5]), mlo, mhi, 5, 1); const unsigned a1_p = cvtpk(y0[0+2], y0[0+3]), b1_p = cvtpk(y0[0+6], y0[0+7]); const auto r1_p = __builtin_amdgcn_permlane32_swap(a1_p, b1_p, false, false); { u32x4 w_ = {r0_p[0], r1_p[0], r0_p[1], r1_p[1]}; pa0 = *reinterpret_cast<bf16x8*>(&w_); } SBAR();
    LGKM(3); SBAR(); p0 = __builtin_amdgcn_mfma_f32_32x32x16_bf16(A1, Q1, p0, 0, 0, 0); SBAR(); y1[6] = mask_and(__builtin_amdgcn_exp2f(y1[6]), mlo, mhi, 6, 1); const unsigned a0_q = cvtpk(y0[8+0], y0[8+1]), b0_q = cvtpk(y0[8+4], y0[8+5]); const auto r0_q = __builtin_amdgcn_permlane32_swap(a0_q, b0_q, false, false); SBAR();
    p1 = __builtin_amdgcn_mfma_f32_32x32x16_bf16(B1, Q1, p1, 0, 0, 0); SBAR(); QK_LD(5, A1, B1, Q1); y1[7] = mask_and(__builtin_amdgcn_exp2f(y1[7]), mlo, mhi, 7, 1); const unsigned a1_q = cvtpk(y0[8+2], y0[8+3]), b1_q = cvtpk(y0[8+6], y0[8+7]); const auto r1_q = __builtin_amdgcn_permlane32_swap(a1_q, b1_q, false, false); { u32x4 w_ = {r0_q[0], r1_q[0], r0_q[1], r1_q[1]}; pa1 = *reinterpret_cast<bf16x8*>(&w_); } SBAR();
    LGKM(3); SBAR(); p0 = __builtin_amdgcn_mfma_f32_32x32x16_bf16(A0, Q0, p0, 0, 0, 0); SBAR(); y1[8] = mask_and(__builtin_amdgcn_exp2f(y1[8]), mlo, mhi, 8, 1); sb += (f32x2){y1[0], y1[1]}; sb += (f32x2){y1[2], y1[3]}; SBAR();
    p1 = __builtin_amdgcn_mfma_f32_32x32x16_bf16(B0, Q0, p1, 0, 0, 0); SBAR(); QK_LD(6, A0, B0, Q0); y1[9] = mask_and(__builtin_amdgcn_exp2f(y1[9]), mlo, mhi, 9, 1); sb += (f32x2){y1[4], y1[5]}; sb += (f32x2){y1[6], y1[7]}; SBAR();
    LGKM(3); SBAR(); p0 = __builtin_amdgcn_mfma_f32_32x32x16_bf16(A1, Q1, p0, 0, 0, 0); SBAR(); y1[10] = mask_and(__builtin_amdgcn_exp2f(y1[10]), mlo, mhi, 10, 1); const unsigned a0_u = cvtpk(y1[0+0], y1[0+1]), b0_u = cvtpk(y1[0+4], y1[0+5]); const auto r0_u = __builtin_amdgcn_permlane32_swap(a0_u, b0_u, false, false); SBAR();
    p1 = __builtin_amdgcn_mfma_f32_32x32x16_bf16(B1, Q1, p1, 0, 0, 0); SBAR(); QK_LD(7, A1, B1, Q1); y1[11] = mask_and(__builtin_amdgcn_exp2f(y1[11]), mlo, mhi, 11, 1); const unsigned a1_u = cvtpk(y1[0+2], y1[0+3]), b1_u = cvtpk(y1[0+6], y1[0+7]); const auto r1_u = __builtin_amdgcn_permlane32_swap(a1_u, b1_u, false, false); { u32x4 w_ = {r0_u[0], r1_u[0], r0_u[1], r1_u[1]}; pa2 = *reinterpret_cast<bf16x8*>(&w_); } SBAR();
    LGKM(3); SBAR(); p0 = __builtin_amdgcn_mfma_f32_32x32x16_bf16(A0, Q0, p0, 0, 0, 0); SBAR(); y1[12] = mask_and(__builtin_amdgcn_exp2f(y1[12]), mlo, mhi, 12, 1); sb += (f32x2){y1[8], y1[9]}; sb += (f32x2){y1[10], y1[11]}; SBAR();
    p1 = __builtin_amdgcn_mfma_f32_32x32x16_bf16(B0, Q0, p1, 0, 0, 0); SBAR(); y1[13] = mask_and(__builtin_amdgcn_exp2f(y1[13]), mlo, mhi, 13, 1);  SBAR();
    LGKM(0); SBAR(); p0 = __builtin_amdgcn_mfma_f32_32x32x16_bf16(A1, Q1, p0, 0, 0, 0); SBAR(); y1[14] = mask_and(__builtin_amdgcn_exp2f(y1[14]), mlo, mhi, 14, 1); sb += (f32x2){y1[12], y1[13]}; SBAR();
    p1 = __builtin_amdgcn_mfma_f32_32x32x16_bf16(B1, Q1, p1, 0, 0, 0); SBAR(); y1[15] = mask_and(__builtin_amdgcn_exp2f(y1[15]), mlo, mhi, 15, 1);  SBAR();
    sb += (f32x2){y1[14], y1[15]};
    const unsigned a0_v = cvtpk(y1[8+0], y1[8+1]), b0_v = cvtpk(y1[8+4], y1[8+5]); const auto r0_v = __builtin_amdgcn_permlane32_swap(a0_v, b0_v, false, false); const unsigned a1_v = cvtpk(y1[8+2], y1[8+3]), b1_v = cvtpk(y1[8+6], y1[8+7]); const auto r1_v = __builtin_amdgcn_permlane32_swap(a1_v, b1_v, false, false); { u32x4 w_ = {r0_v[0], r1_v[0], r0_v[1], r1_v[1]}; pa3 = *reinterpret_cast<bf16x8*>(&w_); }
    float ps = (sa.x + sa.y) + (sb.x + sb.y);
    { auto rr = __builtin_amdgcn_permlane32_swap(__float_as_uint(ps), __float_as_uint(ps), false, false);
      ps = __uint_as_float(rr[0]) + __uint_as_float(rr[1]); }
    l_reg = l_reg * alpha + ps; SBAR();
#undef QK_LD
}
template <int VB>
__device__ __forceinline__ void pv_psm(f32x16* o, int vb0, bf16x8 pa0, bf16x8 pa1, bf16x8 pa2, bf16x8 pa3,
                                       f32x16& p0, f32x16& p1, float& m_reg, float& alpha, unsigned mlo_r, unsigned mhi_r, int hi) {
    const unsigned mlo = hi ? ((mlo_r >> 1) | (mhi_r << 31)) : mlo_r, mhi = mhi_r >> hi;
#define TRRD(dst, off) asm volatile("ds_read_b64_tr_b16 %0, %1 offset:%2" : "=&v"(dst) : "v"(vb0), "i"(off) : "memory")
#define PV_RD(X, d0) do { constexpr int b_ = VB * SHM_V + v_rd_off(d0, 0, 0); \
        TRRD(X##l0, b_); TRRD(X##h0, b_ + 2048); TRRD(X##l1, b_ + 4096); TRRD(X##h1, b_ + 6144); TRRD(X##l2, b_ + 8192); TRRD(X##h2, b_ + 10240); TRRD(X##l3, b_ + 12288); TRRD(X##h3, b_ + 14336); } while (0)
#define PV_MM(X, d0, j, PA) o[d0] = __builtin_amdgcn_mfma_f32_32x32x16_bf16(PA, (bf16x8){X##l##j[0], X##l##j[1], X##l##j[2], X##l##j[3], X##h##j[0], X##h##j[1], X##h##j[2], X##h##j[3]}, o[d0], 0, 0, 0)
    s16x4 el0, el1, el2, el3, eh0, eh1, eh2, eh3, ol0, ol1, ol2, ol3, oh0, oh1, oh2, oh3;
    PV_RD(e, 0);
    LGKM(0); SBAR(); PV_MM(e, 0, 0, pa0); SBAR(); PV_RD(o, 1); float mxa = fmaxf(fmaxf(p0[0], p0[1]), p0[2]), mxb = fmaxf(fmaxf(p1[0], p1[1]), p1[2]); mxa = fmaxf(fmaxf(mxa, p0[3]), p0[4]); mxb = fmaxf(fmaxf(mxb, p1[3]), p1[4]); SBAR();
    PV_MM(e, 0, 1, pa1); SBAR(); mxa = fmaxf(fmaxf(mxa, p0[5]), p0[6]); mxb = fmaxf(fmaxf(mxb, p1[5]), p1[6]); mxa = fmaxf(fmaxf(mxa, p0[7]), p0[8]); mxb = fmaxf(fmaxf(mxb, p1[7]), p1[8]); SBAR();
    PV_MM(e, 0, 2, pa2); SBAR(); mxa = fmaxf(fmaxf(mxa, p0[9]), p0[10]); mxb = fmaxf(fmaxf(mxb, p1[9]), p1[10]); mxa = fmaxf(fmaxf(mxa, p0[11]), p0[12]); mxb = fmaxf(fmaxf(mxb, p1[11]), p1[12]); SBAR();
    PV_MM(e, 0, 3, pa3); SBAR(); mxa = fmaxf(fmaxf(mxa, p0[13]), p0[14]); mxb = fmaxf(fmaxf(mxb, p1[13]), p1[14]); mxa = fmaxf(fmaxf(mxa, p0[15]), p1[15]); float pmax = fmaxf(mxa, mxb); SBAR();
    LGKM(0); SBAR(); PV_MM(o, 1, 0, pa0); SBAR(); PV_RD(e, 2); { auto rr = __builtin_amdgcn_permlane32_swap(__float_as_uint(pmax), __float_as_uint(pmax), false, false); pmax = fmaxf(__uint_as_float(rr[0]), __uint_as_float(rr[1])); } const float mn = (pmax - m_reg <= THR2) ? m_reg : fmaxf(m_reg, pmax);     alpha = __builtin_amdgcn_exp2f(m_reg - mn); m_reg = mn; const f32x2 nm = {-mn, -mn}; SBAR();
    PV_MM(o, 1, 1, pa1); SBAR(); { const f32x2 a_ = (f32x2){p0[0], p0[1]} + nm; p0[0] = a_.x; p0[1] = a_.y; } { const f32x2 a_ = (f32x2){p0[2], p0[3]} + nm; p0[2] = a_.x; p0[3] = a_.y; } { const f32x2 a_ = (f32x2){p0[4], p0[5]} + nm; p0[4] = a_.x; p0[5] = a_.y; } { const f32x2 a_ = (f32x2){p0[6], p0[7]} + nm; p0[6] = a_.x; p0[7] = a_.y; } SBAR();
    PV_MM(o, 1, 2, pa2); SBAR(); { const f32x2 a_ = (f32x2){p0[8], p0[9]} + nm; p0[8] = a_.x; p0[9] = a_.y; } { const f32x2 a_ = (f32x2){p0[10], p0[11]} + nm; p0[10] = a_.x; p0[11] = a_.y; } { const f32x2 a_ = (f32x2){p0[12], p0[13]} + nm; p0[12] = a_.x; p0[13] = a_.y; } { const f32x2 a_ = (f32x2){p0[14], p0[15]} + nm; p0[14] = a_.x; p0[15] = a_.y; } SBAR();
    PV_MM(o, 1, 3, pa3); SBAR(); { const f32x2 a_ = (f32x2){p1[0], p1[1]} + nm; p1[0] = a_.x; p1[1] = a_.y; } { const f32x2 a_ = (f32x2){p1[2], p1[3]} + nm; p1[2] = a_.x; p1[3] = a_.y; } { const f32x2 a_ = (f32x2){p1[4], p1[5]} + nm; p1[4] = a_.x; p1[5] = a_.y; } { const f32x2 a_ = (f32x2){p1[6], p1[7]} + nm; p1[6] = a_.x; p1[7] = a_.y; } { float t_ = mask_and(__builtin_amdgcn_exp2f(p0[0]), mlo, mhi, 0, 0); asm volatile("" : "+v"(t_)); p0[0] = t_; } SBAR();
    LGKM(0); SBAR(); PV_MM(e, 2, 0, pa0); SBAR(); PV_RD(o, 3); { const f32x2 a_ = (f32x2){p1[8], p1[9]} + nm; p1[8] = a_.x; p1[9] = a_.y; } { const f32x2 a_ = (f32x2){p1[10], p1[11]} + nm; p1[10] = a_.x; p1[11] = a_.y; } { const f32x2 a_ = (f32x2){p1[12], p1[13]} + nm; p1[12] = a_.x; p1[13] = a_.y; } { const f32x2 a_ = (f32x2){p1[14], p1[15]} + nm; p1[14] = a_.x; p1[15] = a_.y; } { float t_ = mask_and(__builtin_amdgcn_exp2f(p0[1]), mlo, mhi, 1, 0); asm volatile("" : "+v"(t_)); p0[1] = t_; } SBAR();
    PV_MM(e, 2, 1, pa1); SBAR(); { float t_ = mask_and(__builtin_amdgcn_exp2f(p0[2]), mlo, mhi, 2, 0); asm volatile("" : "+v"(t_)); p0[2] = t_; } { float t_ = mask_and(__builtin_amdgcn_exp2f(p0[3]), mlo, mhi, 3, 0); asm volatile("" : "+v"(t_)); p0[3] = t_; } SBAR();
    PV_MM(e, 2, 2, pa2); SBAR(); { float t_ = mask_and(__builtin_amdgcn_exp2f(p0[4]), mlo, mhi, 4, 0); asm volatile("" : "+v"(t_)); p0[4] = t_; } { float t_ = mask_and(__builtin_amdgcn_exp2f(p0[5]), mlo, mhi, 5, 0); asm volatile("" : "+v"(t_)); p0[5] = t_; } SBAR();
    PV_MM(e, 2, 3, pa3); SBAR(); { float t_ = mask_and(__builtin_amdgcn_exp2f(p0[6]), mlo, mhi, 6, 0); asm volatile("" : "+v"(t_)); p0[6] = t_; } { float t_ = mask_and(__builtin_amdgcn_exp2f(p0[7]), mlo, mhi, 7, 0); asm volatile("" : "+v"(t_)); p0[7] = t_; } SBAR();
    LGKM(0); SBAR(); PV_MM(o, 3, 0, pa0); SBAR(); { float t_ = mask_and(__builtin_amdgcn_exp2f(p0[8]), mlo, mhi, 8, 0); asm volatile("" : "+v"(t_)); p0[8] = t_; } { float t_ = mask_and(__builtin_amdgcn_exp2f(p0[9]), mlo, mhi, 9, 0); asm volatile("" : "+v"(t_)); p0[9] = t_; } SBAR();
    PV_MM(o, 3, 1, pa1); SBAR(); { float t_ = mask_and(__builtin_amdgcn_exp2f(p0[10]), mlo, mhi, 10, 0); asm volatile("" : "+v"(t_)); p0[10] = t_; } { float t_ = mask_and(__builtin_amdgcn_exp2f(p0[11]), mlo, mhi, 11, 0); asm volatile("" : "+v"(t_)); p0[11] = t_; } SBAR();
    PV_MM(o, 3, 2, pa2); SBAR(); { float t_ = mask_and(__builtin_amdgcn_exp2f(p0[12]), mlo, mhi, 12, 0); asm volatile("" : "+v"(t_)); p0[12] = t_; } { float t_ = mask_and(__builtin_amdgcn_exp2f(p0[13]), mlo, mhi, 13, 0); asm volatile("" : "+v"(t_)); p0[13] = t_; } SBAR();
    PV_MM(o, 3, 3, pa3); SBAR(); { float t_ = mask_and(__builtin_amdgcn_exp2f(p0[14]), mlo, mhi, 14, 0); asm volatile("" : "+v"(t_)); p0[14] = t_; } { float t_ = mask_and(__builtin_amdgcn_exp2f(p0[15]), mlo, mhi, 15, 0); asm volatile("" : "+v"(t_)); p0[15] = t_; } SBAR();
#undef PV_MM
#undef PV_RD
#undef TRRD
}
struct BlockRef { const bf16_t* Q; const bf16_t* K; const bf16_t* V; bf16_t* O; const bf16_t* G; const unsigned long long* M; int P0; long kst, mst; };
struct Seam { bf16x8 a_v0, a_v1, a_k0, a_k1, b_v0, b_v1, b_k0, b_k1; };
#define ROW(p, k0, rr) ((p) + (size_t)((k0) + (rr)) * D + sc)
#define VMW() asm volatile("s_waitcnt vmcnt(0)" ::: "memory")
#define VMWN(n) asm volatile("s_waitcnt vmcnt(%0)" :: "i"(n) : "memory")
#define SLD(X, Kp, Vp) do { S.X##_v0 = load8(ROW(Vp, 0, sr)); S.X##_v1 = load8(ROW(Vp, 0, 32 + sr)); S.X##_k0 = load8(ROW(Kp, 0, sr)); S.X##_k1 = load8(ROW(Kp, 0, 32 + sr)); } while (0)
#define SWK(X, bf) do { *(bf16x8*)(K_lds + (bf) * SHM_K + kws) = S.X##_k0; *(bf16x8*)(K_lds + (bf) * SHM_K + kws + 32 * KROWB) = S.X##_k1; } while (0)
#define SWV(X, bf) do { *(bf16x8*)(V_lds + (bf) * SHM_V + vst0) = S.X##_v0; *(bf16x8*)(V_lds + (bf) * SHM_V + vst1) = S.X##_v1; } while (0)
__device__ __forceinline__ void attn_prime(int wv, const BlockRef& cur, char* lds, Seam& S) {
    const int tid = opaque_tid(wv);
    const int sr = tid >> 4, sc = (tid & 15) * 8, kws = KSWZ(sr, sc * 2); char* K_lds = lds + 2 * SHM_V;
    SLD(a, cur.K, cur.V); SBAR(); SWK(a, 0); SBAR(); SLD(b, cur.K + cur.kst, cur.V + cur.kst);
    __syncthreads();
}
__device__ __forceinline__ void attn_block(int wv, const BlockRef& cur, const BlockRef& nxt, char* lds, Seam& S) {
    const int tid = opaque_tid(wv), wid = __builtin_amdgcn_readfirstlane(tid >> 6), lane = tid & 63, r32 = lane & 31, hi = lane >> 5;
    const int NT = cur.P0 / KVBLK + 4;
    char* V_lds = lds; char* K_lds = lds + 2 * SHM_V;
    float* ws = (float*)(lds + 2 * SHM_V + 2 * SHM_K) + wid * 64; float* li_l = ws, * al_l = ws + 32;
    float m_reg = -1e30f, l_reg = 0; f32x16 o[4] = {};
    const int sr = tid >> 4, sc = (tid & 15) * 8, vst0 = v_st(sr, sc), vst1 = v_st(32 + sr, sc), kws = KSWZ(sr, sc * 2);
    const int vb0 = (int)(uintptr_t)V_lds + v_rd_base(lane);
    const bf16_t* Kh = cur.K; const bf16_t* Vh = cur.V;
    const unsigned long long* mp = cur.M + (wid * QBLK + r32); const long mst = cur.mst, kst = cur.kst;
#define MLOAD(lo_, hi_, t) do { const unsigned long long w_ = mp[(long)(t) * mst]; lo_ = (unsigned)w_; hi_ = (unsigned)(w_ >> 32); } while (0)
#define RESC(a) do { if (__any((a) < 1.f)) { if (hi == 0) al_l[r32] = (a); asm volatile("s_waitcnt lgkmcnt(0)" ::: "memory");              \
                     for (int d_ = 0; d_ < 4; ++d_) for (int r = 0; r < 16; ++r) o[d_][r] *= al_l[crow(r, hi)]; } } while (0)
#define KBASE(t) ((long)(t) * kst)
    f32x16 pA0, pA1, pB0, pB1; float alA, alB; bf16x8 pa0, pa1, pa2, pa3;
    unsigned mAlo, mAhi, mBlo, mBhi;
    MLOAD(mAlo, mAhi, 0);
    char* Qw_lds = lds + Q_OFF + wid * (QBLK * QROWB);
    { u32x4 tq[8];
#pragma unroll
        for (int i = 0; i < 8; ++i) tq[i] = *(const u32x4*)(cur.Q + (size_t)(wid * QBLK + 4 * i + (lane >> 4)) * D + (lane & 15) * 8);
#pragma unroll
        for (int i = 0; i < 8; ++i) *(u32x4*)(Qw_lds + (4 * i + (lane >> 4)) * QROWB + (lane & 15) * 16) = tq[i];
        asm volatile("s_waitcnt lgkmcnt(0)" ::: "memory"); }
    const int qal = (int)(uintptr_t)Qw_lds + r32 * QROWB + hi * 16, ka = (int)(uintptr_t)K_lds + r32 * KROWB + hi * 16;
    SWV(a, 0); SBAR();
    SLD(a, Kh + KBASE(2), Vh + KBASE(2));
    SBAR(); qkt<0>(pA0, pA1, ka, qal);
    partialSM(pA0, pA1, m_reg, alA, mAlo, mAhi, hi);
    SWV(b, 1); SWK(b, 1);
    __syncthreads();
#define HALF_STEP(PX0, PX1, mnX, alX, mXlo, mXhi, PY0, PY1, alY, mYlo, mYhi, t, KB, VB, SB, SL, SW, KP, VP) do {                   \
        SBAR(); MLOAD(mXlo, mXhi, t); qkt_fsm<KB>(PX0, PX1, ka, qal, PY0, PY1, alY, l_reg, pa0, pa1, pa2, pa3, mYlo, mYhi, hi); SBAR(); \
        SLD(SL, KP, VP); SBAR();                                                                                              \
        pv_psm<VB>(o, vb0, pa0, pa1, pa2, pa3, PX0, PX1, m_reg, alX, mXlo, mXhi, hi);                                         \
        __syncthreads();                                                                                                      \
        SWV(SW, SB); SWK(SW, SB);                                                                                             \
        RESC(alX); __syncthreads(); } while (0)
    for (int t = 1; t + 1 < NT; t += 2) {
        const bool inr = t + 3 < NT;
        const bf16_t* kp2 = inr ? Kh + KBASE(t + 3) : nxt.K; const bf16_t* vp2 = inr ? Vh + KBASE(t + 3) : nxt.V;
        HALF_STEP(pB0, pB1, mnB, alB, mBlo, mBhi, pA0, pA1, alA, mAlo, mAhi, t, 1, 0, 0, b, a, Kh + KBASE(t + 2), Vh + KBASE(t + 2));
        HALF_STEP(pA0, pA1, mnA, alA, mAlo, mAhi, pB0, pB1, alB, mBlo, mBhi, t + 1, 0, 1, 1, a, b, kp2, vp2);
    }
    MLOAD(mBlo, mBhi, NT - 1);
    SBAR(); qkt_fsm<1>(pB0, pB1, ka, qal, pA0, pA1, alA, l_reg, pa0, pa1, pa2, pa3, mAlo, mAhi, hi); SBAR();
    SLD(b, nxt.K + nxt.kst, nxt.V + nxt.kst); SBAR();
    pv_psm<0>(o, vb0, pa0, pa1, pa2, pa3, pB0, pB1, m_reg, alB, mBlo, mBhi, hi); __syncthreads(); RESC(alB);
    finishSM(pB0, pB1, alB, l_reg, pa0, pa1, pa2, pa3, mBlo, mBhi, hi); SBAR(); pv_tile<1>(o, vb0, pa0, pa1, pa2, pa3);
    SBAR(); SWK(a, 0); SBAR();
    if (hi == 0) li_l[r32] = l_reg; asm volatile("s_waitcnt lgkmcnt(0)" ::: "memory");
    { char* ow_l = Qw_lds + r32 * 2;
#pragma unroll
      for (int r = 0; r < 16; ++r) { const int orow = crow(r, hi); const float rl = __builtin_amdgcn_rcpf(li_l[orow]);
#pragma unroll
          for (int d0 = 0; d0 < 4; ++d0) *(unsigned short*)(ow_l + orow * QROWB + d0 * 64) = (unsigned short)(cvtpk(o[d0][r] * rl, 0.f) & 0xffffu); }
      asm volatile("s_waitcnt lgkmcnt(0)" ::: "memory"); SBAR();
      bf16_t* Ow = cur.O + (size_t)(wid * QBLK + (lane >> 4)) * DM + (lane & 15) * 8; const bf16_t* Gw = cur.G + (size_t)(wid * QBLK + (lane >> 4)) * DM + (lane & 15) * 8;
      u32x4 gv[8];
#pragma unroll
      for (int i = 0; i < 8; ++i) gv[i] = *(const u32x4*)(Gw + (size_t)(4 * i) * DM);
#pragma unroll
      for (int i = 0; i < 8; ++i) { const u32x4 ov = *(const u32x4*)(Qw_lds + (4 * i + (lane >> 4)) * QROWB + (lane & 15) * 16);
          f32x4 a0, a1, g0, g1; unpack8(ov, a0, a1); unpack8(gv[i], g0, g1);
          *(u32x4*)(Ow + (size_t)(4 * i) * DM) = pack8(a0 * g0, a1 * g1); }
      asm volatile("s_waitcnt lgkmcnt(0)" ::: "memory"); }
    __syncthreads();
#undef MLOAD
#undef RESC
#undef KBASE
#undef HALF_STEP
}
#undef ROW
#undef VMW
#undef VMWN
#undef SLD
#undef SWK
#undef SWV
#undef KSWZ
#undef SBAR
}

#define XB_TMO      128
#define XB_XCNT(j)  (256  + 64 * (j))
#define XB_XSUB(j)  (1280 + 64 * (j))
#define XB_XGEN(j)  (2304 + 64 * (j))
#define XB_TOP      3328
#define XB_TOPGEN   3392
#define XCD_BAR_WORDS 3456
#define XB_SPIN_CAP (1u << 22)
__device__ __forceinline__ unsigned xb_ld(unsigned* p)              { return __hip_atomic_load(p, __ATOMIC_RELAXED, __HIP_MEMORY_SCOPE_AGENT); }
__device__ __forceinline__ unsigned xb_add(unsigned* p, unsigned v) { return __hip_atomic_fetch_add(p, v, __ATOMIC_RELAXED, __HIP_MEMORY_SCOPE_AGENT); }
__device__ __forceinline__ unsigned xb_xcc_id() { return (unsigned)__builtin_amdgcn_s_getreg((3 << 11) | 20) & 0xFu; }
#define XB_SPIN(cond, bar) do { unsigned _sp = 0; while (cond) { __builtin_amdgcn_s_sleep(1); \
    if ((++_sp & 255u) == 0u) { if (xb_ld(&(bar)[XB_TMO])) break; if (_sp > XB_SPIN_CAP) { atomicAdd(&(bar)[XB_TMO], 1u); break; } } } } while (0)
struct XcdBarrier { unsigned* bar; unsigned x; volatile LAS unsigned* st; };
__device__ __forceinline__ XcdBarrier xcd_barrier_post(unsigned* bar, volatile LAS unsigned* st) {
    XcdBarrier b; b.bar = bar; b.x = xb_xcc_id(); b.st = st;
    if (threadIdx.x == 0) (void)xb_add(&bar[XB_XCNT(b.x)], 1u);
    return b;
}
__device__ __forceinline__ void xcd_barrier_complete(unsigned* bar, unsigned x, unsigned& nloc, unsigned& nx) {
    const unsigned G = gridDim.x * gridDim.y * gridDim.z;
    unsigned sum, cnt, mine, sp = 0u;
    for (;;) {
        sum = 0u; cnt = 0u; mine = 0u;
        unsigned cj[16];
#pragma unroll
        for (unsigned j = 0; j < 16; ++j) cj[j] = xb_ld(&bar[XB_XCNT(j)]);
        __builtin_amdgcn_sched_barrier(0);
#pragma unroll
        for (unsigned j = 0; j < 16; ++j) { const unsigned c = cj[j]; sum += c; cnt += (c > 0u) ? 1u : 0u; mine = (j == x) ? c : mine; }
        if (sum == G) break;
        __builtin_amdgcn_s_sleep(1);
        if ((++sp & 255u) == 0u) { if (xb_ld(&bar[XB_TMO])) break; if (sp > XB_SPIN_CAP) { atomicAdd(&bar[XB_TMO], 1u); break; } }
    }
    nloc = mine > 0u ? mine : 1u; nx = cnt > 0u ? cnt : 1u;
}
__device__ __forceinline__ void xcd_barrier(const XcdBarrier& b) {
    asm volatile("s_waitcnt vmcnt(0)" ::: "memory");
    __syncthreads();
    if (threadIdx.x == 0) {
        unsigned* bar = b.bar;
        __builtin_amdgcn_s_waitcnt(0);
        unsigned nloc = b.st[0], nx = b.st[1];
        if (nloc == 0u) { xcd_barrier_complete(bar, b.x, nloc, nx); b.st[0] = nloc; b.st[1] = nx; }
        const unsigned old = xb_add(&bar[XB_XSUB(b.x)], 1u);
        const unsigned gen = old / nloc;
        if (old + 1u == (gen + 1u) * nloc) {
            __builtin_amdgcn_fence(__ATOMIC_RELEASE, "agent");
            asm volatile("s_waitcnt vmcnt(0)" ::: "memory");
            const unsigned og = xb_add(&bar[XB_TOP], 1u);
            const unsigned tg = og / nx;
            if (og + 1u == (tg + 1u) * nx) xb_add(&bar[XB_TOPGEN], 1u);
            else XB_SPIN(xb_ld(&bar[XB_TOPGEN]) == tg, bar);
            __builtin_amdgcn_fence(__ATOMIC_ACQUIRE, "agent");
            xb_add(&bar[XB_XGEN(b.x)], 1u);
            asm volatile("s_waitcnt vmcnt(0)" ::: "memory");
        } else {
            XB_SPIN(xb_ld(&bar[XB_XGEN(b.x)]) == gen, bar);
            __builtin_amdgcn_fence(__ATOMIC_ACQUIRE, "agent");
            asm volatile("s_waitcnt vmcnt(0)" ::: "memory");
        }
    }
    __syncthreads();
}

struct Args {
    const float* x; const float* c; const int* pos; const float* norm_g; const float* mod_w; const float* mod_b;
    const float* pwi; const float* pwg; const float* pls; const float* pwo; const float* awi; const float* awo; const float* fg;
    float* out; unsigned char* ws;
    int ph_lo, ph_hi;
};
constexpr int NWAVES = 8, NTHR = 512;
constexpr int RING_BYTES = 131072, LDS_BYTES = 147456, MISC_OFF = LDS_BYTES - 256;

__device__ __forceinline__ void sincos_d(double a, float& s_out, float& c_out) {
    const double k = __builtin_rint(a * 0.6366197723675814);
    double r = __builtin_fma(-k, 1.5707963267948966, a); r = __builtin_fma(-k, 6.123233995736766e-17, r);
    const double r2 = r * r;
    double sp = -7.647163731819816e-13; sp = sp * r2 + 1.6059043836821613e-10; sp = sp * r2 - 2.505210838544172e-08; sp = sp * r2 + 2.7557319223985893e-06;
    sp = sp * r2 - 1.984126984126984e-04; sp = sp * r2 + 8.333333333333333e-03; sp = sp * r2 - 1.6666666666666666e-01; const double s = r + r * r2 * sp;
    double cp = 4.779477332387385e-14; cp = cp * r2 - 1.1470745597729725e-11; cp = cp * r2 + 2.08767569878681e-09; cp = cp * r2 - 2.755731922398589e-07;
    cp = cp * r2 + 2.48015873015873e-05; cp = cp * r2 - 1.388888888888889e-03; cp = cp * r2 + 4.1666666666666664e-02; cp = cp * r2 - 0.5; const double c = 1.0 + r2 * cp;
    const int q = (int)((long long)k & 3);
    const double ss = (q == 0) ? s : (q == 1) ? c : (q == 2) ? -s : -c;
    const double cc = (q == 0) ? c : (q == 1) ? -s : (q == 2) ? -c : s;
    s_out = (float)ss; c_out = (float)cc;
}
__device__ __forceinline__ void transpose_item(const float* W, int K, int N, bf16_t* WT, int row_off, LAS float* scr, int nblk, int item, int lane) {
    const int kb = item / nblk, nb = item % nblk, k0 = 64 * kb, n0 = 32 * nb;
    const int nn = n0 + (lane & 31);
    float tv[32];
#pragma unroll
    for (int i = 0; i < 32; ++i) { const int kk = 2 * i + (lane >> 5); tv[i] = (nn < N) ? W[(size_t)(k0 + kk) * N + nn] : 0.f; }
#pragma unroll
    for (int i = 0; i < 32; ++i) { const int kk = 2 * i + (lane >> 5); scr[kk * 33 + (lane & 31)] = tv[i]; }
    LDS_WAIT(); asm volatile("" ::: "memory");
    const int c = lane & 7;
#pragma unroll
    for (int j = 0; j < 4; ++j) { const int n = (lane >> 3) + 8 * j; const LAS float* s = scr + (8 * c) * 33 + n;
        u32x4 o; o.x = pk2(s[0 * 33], s[1 * 33]); o.y = pk2(s[2 * 33], s[3 * 33]); o.z = pk2(s[4 * 33], s[5 * 33]); o.w = pk2(s[6 * 33], s[7 * 33]);
        *(u32x4*)(WT + (size_t)(row_off + n0 + n) * K + k0 + 8 * c) = o; }
    LDS_WAIT(); asm volatile("" ::: "memory");
}
template <int VAR>
__device__ __forceinline__ void phase0(int wv, const Args& a, LAS unsigned char* lds) {
    const int tid = opaque_tid(wv), lane = tid & 63, wave = __builtin_amdgcn_readfirstlane(tid >> 6);
    const int G = gridDim.x, bx = blockIdx.x;
    unsigned char* ws = a.ws;
    if (VAR == 0 || VAR == 1)
    for (int unit = bx; unit < 256; unit += G) {
        const int layer = unit >> 6, kq = (unit >> 4) & 3, cs = unit & 15;
        const float* W = a.mod_w + ((size_t)layer * DM + 512 * kq) * 6144 + 384 * cs;
        LAS float* red = (LAS float*)lds;
        LAS float* cdl = (LAS float*)(lds + 8192);
        if (tid < 512) cdl[tid] = silu_f(a.c[512 * kq + tid]);
        if (tid < 8) cdl[512 + tid] = 0.f;
        __syncthreads();
        if (tid < 480) {
            const int kg = tid / 96, ln = tid - kg * 96;
            f32x4 acc4 = {0.f, 0.f, 0.f, 0.f};
#pragma unroll 8
            for (int i = 0; i < 103; ++i) { const int k = kg + 5 * i, kc = k < 512 ? k : 511;
                acc4 += *(const f32x4*)(W + (size_t)kc * 6144 + 4 * ln) * cdl[k]; }
            *(LAS f32x4*)(red + kg * 384 + 4 * ln) = acc4;
        }
        __syncthreads();
        if (tid < 384) { float sum = red[tid];
#pragma unroll
            for (int kg = 1; kg < 5; ++kg) sum += red[kg * 384 + tid];
            const int col = 384 * cs + tid;
            if (kq == 0) sum += a.mod_b[layer * 6144 + col];
            ((float*)(ws + WS_MOD))[(layer * 4 + kq) * 6144 + col] = sum; }
        __syncthreads();
    }
    if (VAR == 0 || VAR == 2) {
        float* cosq = (float*)(ws + WS_TAB); float* sinq = cosq + SEQ * 16; float* cosi = sinq + SEQ * 16; float* sini = cosi + SEQ * 8;
        for (int e = bx * NTHR + tid; e < SEQ * 24; e += G * NTHR) {
            const int p = e / 24, i = e - p * 24;
            const float pf = (float)a.pos[p];
            const double frac = i < 16 ? (double)i * (1.0 / 16.0) : (double)(i - 16) * (1.0 / 8.0);
            const float inv = (float)exp2(-18.931568569324174 * frac);
            const float ang = pf * inv;
            float s, c; sincos_d((double)ang, s, c);
            if (i < 16) { cosq[p * 16 + i] = c; sinq[p * 16 + i] = s; } else { cosi[p * 8 + i - 16] = c; sini[p * 8 + i - 16] = s; }
        }
    }
    if (VAR == 0 || VAR == 3) {
        LAS float* scr = (LAS float*)(lds + 16384 + wave * 8704);
        const int gw = bx * NWAVES + wave, NGW = G * NWAVES;
        constexpr int I_PI = 32 * 128, I_PG = 8 * 16, I_PO = 32 * 64, I_AI = 32 * 296, I_AO = 32 * 64;
        constexpr int NITEMS = 2 * I_PI + 8 * I_PG + 2 * I_PO + 2 * I_AI + 2 * I_AO;
        for (int it = gw; it < NITEMS; it += NGW) {
            int r = it;
            if (r < 2 * I_AI) { const int l = r / I_AI; r -= l * I_AI; transpose_item(a.awi + (size_t)l * DM * ATTN_IN, DM, ATTN_IN, (bf16_t*)(ws + WS_WAI) + (size_t)l * ATTN_INP * DM, 0, scr, 296, r, lane); continue; } r -= 2 * I_AI;
            if (r < 2 * I_PI) { const int l = r / I_PI; r -= l * I_PI; transpose_item(a.pwi + (size_t)l * DM * POOL_IN, DM, POOL_IN, (bf16_t*)(ws + WS_WPI) + (size_t)l * POOL_IN * DM, 0, scr, 128, r, lane); continue; } r -= 2 * I_PI;
            if (r < 2 * I_PO) { const int l = r / I_PO; r -= l * I_PO; transpose_item(a.pwo + (size_t)l * DM * DM, DM, DM, (bf16_t*)(ws + WS_WPO) + (size_t)l * DM * DM, 0, scr, 64, r, lane); continue; } r -= 2 * I_PO;
            if (r < 2 * I_AO) { const int l = r / I_AO; r -= l * I_AO; transpose_item(a.awo + (size_t)l * DM * DM, DM, DM, (bf16_t*)(ws + WS_WAO) + (size_t)l * DM * DM, 0, scr, 64, r, lane); continue; } r -= 2 * I_AO;
            { const int lg = r / I_PG; r -= lg * I_PG; const int l = lg >> 2, gi = lg & 3;
              transpose_item(a.pwg + (size_t)lg * 512 * 512, 512, 512, (bf16_t*)(ws + WS_WPG) + (size_t)l * DM * 512, gi * 512, scr, 16, r, lane); }
        }
    }
}

template <bool IN_BF16> __device__ __forceinline__ void phase_norm(int wv, const void* x, const float* g, const float* mod  , bf16_t* h, unsigned char* lds, float* gsum  ) {
    const int tid = opaque_tid(wv), lane = tid & 63, wave = tid >> 6;
    const int gw = blockIdx.x * NWAVES + wave, NGW = gridDim.x * NWAVES;
    u32x4 t[4][4]; f32x4 tf[4][8];
#define NORM_LOAD(row_) do {                                                                                                  \
        _Pragma("unroll") for (int r = 0; r < 4; ++r) { const size_t ro = (size_t)((row_) + r * NGW) * DM;                   \
            if (IN_BF16) { const u32x4* xr = (const u32x4*)((const bf16_t*)x + ro) + lane;                                   \
                _Pragma("unroll") for (int j = 0; j < 4; ++j) t[r][j] = xr[64 * j]; }                                        \
            else { const f32x4* xr = (const f32x4*)((const float*)x + ro) + 2 * lane;                                        \
                _Pragma("unroll") for (int j = 0; j < 4; ++j) { tf[r][2 * j] = xr[128 * j]; tf[r][2 * j + 1] = xr[128 * j + 1]; } } } } while (0)
    float* la = (float*)lds; float* lsft = la + DM;
    { const int col = 4 * tid;
      const f32x4 gg = *(const f32x4*)(g + col);
      const f32x4 p0 = *(const f32x4*)(mod + col), p1 = *(const f32x4*)(mod + 6144 + col), p2 = *(const f32x4*)(mod + 2 * 6144 + col), p3 = *(const f32x4*)(mod + 3 * 6144 + col);
      const f32x4 q0 = *(const f32x4*)(mod + DM + col), q1 = *(const f32x4*)(mod + 6144 + DM + col), q2 = *(const f32x4*)(mod + 2 * 6144 + DM + col), q3 = *(const f32x4*)(mod + 3 * 6144 + DM + col);
      f32x4 r0, r1, r2, r3;
      if (blockIdx.x == 0) { r0 = *(const f32x4*)(mod + 2 * DM + col); r1 = *(const f32x4*)(mod + 6144 + 2 * DM + col); r2 = *(const f32x4*)(mod + 2 * 6144 + 2 * DM + col); r3 = *(const f32x4*)(mod + 3 * 6144 + 2 * DM + col); }
      int row = gw; if (row < SEQ) NORM_LOAD(row);
      const f32x4 sh = ((p0 + p1) + p2) + p3, sc = ((q0 + q1) + q2) + q3;
      *(f32x4*)(la + col) = gg * (sc + 1.0f); *(f32x4*)(lsft + col) = sh;
      if (blockIdx.x == 0) *(f32x4*)(gsum + col) = ((r0 + r1) + r2) + r3; }
    __syncthreads();
    f32x4 av[8], sv[8];
#pragma unroll
    for (int j = 0; j < 8; ++j) { const int col = 8 * lane + 512 * (j >> 1) + 4 * (j & 1); av[j] = *(const f32x4*)(la + col); sv[j] = *(const f32x4*)(lsft + col); }
    for (int row = gw; row < SEQ; ) {
#pragma unroll
        for (int r = 0; r < 4; ++r) {
            f32x4 v[8];
#pragma unroll
            for (int j = 0; j < 4; ++j) { if (IN_BF16) unpack8(t[r][j], v[2 * j], v[2 * j + 1]); else { v[2 * j] = tf[r][2 * j]; v[2 * j + 1] = tf[r][2 * j + 1]; } }
            float s = 0.f;
#pragma unroll
            for (int j = 0; j < 8; ++j) s += (v[j].x * v[j].x + v[j].y * v[j].y) + (v[j].z * v[j].z + v[j].w * v[j].w);
            const float rstd = 1.0f / sqrtf(wave_sum(s) * (1.f / DM) + EPS);
            u32x4* o16 = (u32x4*)(h + (size_t)(row + r * NGW) * DM) + lane;
#pragma unroll
            for (int j = 0; j < 4; ++j) o16[64 * j] = pack8(v[2 * j] * rstd * av[2 * j] + sv[2 * j], v[2 * j + 1] * rstd * av[2 * j + 1] + sv[2 * j + 1]);
        }
        row += 4 * NGW; if (row >= SEQ) break;
        NORM_LOAD(row);
    }
#undef NORM_LOAD
}
__device__ __forceinline__ void phase_final(int wv, const bf16_t* x, float* y, const float* g) {
    const int tid = opaque_tid(wv), lane = tid & 63, wave = tid >> 6;
    const int gw = blockIdx.x * NWAVES + wave, NGW = gridDim.x * NWAVES;
    f32x4 gg[8];
#pragma unroll
    for (int j = 0; j < 8; ++j) gg[j] = *(const f32x4*)(g + 8 * lane + 512 * (j >> 1) + 4 * (j & 1));
    for (int row = gw; row < SEQ; row += 4 * NGW) {
        u32x4 t[4][4];
#pragma unroll
        for (int r = 0; r < 4; ++r) { const u32x4* xr = (const u32x4*)(x + (size_t)(row + r * NGW) * DM) + lane;
#pragma unroll
            for (int j = 0; j < 4; ++j) t[r][j] = xr[64 * j]; }
#pragma unroll
        for (int r = 0; r < 4; ++r) {
            f32x4 v[8]; float s = 0.f;
#pragma unroll
            for (int j = 0; j < 4; ++j) unpack8(t[r][j], v[2 * j], v[2 * j + 1]);
#pragma unroll
            for (int j = 0; j < 8; ++j) s += (v[j].x * v[j].x + v[j].y * v[j].y) + (v[j].z * v[j].z + v[j].w * v[j].w);
            const float rstd = 1.0f / sqrtf(wave_sum(s) * (1.f / DM) + EPS);
            f32x4* yr = (f32x4*)(y + (size_t)(row + r * NGW) * DM) + 2 * lane;
#pragma unroll
            for (int j = 0; j < 8; ++j) yr[128 * (j >> 1) + (j & 1)] = v[j] * rstd * gg[j];
        }
    }
}

template <int W, int R> __device__ __forceinline__ void pool_strip(const bf16_t* VG, bf16_t* PL, int t0, int c0) {
    u32x4 r[W + R - 1];
#pragma unroll
    for (int i = 0; i < W + R - 1; ++i) { const int t = t0 - (W - 1) + i; r[i] = *(const u32x4*)(VG + (size_t)(t < 0 ? 0 : t) * POOL_IN + c0); }
    float S[8];
#pragma unroll
    for (int e = 0; e < 8; ++e) S[e] = 0.f;
#pragma unroll
    for (int i = 0; i < W - 1; ++i) { const float wg = (t0 - (W - 1) + i >= 0) ? 1.f : 0.f;
#pragma unroll
        for (int e = 0; e < 4; ++e) { const unsigned x = r[i][e]; S[2 * e] += wg * __builtin_bit_cast(float, x << 16); S[2 * e + 1] += wg * __builtin_bit_cast(float, x & 0xffff0000u); } }
#pragma unroll
    for (int j = 0; j < R; ++j) { const int t = t0 + j;
        float v[8];
#pragma unroll
        for (int e = 0; e < 4; ++e) { const unsigned x = r[W - 1 + j][e]; v[2 * e] = __builtin_bit_cast(float, x << 16); v[2 * e + 1] = __builtin_bit_cast(float, x & 0xffff0000u); }
        const int cnt = (t + 1 < W) ? (t + 1) : W; const float ic = 1.0f / (float)cnt;
        float o[8];
#pragma unroll
        for (int e = 0; e < 8; ++e) { S[e] += v[e]; o[e] = S[e] * ic - v[e]; }
        u32x4 pw; pw.x = cvt_pk_bf16(o[0], o[1]); pw.y = cvt_pk_bf16(o[2], o[3]); pw.z = cvt_pk_bf16(o[4], o[5]); pw.w = cvt_pk_bf16(o[6], o[7]);
        *(u32x4*)(PL + (size_t)t * DM + c0) = pw;
        const float wg = (t - W + 1 >= 0) ? 1.f : 0.f;
#pragma unroll
        for (int e = 0; e < 4; ++e) { const unsigned x = r[j][e]; S[2 * e] -= wg * __builtin_bit_cast(float, x << 16); S[2 * e + 1] -= wg * __builtin_bit_cast(float, x & 0xffff0000u); } }
}
__device__ __forceinline__ void phase_pool(int wv, const bf16_t* VG, bf16_t* PL) {
    const int total = 512 * 256;
    const int tid = opaque_tid(wv);
    for (int it = blockIdx.x * NTHR + tid; it < total; it += gridDim.x * NTHR) {
        const int cg = it & 255, strip = it >> 8; const int c0 = cg * 8, t0 = strip * 16;
        const int grp = __builtin_amdgcn_readfirstlane(c0 >> 9);
        if (grp == 0) pool_strip<2, 16>(VG, PL, t0, c0); else if (grp == 1) pool_strip<4, 16>(VG, PL, t0, c0); else if (grp == 2) pool_strip<8, 16>(VG, PL, t0, c0);
        else { pool_strip<16, 8>(VG, PL, t0, c0); pool_strip<16, 8>(VG, PL, t0 + 8, c0); }
    }
}

__device__ __forceinline__ size_t sc_block_base(int qb) { return (size_t)65536 * (size_t)(qb * (qb + 1) / 2); }
__device__ __forceinline__ float fma_s(float a, float b, float c) { asm("v_fma_f32 %0, %1, %2, %0" : "+v"(c) : "v"(a), "v"(b)); return c; }
__device__ __forceinline__ float relu_i(float x) { const int b = __builtin_bit_cast(int, x); return __builtin_bit_cast(float, b > 0 ? b : 0); }
template <int VAR>
__device__ __forceinline__ void phase_scores(int wv, const bf16_t* QI, const bf16_t* KI, const float* WI, float* SC, LAS unsigned char* lds, unsigned* ctr  ) {
    const int tid = opaque_tid(wv), wid = __builtin_amdgcn_readfirstlane(tid >> 6), lane = tid & 63, r32 = lane & 31, hi = lane >> 5;
    constexpr int QROW = 2064;
    volatile LAS int* slot = (volatile LAS int*)(lds + 32 * QROW);
    for (;;) {
        __syncthreads();
        if (tid == 0) slot[0] = (int)__hip_atomic_fetch_add(ctr, 1u, __ATOMIC_RELAXED, __HIP_MEMORY_SCOPE_AGENT);
        __syncthreads();
        const int L = slot[0];
        if (L >= 1152) break;
        int kc = 0, base = 0;
        for (; kc < 8; ++kc) { const int n = 256 - 32 * kc; if (L < base + n) break; base += n; }
        const int u = 32 * kc + (L - base);
        const int q0 = 32 * u, qb = u >> 3;
        const int klim = (qb + 1) * 256;
        bf16x8 kf[2][4];
        { const int key0 = kc * 1024 + wid * 64;
#pragma unroll
            for (int b = 0; b < 2; ++b)
#pragma unroll
                for (int kk = 0; kk < 4; ++kk) kf[b][kk] = *(const bf16x8*)(KI + (size_t)(key0 + 32 * b + r32) * 64 + 16 * kk + 8 * hi); }
        {
            int t_ = tid; asm volatile("" : "+v"(t_));
            const bf16_t* src = QI + (size_t)q0 * 1024 + t_ * 8;
            const int ldst = (t_ >> 7) * QROW + (t_ & 127) * 16;
            u32x4 tq[8];
#pragma unroll
            for (int i = 0; i < 8; ++i) tq[i] = *(const u32x4*)(src + i * 4096);
            __builtin_amdgcn_sched_barrier(0);
#pragma unroll
            for (int i = 0; i < 8; ++i) *(LAS u32x4*)(lds + ldst + i * (4 * QROW)) = tq[i];
        }
        f32x4 wq[4];
#pragma unroll
        for (int i = 0; i < 4; ++i) wq[i] = *(const f32x4*)(WI + (size_t)(q0 + r32) * 16 + 4 * i);
        __syncthreads();
        for (int sl = wid; sl < 16; sl += 8) {
            const int key0 = kc * 1024 + sl * 64;
            if (key0 >= klim) continue;
            if (sl != wid) {
#pragma unroll
                for (int b = 0; b < 2; ++b)
#pragma unroll
                    for (int kk = 0; kk < 4; ++kk) kf[b][kk] = *(const bf16x8*)(KI + (size_t)(key0 + 32 * b + r32) * 64 + 16 * kk + 8 * hi); }
            f32x16 acc0 = {}, acc1 = {};
            const LAS unsigned char* qa = lds + r32 * QROW + hi * 16;
#define SC_MM(h, S0, S1) do { bf16x8 af_[4];                                                                                  \
                _Pragma("unroll") for (int kk = 0; kk < 4; ++kk) af_[kk] = *(const LAS bf16x8*)(qa + (h) * 128 + kk * 32);     \
                S0 = __builtin_amdgcn_mfma_f32_32x32x16_bf16(kf[0][0], af_[0], f32x16{}, 0, 0, 0); S1 = __builtin_amdgcn_mfma_f32_32x32x16_bf16(kf[1][0], af_[0], f32x16{}, 0, 0, 0); \
                _Pragma("unroll") for (int kk = 1; kk < 4; ++kk) { S0 = __builtin_amdgcn_mfma_f32_32x32x16_bf16(kf[0][kk], af_[kk], S0, 0, 0, 0); S1 = __builtin_amdgcn_mfma_f32_32x32x16_bf16(kf[1][kk], af_[kk], S1, 0, 0, 0); } } while (0)
#define SC_VA(h, S0, S1) do { const float w_ = wq[(h) >> 2][(h) & 3];                                                          \
                _Pragma("unroll") for (int r = 0; r < 16; ++r) { acc0[r] = fma_s(relu_i(S0[r]), w_, acc0[r]); acc1[r] = fma_s(relu_i(S1[r]), w_, acc1[r]); } } while (0)
#define SC_SB() __builtin_amdgcn_sched_barrier(0)
            f32x16 sA0, sA1, sB0, sB1;
            SC_MM(0, sA0, sA1); SC_SB();
            if (wid < 4) {
#pragma unroll
                for (int h = 0; h < 14; h += 2) {
                    SC_MM(h + 1, sB0, sB1); SC_SB(); SC_VA(h, sA0, sA1); SC_SB();
                    SC_MM(h + 2, sA0, sA1); SC_SB(); SC_VA(h + 1, sB0, sB1); SC_SB();
                }
                SC_MM(15, sB0, sB1); SC_SB(); SC_VA(14, sA0, sA1); SC_SB();
                SC_VA(15, sB0, sB1);
            } else {
                SC_MM(1, sB0, sB1); SC_SB();
#pragma unroll
                for (int h = 0; h < 14; h += 2) {
                    SC_VA(h, sA0, sA1); SC_SB(); SC_MM(h + 2, sA0, sA1); SC_SB();
                    SC_VA(h + 1, sB0, sB1); SC_SB(); SC_MM(h + 3, sB0, sB1); SC_SB();
                }
                SC_VA(14, sA0, sA1); SC_SB();
                SC_VA(15, sB0, sB1);
            }
#undef SC_SB
#undef SC_MM
#undef SC_VA
            float* out = SC + sc_block_base(qb) + (size_t)(q0 - qb * 256 + r32) * (size_t)klim + key0 + 4 * hi;
#pragma unroll
            for (int g = 0; g < 4; ++g) {
                *(f32x4*)(out + 8 * g) = (f32x4){acc0[4 * g], acc0[4 * g + 1], acc0[4 * g + 2], acc0[4 * g + 3]};
                *(f32x4*)(out + 32 + 8 * g) = (f32x4){acc1[4 * g], acc1[4 * g + 1], acc1[4 * g + 2], acc1[4 * g + 3]}; }
        }
    }
}

template <int VAR>
__device__ __forceinline__ void phase_select(int wv, const float* SC, unsigned long long* MASK, LAS unsigned char* lds) {
    const int tid = opaque_tid(wv), lane0 = tid & 63, wave = __builtin_amdgcn_readfirstlane(tid >> 6);
    LAS unsigned* hist = (LAS unsigned*)(lds + wave * 9216);
    const int gw = blockIdx.x * NWAVES + wave, NGW = gridDim.x * NWAVES;
    for (int q = gw; q < SEQ; q += NGW) {
        int lane = lane0; asm volatile("" : "+v"(lane));
        const int qb = q >> 8, klim = (qb + 1) * 256;
        const float* rowp = SC + sc_block_base(qb) + (size_t)(q - qb * 256) * (size_t)klim;
        const int ngrp = qb + 1;
        unsigned key[32][4];
#pragma unroll
        for (int g = 0; g < 8; ++g) {
            if (4 * g < ngrp) {
#pragma unroll
                for (int i = 0; i < 4; ++i) { const u32x4 v = *(const u32x4*)(rowp + 256 * (4 * g + i) + 4 * lane);
                    key[4 * g + i][0] = v.x; key[4 * g + i][1] = v.y; key[4 * g + i][2] = v.z; key[4 * g + i][3] = v.w; }
            } else {
#pragma unroll
                for (int i = 0; i < 4; ++i) { key[4 * g + i][0] = 0u; key[4 * g + i][1] = 0u; key[4 * g + i][2] = 0u; key[4 * g + i][3] = 0u; }
            }
        }
        unsigned T = 1u; unsigned need_eq = 0xffffffffu, n_eq = 0u;
        const bool radix = (q + 1 > TOPK) && (VAR != 1 && VAR != 3);
        if (VAR == 3) { unsigned x_ = 0u;
#pragma unroll
            for (int j = 0; j < 32; ++j) x_ |= key[j][0] & key[j][1] & key[j][2] & key[j][3];
            if (x_ == 0x12345u) MASK[q] = x_; continue; }
        if (radix) {
#pragma unroll
            for (int i = 0; i < 9; ++i) *(LAS u32x4*)(hist + 4 * (lane + 64 * i)) = (u32x4){0u, 0u, 0u, 0u};
        }
        __builtin_amdgcn_sched_barrier(0);
#pragma unroll
        for (int g = 0; g < 8; ++g) { if (4 * g < ngrp) {
#pragma unroll
            for (int i = 0; i < 4; ++i)
#pragma unroll
                for (int e = 0; e < 4; ++e) { const int j = 4 * g + i; const unsigned uu = key[j][e];
                    const unsigned kx = uu ^ ((unsigned)((int)uu >> 31) | 0x80000000u); key[j][e] = (256 * j + 4 * lane + e <= q) ? kx : 0u; }
            } __builtin_amdgcn_sched_barrier(0); }
        if (radix) {
            unsigned gm0 = 0u, gm1 = 0u, gm2 = 0u, gm3 = 0u;
#pragma unroll
            for (int g = 0; g < 8; ++g) if (4 * g < ngrp) {
#pragma unroll
                for (int i = 0; i < 4; ++i) { const int j = 4 * g + i; gm0 = key[j][0] > gm0 ? key[j][0] : gm0; gm1 = key[j][1] > gm1 ? key[j][1] : gm1; gm2 = key[j][2] > gm2 ? key[j][2] : gm2; gm3 = key[j][3] > gm3 ? key[j][3] : gm3; }
            }
            unsigned Pmin = gm0 < gm1 ? gm0 : gm1; { const unsigned p2 = gm2 < gm3 ? gm2 : gm3; Pmin = Pmin < p2 ? Pmin : p2; }
#pragma unroll
            for (int off = 1; off < 64; off <<= 1) { const unsigned tt = (unsigned)__builtin_amdgcn_ds_bpermute((lane ^ off) << 2, (int)Pmin); Pmin = tt < Pmin ? tt : Pmin; }
            LDS_WAIT();
#pragma unroll
            for (int g = 0; g < 8; ++g) if (4 * g < ngrp) {
#pragma unroll
                for (int i = 0; i < 4; ++i) {
#pragma unroll
                    for (int e = 0; e < 4; ++e) { const unsigned k = key[4 * g + i][e];
                        if (k >= Pmin) { const unsigned b = k >> 21; __hip_atomic_fetch_add(hist + b + ((b >> 5) << 2), 1u, __ATOMIC_RELAXED, __HIP_MEMORY_SCOPE_WORKGROUP); } }
                    __builtin_amdgcn_sched_barrier(0); }
            }
            unsigned prefix = 0u, pmask = 0u, kk = TOPK;
#pragma unroll 1
            for (int pass = 0; pass < ((VAR == 4) ? 1 : 3); ++pass) {
                const int shift = (pass == 0) ? 21 : (pass == 1) ? 10 : 0;
                const unsigned dmask = (pass == 2) ? 1023u : 2047u;
                LDS_WAIT();
                if (pass > 0) {
#pragma unroll
                    for (int g = 0; g < 8; ++g) if (4 * g < ngrp) {
#pragma unroll
                        for (int i = 0; i < 4; ++i) {
#pragma unroll
                            for (int e = 0; e < 4; ++e) { const unsigned k = key[4 * g + i][e];
                                if ((k & pmask) == prefix) { const unsigned b = (k >> shift) & dmask; __hip_atomic_fetch_add(hist + b + ((b >> 5) << 2), 1u, __ATOMIC_RELAXED, __HIP_MEMORY_SCOPE_WORKGROUP); } }
                            __builtin_amdgcn_sched_barrier(0); }
                    }
                }
                LDS_WAIT();
                if (VAR == 5) { prefix |= (0x5a5u & dmask) << shift; pmask |= dmask << shift; continue; }
                unsigned s = 0u;
#pragma unroll
                for (int i = 0; i < 8; ++i) { const u32x4 v = *(const LAS u32x4*)(hist + 36 * lane + 4 * i); s += (v.x + v.y) + (v.z + v.w); }
                unsigned suf = s;
#pragma unroll
                for (int off = 1; off < 64; off <<= 1) { const unsigned tt = (unsigned)__builtin_amdgcn_ds_bpermute(((lane + off) & 63) << 2, (int)suf); if (lane + off < 64) suf += tt; }
                const unsigned long long bal = __ballot(suf >= kk);
                const int Ls = 63 - __builtin_clzll(bal);
                const unsigned above1 = (unsigned)__builtin_amdgcn_readlane((int)(suf - s), Ls);
                const unsigned c2 = hist[36 * Ls + (lane & 31)];
                unsigned suf2 = (lane < 32) ? c2 : 0u;
#pragma unroll
                for (int off = 1; off < 32; off <<= 1) { const unsigned tt = (unsigned)__builtin_amdgcn_ds_bpermute(((lane + off) & 63) << 2, (int)suf2); if (lane + off < 32) suf2 += tt; }
                const unsigned long long bal2 = __ballot(lane < 32 && above1 + suf2 >= kk);
                const int Bs = 63 - __builtin_clzll(bal2);
                const int dsel = 32 * Ls + Bs;
                const unsigned cnt_b = (unsigned)__builtin_amdgcn_readlane((int)c2, Bs);
                const unsigned kk_new = kk - (above1 + (unsigned)__builtin_amdgcn_readlane((int)suf2, Bs) - cnt_b);
                LDS_WAIT();
#pragma unroll
                for (int i = 0; i < 9; ++i) *(LAS u32x4*)(hist + 4 * (lane + 64 * i)) = (u32x4){0u, 0u, 0u, 0u};
                const unsigned d = (unsigned)dsel; kk = kk_new; n_eq = cnt_b;
                prefix |= d << shift; pmask |= dmask << shift;
            }
            T = prefix; need_eq = kk;
        }
        if (VAR == 2 || VAR == 4 || VAR == 5) { if (T == 0x12345u) MASK[q] = T; continue; }
        const bool tie_path = (need_eq != 0xffffffffu) && (n_eq > need_eq);
        unsigned tie_seen = 0u;
        const unsigned long long lt = (lane == 0) ? 0ull : (~0ull >> (64 - lane));
        int w0lo = 0, w0hi = 0, w1lo = 0, w1hi = 0;
#pragma unroll
        for (int g = 0; g < 8; ++g) if (4 * g < ngrp) {
#pragma unroll
            for (int i = 0; i < 4; ++i) { const int j = 4 * g + i;
                unsigned long long B[4];
                if (!tie_path) {
#pragma unroll
                    for (int e = 0; e < 4; ++e) B[e] = __ballot(key[j][e] >= T);
                } else {
                    unsigned long long E[4]; unsigned before = tie_seen;
#pragma unroll
                    for (int e = 0; e < 4; ++e) { E[e] = __ballot(key[j][e] == T); before += (unsigned)__builtin_popcountll(E[e] & lt); }
                    unsigned mine = 0u;
#pragma unroll
                    for (int e = 0; e < 4; ++e) { const bool eq = (key[j][e] == T);
                        B[e] = __ballot(key[j][e] > T || (eq && (before + mine) < need_eq)); mine += eq ? 1u : 0u; }
#pragma unroll
                    for (int e = 0; e < 4; ++e) tie_seen += (unsigned)__builtin_popcountll(E[e]);
                }
#pragma unroll
                for (int k = 0; k < 4; ++k) { const int t = 4 * j + k;
                    const unsigned blo_ = (unsigned)((B[0] >> (16 * k)) & 0xffffull) | ((unsigned)((B[1] >> (16 * k)) & 0xffffull) << 16);
                    const unsigned bhi_ = (unsigned)((B[2] >> (16 * k)) & 0xffffull) | ((unsigned)((B[3] >> (16 * k)) & 0xffffull) << 16);
                    if (t < 64) asm volatile("s_nop 3\n\tv_writelane_b32 %0, %2, %4\n\tv_writelane_b32 %1, %3, %4" : "+v"(w0lo), "+v"(w0hi) : "s"(blo_), "s"(bhi_), "n"(t & 63));
                    else asm volatile("s_nop 3\n\tv_writelane_b32 %0, %2, %4\n\tv_writelane_b32 %1, %3, %4" : "+v"(w1lo), "+v"(w1hi) : "s"(blo_), "s"(bhi_), "n"(t & 63)); }
            }
        }
        const int ntile = 4 * ngrp;
        if (lane < ntile) MASK[(size_t)lane * SEQ + q] = ((unsigned long long)(unsigned)w0hi << 32) | (unsigned)w0lo;
        if (lane + 64 < ntile) MASK[(size_t)(lane + 64) * SEQ + q] = ((unsigned long long)(unsigned)w1hi << 32) | (unsigned)w1lo;
    }
}

__device__ __forceinline__ att::BlockRef attn_ref(int h, int qb, bool rev, const bf16_t* Qh, const bf16_t* Kh, const bf16_t* Vh, bf16_t* O, const bf16_t* SG, const unsigned long long* MASK) {
    att::BlockRef r;
    const long first = rev ? (long)(4 * qb + 3) : 0l;
    r.Q = Qh + ((size_t)h * SEQ + (size_t)qb * 256) * HD; r.K = Kh + (size_t)h * SEQ * HD + first * (att::KVBLK * HD); r.V = Vh + (size_t)h * SEQ * HD + first * (att::KVBLK * HD);
    r.O = O + (size_t)qb * 256 * DM + h * HD; r.G = SG + (size_t)qb * 256 * DM + h * HD; r.M = MASK + qb * 256 + first * SEQ; r.P0 = qb * 256;
    r.kst = rev ? -(long)(att::KVBLK * HD) : (long)(att::KVBLK * HD); r.mst = rev ? -(long)SEQ : (long)SEQ;
    return r;
}
__device__ __forceinline__ void phase_attn(int wv, const bf16_t* Qh, const bf16_t* Kh, const bf16_t* Vh, bf16_t* O, const bf16_t* SG, const unsigned long long* MASK, char* lds) {
    const int total = NHEAD * 16, stride = gridDim.x;
    int L = blockIdx.x; if (L >= total) return;
    if (gridDim.x == 256) { const int b = L; L = 16 * ((b & 7) + 8 * (b >> 7)) + ((b >> 3) & 15); }
    int pass = 0;
    att::BlockRef cur = attn_ref(L >> 4, L & 15, false, Qh, Kh, Vh, O, SG, MASK);
    att::Seam S;
    att::attn_prime(wv, cur, lds, S);
    for (;;) {
        const bool more_pass = pass == 0, more_item = L + stride < total, last = !more_pass && !more_item;
        int passn = pass + 1, Ln = L;
        if (!more_pass) { passn = 0; Ln = more_item ? L + stride : L; }
        const int hn = Ln >> 4, xn = Ln & 15;
        const att::BlockRef nxt = last ? cur : attn_ref(hn, passn ? 31 - xn : xn, passn != 0, Qh, Kh, Vh, O, SG, MASK);
        att::attn_block(wv, cur, nxt, lds, S);
        if (last) break;
        cur = nxt; pass = passn; L = Ln;
    }
}

__global__ void __launch_bounds__(NTHR, 2) trunk_fwd(Args args) {
    extern __shared__ __attribute__((aligned(16))) unsigned char lds_raw[];
    LAS unsigned char* lds = (LAS unsigned char*)lds_raw;
    volatile LAS unsigned* MISC = (volatile LAS unsigned*)(lds + MISC_OFF);
    const int wv = __builtin_amdgcn_readfirstlane((int)threadIdx.x >> 6);
    const int tid = opaque_tid(wv);
    unsigned char* ws = args.ws;
    if (tid < 32) MISC[tid] = 0u;
    __syncthreads();
    XcdBarrier bar; bar.bar = (unsigned*)(ws + WS_CTL) + 1024; bar.x = 0; bar.st = nullptr;
    if (MK_ONE_LAUNCH) bar = xcd_barrier_post((unsigned*)(ws + WS_CTL) + 1024, MISC + 8);
    const int lo = args.ph_lo, hi = args.ph_hi;
    int ph = 0;
#ifndef PHASE_MASK
#define PHASE_MASK 0xFFFF
#endif
#define IN(k) (lo <= (k) && (k) < hi)
#define PM(b) ((PHASE_MASK >> (b)) & 1)
#ifndef DUP_MASK
#define DUP_MASK 0
#endif
#ifndef SC_VAR
#define SC_VAR 0
#endif
#define DUP(b) ((DUP_MASK >> (b)) & 1)
#define REDO(b, stmt) do { if (DUP(b)) { if (MK_ONE_LAUNCH) xcd_barrier(bar); else __syncthreads(); stmt; } } while (0)
#ifndef ECHO_MASK
#define ECHO_MASK 0
#endif
#define ECHO_K 4
    unsigned long long echo_acc = 0ull, echo_prev = ECHO_MASK ? __builtin_amdgcn_s_memrealtime() : 0ull;
#define SEAM(b) do { if (IN(ph) && IN(ph + 1)) xcd_barrier(bar); ++ph; \
        if (ECHO_MASK) { const unsigned long long now_ = __builtin_amdgcn_s_memrealtime(); if ((ECHO_MASK >> (b)) & 1) echo_acc += now_ - echo_prev; echo_prev = now_; } } while (0)

    float* mod = (float*)(ws + WS_MOD);
    bf16_t* HU = (bf16_t*)(ws + WS_HU);
    const float* cosq = (const float*)(ws + WS_TAB); const float* sinq = cosq + SEQ * 16; const float* cosi = sinq + SEQ * 16; const float* sini = cosi + SEQ * 8;
    const int G = gridDim.x, bx = blockIdx.x;

    if (PM(0) && IN(ph)) { phase0<0>(wv, args, lds); REDO(0, phase0<SC_VAR>(wv, args, lds)); }
    SEAM(0);
#pragma unroll 1
    for (int layer = 0; layer < 4; ++layer) {
        const int j = layer >> 1;
        bf16_t* XB = (bf16_t*)(ws + WS_XB);
        float* lgs = (float*)mod + 16 * 6144 + layer * DM;
        const float* lmod = mod + layer * 4 * 6144;
        if (PM(1) && IN(ph)) { if (layer == 0) phase_norm<false>(wv, args.x, args.norm_g, lmod, HU, lds_raw, lgs); else phase_norm<true>(wv, XB, args.norm_g + layer * DM, lmod, HU, lds_raw, lgs); }
        SEAM(1);
        if ((layer & 1) == 0) {
            bf16_t* VG = (bf16_t*)(ws + WS_VG); bf16_t* PL = (bf16_t*)(ws + WS_PL);
            if (PM(2) && IN(ph)) { pg8::Gemm g{HU, (const bf16_t*)(ws + WS_WPI) + (size_t)j * POOL_IN * DM, SEQ, POOL_IN, DM, DM, DM, 0, 0};
                pg8::StaticOrder S; S.init(SEQ, POOL_IN, G, bx); pg8::EpiBf16 E{VG, POOL_IN};
                pg8::gemm_phase<pg8::EpiBf16, true>(wv, lds, g, S, E); REDO(2, (pg8::gemm_phase<pg8::EpiBf16, true>(wv, lds, g, S, E))); }
            SEAM(2);
            if (PM(3) && IN(ph)) { phase_pool(wv, VG, PL); REDO(3, phase_pool(wv, VG, PL)); }
            SEAM(3);
            if (PM(4) && IN(ph)) { pg8::Gemm g{PL, (const bf16_t*)(ws + WS_WPG) + (size_t)j * DM * 512, SEQ, DM, 512, DM, 512, 1, 512};
                pg8::StaticOrder S; S.init(SEQ, DM, G, bx); pg8::EpiPoolGrp E{HU, VG, args.pls + j * DM};
                pg8::gemm_phase<pg8::EpiPoolGrp, true>(wv, lds, g, S, E); REDO(4, (pg8::gemm_phase<pg8::EpiPoolGrp, true>(wv, lds, g, S, E))); }
            SEAM(4);
            if (PM(5) && IN(ph)) { pg8::Gemm g{HU, (const bf16_t*)(ws + WS_WPO) + (size_t)j * DM * DM, SEQ, DM, DM, DM, DM, 0, 0};
                pg8::StaticOrder S; S.init(SEQ, DM, G, bx);
                if (layer == 0) { pg8::EpiResid<false, true> E{args.x, XB, lgs}; pg8::gemm_phase<pg8::EpiResid<false, true>, true>(wv, lds, g, S, E); }
                else { pg8::EpiResid<true, true> E{XB, XB, lgs}; pg8::gemm_phase<pg8::EpiResid<true, true>, true>(wv, lds, g, S, E); } }
            SEAM(5);
        } else {
            bf16_t* Qh = (bf16_t*)(ws + WS_Q); bf16_t* Kh = (bf16_t*)(ws + WS_K); bf16_t* Vh = (bf16_t*)(ws + WS_V); bf16_t* SG = (bf16_t*)(ws + WS_GATE);
            bf16_t* QI = (bf16_t*)(ws + WS_QI); bf16_t* KI = (bf16_t*)(ws + WS_KI); float* WI = (float*)(ws + WS_WI);
            unsigned long long* MASK = (unsigned long long*)(ws + WS_MASK); float* SC = (float*)(ws + WS_SC);
            if (PM(6) && IN(ph)) { pg8::Gemm g{HU, (const bf16_t*)(ws + WS_WAI) + (size_t)j * ATTN_INP * DM, SEQ, ATTN_INP, DM, DM, DM, 0, 0};
                pg8::StaticOrder S; S.init(SEQ, ATTN_INP, G, bx); pg8::EpiAttnIn E{ws, args.pos};
                pg8::gemm_phase<pg8::EpiAttnIn, true>(wv, lds, g, S, E); REDO(6, (pg8::gemm_phase<pg8::EpiAttnIn, true>(wv, lds, g, S, E))); }
            SEAM(6);
            if (PM(7) && IN(ph)) { unsigned* qctr = (unsigned*)(ws + WS_CTL) + 8192 + 128 * j; phase_scores<0>(wv, QI, KI, WI, SC, lds, qctr); REDO(7, phase_scores<SC_VAR>(wv, QI, KI, WI, (float*)(ws + WS_END), lds, qctr + 64)); }
            SEAM(7);
            if (PM(8) && IN(ph)) { phase_select<0>(wv, SC, MASK, lds); REDO(8, phase_select<SC_VAR>(wv, SC, (unsigned long long*)(ws + WS_END), lds)); }
            SEAM(8);
            if (PM(9) && IN(ph)) { phase_attn(wv, Qh, Kh, Vh, HU, SG, MASK, (char*)lds_raw); REDO(9, phase_attn(wv, Qh, Kh, Vh, HU, SG, MASK, (char*)lds_raw)); }
            SEAM(9);
            if (PM(5) && IN(ph)) { pg8::Gemm g{HU, (const bf16_t*)(ws + WS_WAO) + (size_t)j * DM * DM, SEQ, DM, DM, DM, DM, 0, 0};
                pg8::StaticOrder S; S.init(SEQ, DM, G, bx);
                { pg8::EpiResid<true, true> E{XB, XB, lgs}; pg8::gemm_phase<pg8::EpiResid<true, true>, true>(wv, lds, g, S, E); } }
            SEAM(5);
        }
    }
    if (PM(10) && IN(ph)) { phase_final(wv, (const bf16_t*)(ws + WS_XB), args.out, args.fg); REDO(10, phase_final(wv, (const bf16_t*)(ws + WS_XB), args.out, args.fg)); }
    if (ECHO_MASK) { if ((ECHO_MASK >> 10) & 1) echo_acc += __builtin_amdgcn_s_memrealtime() - echo_prev;
        if (bx == 0) { const unsigned long long target_ = __builtin_amdgcn_s_memrealtime() + (unsigned long long)ECHO_K * echo_acc; while (__builtin_amdgcn_s_memrealtime() < target_) __builtin_amdgcn_s_sleep(32); } }
#undef IN
#undef PM
#undef SEAM
#undef REDO
}
constexpr int N_PHASES = 1 + 2 * 5 + 2 * 6 + 1;

extern "C" void kernel_launch(void* const* d_in, const int* in_sizes, int n_in, void* d_out, int out_size, void* d_ws, size_t ws_size, hipStream_t stream) {
    static int grid = 0;
    if (grid == 0) {
        if (n_in != 13 || in_sizes[0] != SEQ * DM || out_size != SEQ * DM || ws_size < WS_END) {
            fprintf(stderr, "kernel_launch: unexpected shapes / workspace (n_in %d, in0 %d, out %d, ws %zu, need %zu)\n", n_in, n_in > 0 ? in_sizes[0] : -1, out_size, ws_size, (size_t)WS_END);
            grid = -1; return; }
        int dev = 0, cus = 0, per_cu = 0;
        if (hipGetDevice(&dev) != hipSuccess || hipDeviceGetAttribute(&cus, hipDeviceAttributeMultiprocessorCount, dev) != hipSuccess) { grid = -1; return; }
        if (hipFuncSetAttribute((const void*)trunk_fwd, hipFuncAttributeMaxDynamicSharedMemorySize, LDS_BYTES) != hipSuccess) { fprintf(stderr, "kernel_launch: hipFuncSetAttribute failed\n"); grid = -1; return; }
        if (hipOccupancyMaxActiveBlocksPerMultiprocessor(&per_cu, (const void*)trunk_fwd, NTHR, LDS_BYTES) != hipSuccess || per_cu < 1) {
            fprintf(stderr, "kernel_launch: occupancy query reports %d workgroups per CU\n", per_cu); per_cu = 1; }
        (void)hipGetLastError();
        grid = cus;
        if (grid > 256) grid = 256;
    }
    if (grid < 0) return;
    (void)hipMemsetAsync((char*)d_ws + WS_CTL, 0, CTL_ZERO_BYTES, stream);
    Args a{};
    a.x = (const float*)d_in[0]; a.c = (const float*)d_in[1]; a.pos = (const int*)d_in[2]; a.norm_g = (const float*)d_in[3];
    a.mod_w = (const float*)d_in[4]; a.mod_b = (const float*)d_in[5]; a.pwi = (const float*)d_in[6]; a.pwg = (const float*)d_in[7];
    a.pls = (const float*)d_in[8]; a.pwo = (const float*)d_in[9]; a.awi = (const float*)d_in[10]; a.awo = (const float*)d_in[11]; a.fg = (const float*)d_in[12];
    a.out = (float*)d_out; a.ws = (unsigned char*)d_ws;
#if MK_ONE_LAUNCH
    a.ph_lo = 0; a.ph_hi = N_PHASES;
    hipLaunchKernelGGL(trunk_fwd, dim3(grid), dim3(NTHR), LDS_BYTES, stream, a);
#else
    for (int p = 0; p < N_PHASES; ++p) { a.ph_lo = p; a.ph_hi = p + 1; hipLaunchKernelGGL(trunk_fwd, dim3(grid), dim3(NTHR), LDS_BYTES, stream, a); }
#endif
}
```

```cpp
#include <hip/hip_runtime.h>
#include <cstdio>
#include <cstdint>
#include <cmath>

#ifndef MK_ONE_LAUNCH
#define MK_ONE_LAUNCH 1
#endif

#define LAS __attribute__((address_space(3)))
#define GAS __attribute__((address_space(1)))
typedef unsigned short bf16_t;
typedef short bf16x8 __attribute__((ext_vector_type(8)));
typedef short s16x4 __attribute__((ext_vector_type(4)));
typedef float f32x4 __attribute__((ext_vector_type(4)));
typedef float f32x2 __attribute__((ext_vector_type(2)));
typedef float f32x16 __attribute__((ext_vector_type(16)));
typedef unsigned u32x4 __attribute__((ext_vector_type(4)));
typedef unsigned u32x2 __attribute__((ext_vector_type(2)));

constexpr int DM = 2048, SEQ = 8192, NHEAD = 16, HD = 128, IDXH = 16, IDXD = 64;
constexpr int POOL_IN = 4096, ATTN_IN = 9296, ATTN_INP = 9472  ;
constexpr int TOPK = 256;
constexpr float EPS = 1e-6f;

constexpr size_t MiB = 1u << 20;
constexpr size_t WS_CTL = 0, CTL_ZERO_BYTES = 64 * 1024;
constexpr size_t WS_MOD = 1 * MiB;
constexpr size_t WS_TAB = 2 * MiB;
constexpr size_t WS_WPI = 4 * MiB;
constexpr size_t WS_WPG = 36 * MiB;
constexpr size_t WS_WPO = 40 * MiB;
constexpr size_t WS_WAI = 56 * MiB;
constexpr size_t WS_WAO = 130 * MiB;
constexpr size_t WS_HU = 146 * MiB;
constexpr size_t WS_L = 178 * MiB;
constexpr size_t WS_VG = WS_L;
constexpr size_t WS_PL = WS_L + 64 * MiB;
constexpr size_t WS_Q = WS_L, WS_K = WS_L + 32 * MiB, WS_V = WS_L + 64 * MiB;
constexpr size_t WS_GATE = WS_L + 96 * MiB;
constexpr size_t WS_QI = WS_L + 128 * MiB;
constexpr size_t WS_KI = WS_L + 144 * MiB;
constexpr size_t WS_WI = WS_L + 145 * MiB;
constexpr size_t WS_MASK = WS_L + 146 * MiB;
constexpr size_t WS_SC = WS_L + 154 * MiB;
constexpr size_t WS_XB = WS_SC + 139 * MiB;
constexpr size_t WS_END = WS_XB + 32 * MiB;

__device__ __forceinline__ unsigned cvt_pk_bf16(float lo, float hi) { unsigned r; asm volatile("v_cvt_pk_bf16_f32 %0, %1, %2" : "=v"(r) : "v"(lo), "v"(hi)); return r; }
__device__ __forceinline__ unsigned f2bf(float f) { unsigned u = __builtin_bit_cast(unsigned, f); return (u + 0x7fffu + ((u >> 16) & 1u)) >> 16; }
__device__ __forceinline__ unsigned pk2(float lo, float hi) { return f2bf(lo) | (f2bf(hi) << 16); }
__device__ __forceinline__ float bf2f(unsigned short b) { return __builtin_bit_cast(float, (unsigned)b << 16); }
__device__ __forceinline__ float fast_sigmoid(float x) { return __builtin_amdgcn_rcpf(1.0f + __builtin_amdgcn_exp2f(-1.4426950408889634f * x)); }
__device__ __forceinline__ float silu_f(float x) { return x * fast_sigmoid(x); }
template <int X> __device__ __forceinline__ float swz_xor(float v) {
    return __builtin_bit_cast(float, __builtin_amdgcn_ds_swizzle(__builtin_bit_cast(int, v), (X << 10) | 0x1f)); }
__device__ __forceinline__ float wave_sum(float v) {
    v += swz_xor<1>(v); v += swz_xor<2>(v); v += swz_xor<4>(v); v += swz_xor<8>(v); v += swz_xor<16>(v);
    const auto rr = __builtin_amdgcn_permlane32_swap(__builtin_bit_cast(unsigned, v), __builtin_bit_cast(unsigned, v), false, false);
    const unsigned r0 = rr[0], r1 = rr[1];
    return __builtin_bit_cast(float, r0) + __builtin_bit_cast(float, r1);
}
__device__ __forceinline__ int opaque_tid(int wv) { int t; asm volatile("v_mbcnt_lo_u32_b32 %0, -1, 0\n\tv_mbcnt_hi_u32_b32 %0, -1, %0\n\tv_lshl_add_u32 %0, %1, 6, %0" : "=&v"(t) : "s"(wv)); return t; }
#define LDS_WAIT() asm volatile("s_waitcnt lgkmcnt(0)" ::: "memory")
#define VM_WAIT() asm volatile("s_waitcnt vmcnt(0)" ::: "memory")

__device__ __forceinline__ void unpack8(const u32x4 w, f32x4& a, f32x4& b) {
    const unsigned w0 = w.x, w1 = w.y, w2 = w.z, w3 = w.w;
    a = (f32x4){__builtin_bit_cast(float, w0 << 16), __builtin_bit_cast(float, w0 & 0xffff0000u), __builtin_bit_cast(float, w1 << 16), __builtin_bit_cast(float, w1 & 0xffff0000u)};
    b = (f32x4){__builtin_bit_cast(float, w2 << 16), __builtin_bit_cast(float, w2 & 0xffff0000u), __builtin_bit_cast(float, w3 << 16), __builtin_bit_cast(float, w3 & 0xffff0000u)};
}
__device__ __forceinline__ u32x4 pack8(const f32x4 a, const f32x4 b) { u32x4 w; w.x = cvt_pk_bf16(a[0], a[1]); w.y = cvt_pk_bf16(a[2], a[3]); w.z = cvt_pk_bf16(b[0], b[1]); w.w = cvt_pk_bf16(b[2], b[3]); return w; }

constexpr float ATT_QSCALE = 0.08838834764831845f * 1.4426950408889634f;
namespace pg8 {
constexpr int BM = 256, BK = 64, HALF = 128, HTB = HALF * BK * 2, STAGE_BYTES = 8 * HTB, NXCD = 8, WGM = 8;
__host__ __device__ __forceinline__ int lds_byte(int r, int c) { const int st = (r >> 4) * 2 + (c >> 5), rr = r & 15, cc = c & 31, ob = rr * 64 + cc * 2; return st * 1024 + (ob ^ (((ob >> 9) & 1) << 5)); }
__host__ __device__ __forceinline__ void stage_rc(int b, int& R, int& C) { const int st = b / 1024, sb = b % 1024, swz = sb ^ (((sb >> 9) & 1) << 5); R = (st >> 1) * 16 + swz / 64; C = (st & 1) * 32 + (swz % 64) / 2; }
__host__ __device__ __forceinline__ int perm32(int rho) { const int n = rho >> 4, i = rho & 15; return 8 * (i >> 2) + 4 * n + (i & 3); }

struct Unit { int pm, pn; };
struct Gemm { const bf16_t* A; const bf16_t* Bt; int M, N, K, lda, ldb, agsh, agstride; };

struct StaticOrder {
    int nM, nN, nwg, G, c;
    __host__ __device__ void init(int M, int N, int G_, int c_) { nM = M / BM; nN = N / BM; nwg = nM * nN; G = G_; c = c_; }
    __host__ __device__ bool next(int i, Unit& u) const {
        const long L = (long)i * G + c; if (L >= nwg) return false;
        int wgid = (int)L; { const int q = nwg / NXCD, r = nwg % NXCD, xcd = wgid % NXCD, off = wgid / NXCD; wgid = (xcd < r ? xcd * (q + 1) : r * (q + 1) + (xcd - r) * q) + off; }
        const int nig = WGM * nN, gid = wgid / nig, fm = gid * WGM, gsz = (nM - fm) < WGM ? (nM - fm) : WGM;
        u.pm = fm + ((wgid % nig) % gsz); u.pn = (wgid % nig) / gsz; return true;
    }
};

template <class Epi, bool ALIGN_EPI>
__device__ __forceinline__ void gemm_phase(int wv, LAS unsigned char* lds, const Gemm g, const StaticOrder& S, const Epi& E) {
    const int tid = opaque_tid(wv), wid = __builtin_amdgcn_readfirstlane(tid >> 6), lane = tid & 63, wr = wid >> 2, wc = wid & 3, fr = lane & 15, fq = lane >> 4;
    const int K = g.K, nt = K / BK;
    unsigned voffA[2], voffB[2];
#pragma unroll
    for (int i = 0; i < 2; ++i) { int R, C; stage_rc(tid * 16 + i * 8192, R, C); const int Rb = Epi::PERM ? ((R & ~31) + perm32(R & 31)) : R;
        voffA[i] = (unsigned)(R * g.lda + C) * 2u; voffB[i] = (unsigned)(Rb * g.ldb + C) * 2u; }
    const size_t kstep = (size_t)(BK * 2);
    const size_t hstepA = (size_t)HALF * g.lda * 2, hstepB = (size_t)HALF * g.ldb * 2;
    const size_t tstepA = 2 * hstepA, tstepB = 2 * hstepB;
    const unsigned ldsw = (unsigned)wid * 1024u;
    const int aoff = lds_byte(wr * 64 + fr, fq * 8), boff = lds_byte(wc * 32 + fr, fq * 8);
#define PG8_SA(b, h) (((b) * 2 + (h)) * HTB)
#define PG8_SB(b, h) ((4 + (b) * 2 + (h)) * HTB)
#define PG8_STAGE(bufoff, gbase, voff) do { _Pragma("unroll") for (int _i = 0; _i < 2; ++_i) \
        __builtin_amdgcn_global_load_lds((const unsigned*)((const char*)(gbase) + (voff)[_i]), (LAS unsigned*)(lds + (bufoff) + ldsw + _i * 8192), 16, 0, 0); } while (0)
#define PG8_LDA(dst, b, h) do { _Pragma("unroll") for (int m = 0; m < 4; ++m) _Pragma("unroll") for (int k = 0; k < 2; ++k) dst[m][k] = *(const LAS bf16x8*)(lds + PG8_SA(b, h) + aoff + m * 2048 + k * 1024); } while (0)
#define PG8_LDB(dst, b, h) do { _Pragma("unroll") for (int n = 0; n < 2; ++n) _Pragma("unroll") for (int k = 0; k < 2; ++k) dst[n][k] = *(const LAS bf16x8*)(lds + PG8_SB(b, h) + boff + n * 2048 + k * 1024); } while (0)
#define PG8_MMA(ai, bj, At, Bt) do { __builtin_amdgcn_s_setprio(1); _Pragma("unroll") for (int m = 0; m < 4; ++m) _Pragma("unroll") for (int n = 0; n < 2; ++n) _Pragma("unroll") for (int k = 0; k < 2; ++k) \
        acc[ai][bj][m][n] = __builtin_amdgcn_mfma_f32_16x16x32_bf16(Bt[n][k], At[m][k], acc[ai][bj][m][n], 0, 0, 0); __builtin_amdgcn_s_setprio(0); } while (0)
#define PG8_WAIT_V(n) asm volatile("s_waitcnt vmcnt(" #n ")" ::: "memory")
#define PG8_WAIT_L(n) asm volatile("s_waitcnt lgkmcnt(" #n ")" ::: "memory")
#define PG8_BAR __builtin_amdgcn_s_barrier()
#define PG8_SCHED __builtin_amdgcn_sched_barrier(0)
#define PG8_AOFF(u) ((size_t)(u).pm * tstepA + (size_t)(((u).pn >> g.agsh) * g.agstride) * 2)
    Unit cur, nxt; int ui = 0;
    if (!S.next(0, cur)) return;
    f32x4 acc[2][2][4][2];
#pragma unroll
    for (int a = 0; a < 2; ++a)
#pragma unroll
        for (int b = 0; b < 2; ++b)
#pragma unroll
            for (int m = 0; m < 4; ++m)
#pragma unroll
                for (int n = 0; n < 2; ++n) acc[a][b][m][n] = (f32x4){0.f, 0.f, 0.f, 0.f};
    bf16x8 At[4][2], B0[2][2], B1[2][2];
    const char* cA = (const char*)g.A + PG8_AOFF(cur); const char* cB = (const char*)g.Bt + (size_t)cur.pn * tstepB;
    PG8_STAGE(PG8_SB(0, 0), cB, voffB); PG8_STAGE(PG8_SB(0, 1), cB + hstepB, voffB); PG8_STAGE(PG8_SA(0, 0), cA, voffA); PG8_STAGE(PG8_SA(0, 1), cA + hstepA, voffA);
    if (wr == 1) PG8_BAR;
    PG8_WAIT_V(2); PG8_BAR;
    PG8_STAGE(PG8_SB(1, 0), cB + kstep, voffB); PG8_STAGE(PG8_SA(1, 0), cA + kstep, voffA); PG8_STAGE(PG8_SB(1, 1), cB + hstepB + kstep, voffB);
    PG8_WAIT_V(6); PG8_BAR;
    for (;;) {
        const bool has_next = S.next(ui + 1, nxt);
        const char* nA = has_next ? (const char*)g.A + PG8_AOFF(nxt) : cA; const char* nB = has_next ? (const char*)g.Bt + (size_t)nxt.pn * tstepB : cB;
        for (int t = 0; t < nt; t += 2) {
            const bool last = (t == nt - 2);
            const char* a1 = cA + (size_t)(t + 1) * kstep;
            const char* a2 = last ? nA : cA + (size_t)(t + 2) * kstep; const char* b2 = last ? nB : cB + (size_t)(t + 2) * kstep;
            const char* a3 = a2 + kstep; const char* b3 = b2 + kstep;
            PG8_LDB(B0, 0, 0); PG8_LDB(B1, 0, 1); PG8_SCHED; PG8_LDA(At, 0, 0); PG8_STAGE(PG8_SA(1, 1), a1 + hstepA, voffA);
            PG8_WAIT_V(8); PG8_WAIT_L(0); PG8_BAR; PG8_MMA(0, 0, At, B0); PG8_MMA(0, 1, At, B1); PG8_BAR; PG8_SCHED;
            PG8_LDA(At, 0, 1); PG8_STAGE(PG8_SB(0, 0), b2, voffB); PG8_STAGE(PG8_SB(0, 1), b2 + hstepB, voffB); PG8_STAGE(PG8_SA(0, 0), a2, voffA);
            PG8_WAIT_V(8); PG8_WAIT_L(0); PG8_BAR; PG8_MMA(1, 0, At, B0); PG8_MMA(1, 1, At, B1); PG8_BAR; PG8_SCHED;
            PG8_LDB(B0, 1, 0); PG8_LDB(B1, 1, 1); PG8_SCHED; PG8_LDA(At, 1, 0); PG8_STAGE(PG8_SA(0, 1), a2 + hstepA, voffA);
            PG8_WAIT_V(8); PG8_WAIT_L(0); PG8_BAR; PG8_MMA(0, 0, At, B0); PG8_MMA(0, 1, At, B1); PG8_BAR; PG8_SCHED;
            PG8_LDA(At, 1, 1); PG8_STAGE(PG8_SB(1, 0), b3, voffB); PG8_STAGE(PG8_SB(1, 1), b3 + hstepB, voffB); PG8_STAGE(PG8_SA(1, 0), a3, voffA);
            PG8_WAIT_V(8); PG8_WAIT_L(0); PG8_BAR; PG8_MMA(1, 0, At, B0); PG8_MMA(1, 1, At, B1); PG8_BAR; PG8_SCHED;
        }
        if constexpr (ALIGN_EPI) { if (wr == 0) PG8_BAR; }
        E(acc, cur, wr, wc, fr, fq);
        if (!has_next) break;
#pragma unroll
        for (int a = 0; a < 2; ++a)
#pragma unroll
            for (int b = 0; b < 2; ++b)
#pragma unroll
                for (int m = 0; m < 4; ++m)
#pragma unroll
                    for (int n = 0; n < 2; ++n) acc[a][b][m][n] = (f32x4){0.f, 0.f, 0.f, 0.f};
        cur = nxt; cA = nA; cB = nB; ++ui;
        if constexpr (ALIGN_EPI) { if (wr == 1) PG8_BAR; }
    }
    PG8_WAIT_V(0);
    if constexpr (!ALIGN_EPI) { if (wr == 0) PG8_BAR; }
    PG8_BAR;
#undef PG8_SA
#undef PG8_SB
#undef PG8_STAGE
#undef PG8_LDA
#undef PG8_LDB
#undef PG8_MMA
#undef PG8_WAIT_V
#undef PG8_WAIT_L
#undef PG8_BAR
#undef PG8_SCHED
#undef PG8_AOFF
}

struct EpiBf16 {
    static constexpr bool PERM = true;
    bf16_t* O; int ldc;
    __device__ __forceinline__ void operator()(const f32x4 (&acc)[2][2][4][2], const Unit& u, int wr, int wc, int fr, int fq) const {
        const int row0 = u.pm * BM + wr * 64 + fr; const int col0 = u.pn * BM + wc * 32 + 8 * fq;
#pragma unroll
        for (int ai = 0; ai < 2; ++ai)
#pragma unroll
            for (int m = 0; m < 4; ++m) { bf16_t* rowp = O + (size_t)(row0 + ai * HALF + m * 16) * ldc + col0;
#pragma unroll
                for (int bj = 0; bj < 2; ++bj) { const f32x4 v0 = acc[ai][bj][m][0], v1 = acc[ai][bj][m][1];
                    u32x4 w; w.x = cvt_pk_bf16(v0[0], v0[1]); w.y = cvt_pk_bf16(v0[2], v0[3]); w.z = cvt_pk_bf16(v1[0], v1[1]); w.w = cvt_pk_bf16(v1[2], v1[3]);
                    *(u32x4*)(rowp + bj * HALF) = w; } }
    }
};
struct EpiPoolGrp {
    static constexpr bool PERM = true;
    bf16_t* U; const bf16_t* VG; const float* ls;
    __device__ __forceinline__ void operator()(const f32x4 (&acc)[2][2][4][2], const Unit& u, int wr, int wc, int fr, int fq) const {
        const int row0 = u.pm * BM + wr * 64 + fr; const int col0 = u.pn * BM + wc * 32 + 8 * fq;
        f32x4 lv[2][2];
#pragma unroll
        for (int bj = 0; bj < 2; ++bj)
#pragma unroll
            for (int n = 0; n < 2; ++n) lv[bj][n] = *(const f32x4*)(ls + col0 + bj * HALF + 4 * n);
#pragma unroll
        for (int ai = 0; ai < 2; ++ai) {
            u32x4 gw[4][2];
#pragma unroll
            for (int m = 0; m < 4; ++m)
#pragma unroll
                for (int bj = 0; bj < 2; ++bj) gw[m][bj] = *(const u32x4*)(VG + (size_t)(row0 + ai * HALF + m * 16) * POOL_IN + DM + col0 + bj * HALF);
            __builtin_amdgcn_sched_barrier(0);
#pragma unroll
            for (int m = 0; m < 4; ++m) { const size_t row = (size_t)(row0 + ai * HALF + m * 16);
#pragma unroll
                for (int bj = 0; bj < 2; ++bj) {
                    f32x4 v0 = acc[ai][bj][m][0] * lv[bj][0], v1 = acc[ai][bj][m][1] * lv[bj][1];
                    f32x4 g0, g1; unpack8(gw[m][bj], g0, g1);
#pragma unroll
                    for (int e = 0; e < 4; ++e) { v0[e] *= silu_f(g0[e]); v1[e] *= silu_f(g1[e]); }
                    *(u32x4*)(U + row * DM + col0 + bj * HALF) = pack8(v0, v1); } }
            __builtin_amdgcn_sched_barrier(0); }
    }
};
template <bool IN_BF16, bool OUT_BF16> struct EpiResid {
    static constexpr bool PERM = true;
    const void* xin; void* xout; const float* gmod;
    __device__ __forceinline__ void operator()(const f32x4 (&acc)[2][2][4][2], const Unit& u, int wr, int wc, int fr, int fq) const {
        const int row0 = u.pm * BM + wr * 64 + fr; const int col0 = u.pn * BM + wc * 32 + 8 * fq;
        f32x4 gv[2][2];
#pragma unroll
        for (int bj = 0; bj < 2; ++bj)
#pragma unroll
            for (int n = 0; n < 2; ++n) gv[bj][n] = *(const f32x4*)(gmod + col0 + bj * HALF + 4 * n);
#pragma unroll
        for (int ai = 0; ai < 2; ++ai)
#pragma unroll
          for (int mh = 0; mh < (IN_BF16 ? 1 : 2); ++mh) {
            constexpr int MB = IN_BF16 ? 4 : 2;
            u32x4 rw[MB][2]; f32x4 rf[MB][2][2];
#pragma unroll
            for (int mm = 0; mm < MB; ++mm)
#pragma unroll
                for (int bj = 0; bj < 2; ++bj) { const size_t off = (size_t)(row0 + ai * HALF + (mh * MB + mm) * 16) * DM + col0 + bj * HALF;
                    if (IN_BF16) rw[mm][bj] = *(const u32x4*)((const bf16_t*)xin + off);
                    else { rf[mm][bj][0] = *(const f32x4*)((const float*)xin + off); rf[mm][bj][1] = *(const f32x4*)((const float*)xin + off + 4); } }
            __builtin_amdgcn_sched_barrier(0);
#pragma unroll
            for (int mm = 0; mm < MB; ++mm)
#pragma unroll
                for (int bj = 0; bj < 2; ++bj) { const int m = mh * MB + mm; const size_t off = (size_t)(row0 + ai * HALF + m * 16) * DM + col0 + bj * HALF;
                    f32x4 b0, b1;
                    if (IN_BF16) unpack8(rw[mm][bj], b0, b1); else { b0 = rf[mm][bj][0]; b1 = rf[mm][bj][1]; }
                    const f32x4 y0 = b0 + gv[bj][0] * acc[ai][bj][m][0], y1 = b1 + gv[bj][1] * acc[ai][bj][m][1];
                    if (OUT_BF16) *(u32x4*)((bf16_t*)xout + off) = pack8(y0, y1);
                    else { *(f32x4*)((float*)xout + off) = y0; *(f32x4*)((float*)xout + off + 4) = y1; } }
            __builtin_amdgcn_sched_barrier(0); }
    }
};
struct EpiAttnIn {
    static constexpr bool PERM = true;
    unsigned char* ws; const int* pos;
    __device__ __forceinline__ void operator()(const f32x4 (&acc)[2][2][4][2], const Unit& u, int wr, int wc, int fr, int fq) const {
        const int row0 = u.pm * BM + wr * 64 + fr; const int pn = u.pn;
        bf16_t* const Qh = (bf16_t*)(ws + WS_Q); bf16_t* const SG = (bf16_t*)(ws + WS_GATE); bf16_t* const QI = (bf16_t*)(ws + WS_QI); bf16_t* const KI = (bf16_t*)(ws + WS_KI); float* const WI = (float*)(ws + WS_WI);
        const float* const cosq = (const float*)(ws + WS_TAB); const float* const sinq = cosq + SEQ * 16; const float* const cosi = sinq + SEQ * 16; const float* const sini = cosi + SEQ * 8;
#pragma unroll
        for (int ai = 0; ai < 2; ++ai)
#pragma unroll
            for (int m = 0; m < 4; ++m) {
                const int row = row0 + ai * HALF + m * 16;
                if (pn < 24) {
                    bf16_t* base = Qh + (size_t)(pn >> 3) * ((size_t)SEQ * DM);
                    const bool rope = (pn < 16) && (wc == 0);
                    f32x4 cs[2] = {{1.f, 1.f, 1.f, 1.f}, {1.f, 1.f, 1.f, 1.f}}, sn[2] = {{0.f, 0.f, 0.f, 0.f}, {0.f, 0.f, 0.f, 0.f}};
                    if (rope) { const float* cp = cosq + (size_t)row * 16 + 8 * (fq & 1); const float* sp = sinq + (size_t)row * 16 + 8 * (fq & 1);
                        cs[0] = *(const f32x4*)cp; cs[1] = *(const f32x4*)(cp + 4); sn[0] = *(const f32x4*)sp; sn[1] = *(const f32x4*)(sp + 4); }
#pragma unroll
                    for (int bj = 0; bj < 2; ++bj) { const int head = 2 * (pn & 7) + bj;
                        f32x4 v[2] = {acc[ai][bj][m][0], acc[ai][bj][m][1]};
                        if (pn < 8) { v[0] *= ATT_QSCALE; v[1] *= ATT_QSCALE; }
                        if (rope) {
#pragma unroll
                            for (int n = 0; n < 2; ++n) { f32x4 pr;
#pragma unroll
                                for (int e = 0; e < 4; ++e) { const float ve = v[n][e];
                                    const auto rr = __builtin_amdgcn_permlane32_swap(__builtin_bit_cast(unsigned, ve), __builtin_bit_cast(unsigned, ve), false, false);
                                    const unsigned pu = (fq < 2) ? rr[1] : rr[0]; pr[e] = __builtin_bit_cast(float, pu); }
                                v[n] = (fq < 2) ? (v[n] * cs[n] - pr * sn[n]) : (v[n] * cs[n] + pr * sn[n]); } }
                        *(u32x4*)(base + ((size_t)head * SEQ + row) * HD + 32 * wc + 8 * fq) = pack8(v[0], v[1]); }
                } else if (pn < 32) {
#pragma unroll
                    for (int bj = 0; bj < 2; ++bj) { f32x4 v0 = acc[ai][bj][m][0], v1 = acc[ai][bj][m][1];
#pragma unroll
                        for (int e = 0; e < 4; ++e) { v0[e] = silu_f(v0[e]); v1[e] = silu_f(v1[e]); }
                        *(u32x4*)(SG + (size_t)row * DM + (pn - 24) * BM + bj * HALF + 32 * wc + 8 * fq) = pack8(v0, v1); }
                } else {
                    const bool isq = pn < 36;
                    const bool rope = ((wc & 1) == 0) && (isq || wc == 0);
                    f32x4 cs[2], sn[2];
                    { const float* cp = cosi + (size_t)row * 8; const float* sp = sini + (size_t)row * 8;
                      cs[0] = *(const f32x4*)cp; cs[1] = *(const f32x4*)(cp + 4); sn[0] = *(const f32x4*)sp; sn[1] = *(const f32x4*)(sp + 4); }
#pragma unroll
                    for (int bj = 0; bj < 2; ++bj) {
                        if (!isq && bj == 1) continue;
                        f32x4 v[2] = {acc[ai][bj][m][0], acc[ai][bj][m][1]};
                        if (rope) {
#pragma unroll
                            for (int n = 0; n < 2; ++n) { f32x4 pr;
#pragma unroll
                                for (int e = 0; e < 4; ++e) pr[e] = swz_xor<16>(v[n][e]);
                                const f32x4 ro = (fq == 0) ? (v[n] * cs[n] - pr * sn[n]) : (v[n] * cs[n] + pr * sn[n]);
                                v[n] = (fq < 2) ? ro : v[n]; } }
                        const int cl = bj * HALF + 32 * wc + 8 * fq;
                        if (isq) *(u32x4*)(QI + (size_t)row * 1024 + (pn - 32) * BM + cl) = pack8(v[0], v[1]);
                        else if (cl < 64) *(u32x4*)(KI + (size_t)row * 64 + cl) = pack8(v[0], v[1]);
                        else if (cl < 80) { *(f32x4*)(WI + (size_t)row * 16 + (cl - 64)) = v[0]; *(f32x4*)(WI + (size_t)row * 16 + (cl - 64) + 4) = v[1]; }
                    }
                }
                asm volatile("" ::: "memory");
            }
    }
};
}

namespace att {
constexpr int D = 128, NW = 8, QBLK = 32, KVBLK = 64, QB = NW * QBLK;
constexpr int KROWB = 272;
constexpr int SHM_V = KVBLK * D * 2, SHM_K = KVBLK * KROWB;
constexpr int QROWB = 272;
constexpr int NVB = 3;
constexpr int Q_OFF = NVB * SHM_V + 2 * SHM_K + NW * 64 * 4;
constexpr int LDS_BYTES = Q_OFF + QB * QROWB;
constexpr float SCALE = 0.08838834764831845f;
constexpr float THR = 8.f;
#define KSWZ(row, colB) ((row) * KROWB + (colB))
#define SBAR() __builtin_amdgcn_sched_barrier(0)
__device__ __forceinline__ int v_st(int k, int c) { const int kk = (k & ~0xC) | ((k & 4) << 1) | ((k & 8) >> 1); return ((kk >> 3) * 4 + (c >> 5)) * 512 + ((kk & 7) * 32 + (c & 31)) * 2; }
__device__ __forceinline__ int v_rd_base(int lane) { return ((lane & 3) << 3) | (((lane >> 2) & 3) << 6) | (((lane >> 4) & 1) << 5) | (((lane >> 5) & 1) << 8); }
constexpr int v_rd_off(int d0, int ks, int half) { return d0 * 512 + ks * 4096 + half * 2048; }
__device__ __forceinline__ int crow(int r, int hi) { return (r & 3) + 8 * (r >> 2) + 4 * hi; }
__device__ __forceinline__ unsigned cvtpk(float lo, float hi) { unsigned r; asm volatile("v_cvt_pk_bf16_f32 %0, %1, %2" : "=v"(r) : "v"(lo), "v"(hi)); return r; }
__device__ __forceinline__ bf16x8 load8(const bf16_t* p) { return *reinterpret_cast<const bf16x8*>(p); }
__device__ __forceinline__ float mask_and(float v, unsigned mlo, unsigned mhi, int r, int p) {
    const int pos = 16 * (r & 1) + 2 * (r >> 2) + 8 * p;
    const unsigned w = (r & 2) ? mhi : mlo;
    int bits; asm("v_bfe_i32 %0, %1, %2, 1" : "=v"(bits) : "v"(w), "n"(pos));
    return __builtin_bit_cast(float, __builtin_bit_cast(unsigned, v) & (unsigned)bits);
}
constexpr float THR2 = 8.f * 1.4426950408889634f;
__device__ __forceinline__ void partialSM(f32x16& p0, f32x16& p1, float& m_reg, float& alpha, unsigned mlo_r, unsigned mhi_r, int hi) {
    float pmax = p0[0];
#pragma unroll
    for (int r = 1; r < 16; ++r) pmax = fmaxf(pmax, p0[r]);
#pragma unroll
    for (int r = 0; r < 16; ++r) pmax = fmaxf(pmax, p1[r]);
    { auto rr = __builtin_amdgcn_permlane32_swap(__float_as_uint(pmax), __float_as_uint(pmax), false, false);
      pmax = fmaxf(__uint_as_float(rr[0]), __uint_as_float(rr[1])); }
    float mn;
    if (__builtin_expect(__all(pmax - m_reg <= THR2), 1)) { mn = m_reg; alpha = 1.f; }
    else { mn = fmaxf(m_reg, pmax); alpha = __builtin_amdgcn_exp2f(m_reg - mn); m_reg = mn; }
    const f32x2 nm = {-mn, -mn};
#pragma unroll
    for (int r = 0; r < 16; r += 2) { const f32x2 a = (f32x2){p0[r], p0[r + 1]} + nm, b = (f32x2){p1[r], p1[r + 1]} + nm; p0[r] = a.x; p0[r + 1] = a.y; p1[r] = b.x; p1[r + 1] = b.y; }
    const unsigned mlo = hi ? ((mlo_r >> 1) | (mhi_r << 31)) : mlo_r, mhi = mhi_r >> hi;
#pragma unroll
    for (int r = 0; r < 16; ++r) p0[r] = mask_and(__builtin_amdgcn_exp2f(p0[r]), mlo, mhi, r, 0);
}
__device__ __forceinline__ void finishSM(f32x16& p0, f32x16& p1, float alpha, float& l_reg, bf16x8& pa0, bf16x8& pa1, bf16x8& pa2, bf16x8& pa3, unsigned mlo_r, unsigned mhi_r, int hi) {
    const unsigned mlo = hi ? ((mlo_r >> 1) | (mhi_r << 31)) : mlo_r, mhi = mhi_r >> hi;
#pragma unroll
    for (int r = 0; r < 16; ++r) p1[r] = mask_and(__builtin_amdgcn_exp2f(p1[r]), mlo, mhi, r, 1);
    f32x2 ps2 = {p0[0], p0[1]};
#pragma unroll
    for (int r = 2; r < 16; r += 2) ps2 += (f32x2){p0[r], p0[r + 1]};
#pragma unroll
    for (int r = 0; r < 16; r += 2) ps2 += (f32x2){p1[r], p1[r + 1]};
    float ps = ps2.x + ps2.y;
    { auto rr = __builtin_amdgcn_permlane32_swap(__float_as_uint(ps), __float_as_uint(ps), false, false);
      ps = __uint_as_float(rr[0]) + __uint_as_float(rr[1]); }
    l_reg = l_reg * alpha + ps;
#define PK4(P, B_, OUT) do { unsigned a0 = cvtpk(P[B_+0], P[B_+1]), a1 = cvtpk(P[B_+2], P[B_+3]);                          \
        unsigned b0 = cvtpk(P[B_+4], P[B_+5]), b1 = cvtpk(P[B_+6], P[B_+7]);                                             \
        auto r0 = __builtin_amdgcn_permlane32_swap(a0, b0, false, false); auto r1 = __builtin_amdgcn_permlane32_swap(a1, b1, false, false); \
        u32x4 w = {r0[0], r1[0], r0[1], r1[1]}; OUT = *reinterpret_cast<bf16x8*>(&w); } while (0)
    PK4(p0, 0, pa0); PK4(p0, 8, pa1); PK4(p1, 0, pa2); PK4(p1, 8, pa3);
#undef PK4
}
template <int KB>
__device__ __forceinline__ void qkt(f32x16& p0, f32x16& p1, int ka  , int qa  ) {
    const f32x16 zero16 = {};
    bf16x8 A0, B0, Q0, A1, B1, Q1;
#define LDSRD128(dst, addr, off) asm volatile("ds_read_b128 %0, %1 offset:%2" : "=&v"(dst) : "v"(addr), "i"(off) : "memory")
#define LGKM(n) asm volatile("s_waitcnt lgkmcnt(%0)" :: "i"(n) : "memory")
#define QK_LD(i, A, B, Q) do { LDSRD128(A, ka, KB * SHM_K + (i) * 32); LDSRD128(B, ka, KB * SHM_K + (i) * 32 + 32 * KROWB); LDSRD128(Q, qa, (i) * 32); } while (0)
#define QK_MM(A, B, Q) do { p0 = __builtin_amdgcn_mfma_f32_32x32x16_bf16(A, Q, p0, 0, 0, 0); p1 = __builtin_amdgcn_mfma_f32_32x32x16_bf16(B, Q, p1, 0, 0, 0); } while (0)
    QK_LD(0, A0, B0, Q0); QK_LD(1, A1, B1, Q1);
    LGKM(3); SBAR();
    p0 = __builtin_amdgcn_mfma_f32_32x32x16_bf16(A0, Q0, zero16, 0, 0, 0); p1 = __builtin_amdgcn_mfma_f32_32x32x16_bf16(B0, Q0, zero16, 0, 0, 0);
    SBAR(); QK_LD(2, A0, B0, Q0);
    LGKM(3); SBAR(); QK_MM(A1, B1, Q1); SBAR(); QK_LD(3, A1, B1, Q1);
    LGKM(3); SBAR(); QK_MM(A0, B0, Q0); SBAR(); QK_LD(4, A0, B0, Q0);
    LGKM(3); SBAR(); QK_MM(A1, B1, Q1); SBAR(); QK_LD(5, A1, B1, Q1);
    LGKM(3); SBAR(); QK_MM(A0, B0, Q0); SBAR(); QK_LD(6, A0, B0, Q0);
    LGKM(3); SBAR(); QK_MM(A1, B1, Q1); SBAR(); QK_LD(7, A1, B1, Q1);
    LGKM(3); SBAR(); QK_MM(A0, B0, Q0); SBAR();
    LGKM(0); SBAR(); QK_MM(A1, B1, Q1); SBAR();
#undef QK_LD
#undef QK_MM
}
template <int VB>
__device__ __forceinline__ void pv_tile(f32x16* o, int vb0, bf16x8 pa0, bf16x8 pa1, bf16x8 pa2, bf16x8 pa3) {
#define TRRD(dst, off) asm volatile("ds_read_b64_tr_b16 %0, %1 offset:%2" : "=&v"(dst) : "v"(vb0), "i"(off) : "memory")
#define PV_D0(d0) do { s16x4 l0, l1, l2, l3, h0, h1, h2, h3; constexpr int b_ = VB * SHM_V + v_rd_off(d0, 0, 0); \
        TRRD(l0, b_); TRRD(h0, b_ + 2048); TRRD(l1, b_ + 4096); TRRD(h1, b_ + 6144); TRRD(l2, b_ + 8192); TRRD(h2, b_ + 10240); TRRD(l3, b_ + 12288); TRRD(h3, b_ + 14336); \
        asm volatile("s_waitcnt lgkmcnt(0)" ::: "memory"); SBAR();   \
        o[d0] = __builtin_amdgcn_mfma_f32_32x32x16_bf16(pa0, (bf16x8){l0[0], l0[1], l0[2], l0[3], h0[0], h0[1], h0[2], h0[3]}, o[d0], 0, 0, 0);   \
        o[d0] = __builtin_amdgcn_mfma_f32_32x32x16_bf16(pa1, (bf16x8){l1[0], l1[1], l1[2], l1[3], h1[0], h1[1], h1[2], h1[3]}, o[d0], 0, 0, 0);   \
        o[d0] = __builtin_amdgcn_mfma_f32_32x32x16_bf16(pa2, (bf16x8){l2[0], l2[1], l2[2], l2[3], h2[0], h2[1], h2[2], h2[3]}, o[d0], 0, 0, 0);   \
        o[d0] = __builtin_amdgcn_mfma_f32_32x32x16_bf16(pa3, (bf16x8){l3[0], l3[1], l3[2], l3[3], h3[0], h3[1], h3[2], h3[3]}, o[d0], 0, 0, 0); } while (0)
    PV_D0(0); PV_D0(1); PV_D0(2); PV_D0(3);
#undef PV_D0
#undef TRRD
}
template <int KB>
__device__ __forceinline__ void qkt_fsm(f32x16& p0, f32x16& p1, int ka, int qa,
                                        f32x16& y0, f32x16& y1, float alpha, float& l_reg, bf16x8& pa0, bf16x8& pa1, bf16x8& pa2, bf16x8& pa3, unsigned mlo_r, unsigned mhi_r, int hi) {
    const unsigned mlo = hi ? ((mlo_r >> 1) | (mhi_r << 31)) : mlo_r, mhi = mhi_r >> hi;
    const f32x16 zero16 = {};
    f32x2 sa = {0.f, 0.f}, sb = {0.f, 0.f};
    bf16x8 A0, B0, Q0, A1, B1, Q1;
#define QK_LD(i, A, B, Q) do { LDSRD128(A, ka, KB * SHM_K + (i) * 32); LDSRD128(B, ka, KB * SHM_K + (i) * 32 + 32 * KROWB); LDSRD128(Q, qa, (i) * 32); } while (0)
    QK_LD(0, A0, B0, Q0); QK_LD(1, A1, B1, Q1);
    LGKM(3); SBAR(); p0 = __builtin_amdgcn_mfma_f32_32x32x16_bf16(A0, Q0, zero16, 0, 0, 0); SBAR(); y1[0] = mask_and(__builtin_amdgcn_exp2f(y1[0]), mlo, mhi, 0, 1); sa += (f32x2){y0[0], y0[1]}; sa += (f32x2){y0[2], y0[3]}; SBAR();
    p1 = __builtin_amdgcn_mfma_f32_32x32x16_bf16(B0, Q0, zero16, 0, 0, 0); SBAR(); QK_LD(2, A0, B0, Q0); y1[1] = mask_and(__builtin_amdgcn_exp2f(y1[1]), mlo, mhi, 1, 1); sa += (f32x2){y0[4], y0[5]}; sa += (f32x2){y0[6], y0[7]}; SBAR();
    LGKM(3); SBAR(); p0 = __builtin_amdgcn_mfma_f32_32x32x16_bf16(A1, Q1, p0, 0, 0, 0); SBAR(); y1[2] = mask_and(__builtin_amdgcn_exp2f(y1[2]), mlo, mhi, 2, 1); sa += (f32x2){y0[8], y0[9]}; sa += (f32x2){y0[10], y0[11]}; SBAR();
    p1 = __builtin_amdgcn_mfma_f32_32x32x16_bf16(B1, Q1, p1, 0, 0, 0); SBAR(); QK_LD(3, A1, B1, Q1); y1[3] = mask_and(__builtin_amdgcn_exp2f(y1[3]), mlo, mhi, 3, 1); sa += (f32x2){y0[12], y0[13]}; sa += (f32x2){y0[14], y0[15]}; SBAR();
    LGKM(3); SBAR(); p0 = __builtin_amdgcn_mfma_f32_32x32x16_bf16(A0, Q0, p0, 0, 0, 0); SBAR(); y1[4] = mask_and(__builtin_amdgcn_exp2f(y1[4]), mlo, mhi, 4, 1); const unsigned a0_p = cvtpk(y0[0+0], y0[0+1]), b0_p = cvtpk(y0[0+4], y0[0+5]); const auto r0_p = __builtin_amdgcn_permlane32_swap(a0_p, b0_p, false, false); SBAR();
    p1 = __builtin_amdgcn_mfma_f32_32x32x16_bf16(B0, Q0, p1, 0, 0, 0); SBAR(); QK_LD(4, A0, B0, Q0); y1[5] = mask_and(__builtin_amdgcn_exp2f(y1[5]), mlo, mhi, 5, 1); const unsigned a1_p = cvtpk(y0[0+2], y0[0+3]), b1_p = cvtpk(y0[0+6], y0[0+7]); const auto r1_p = __builtin_amdgcn_permlane32_swap(a1_p, b1_p, false, false); { u32x4 w_ = {r0_p[0], r1_p[0], r0_p[1], r1_p[1]}; pa0 = *reinterpret_cast<bf16x8*>(&w_); } SBAR();
    LGKM(3); SBAR(); p0 = __builtin_amdgcn_mfma_f32_32x32x16_bf16(A1, Q1, p0, 0, 0, 0); SBAR(); y1[6] = mask_and(__builtin_amdgcn_exp2f(y1[6]), mlo, mhi, 6, 1); const unsigned a0_q = cvtpk(y0[8+0], y0[8+1]), b0_q = cvtpk(y0[8+4], y0[8+5]); const auto r0_q = __builtin_amdgcn_permlane32_swap(a0_q, b0_q, false, false); SBAR();
    p1 = __builtin_amdgcn_mfma_f32_32x32x16_bf16(B1, Q1, p1, 0, 0, 0); SBAR(); QK_LD(5, A1, B1, Q1); y1[7] = mask_and(__builtin_amdgcn_exp2f(y1[7]), mlo, mhi, 7, 1); const unsigned a1_q = cvtpk(y0[8+2], y0[8+3]), b1_q = cvtpk(y0[8+6], y0[8+7]); const auto r1_q = __builtin_amdgcn_permlane32_swap(a1_q, b1_q, false, false); { u32x4 w_ = {r0_q[0], r1_q[0], r0_q[1], r1_q[1]}; pa1 = *reinterpret_cast<bf16x8*>(&w_); } SBAR();
    LGKM(3); SBAR(); p0 = __builtin_amdgcn_mfma_f32_32x32x16_bf16(A0, Q0, p0, 0, 0, 0); SBAR(); y1[8] = mask_and(__builtin_amdgcn_exp2f(y1[8]), mlo, mhi, 8, 1); sb += (f32x2){y1[0], y1[1]}; sb += (f32x2){y1[2], y1[3]}; SBAR();
    p1 = __builtin_amdgcn_mfma_f32_32x32x16_bf16(B0, Q0, p1, 0, 0, 0); SBAR(); QK_LD(6, A0, B0, Q0); y1[9] = mask_and(__builtin_amdgcn_exp2f(y1[9]), mlo, mhi, 9, 1); sb += (f32x2){y1[4], y1[5]}; sb += (f32x2){y1[6], y1[7]}; SBAR();
    LGKM(3); SBAR(); p0 = __builtin_amdgcn_mfma_f32_32x32x16_bf16(A1, Q1, p0, 0, 0, 0); SBAR(); y1[10] = mask_and(__builtin_amdgcn_exp2f(y1[10]), mlo, mhi, 10, 1); const unsigned a0_u = cvtpk(y1[0+0], y1[0+1]), b0_u = cvtpk(y1[0+4], y1[0+5]); const auto r0_u = __builtin_amdgcn_permlane32_swap(a0_u, b0_u, false, false); SBAR();
    p1 = __builtin_amdgcn_mfma_f32_32x32x16_bf16(B1, Q1, p1, 0, 0, 0); SBAR(); QK_LD(7, A1, B1, Q1); y1[11] = mask_and(__builtin_amdgcn_exp2f(y1[11]), mlo, mhi, 11, 1); const unsigned a1_u = cvtpk(y1[0+2], y1[0+3]), b1_u = cvtpk(y1[0+6], y1[0+7]); const auto r1_u = __builtin_amdgcn_permlane32_swap(a1_u, b1_u, false, false); { u32x4 w_ = {r0_u[0], r1_u[0], r0_u[1], r1_u[1]}; pa2 = *reinterpret_cast<bf16x8*>(&w_); } SBAR();
    LGKM(3); SBAR(); p0 = __builtin_amdgcn_mfma_f32_32x32x16_bf16(A0, Q0, p0, 0, 0, 0); SBAR(); y1[12] = mask_and(__builtin_amdgcn_exp2f(y1[12]), mlo, mhi, 12, 1); sb += (f32x2){y1[8], y1[9]}; sb += (f32x2){y1[10], y1[11]}; SBAR();
    p1 = __builtin_amdgcn_mfma_f32_32x32x16_bf16(B0, Q0, p1, 0, 0, 0); SBAR(); y1[13] = mask_and(__builtin_amdgcn_exp2f(y1[13]), mlo, mhi, 13, 1);  SBAR();
    LGKM(0); SBAR(); p0 = __builtin_amdgcn_mfma_f32_32x32x16_bf16(A1, Q1, p0, 0, 0, 0); SBAR(); y1[14] = mask_and(__builtin_amdgcn_exp2f(y1[14]), mlo, mhi, 14, 1); sb += (f32x2){y1[12], y1[13]}; SBAR();
    p1 = __builtin_amdgcn_mfma_f32_32x32x16_bf16(B1, Q1, p1, 0, 0, 0); SBAR(); y1[15] = mask_and(__builtin_amdgcn_exp2f(y1[15]), mlo, mhi, 15, 1);  SBAR();
    sb += (f32x2){y1[14], y1[15]};
    const unsigned a0_v = cvtpk(y1[8+0], y1[8+1]), b0_v = cvtpk(y1[8+4], y1[8+5]); const auto r0_v = __builtin_amdgcn_permlane32_swap(a0_v, b0_v, false, false); const unsigned a1_v = cvtpk(y1[8+2], y1[8+3]), b1_v = cvtpk(y1[8+6], y1[8+7]); const auto r1_v = __builtin_amdgcn_permlane32_swap(a1_v, b1_v, false, false); { u32x4 w_ = {r0_v[0], r1_v[0], r0_v[1], r1_v[1]}; pa3 = *reinterpret_cast<bf16x8*>(&w_); }
    float ps = (sa.x + sa.y) + (sb.x + sb.y);
    { auto rr = __builtin_amdgcn_permlane32_swap(__float_as_uint(ps), __float_as_uint(ps), false, false);
      ps = __uint_as_float(rr[0]) + __uint_as_float(rr[1]); }
    l_reg = l_reg * alpha + ps; SBAR();
#undef QK_LD
}
template <int VB>
__device__ __forceinline__ void pv_psm(f32x16* o, int vb0, bf16x8 pa0, bf16x8 pa1, bf16x8 pa2, bf16x8 pa3,
                                       f32x16& p0, f32x16& p1, float& m_reg, float& alpha, unsigned mlo_r, unsigned mhi_r, int hi) {
    const unsigned mlo = hi ? ((mlo_r >> 1) | (mhi_r << 31)) : mlo_r, mhi = mhi_r >> hi;
#define TRRD(dst, off) asm volatile("ds_read_b64_tr_b16 %0, %1 offset:%2" : "=&v"(dst) : "v"(vb0), "i"(off) : "memory")
#define PV_RD(X, d0) do { constexpr int b_ = VB * SHM_V + v_rd_off(d0, 0, 0); \
        TRRD(X##l0, b_); TRRD(X##h0, b_ + 2048); TRRD(X##l1, b_ + 4096); TRRD(X##h1, b_ + 6144); TRRD(X##l2, b_ + 8192); TRRD(X##h2, b_ + 10240); TRRD(X##l3, b_ + 12288); TRRD(X##h3, b_ + 14336); } while (0)
#define PV_MM(X, d0, j, PA) o[d0] = __builtin_amdgcn_mfma_f32_32x32x16_bf16(PA, (bf16x8){X##l##j[0], X##l##j[1], X##l##j[2], X##l##j[3], X##h##j[0], X##h##j[1], X##h##j[2], X##h##j[3]}, o[d0], 0, 0, 0)
    s16x4 el0, el1, el2, el3, eh0, eh1, eh2, eh3, ol0, ol1, ol2, ol3, oh0, oh1, oh2, oh3;
    PV_RD(e, 0);
    LGKM(0); SBAR(); PV_MM(e, 0, 0, pa0); SBAR(); PV_RD(o, 1); float mxa = fmaxf(fmaxf(p0[0], p0[1]), p0[2]), mxb = fmaxf(fmaxf(p1[0], p1[1]), p1[2]); mxa = fmaxf(fmaxf(mxa, p0[3]), p0[4]); mxb = fmaxf(fmaxf(mxb, p1[3]), p1[4]); SBAR();
    PV_MM(e, 0, 1, pa1); SBAR(); mxa = fmaxf(fmaxf(mxa, p0[5]), p0[6]); mxb = fmaxf(fmaxf(mxb, p1[5]), p1[6]); mxa = fmaxf(fmaxf(mxa, p0[7]), p0[8]); mxb = fmaxf(fmaxf(mxb, p1[7]), p1[8]); SBAR();
    PV_MM(e, 0, 2, pa2); SBAR(); mxa = fmaxf(fmaxf(mxa, p0[9]), p0[10]); mxb = fmaxf(fmaxf(mxb, p1[9]), p1[10]); mxa = fmaxf(fmaxf(mxa, p0[11]), p0[12]); mxb = fmaxf(fmaxf(mxb, p1[11]), p1[12]); SBAR();
    PV_MM(e, 0, 3, pa3); SBAR(); mxa = fmaxf(fmaxf(mxa, p0[13]), p0[14]); mxb = fmaxf(fmaxf(mxb, p1[13]), p1[14]); mxa = fmaxf(fmaxf(mxa, p0[15]), p1[15]); float pmax = fmaxf(mxa, mxb); SBAR();
    LGKM(0); SBAR(); PV_MM(o, 1, 0, pa0); SBAR(); PV_RD(e, 2); { auto rr = __builtin_amdgcn_permlane32_swap(__float_as_uint(pmax), __float_as_uint(pmax), false, false); pmax = fmaxf(__uint_as_float(rr[0]), __uint_as_float(rr[1])); } const float mn = (pmax - m_reg <= THR2) ? m_reg : fmaxf(m_reg, pmax);     alpha = __builtin_amdgcn_exp2f(m_reg - mn); m_reg = mn; const f32x2 nm = {-mn, -mn}; SBAR();
    PV_MM(o, 1, 1, pa1); SBAR(); { const f32x2 a_ = (f32x2){p0[0], p0[1]} + nm; p0[0] = a_.x; p0[1] = a_.y; } { const f32x2 a_ = (f32x2){p0[2], p0[3]} + nm; p0[2] = a_.x; p0[3] = a_.y; } { const f32x2 a_ = (f32x2){p0[4], p0[5]} + nm; p0[4] = a_.x; p0[5] = a_.y; } { const f32x2 a_ = (f32x2){p0[6], p0[7]} + nm; p0[6] = a_.x; p0[7] = a_.y; } SBAR();
    PV_MM(o, 1, 2, pa2); SBAR(); { const f32x2 a_ = (f32x2){p0[8], p0[9]} + nm; p0[8] = a_.x; p0[9] = a_.y; } { const f32x2 a_ = (f32x2){p0[10], p0[11]} + nm; p0[10] = a_.x; p0[11] = a_.y; } { const f32x2 a_ = (f32x2){p0[12], p0[13]} + nm; p0[12] = a_.x; p0[13] = a_.y; } { const f32x2 a_ = (f32x2){p0[14], p0[15]} + nm; p0[14] = a_.x; p0[15] = a_.y; } SBAR();
    PV_MM(o, 1, 3, pa3); SBAR(); { const f32x2 a_ = (f32x2){p1[0], p1[1]} + nm; p1[0] = a_.x; p1[1] = a_.y; } { const f32x2 a_ = (f32x2){p1[2], p1[3]} + nm; p1[2] = a_.x; p1[3] = a_.y; } { const f32x2 a_ = (f32x2){p1[4], p1[5]} + nm; p1[4] = a_.x; p1[5] = a_.y; } { const f32x2 a_ = (f32x2){p1[6], p1[7]} + nm; p1[6] = a_.x; p1[7] = a_.y; } { float t_ = mask_and(__builtin_amdgcn_exp2f(p0[0]), mlo, mhi, 0, 0); asm volatile("" : "+v"(t_)); p0[0] = t_; } SBAR();
    LGKM(0); SBAR(); PV_MM(e, 2, 0, pa0); SBAR(); PV_RD(o, 3); { const f32x2 a_ = (f32x2){p1[8], p1[9]} + nm; p1[8] = a_.x; p1[9] = a_.y; } { const f32x2 a_ = (f32x2){p1[10], p1[11]} + nm; p1[10] = a_.x; p1[11] = a_.y; } { const f32x2 a_ = (f32x2){p1[12], p1[13]} + nm; p1[12] = a_.x; p1[13] = a_.y; } { const f32x2 a_ = (f32x2){p1[14], p1[15]} + nm; p1[14] = a_.x; p1[15] = a_.y; } { float t_ = mask_and(__builtin_amdgcn_exp2f(p0[1]), mlo, mhi, 1, 0); asm volatile("" : "+v"(t_)); p0[1] = t_; } SBAR();
    PV_MM(e, 2, 1, pa1); SBAR(); { float t_ = mask_and(__builtin_amdgcn_exp2f(p0[2]), mlo, mhi, 2, 0); asm volatile("" : "+v"(t_)); p0[2] = t_; } { float t_ = mask_and(__builtin_amdgcn_exp2f(p0[3]), mlo, mhi, 3, 0); asm volatile("" : "+v"(t_)); p0[3] = t_; } SBAR();
    PV_MM(e, 2, 2, pa2); SBAR(); { float t_ = mask_and(__builtin_amdgcn_exp2f(p0[4]), mlo, mhi, 4, 0); asm volatile("" : "+v"(t_)); p0[4] = t_; } { float t_ = mask_and(__builtin_amdgcn_exp2f(p0[5]), mlo, mhi, 5, 0); asm volatile("" : "+v"(t_)); p0[5] = t_; } SBAR();
    PV_MM(e, 2, 3, pa3); SBAR(); { float t_ = mask_and(__builtin_amdgcn_exp2f(p0[6]), mlo, mhi, 6, 0); asm volatile("" : "+v"(t_)); p0[6] = t_; } { float t_ = mask_and(__builtin_amdgcn_exp2f(p0[7]), mlo, mhi, 7, 0); asm volatile("" : "+v"(t_)); p0[7] = t_; } SBAR();
    LGKM(0); SBAR(); PV_MM(o, 3, 0, pa0); SBAR(); { float t_ = mask_and(__builtin_amdgcn_exp2f(p0[8]), mlo, mhi, 8, 0); asm volatile("" : "+v"(t_)); p0[8] = t_; } { float t_ = mask_and(__builtin_amdgcn_exp2f(p0[9]), mlo, mhi, 9, 0); asm volatile("" : "+v"(t_)); p0[9] = t_; } SBAR();
    PV_MM(o, 3, 1, pa1); SBAR(); { float t_ = mask_and(__builtin_amdgcn_exp2f(p0[10]), mlo, mhi, 10, 0); asm volatile("" : "+v"(t_)); p0[10] = t_; } { float t_ = mask_and(__builtin_amdgcn_exp2f(p0[11]), mlo, mhi, 11, 0); asm volatile("" : "+v"(t_)); p0[11] = t_; } SBAR();
    PV_MM(o, 3, 2, pa2); SBAR(); { float t_ = mask_and(__builtin_amdgcn_exp2f(p0[12]), mlo, mhi, 12, 0); asm volatile("" : "+v"(t_)); p0[12] = t_; } { float t_ = mask_and(__builtin_amdgcn_exp2f(p0[13]), mlo, mhi, 13, 0); asm volatile("" : "+v"(t_)); p0[13] = t_; } SBAR();
    PV_MM(o, 3, 3, pa3); SBAR(); { float t_ = mask_and(__builtin_amdgcn_exp2f(p0[14]), mlo, mhi, 14, 0); asm volatile("" : "+v"(t_)); p0[14] = t_; } { float t_ = mask_and(__builtin_amdgcn_exp2f(p0[15]), mlo, mhi, 15, 0); asm volatile("" : "+v"(t_)); p0[15] = t_; } SBAR();
#undef PV_MM
#undef PV_RD
#undef TRRD
}
struct BlockRef { const bf16_t* Q; const bf16_t* K; const bf16_t* V; bf16_t* O; const bf16_t* G; const unsigned long long* M; int P0; long kst, mst; };
struct Seam { bf16x8 a_v0, a_v1, a_k0, a_k1, b_v0, b_v1, b_k0, b_k1; };
#define ROW(p, k0, rr) ((p) + (size_t)((k0) + (rr)) * D + sc)
#define VMW() asm volatile("s_waitcnt vmcnt(0)" ::: "memory")
#define VMWN(n) asm volatile("s_waitcnt vmcnt(%0)" :: "i"(n) : "memory")
#define SLD(X, Kp, Vp) do { S.X##_v0 = load8(ROW(Vp, 0, sr)); S.X##_v1 = load8(ROW(Vp, 0, 32 + sr)); S.X##_k0 = load8(ROW(Kp, 0, sr)); S.X##_k1 = load8(ROW(Kp, 0, 32 + sr)); } while (0)
#define SWK(X, bf) do { *(bf16x8*)(K_lds + (bf) * SHM_K + kws) = S.X##_k0; *(bf16x8*)(K_lds + (bf) * SHM_K + kws + 32 * KROWB) = S.X##_k1; } while (0)
#define SWV(X, off) do { *(bf16x8*)(V_lds + (off) + vst0) = S.X##_v0; *(bf16x8*)(V_lds + (off) + vst1) = S.X##_v1; } while (0)
__device__ __forceinline__ void attn_prime(int wv, const BlockRef& cur, char* lds, Seam& S) {
    const int tid = opaque_tid(wv);
    const int sr = tid >> 4, sc = (tid & 15) * 8, kws = KSWZ(sr, sc * 2); char* K_lds = lds + NVB * SHM_V;
    SLD(a, cur.K, cur.V); SBAR(); SWK(a, 0); SBAR(); SLD(b, cur.K + cur.kst, cur.V + cur.kst);
    __syncthreads();
}
__device__ __forceinline__ void attn_block(int wv, const BlockRef& cur, const BlockRef& nxt, char* lds, Seam& S) {
    const int tid = opaque_tid(wv), wid = __builtin_amdgcn_readfirstlane(tid >> 6), lane = tid & 63, r32 = lane & 31, hi = lane >> 5;
    const int NT = cur.P0 / KVBLK + 4;
    char* V_lds = lds; char* K_lds = lds + NVB * SHM_V;
    float* ws = (float*)(lds + NVB * SHM_V + 2 * SHM_K) + wid * 64; float* li_l = ws, * al_l = ws + 32;
    float m_reg = -1e30f, l_reg = 0; f32x16 o[4] = {};
    const int sr = tid >> 4, sc = (tid & 15) * 8, vst0 = v_st(sr, sc), vst1 = v_st(32 + sr, sc), kws = KSWZ(sr, sc * 2);
    const int vb0 = (int)(uintptr_t)V_lds + v_rd_base(lane);
    const bf16_t* Kh = cur.K; const bf16_t* Vh = cur.V;
    const unsigned long long* mp = cur.M + (wid * QBLK + r32); const long mst = cur.mst, kst = cur.kst;
#define MLOAD(lo_, hi_, t) do { const unsigned long long w_ = mp[(long)(t) * mst]; lo_ = (unsigned)w_; hi_ = (unsigned)(w_ >> 32); } while (0)
#define RESC(a) do { if (__any((a) < 1.f)) { if (hi == 0) al_l[r32] = (a); asm volatile("s_waitcnt lgkmcnt(0)" ::: "memory");              \
                     for (int d_ = 0; d_ < 4; ++d_) for (int r = 0; r < 16; ++r) o[d_][r] *= al_l[crow(r, hi)]; } } while (0)
#define KBASE(t) ((long)(t) * kst)
    f32x16 pA0, pA1, pB0, pB1; float alA, alB; bf16x8 pa0, pa1, pa2, pa3;
    unsigned mAlo, mAhi, mBlo, mBhi;
    MLOAD(mAlo, mAhi, 0);
    char* Qw_lds = lds + Q_OFF + wid * (QBLK * QROWB);
    { u32x4 tq[8];
#pragma unroll
        for (int i = 0; i < 8; ++i) tq[i] = *(const u32x4*)(cur.Q + (size_t)(wid * QBLK + 4 * i + (lane >> 4)) * D + (lane & 15) * 8);
#pragma unroll
        for (int i = 0; i < 8; ++i) *(u32x4*)(Qw_lds + (4 * i + (lane >> 4)) * QROWB + (lane & 15) * 16) = tq[i];
        asm volatile("s_waitcnt lgkmcnt(0)" ::: "memory"); }
    const int qal = (int)(uintptr_t)Qw_lds + r32 * QROWB + hi * 16, ka = (int)(uintptr_t)K_lds + r32 * KROWB + hi * 16;
    SWV(a, 0); SBAR();
    SLD(a, Kh + KBASE(2), Vh + KBASE(2));
    SBAR(); qkt<0>(pA0, pA1, ka, qal);
    partialSM(pA0, pA1, m_reg, alA, mAlo, mAhi, hi);
    SWV(b, SHM_V); SWK(b, 1);
    __syncthreads();
    int vro = 0, vwo = 2 * SHM_V;
#define HALF_STEP(PX0, PX1, mnX, alX, mXlo, mXhi, PY0, PY1, alY, mYlo, mYhi, t, KB, VB, SB, SL, SW, KP, VP) do {                   \
        SBAR(); SWV(SW, vwo); SWK(SW, SB); SBAR();                                                                            \
        MLOAD(mXlo, mXhi, t); qkt_fsm<KB>(PX0, PX1, ka, qal, PY0, PY1, alY, l_reg, pa0, pa1, pa2, pa3, mYlo, mYhi, hi); SBAR(); \
        SLD(SL, KP, VP); SBAR();                                                                                              \
        pv_psm<0>(o, vb0 + vro, pa0, pa1, pa2, pa3, PX0, PX1, m_reg, alX, mXlo, mXhi, hi);                                    \
        RESC(alX);                                                                                                            \
        vro = (vro == 2 * SHM_V) ? 0 : vro + SHM_V; vwo = (vwo == 2 * SHM_V) ? 0 : vwo + SHM_V;                               \
        __syncthreads(); } while (0)
    for (int t = 1; t + 1 < NT; t += 2) {
        const bool inr = t + 3 < NT;
        const bf16_t* kp2 = inr ? Kh + KBASE(t + 3) : nxt.K; const bf16_t* vp2 = inr ? Vh + KBASE(t + 3) : nxt.V;
        HALF_STEP(pB0, pB1, mnB, alB, mBlo, mBhi, pA0, pA1, alA, mAlo, mAhi, t, 1, 0, 0, b, a, Kh + KBASE(t + 2), Vh + KBASE(t + 2));
        HALF_STEP(pA0, pA1, mnA, alA, mAlo, mAhi, pB0, pB1, alB, mBlo, mBhi, t + 1, 0, 1, 1, a, b, kp2, vp2);
    }
    MLOAD(mBlo, mBhi, NT - 1);
    SBAR(); qkt_fsm<1>(pB0, pB1, ka, qal, pA0, pA1, alA, l_reg, pa0, pa1, pa2, pa3, mAlo, mAhi, hi); SBAR();
    SLD(b, nxt.K + nxt.kst, nxt.V + nxt.kst); SBAR();
    pv_psm<0>(o, vb0 + vro, pa0, pa1, pa2, pa3, pB0, pB1, m_reg, alB, mBlo, mBhi, hi); RESC(alB);
    vro = (vro == 2 * SHM_V) ? 0 : vro + SHM_V;
    finishSM(pB0, pB1, alB, l_reg, pa0, pa1, pa2, pa3, mBlo, mBhi, hi); SBAR(); pv_tile<0>(o, vb0 + vro, pa0, pa1, pa2, pa3);
    SBAR(); SWK(a, 0); SBAR();
    if (hi == 0) li_l[r32] = l_reg; asm volatile("s_waitcnt lgkmcnt(0)" ::: "memory");
    { char* ow_l = Qw_lds + r32 * 2;
#pragma unroll
      for (int r = 0; r < 16; ++r) { const int orow = crow(r, hi); const float rl = __builtin_amdgcn_rcpf(li_l[orow]);
#pragma unroll
          for (int d0 = 0; d0 < 4; ++d0) *(unsigned short*)(ow_l + orow * QROWB + d0 * 64) = (unsigned short)(cvtpk(o[d0][r] * rl, 0.f) & 0xffffu); }
      asm volatile("s_waitcnt lgkmcnt(0)" ::: "memory"); SBAR();
      bf16_t* Ow = cur.O + (size_t)(wid * QBLK + (lane >> 4)) * DM + (lane & 15) * 8; const bf16_t* Gw = cur.G + (size_t)(wid * QBLK + (lane >> 4)) * DM + (lane & 15) * 8;
      u32x4 gv[8];
#pragma unroll
      for (int i = 0; i < 8; ++i) gv[i] = *(const u32x4*)(Gw + (size_t)(4 * i) * DM);
#pragma unroll
      for (int i = 0; i < 8; ++i) { const u32x4 ov = *(const u32x4*)(Qw_lds + (4 * i + (lane >> 4)) * QROWB + (lane & 15) * 16);
          f32x4 a0, a1, g0, g1; unpack8(ov, a0, a1); unpack8(gv[i], g0, g1);
          *(u32x4*)(Ow + (size_t)(4 * i) * DM) = pack8(a0 * g0, a1 * g1); }
      asm volatile("s_waitcnt lgkmcnt(0)" ::: "memory"); }
    __syncthreads();
#undef MLOAD
#undef RESC
#undef KBASE
#undef HALF_STEP
}
#undef ROW
#undef VMW
#undef VMWN
#undef SLD
#undef SWK
#undef SWV
#undef KSWZ
#undef SBAR
}

#define XB_TMO      128
#define XB_XCNT(j)  (256  + 64 * (j))
#define XB_XSUB(j)  (1280 + 64 * (j))
#define XB_XGEN(j)  (2304 + 64 * (j))
#define XB_TOP      3328
#define XB_TOPGEN   3392
#define XCD_BAR_WORDS 3456
#define XB_SPIN_CAP (1u << 22)
__device__ __forceinline__ unsigned xb_ld(unsigned* p)              { return __hip_atomic_load(p, __ATOMIC_RELAXED, __HIP_MEMORY_SCOPE_AGENT); }
__device__ __forceinline__ unsigned xb_add(unsigned* p, unsigned v) { return __hip_atomic_fetch_add(p, v, __ATOMIC_RELAXED, __HIP_MEMORY_SCOPE_AGENT); }
__device__ __forceinline__ unsigned xb_xcc_id() { return (unsigned)__builtin_amdgcn_s_getreg((3 << 11) | 20) & 0xFu; }
#define XB_SPIN(cond, bar) do { unsigned _sp = 0; while (cond) { __builtin_amdgcn_s_sleep(1); \
    if ((++_sp & 255u) == 0u) { if (xb_ld(&(bar)[XB_TMO])) break; if (_sp > XB_SPIN_CAP) { atomicAdd(&(bar)[XB_TMO], 1u); break; } } } } while (0)
struct XcdBarrier { unsigned* bar; unsigned x; volatile LAS unsigned* st; };
__device__ __forceinline__ XcdBarrier xcd_barrier_post(unsigned* bar, volatile LAS unsigned* st) {
    XcdBarrier b; b.bar = bar; b.x = xb_xcc_id(); b.st = st;
    if (threadIdx.x == 0) (void)xb_add(&bar[XB_XCNT(b.x)], 1u);
    return b;
}
__device__ __forceinline__ void xcd_barrier_complete(unsigned* bar, unsigned x, unsigned& nloc, unsigned& nx) {
    const unsigned G = gridDim.x * gridDim.y * gridDim.z;
    unsigned sum, cnt, mine, sp = 0u;
    for (;;) {
        sum = 0u; cnt = 0u; mine = 0u;
        unsigned cj[16];
#pragma unroll
        for (unsigned j = 0; j < 16; ++j) cj[j] = xb_ld(&bar[XB_XCNT(j)]);
        __builtin_amdgcn_sched_barrier(0);
#pragma unroll
        for (unsigned j = 0; j < 16; ++j) { const unsigned c = cj[j]; sum += c; cnt += (c > 0u) ? 1u : 0u; mine = (j == x) ? c : mine; }
        if (sum == G) break;
        __builtin_amdgcn_s_sleep(1);
        if ((++sp & 255u) == 0u) { if (xb_ld(&bar[XB_TMO])) break; if (sp > XB_SPIN_CAP) { atomicAdd(&bar[XB_TMO], 1u); break; } }
    }
    nloc = mine > 0u ? mine : 1u; nx = cnt > 0u ? cnt : 1u;
}
__device__ __forceinline__ void xcd_barrier(const XcdBarrier& b) {
    asm volatile("s_waitcnt vmcnt(0)" ::: "memory");
    __syncthreads();
    if (threadIdx.x == 0) {
        unsigned* bar = b.bar;
        __builtin_amdgcn_s_waitcnt(0);
        unsigned nloc = b.st[0], nx = b.st[1];
        if (nloc == 0u) { xcd_barrier_complete(bar, b.x, nloc, nx); b.st[0] = nloc; b.st[1] = nx; }
        const unsigned old = xb_add(&bar[XB_XSUB(b.x)], 1u);
        const unsigned gen = old / nloc;
        if (old + 1u == (gen + 1u) * nloc) {
            __builtin_amdgcn_fence(__ATOMIC_RELEASE, "agent");
            asm volatile("s_waitcnt vmcnt(0)" ::: "memory");
            const unsigned og = xb_add(&bar[XB_TOP], 1u);
            const unsigned tg = og / nx;
            if (og + 1u == (tg + 1u) * nx) xb_add(&bar[XB_TOPGEN], 1u);
            else XB_SPIN(xb_ld(&bar[XB_TOPGEN]) == tg, bar);
            __builtin_amdgcn_fence(__ATOMIC_ACQUIRE, "agent");
            xb_add(&bar[XB_XGEN(b.x)], 1u);
            asm volatile("s_waitcnt vmcnt(0)" ::: "memory");
        } else {
            XB_SPIN(xb_ld(&bar[XB_XGEN(b.x)]) == gen, bar);
            __builtin_amdgcn_fence(__ATOMIC_ACQUIRE, "agent");
            asm volatile("s_waitcnt vmcnt(0)" ::: "memory");
        }
    }
    __syncthreads();
}

struct Args {
    const float* x; const float* c; const int* pos; const float* norm_g; const float* mod_w; const float* mod_b;
    const float* pwi; const float* pwg; const float* pls; const float* pwo; const float* awi; const float* awo; const float* fg;
    float* out; unsigned char* ws;
    int ph_lo, ph_hi;
};
constexpr int NWAVES = 8, NTHR = 512;
constexpr int RING_BYTES = 131072, LDS_BYTES = 157696, MISC_OFF = LDS_BYTES - 256;

__device__ __forceinline__ void sincos_d(double a, float& s_out, float& c_out) {
    const double k = __builtin_rint(a * 0.6366197723675814);
    double r = __builtin_fma(-k, 1.5707963267948966, a); r = __builtin_fma(-k, 6.123233995736766e-17, r);
    const double r2 = r * r;
    double sp = -7.647163731819816e-13; sp = sp * r2 + 1.6059043836821613e-10; sp = sp * r2 - 2.505210838544172e-08; sp = sp * r2 + 2.7557319223985893e-06;
    sp = sp * r2 - 1.984126984126984e-04; sp = sp * r2 + 8.333333333333333e-03; sp = sp * r2 - 1.6666666666666666e-01; const double s = r + r * r2 * sp;
    double cp = 4.779477332387385e-14; cp = cp * r2 - 1.1470745597729725e-11; cp = cp * r2 + 2.08767569878681e-09; cp = cp * r2 - 2.755731922398589e-07;
    cp = cp * r2 + 2.48015873015873e-05; cp = cp * r2 - 1.388888888888889e-03; cp = cp * r2 + 4.1666666666666664e-02; cp = cp * r2 - 0.5; const double c = 1.0 + r2 * cp;
    const int q = (int)((long long)k & 3);
    const double ss = (q == 0) ? s : (q == 1) ? c : (q == 2) ? -s : -c;
    const double cc = (q == 0) ? c : (q == 1) ? -s : (q == 2) ? -c : s;
    s_out = (float)ss; c_out = (float)cc;
}
__device__ __forceinline__ void transpose_item(const float* W, int K, int N, bf16_t* WT, int row_off, LAS float* scr, int nblk, int item, int lane) {
    const int kb = item / nblk, nb = item % nblk, k0 = 64 * kb, n0 = 32 * nb;
    const int nn = n0 + (lane & 31);
    float tv[32];
#pragma unroll
    for (int i = 0; i < 32; ++i) { const int kk = 2 * i + (lane >> 5); tv[i] = (nn < N) ? W[(size_t)(k0 + kk) * N + nn] : 0.f; }
#pragma unroll
    for (int i = 0; i < 32; ++i) { const int kk = 2 * i + (lane >> 5); scr[kk * 33 + (lane & 31)] = tv[i]; }
    LDS_WAIT(); asm volatile("" ::: "memory");
    const int c = lane & 7;
#pragma unroll
    for (int j = 0; j < 4; ++j) { const int n = (lane >> 3) + 8 * j; const LAS float* s = scr + (8 * c) * 33 + n;
        u32x4 o; o.x = pk2(s[0 * 33], s[1 * 33]); o.y = pk2(s[2 * 33], s[3 * 33]); o.z = pk2(s[4 * 33], s[5 * 33]); o.w = pk2(s[6 * 33], s[7 * 33]);
        *(u32x4*)(WT + (size_t)(row_off + n0 + n) * K + k0 + 8 * c) = o; }
    LDS_WAIT(); asm volatile("" ::: "memory");
}
template <int VAR>
__device__ __forceinline__ void phase0(int wv, const Args& a, LAS unsigned char* lds) {
    const int tid = opaque_tid(wv), lane = tid & 63, wave = __builtin_amdgcn_readfirstlane(tid >> 6);
    const int G = gridDim.x, bx = blockIdx.x;
    unsigned char* ws = a.ws;
    if (VAR == 0 || VAR == 1)
    for (int unit = bx; unit < 256; unit += G) {
        const int layer = unit >> 6, kq = (unit >> 4) & 3, cs = unit & 15;
        const float* W = a.mod_w + ((size_t)layer * DM + 512 * kq) * 6144 + 384 * cs;
        LAS float* red = (LAS float*)lds;
        LAS float* cdl = (LAS float*)(lds + 8192);
        if (tid < 512) cdl[tid] = silu_f(a.c[512 * kq + tid]);
        if (tid < 8) cdl[512 + tid] = 0.f;
        __syncthreads();
        if (tid < 480) {
            const int kg = tid / 96, ln = tid - kg * 96;
            f32x4 acc4 = {0.f, 0.f, 0.f, 0.f};
#pragma unroll 8
            for (int i = 0; i < 103; ++i) { const int k = kg + 5 * i, kc = k < 512 ? k : 511;
                acc4 += *(const f32x4*)(W + (size_t)kc * 6144 + 4 * ln) * cdl[k]; }
            *(LAS f32x4*)(red + kg * 384 + 4 * ln) = acc4;
        }
        __syncthreads();
        if (tid < 384) { float sum = red[tid];
#pragma unroll
            for (int kg = 1; kg < 5; ++kg) sum += red[kg * 384 + tid];
            const int col = 384 * cs + tid;
            if (kq == 0) sum += a.mod_b[layer * 6144 + col];
            ((float*)(ws + WS_MOD))[(layer * 4 + kq) * 6144 + col] = sum; }
        __syncthreads();
    }
    if (VAR == 0 || VAR == 2) {
        float* cosq = (float*)(ws + WS_TAB); float* sinq = cosq + SEQ * 16; float* cosi = sinq + SEQ * 16; float* sini = cosi + SEQ * 8;
        for (int e = bx * NTHR + tid; e < SEQ * 24; e += G * NTHR) {
            const int p = e / 24, i = e - p * 24;
            const float pf = (float)a.pos[p];
            const double frac = i < 16 ? (double)i * (1.0 / 16.0) : (double)(i - 16) * (1.0 / 8.0);
            const float inv = (float)exp2(-18.931568569324174 * frac);
            const float ang = pf * inv;
            float s, c; sincos_d((double)ang, s, c);
            if (i < 16) { cosq[p * 16 + i] = c; sinq[p * 16 + i] = s; } else { cosi[p * 8 + i - 16] = c; sini[p * 8 + i - 16] = s; }
        }
    }
    if (VAR == 0 || VAR == 3) {
        LAS float* scr = (LAS float*)(lds + 16384 + wave * 8704);
        const int gw = bx * NWAVES + wave, NGW = G * NWAVES;
        constexpr int I_PI = 32 * 128, I_PG = 8 * 16, I_PO = 32 * 64, I_AI = 32 * 296, I_AO = 32 * 64;
        constexpr int NITEMS = 2 * I_PI + 8 * I_PG + 2 * I_PO + 2 * I_AI + 2 * I_AO;
        for (int it = gw; it < NITEMS; it += NGW) {
            int r = it;
            if (r < 2 * I_AI) { const int l = r / I_AI; r -= l * I_AI; transpose_item(a.awi + (size_t)l * DM * ATTN_IN, DM, ATTN_IN, (bf16_t*)(ws + WS_WAI) + (size_t)l * ATTN_INP * DM, 0, scr, 296, r, lane); continue; } r -= 2 * I_AI;
            if (r < 2 * I_PI) { const int l = r / I_PI; r -= l * I_PI; transpose_item(a.pwi + (size_t)l * DM * POOL_IN, DM, POOL_IN, (bf16_t*)(ws + WS_WPI) + (size_t)l * POOL_IN * DM, 0, scr, 128, r, lane); continue; } r -= 2 * I_PI;
            if (r < 2 * I_PO) { const int l = r / I_PO; r -= l * I_PO; transpose_item(a.pwo + (size_t)l * DM * DM, DM, DM, (bf16_t*)(ws + WS_WPO) + (size_t)l * DM * DM, 0, scr, 64, r, lane); continue; } r -= 2 * I_PO;
            if (r < 2 * I_AO) { const int l = r / I_AO; r -= l * I_AO; transpose_item(a.awo + (size_t)l * DM * DM, DM, DM, (bf16_t*)(ws + WS_WAO) + (size_t)l * DM * DM, 0, scr, 64, r, lane); continue; } r -= 2 * I_AO;
            { const int lg = r / I_PG; r -= lg * I_PG; const int l = lg >> 2, gi = lg & 3;
              transpose_item(a.pwg + (size_t)lg * 512 * 512, 512, 512, (bf16_t*)(ws + WS_WPG) + (size_t)l * DM * 512, gi * 512, scr, 16, r, lane); }
        }
    }
}

template <bool IN_BF16> __device__ __forceinline__ void phase_norm(int wv, const void* x, const float* g, const float* mod  , bf16_t* h, unsigned char* lds, float* gsum  ) {
    const int tid = opaque_tid(wv), lane = tid & 63, wave = tid >> 6;
    const int gw = blockIdx.x * NWAVES + wave, NGW = gridDim.x * NWAVES;
    u32x4 t[4][4]; f32x4 tf[4][8];
#define NORM_LOAD(row_) do {                                                                                                  \
        _Pragma("unroll") for (int r = 0; r < 4; ++r) { const size_t ro = (size_t)((row_) + r * NGW) * DM;                   \
            if (IN_BF16) { const u32x4* xr = (const u32x4*)((const bf16_t*)x + ro) + lane;                                   \
                _Pragma("unroll") for (int j = 0; j < 4; ++j) t[r][j] = xr[64 * j]; }                                        \
            else { const f32x4* xr = (const f32x4*)((const float*)x + ro) + 2 * lane;                                        \
                _Pragma("unroll") for (int j = 0; j < 4; ++j) { tf[r][2 * j] = xr[128 * j]; tf[r][2 * j + 1] = xr[128 * j + 1]; } } } } while (0)
    float* la = (float*)lds; float* lsft = la + DM;
    { const int col = 4 * tid;
      const f32x4 gg = *(const f32x4*)(g + col);
      const f32x4 p0 = *(const f32x4*)(mod + col), p1 = *(const f32x4*)(mod + 6144 + col), p2 = *(const f32x4*)(mod + 2 * 6144 + col), p3 = *(const f32x4*)(mod + 3 * 6144 + col);
      const f32x4 q0 = *(const f32x4*)(mod + DM + col), q1 = *(const f32x4*)(mod + 6144 + DM + col), q2 = *(const f32x4*)(mod + 2 * 6144 + DM + col), q3 = *(const f32x4*)(mod + 3 * 6144 + DM + col);
      f32x4 r0, r1, r2, r3;
      if (blockIdx.x == 0) { r0 = *(const f32x4*)(mod + 2 * DM + col); r1 = *(const f32x4*)(mod + 6144 + 2 * DM + col); r2 = *(const f32x4*)(mod + 2 * 6144 + 2 * DM + col); r3 = *(const f32x4*)(mod + 3 * 6144 + 2 * DM + col); }
      int row = gw; if (row < SEQ) NORM_LOAD(row);
      const f32x4 sh = ((p0 + p1) + p2) + p3, sc = ((q0 + q1) + q2) + q3;
      *(f32x4*)(la + col) = gg * (sc + 1.0f); *(f32x4*)(lsft + col) = sh;
      if (blockIdx.x == 0) *(f32x4*)(gsum + col) = ((r0 + r1) + r2) + r3; }
    __syncthreads();
    f32x4 av[8], sv[8];
#pragma unroll
    for (int j = 0; j < 8; ++j) { const int col = 8 * lane + 512 * (j >> 1) + 4 * (j & 1); av[j] = *(const f32x4*)(la + col); sv[j] = *(const f32x4*)(lsft + col); }
    for (int row = gw; row < SEQ; ) {
#pragma unroll
        for (int r = 0; r < 4; ++r) {
            f32x4 v[8];
#pragma unroll
            for (int j = 0; j < 4; ++j) { if (IN_BF16) unpack8(t[r][j], v[2 * j], v[2 * j + 1]); else { v[2 * j] = tf[r][2 * j]; v[2 * j + 1] = tf[r][2 * j + 1]; } }
            float s = 0.f;
#pragma unroll
            for (int j = 0; j < 8; ++j) s += (v[j].x * v[j].x + v[j].y * v[j].y) + (v[j].z * v[j].z + v[j].w * v[j].w);
            const float rstd = 1.0f / sqrtf(wave_sum(s) * (1.f / DM) + EPS);
            u32x4* o16 = (u32x4*)(h + (size_t)(row + r * NGW) * DM) + lane;
#pragma unroll
            for (int j = 0; j < 4; ++j) o16[64 * j] = pack8(v[2 * j] * rstd * av[2 * j] + sv[2 * j], v[2 * j + 1] * rstd * av[2 * j + 1] + sv[2 * j + 1]);
        }
        row += 4 * NGW; if (row >= SEQ) break;
        NORM_LOAD(row);
    }
#undef NORM_LOAD
}
__device__ __forceinline__ void phase_final(int wv, const bf16_t* x, float* y, const float* g) {
    const int tid = opaque_tid(wv), lane = tid & 63, wave = tid >> 6;
    const int gw = blockIdx.x * NWAVES + wave, NGW = gridDim.x * NWAVES;
    f32x4 gg[8];
#pragma unroll
    for (int j = 0; j < 8; ++j) gg[j] = *(const f32x4*)(g + 8 * lane + 512 * (j >> 1) + 4 * (j & 1));
    for (int row = gw; row < SEQ; row += 4 * NGW) {
        u32x4 t[4][4];
#pragma unroll
        for (int r = 0; r < 4; ++r) { const u32x4* xr = (const u32x4*)(x + (size_t)(row + r * NGW) * DM) + lane;
#pragma unroll
            for (int j = 0; j < 4; ++j) t[r][j] = xr[64 * j]; }
#pragma unroll
        for (int r = 0; r < 4; ++r) {
            f32x4 v[8]; float s = 0.f;
#pragma unroll
            for (int j = 0; j < 4; ++j) unpack8(t[r][j], v[2 * j], v[2 * j + 1]);
#pragma unroll
            for (int j = 0; j < 8; ++j) s += (v[j].x * v[j].x + v[j].y * v[j].y) + (v[j].z * v[j].z + v[j].w * v[j].w);
            const float rstd = 1.0f / sqrtf(wave_sum(s) * (1.f / DM) + EPS);
            f32x4* yr = (f32x4*)(y + (size_t)(row + r * NGW) * DM) + 2 * lane;
#pragma unroll
            for (int j = 0; j < 8; ++j) yr[128 * (j >> 1) + (j & 1)] = v[j] * rstd * gg[j];
        }
    }
}

template <int W, int R> __device__ __forceinline__ void pool_strip(const bf16_t* VG, bf16_t* PL, int t0, int c0) {
    u32x4 r[W + R - 1];
#pragma unroll
    for (int i = 0; i < W + R - 1; ++i) { const int t = t0 - (W - 1) + i; r[i] = *(const u32x4*)(VG + (size_t)(t < 0 ? 0 : t) * POOL_IN + c0); }
    float S[8];
#pragma unroll
    for (int e = 0; e < 8; ++e) S[e] = 0.f;
#pragma unroll
    for (int i = 0; i < W - 1; ++i) { const float wg = (t0 - (W - 1) + i >= 0) ? 1.f : 0.f;
#pragma unroll
        for (int e = 0; e < 4; ++e) { const unsigned x = r[i][e]; S[2 * e] += wg * __builtin_bit_cast(float, x << 16); S[2 * e + 1] += wg * __builtin_bit_cast(float, x & 0xffff0000u); } }
#pragma unroll
    for (int j = 0; j < R; ++j) { const int t = t0 + j;
        float v[8];
#pragma unroll
        for (int e = 0; e < 4; ++e) { const unsigned x = r[W - 1 + j][e]; v[2 * e] = __builtin_bit_cast(float, x << 16); v[2 * e + 1] = __builtin_bit_cast(float, x & 0xffff0000u); }
        const int cnt = (t + 1 < W) ? (t + 1) : W; const float ic = 1.0f / (float)cnt;
        float o[8];
#pragma unroll
        for (int e = 0; e < 8; ++e) { S[e] += v[e]; o[e] = S[e] * ic - v[e]; }
        u32x4 pw; pw.x = cvt_pk_bf16(o[0], o[1]); pw.y = cvt_pk_bf16(o[2], o[3]); pw.z = cvt_pk_bf16(o[4], o[5]); pw.w = cvt_pk_bf16(o[6], o[7]);
        *(u32x4*)(PL + (size_t)t * DM + c0) = pw;
        const float wg = (t - W + 1 >= 0) ? 1.f : 0.f;
#pragma unroll
        for (int e = 0; e < 4; ++e) { const unsigned x = r[j][e]; S[2 * e] -= wg * __builtin_bit_cast(float, x << 16); S[2 * e + 1] -= wg * __builtin_bit_cast(float, x & 0xffff0000u); } }
}
__device__ __forceinline__ void phase_pool(int wv, const bf16_t* VG, bf16_t* PL) {
    const int total = 512 * 256;
    const int tid = opaque_tid(wv);
    for (int it = blockIdx.x * NTHR + tid; it < total; it += gridDim.x * NTHR) {
        const int cg = it & 255, strip = it >> 8; const int c0 = cg * 8, t0 = strip * 16;
        const int grp = __builtin_amdgcn_readfirstlane(c0 >> 9);
        if (grp == 0) pool_strip<2, 16>(VG, PL, t0, c0); else if (grp == 1) pool_strip<4, 16>(VG, PL, t0, c0); else if (grp == 2) pool_strip<8, 16>(VG, PL, t0, c0);
        else { pool_strip<16, 8>(VG, PL, t0, c0); pool_strip<16, 8>(VG, PL, t0 + 8, c0); }
    }
}

__device__ __forceinline__ size_t sc_block_base(int qb) { return (size_t)65536 * (size_t)(qb * (qb + 1) / 2); }
__device__ __forceinline__ float fma_s(float a, float b, float c) { asm("v_fma_f32 %0, %1, %2, %0" : "+v"(c) : "v"(a), "v"(b)); return c; }
__device__ __forceinline__ float relu_i(float x) { const int b = __builtin_bit_cast(int, x); return __builtin_bit_cast(float, b > 0 ? b : 0); }
template <int VAR>
__device__ __forceinline__ void phase_scores(int wv, const bf16_t* QI, const bf16_t* KI, const float* WI, float* SC, LAS unsigned char* lds, unsigned* ctr  ) {
    const int tid = opaque_tid(wv), wid = __builtin_amdgcn_readfirstlane(tid >> 6), lane = tid & 63, r32 = lane & 31, hi = lane >> 5;
    constexpr int QROW = 2064;
    volatile LAS int* slot = (volatile LAS int*)(lds + 32 * QROW);
    for (;;) {
        __syncthreads();
        if (tid == 0) slot[0] = (int)__hip_atomic_fetch_add(ctr, 1u, __ATOMIC_RELAXED, __HIP_MEMORY_SCOPE_AGENT);
        __syncthreads();
        const int L = slot[0];
        if (L >= 1152) break;
        int kc = 0, base = 0;
        for (; kc < 8; ++kc) { const int n = 256 - 32 * kc; if (L < base + n) break; base += n; }
        const int u = 32 * kc + (L - base);
        const int q0 = 32 * u, qb = u >> 3;
        const int klim = (qb + 1) * 256;
        bf16x8 kf[2][4];
        { const int key0 = kc * 1024 + wid * 64;
#pragma unroll
            for (int b = 0; b < 2; ++b)
#pragma unroll
                for (int kk = 0; kk < 4; ++kk) kf[b][kk] = *(const bf16x8*)(KI + (size_t)(key0 + 32 * b + r32) * 64 + 16 * kk + 8 * hi); }
        {
            int t_ = tid; asm volatile("" : "+v"(t_));
            const bf16_t* src = QI + (size_t)q0 * 1024 + t_ * 8;
            const int ldst = (t_ >> 7) * QROW + (t_ & 127) * 16;
            u32x4 tq[8];
#pragma unroll
            for (int i = 0; i < 8; ++i) tq[i] = *(const u32x4*)(src + i * 4096);
            __builtin_amdgcn_sched_barrier(0);
#pragma unroll
            for (int i = 0; i < 8; ++i) *(LAS u32x4*)(lds + ldst + i * (4 * QROW)) = tq[i];
        }
        f32x4 wq[4];
#pragma unroll
        for (int i = 0; i < 4; ++i) wq[i] = *(const f32x4*)(WI + (size_t)(q0 + r32) * 16 + 4 * i);
        __syncthreads();
        for (int sl = wid; sl < 16; sl += 8) {
            const int key0 = kc * 1024 + sl * 64;
            if (key0 >= klim) continue;
            if (sl != wid) {
#pragma unroll
                for (int b = 0; b < 2; ++b)
#pragma unroll
                    for (int kk = 0; kk < 4; ++kk) kf[b][kk] = *(const bf16x8*)(KI + (size_t)(key0 + 32 * b + r32) * 64 + 16 * kk + 8 * hi); }
            f32x16 acc0 = {}, acc1 = {};
            const LAS unsigned char* qa = lds + r32 * QROW + hi * 16;
#define SC_MM(h, S0, S1) do { bf16x8 af_[4];                                                                                  \
                _Pragma("unroll") for (int kk = 0; kk < 4; ++kk) af_[kk] = *(const LAS bf16x8*)(qa + (h) * 128 + kk * 32);     \
                S0 = __builtin_amdgcn_mfma_f32_32x32x16_bf16(kf[0][0], af_[0], f32x16{}, 0, 0, 0); S1 = __builtin_amdgcn_mfma_f32_32x32x16_bf16(kf[1][0], af_[0], f32x16{}, 0, 0, 0); \
                _Pragma("unroll") for (int kk = 1; kk < 4; ++kk) { S0 = __builtin_amdgcn_mfma_f32_32x32x16_bf16(kf[0][kk], af_[kk], S0, 0, 0, 0); S1 = __builtin_amdgcn_mfma_f32_32x32x16_bf16(kf[1][kk], af_[kk], S1, 0, 0, 0); } } while (0)
#define SC_VA(h, S0, S1) do { const float w_ = wq[(h) >> 2][(h) & 3];                                                          \
                _Pragma("unroll") for (int r = 0; r < 16; ++r) { acc0[r] = fma_s(relu_i(S0[r]), w_, acc0[r]); acc1[r] = fma_s(relu_i(S1[r]), w_, acc1[r]); } } while (0)
#define SC_SB() __builtin_amdgcn_sched_barrier(0)
            f32x16 sA0, sA1, sB0, sB1;
            SC_MM(0, sA0, sA1); SC_SB();
            if (wid < 4) {
#pragma unroll
                for (int h = 0; h < 14; h += 2) {
                    SC_MM(h + 1, sB0, sB1); SC_SB(); SC_VA(h, sA0, sA1); SC_SB();
                    SC_MM(h + 2, sA0, sA1); SC_SB(); SC_VA(h + 1, sB0, sB1); SC_SB();
                }
                SC_MM(15, sB0, sB1); SC_SB(); SC_VA(14, sA0, sA1); SC_SB();
                SC_VA(15, sB0, sB1);
            } else {
                SC_MM(1, sB0, sB1); SC_SB();
#pragma unroll
                for (int h = 0; h < 14; h += 2) {
                    SC_VA(h, sA0, sA1); SC_SB(); SC_MM(h + 2, sA0, sA1); SC_SB();
                    SC_VA(h + 1, sB0, sB1); SC_SB(); SC_MM(h + 3, sB0, sB1); SC_SB();
                }
                SC_VA(14, sA0, sA1); SC_SB();
                SC_VA(15, sB0, sB1);
            }
#undef SC_SB
#undef SC_MM
#undef SC_VA
            float* out = SC + sc_block_base(qb) + (size_t)(q0 - qb * 256 + r32) * (size_t)klim + key0 + 4 * hi;
#pragma unroll
            for (int g = 0; g < 4; ++g) {
                *(f32x4*)(out + 8 * g) = (f32x4){acc0[4 * g], acc0[4 * g + 1], acc0[4 * g + 2], acc0[4 * g + 3]};
                *(f32x4*)(out + 32 + 8 * g) = (f32x4){acc1[4 * g], acc1[4 * g + 1], acc1[4 * g + 2], acc1[4 * g + 3]}; }
        }
    }
}

template <int VAR>
__device__ __forceinline__ void phase_select(int wv, const float* SC, unsigned long long* MASK, LAS unsigned char* lds) {
    const int tid = opaque_tid(wv), lane0 = tid & 63, wave = __builtin_amdgcn_readfirstlane(tid >> 6);
    LAS unsigned* hist = (LAS unsigned*)(lds + wave * 9216);
    const int gw = blockIdx.x * NWAVES + wave, NGW = gridDim.x * NWAVES;
    for (int q = gw; q < SEQ; q += NGW) {
        int lane = lane0; asm volatile("" : "+v"(lane));
        const int qb = q >> 8, klim = (qb + 1) * 256;
        const float* rowp = SC + sc_block_base(qb) + (size_t)(q - qb * 256) * (size_t)klim;
        const int ngrp = qb + 1;
        unsigned key[32][4];
#pragma unroll
        for (int g = 0; g < 8; ++g) {
            if (4 * g < ngrp) {
#pragma unroll
                for (int i = 0; i < 4; ++i) { const u32x4 v = *(const u32x4*)(rowp + 256 * (4 * g + i) + 4 * lane);
                    key[4 * g + i][0] = v.x; key[4 * g + i][1] = v.y; key[4 * g + i][2] = v.z; key[4 * g + i][3] = v.w; }
            } else {
#pragma unroll
                for (int i = 0; i < 4; ++i) { key[4 * g + i][0] = 0u; key[4 * g + i][1] = 0u; key[4 * g + i][2] = 0u; key[4 * g + i][3] = 0u; }
            }
        }
        unsigned T = 1u; unsigned need_eq = 0xffffffffu, n_eq = 0u;
        const bool radix = (q + 1 > TOPK) && (VAR != 1 && VAR != 3);
        if (VAR == 3) { unsigned x_ = 0u;
#pragma unroll
            for (int j = 0; j < 32; ++j) x_ |= key[j][0] & key[j][1] & key[j][2] & key[j][3];
            if (x_ == 0x12345u) MASK[q] = x_; continue; }
        if (radix) {
#pragma unroll
            for (int i = 0; i < 9; ++i) *(LAS u32x4*)(hist + 4 * (lane + 64 * i)) = (u32x4){0u, 0u, 0u, 0u};
        }
        __builtin_amdgcn_sched_barrier(0);
#pragma unroll
        for (int g = 0; g < 8; ++g) { if (4 * g < ngrp) {
#pragma unroll
            for (int i = 0; i < 4; ++i)
#pragma unroll
                for (int e = 0; e < 4; ++e) { const int j = 4 * g + i; const unsigned uu = key[j][e];
                    const unsigned kx = uu ^ ((unsigned)((int)uu >> 31) | 0x80000000u); key[j][e] = (256 * j + 4 * lane + e <= q) ? kx : 0u; }
            } __builtin_amdgcn_sched_barrier(0); }
        if (radix) {
            unsigned gm0 = 0u, gm1 = 0u, gm2 = 0u, gm3 = 0u;
#pragma unroll
            for (int g = 0; g < 8; ++g) if (4 * g < ngrp) {
#pragma unroll
                for (int i = 0; i < 4; ++i) { const int j = 4 * g + i; gm0 = key[j][0] > gm0 ? key[j][0] : gm0; gm1 = key[j][1] > gm1 ? key[j][1] : gm1; gm2 = key[j][2] > gm2 ? key[j][2] : gm2; gm3 = key[j][3] > gm3 ? key[j][3] : gm3; }
            }
            unsigned Pmin = gm0 < gm1 ? gm0 : gm1; { const unsigned p2 = gm2 < gm3 ? gm2 : gm3; Pmin = Pmin < p2 ? Pmin : p2; }
#pragma unroll
            for (int off = 1; off < 64; off <<= 1) { const unsigned tt = (unsigned)__builtin_amdgcn_ds_bpermute((lane ^ off) << 2, (int)Pmin); Pmin = tt < Pmin ? tt : Pmin; }
            LDS_WAIT();
#pragma unroll
            for (int g = 0; g < 8; ++g) if (4 * g < ngrp) {
#pragma unroll
                for (int i = 0; i < 4; ++i) {
#pragma unroll
                    for (int e = 0; e < 4; ++e) { const unsigned k = key[4 * g + i][e];
                        if (k >= Pmin) { const unsigned b = k >> 21; __hip_atomic_fetch_add(hist + b + ((b >> 5) << 2), 1u, __ATOMIC_RELAXED, __HIP_MEMORY_SCOPE_WORKGROUP); } }
                    __builtin_amdgcn_sched_barrier(0); }
            }
            unsigned prefix = 0u, pmask = 0u, kk = TOPK;
#pragma unroll 1
            for (int pass = 0; pass < ((VAR == 4) ? 1 : 3); ++pass) {
                const int shift = (pass == 0) ? 21 : (pass == 1) ? 10 : 0;
                const unsigned dmask = (pass == 2) ? 1023u : 2047u;
                LDS_WAIT();
                if (pass > 0) {
#pragma unroll
                    for (int g = 0; g < 8; ++g) if (4 * g < ngrp) {
#pragma unroll
                        for (int i = 0; i < 4; ++i) {
#pragma unroll
                            for (int e = 0; e < 4; ++e) { const unsigned k = key[4 * g + i][e];
                                if ((k & pmask) == prefix) { const unsigned b = (k >> shift) & dmask; __hip_atomic_fetch_add(hist + b + ((b >> 5) << 2), 1u, __ATOMIC_RELAXED, __HIP_MEMORY_SCOPE_WORKGROUP); } }
                            __builtin_amdgcn_sched_barrier(0); }
                    }
                }
                LDS_WAIT();
                if (VAR == 5) { prefix |= (0x5a5u & dmask) << shift; pmask |= dmask << shift; continue; }
                unsigned s = 0u;
#pragma unroll
                for (int i = 0; i < 8; ++i) { const u32x4 v = *(const LAS u32x4*)(hist + 36 * lane + 4 * i); s += (v.x + v.y) + (v.z + v.w); }
                unsigned suf = s;
#pragma unroll
                for (int off = 1; off < 64; off <<= 1) { const unsigned tt = (unsigned)__builtin_amdgcn_ds_bpermute(((lane + off) & 63) << 2, (int)suf); if (lane + off < 64) suf += tt; }
                const unsigned long long bal = __ballot(suf >= kk);
                const int Ls = 63 - __builtin_clzll(bal);
                const unsigned above1 = (unsigned)__builtin_amdgcn_readlane((int)(suf - s), Ls);
                const unsigned c2 = hist[36 * Ls + (lane & 31)];
                unsigned suf2 = (lane < 32) ? c2 : 0u;
#pragma unroll
                for (int off = 1; off < 32; off <<= 1) { const unsigned tt = (unsigned)__builtin_amdgcn_ds_bpermute(((lane + off) & 63) << 2, (int)suf2); if (lane + off < 32) suf2 += tt; }
                const unsigned long long bal2 = __ballot(lane < 32 && above1 + suf2 >= kk);
                const int Bs = 63 - __builtin_clzll(bal2);
                const int dsel = 32 * Ls + Bs;
                const unsigned cnt_b = (unsigned)__builtin_amdgcn_readlane((int)c2, Bs);
                const unsigned kk_new = kk - (above1 + (unsigned)__builtin_amdgcn_readlane((int)suf2, Bs) - cnt_b);
                LDS_WAIT();
#pragma unroll
                for (int i = 0; i < 9; ++i) *(LAS u32x4*)(hist + 4 * (lane + 64 * i)) = (u32x4){0u, 0u, 0u, 0u};
                const unsigned d = (unsigned)dsel; kk = kk_new; n_eq = cnt_b;
                prefix |= d << shift; pmask |= dmask << shift;
            }
            T = prefix; need_eq = kk;
        }
        if (VAR == 2 || VAR == 4 || VAR == 5) { if (T == 0x12345u) MASK[q] = T; continue; }
        const bool tie_path = (need_eq != 0xffffffffu) && (n_eq > need_eq);
        unsigned tie_seen = 0u;
        const unsigned long long lt = (lane == 0) ? 0ull : (~0ull >> (64 - lane));
        int w0lo = 0, w0hi = 0, w1lo = 0, w1hi = 0;
#pragma unroll
        for (int g = 0; g < 8; ++g) if (4 * g < ngrp) {
#pragma unroll
            for (int i = 0; i < 4; ++i) { const int j = 4 * g + i;
                unsigned long long B[4];
                if (!tie_path) {
#pragma unroll
                    for (int e = 0; e < 4; ++e) B[e] = __ballot(key[j][e] >= T);
                } else {
                    unsigned long long E[4]; unsigned before = tie_seen;
#pragma unroll
                    for (int e = 0; e < 4; ++e) { E[e] = __ballot(key[j][e] == T); before += (unsigned)__builtin_popcountll(E[e] & lt); }
                    unsigned mine = 0u;
#pragma unroll
                    for (int e = 0; e < 4; ++e) { const bool eq = (key[j][e] == T);
                        B[e] = __ballot(key[j][e] > T || (eq && (before + mine) < need_eq)); mine += eq ? 1u : 0u; }
#pragma unroll
                    for (int e = 0; e < 4; ++e) tie_seen += (unsigned)__builtin_popcountll(E[e]);
                }
#pragma unroll
                for (int k = 0; k < 4; ++k) { const int t = 4 * j + k;
                    const unsigned blo_ = (unsigned)((B[0] >> (16 * k)) & 0xffffull) | ((unsigned)((B[1] >> (16 * k)) & 0xffffull) << 16);
                    const unsigned bhi_ = (unsigned)((B[2] >> (16 * k)) & 0xffffull) | ((unsigned)((B[3] >> (16 * k)) & 0xffffull) << 16);
                    if (t < 64) asm volatile("s_nop 3\n\tv_writelane_b32 %0, %2, %4\n\tv_writelane_b32 %1, %3, %4" : "+v"(w0lo), "+v"(w0hi) : "s"(blo_), "s"(bhi_), "n"(t & 63));
                    else asm volatile("s_nop 3\n\tv_writelane_b32 %0, %2, %4\n\tv_writelane_b32 %1, %3, %4" : "+v"(w1lo), "+v"(w1hi) : "s"(blo_), "s"(bhi_), "n"(t & 63)); }
            }
        }
        const int ntile = 4 * ngrp;
        if (lane < ntile) MASK[(size_t)lane * SEQ + q] = ((unsigned long long)(unsigned)w0hi << 32) | (unsigned)w0lo;
        if (lane + 64 < ntile) MASK[(size_t)(lane + 64) * SEQ + q] = ((unsigned long long)(unsigned)w1hi << 32) | (unsigned)w1lo;
    }
}

__device__ __forceinline__ att::BlockRef attn_ref(int h, int qb, bool rev, const bf16_t* Qh, const bf16_t* Kh, const bf16_t* Vh, bf16_t* O, const bf16_t* SG, const unsigned long long* MASK) {
    att::BlockRef r;
    const long first = rev ? (long)(4 * qb + 3) : 0l;
    r.Q = Qh + ((size_t)h * SEQ + (size_t)qb * 256) * HD; r.K = Kh + (size_t)h * SEQ * HD + first * (att::KVBLK * HD); r.V = Vh + (size_t)h * SEQ * HD + first * (att::KVBLK * HD);
    r.O = O + (size_t)qb * 256 * DM + h * HD; r.G = SG + (size_t)qb * 256 * DM + h * HD; r.M = MASK + qb * 256 + first * SEQ; r.P0 = qb * 256;
    r.kst = rev ? -(long)(att::KVBLK * HD) : (long)(att::KVBLK * HD); r.mst = rev ? -(long)SEQ : (long)SEQ;
    return r;
}
__device__ __forceinline__ void phase_attn(int wv, const bf16_t* Qh, const bf16_t* Kh, const bf16_t* Vh, bf16_t* O, const bf16_t* SG, const unsigned long long* MASK, char* lds) {
    const int total = NHEAD * 16, stride = gridDim.x;
    int L = blockIdx.x; if (L >= total) return;
    if (gridDim.x == 256) { const int b = L; L = 16 * ((b & 7) + 8 * (b >> 7)) + ((b >> 3) & 15); }
    int pass = 0;
    att::BlockRef cur = attn_ref(L >> 4, L & 15, false, Qh, Kh, Vh, O, SG, MASK);
    att::Seam S;
    att::attn_prime(wv, cur, lds, S);
    for (;;) {
        const bool more_pass = pass == 0, more_item = L + stride < total, last = !more_pass && !more_item;
        int passn = pass + 1, Ln = L;
        if (!more_pass) { passn = 0; Ln = more_item ? L + stride : L; }
        const int hn = Ln >> 4, xn = Ln & 15;
        const att::BlockRef nxt = last ? cur : attn_ref(hn, passn ? 31 - xn : xn, passn != 0, Qh, Kh, Vh, O, SG, MASK);
        att::attn_block(wv, cur, nxt, lds, S);
        if (last) break;
        cur = nxt; pass = passn; L = Ln;
    }
}

__global__ void __launch_bounds__(NTHR, 2) trunk_fwd(Args args) {
    extern __shared__ __attribute__((aligned(16))) unsigned char lds_raw[];
    LAS unsigned char* lds = (LAS unsigned char*)lds_raw;
    volatile LAS unsigned* MISC = (volatile LAS unsigned*)(lds + MISC_OFF);
    const int wv = __builtin_amdgcn_readfirstlane((int)threadIdx.x >> 6);
    const int tid = opaque_tid(wv);
    unsigned char* ws = args.ws;
    if (tid < 32) MISC[tid] = 0u;
    __syncthreads();
    XcdBarrier bar; bar.bar = (unsigned*)(ws + WS_CTL) + 1024; bar.x = 0; bar.st = nullptr;
    if (MK_ONE_LAUNCH) bar = xcd_barrier_post((unsigned*)(ws + WS_CTL) + 1024, MISC + 8);
    const int lo = args.ph_lo, hi = args.ph_hi;
    int ph = 0;
#ifndef PHASE_MASK
#define PHASE_MASK 0xFFFF
#endif
#define IN(k) (lo <= (k) && (k) < hi)
#define PM(b) ((PHASE_MASK >> (b)) & 1)
#ifndef DUP_MASK
#define DUP_MASK 0
#endif
#ifndef SC_VAR
#define SC_VAR 0
#endif
#define DUP(b) ((DUP_MASK >> (b)) & 1)
#define REDO(b, stmt) do { if (DUP(b)) { if (MK_ONE_LAUNCH) xcd_barrier(bar); else __syncthreads(); stmt; } } while (0)
#ifndef ECHO_MASK
#define ECHO_MASK 0
#endif
#define ECHO_K 4
    unsigned long long echo_acc = 0ull, echo_prev = ECHO_MASK ? __builtin_amdgcn_s_memrealtime() : 0ull;
#define SEAM(b) do { if (IN(ph) && IN(ph + 1)) xcd_barrier(bar); ++ph; \
        if (ECHO_MASK) { const unsigned long long now_ = __builtin_amdgcn_s_memrealtime(); if ((ECHO_MASK >> (b)) & 1) echo_acc += now_ - echo_prev; echo_prev = now_; } } while (0)

    float* mod = (float*)(ws + WS_MOD);
    bf16_t* HU = (bf16_t*)(ws + WS_HU);
    const float* cosq = (const float*)(ws + WS_TAB); const float* sinq = cosq + SEQ * 16; const float* cosi = sinq + SEQ * 16; const float* sini = cosi + SEQ * 8;
    const int G = gridDim.x, bx = blockIdx.x;

    if (PM(0) && IN(ph)) { phase0<0>(wv, args, lds); REDO(0, phase0<SC_VAR>(wv, args, lds)); }
    SEAM(0);
#pragma unroll 1
    for (int layer = 0; layer < 4; ++layer) {
        const int j = layer >> 1;
        bf16_t* XB = (bf16_t*)(ws + WS_XB);
        float* lgs = (float*)mod + 16 * 6144 + layer * DM;
        const float* lmod = mod + layer * 4 * 6144;
        if (PM(1) && IN(ph)) { if (layer == 0) phase_norm<false>(wv, args.x, args.norm_g, lmod, HU, lds_raw, lgs); else phase_norm<true>(wv, XB, args.norm_g + layer * DM, lmod, HU, lds_raw, lgs); }
        SEAM(1);
        if ((layer & 1) == 0) {
            bf16_t* VG = (bf16_t*)(ws + WS_VG); bf16_t* PL = (bf16_t*)(ws + WS_PL);
            if (PM(2) && IN(ph)) { pg8::Gemm g{HU, (const bf16_t*)(ws + WS_WPI) + (size_t)j * POOL_IN * DM, SEQ, POOL_IN, DM, DM, DM, 0, 0};
                pg8::StaticOrder S; S.init(SEQ, POOL_IN, G, bx); pg8::EpiBf16 E{VG, POOL_IN};
                pg8::gemm_phase<pg8::EpiBf16, true>(wv, lds, g, S, E); REDO(2, (pg8::gemm_phase<pg8::EpiBf16, true>(wv, lds, g, S, E))); }
            SEAM(2);
            if (PM(3) && IN(ph)) { phase_pool(wv, VG, PL); REDO(3, phase_pool(wv, VG, PL)); }
            SEAM(3);
            if (PM(4) && IN(ph)) { pg8::Gemm g{PL, (const bf16_t*)(ws + WS_WPG) + (size_t)j * DM * 512, SEQ, DM, 512, DM, 512, 1, 512};
                pg8::StaticOrder S; S.init(SEQ, DM, G, bx); pg8::EpiPoolGrp E{HU, VG, args.pls + j * DM};
                pg8::gemm_phase<pg8::EpiPoolGrp, true>(wv, lds, g, S, E); REDO(4, (pg8::gemm_phase<pg8::EpiPoolGrp, true>(wv, lds, g, S, E))); }
            SEAM(4);
            if (PM(5) && IN(ph)) { pg8::Gemm g{HU, (const bf16_t*)(ws + WS_WPO) + (size_t)j * DM * DM, SEQ, DM, DM, DM, DM, 0, 0};
                pg8::StaticOrder S; S.init(SEQ, DM, G, bx);
                if (layer == 0) { pg8::EpiResid<false, true> E{args.x, XB, lgs}; pg8::gemm_phase<pg8::EpiResid<false, true>, true>(wv, lds, g, S, E); }
                else { pg8::EpiResid<true, true> E{XB, XB, lgs}; pg8::gemm_phase<pg8::EpiResid<true, true>, true>(wv, lds, g, S, E); } }
            SEAM(5);
        } else {
            bf16_t* Qh = (bf16_t*)(ws + WS_Q); bf16_t* Kh = (bf16_t*)(ws + WS_K); bf16_t* Vh = (bf16_t*)(ws + WS_V); bf16_t* SG = (bf16_t*)(ws + WS_GATE);
            bf16_t* QI = (bf16_t*)(ws + WS_QI); bf16_t* KI = (bf16_t*)(ws + WS_KI); float* WI = (float*)(ws + WS_WI);
            unsigned long long* MASK = (unsigned long long*)(ws + WS_MASK); float* SC = (float*)(ws + WS_SC);
            if (PM(6) && IN(ph)) { pg8::Gemm g{HU, (const bf16_t*)(ws + WS_WAI) + (size_t)j * ATTN_INP * DM, SEQ, ATTN_INP, DM, DM, DM, 0, 0};
                pg8::StaticOrder S; S.init(SEQ, ATTN_INP, G, bx); pg8::EpiAttnIn E{ws, args.pos};
                pg8::gemm_phase<pg8::EpiAttnIn, true>(wv, lds, g, S, E); REDO(6, (pg8::gemm_phase<pg8::EpiAttnIn, true>(wv, lds, g, S, E))); }
            SEAM(6);
            if (PM(7) && IN(ph)) { unsigned* qctr = (unsigned*)(ws + WS_CTL) + 8192 + 128 * j; phase_scores<0>(wv, QI, KI, WI, SC, lds, qctr); REDO(7, phase_scores<SC_VAR>(wv, QI, KI, WI, (float*)(ws + WS_END), lds, qctr + 64)); }
            SEAM(7);
            if (PM(8) && IN(ph)) { phase_select<0>(wv, SC, MASK, lds); REDO(8, phase_select<SC_VAR>(wv, SC, (unsigned long long*)(ws + WS_END), lds)); }
            SEAM(8);
            if (PM(9) && IN(ph)) { phase_attn(wv, Qh, Kh, Vh, HU, SG, MASK, (char*)lds_raw); REDO(9, phase_attn(wv, Qh, Kh, Vh, HU, SG, MASK, (char*)lds_raw)); }
            SEAM(9);
            if (PM(5) && IN(ph)) { pg8::Gemm g{HU, (const bf16_t*)(ws + WS_WAO) + (size_t)j * DM * DM, SEQ, DM, DM, DM, DM, 0, 0};
                pg8::StaticOrder S; S.init(SEQ, DM, G, bx);
                { pg8::EpiResid<true, true> E{XB, XB, lgs}; pg8::gemm_phase<pg8::EpiResid<true, true>, true>(wv, lds, g, S, E); } }
            SEAM(5);
        }
    }
    if (PM(10) && IN(ph)) { phase_final(wv, (const bf16_t*)(ws + WS_XB), args.out, args.fg); REDO(10, phase_final(wv, (const bf16_t*)(ws + WS_XB), args.out, args.fg)); }
    if (ECHO_MASK) { if ((ECHO_MASK >> 10) & 1) echo_acc += __builtin_amdgcn_s_memrealtime() - echo_prev;
        if (bx == 0) { const unsigned long long target_ = __builtin_amdgcn_s_memrealtime() + (unsigned long long)ECHO_K * echo_acc; while (__builtin_amdgcn_s_memrealtime() < target_) __builtin_amdgcn_s_sleep(32); } }
#undef IN
#undef PM
#undef SEAM
#undef REDO
}
constexpr int N_PHASES = 1 + 2 * 5 + 2 * 6 + 1;

extern "C" void kernel_launch(void* const* d_in, const int* in_sizes, int n_in, void* d_out, int out_size, void* d_ws, size_t ws_size, hipStream_t stream) {
    static int grid = 0;
    if (grid == 0) {
        if (n_in != 13 || in_sizes[0] != SEQ * DM || out_size != SEQ * DM || ws_size < WS_END) {
            fprintf(stderr, "kernel_launch: unexpected shapes / workspace (n_in %d, in0 %d, out %d, ws %zu, need %zu)\n", n_in, n_in > 0 ? in_sizes[0] : -1, out_size, ws_size, (size_t)WS_END);
            grid = -1; return; }
        int dev = 0, cus = 0, per_cu = 0;
        if (hipGetDevice(&dev) != hipSuccess || hipDeviceGetAttribute(&cus, hipDeviceAttributeMultiprocessorCount, dev) != hipSuccess) { grid = -1; return; }
        if (hipFuncSetAttribute((const void*)trunk_fwd, hipFuncAttributeMaxDynamicSharedMemorySize, LDS_BYTES) != hipSuccess) { fprintf(stderr, "kernel_launch: hipFuncSetAttribute failed\n"); grid = -1; return; }
        if (hipOccupancyMaxActiveBlocksPerMultiprocessor(&per_cu, (const void*)trunk_fwd, NTHR, LDS_BYTES) != hipSuccess || per_cu < 1) {
            fprintf(stderr, "kernel_launch: occupancy query reports %d workgroups per CU\n", per_cu); per_cu = 1; }
        (void)hipGetLastError();
        grid = cus;
        if (grid > 256) grid = 256;
    }
    if (grid < 0) return;
    (void)hipMemsetAsync((char*)d_ws + WS_CTL, 0, CTL_ZERO_BYTES, stream);
    Args a{};
    a.x = (const float*)d_in[0]; a.c = (const float*)d_in[1]; a.pos = (const int*)d_in[2]; a.norm_g = (const float*)d_in[3];
    a.mod_w = (const float*)d_in[4]; a.mod_b = (const float*)d_in[5]; a.pwi = (const float*)d_in[6]; a.pwg = (const float*)d_in[7];
    a.pls = (const float*)d_in[8]; a.pwo = (const float*)d_in[9]; a.awi = (const float*)d_in[10]; a.awo = (const float*)d_in[11]; a.fg = (const float*)d_in[12];
    a.out = (float*)d_out; a.ws = (unsigned char*)d_ws;
#if MK_ONE_LAUNCH
    a.ph_lo = 0; a.ph_hi = N_PHASES;
    hipLaunchKernelGGL(trunk_fwd, dim3(grid), dim3(NTHR), LDS_BYTES, stream, a);
#else
    for (int p = 0; p < N_PHASES; ++p) { a.ph_lo = p; a.ph_hi = p + 1; hipLaunchKernelGGL(trunk_fwd, dim3(grid), dim3(NTHR), LDS_BYTES, stream, a); }
#endif
}
```

```cpp
#include <hip/hip_runtime.h>
#include <cstdio>
#include <cstdint>
#include <cmath>

#ifndef MK_ONE_LAUNCH
#define MK_ONE_LAUNCH 1
#endif

#define LAS __attribute__((address_space(3)))
#define GAS __attribute__((address_space(1)))
typedef unsigned short bf16_t;
typedef short bf16x8 __attribute__((ext_vector_type(8)));
typedef short s16x4 __attribute__((ext_vector_type(4)));
typedef float f32x4 __attribute__((ext_vector_type(4)));
typedef float f32x2 __attribute__((ext_vector_type(2)));
typedef float f32x16 __attribute__((ext_vector_type(16)));
typedef unsigned u32x4 __attribute__((ext_vector_type(4)));
typedef unsigned u32x2 __attribute__((ext_vector_type(2)));

constexpr int DM = 2048, SEQ = 8192, NHEAD = 16, HD = 128, IDXH = 16, IDXD = 64;
constexpr int POOL_IN = 4096, ATTN_IN = 9296, ATTN_INP = 9472  ;
constexpr int TOPK = 256;
constexpr float EPS = 1e-6f;

constexpr size_t MiB = 1u << 20;
constexpr size_t WS_CTL = 0, CTL_ZERO_BYTES = 64 * 1024;
constexpr size_t WS_MOD = 1 * MiB;
constexpr size_t WS_TAB = 2 * MiB;
constexpr size_t WS_WPI = 4 * MiB;
constexpr size_t WS_WPG = 36 * MiB;
constexpr size_t WS_WPO = 40 * MiB;
constexpr size_t WS_WAI = 56 * MiB;
constexpr size_t WS_WAO = 130 * MiB;
constexpr size_t WS_HU = 146 * MiB;
constexpr size_t WS_L = 178 * MiB;
constexpr size_t WS_VG = WS_L;
constexpr size_t WS_PL = WS_L + 64 * MiB;
constexpr size_t WS_Q = WS_L, WS_K = WS_L + 32 * MiB, WS_V = WS_L + 64 * MiB;
constexpr size_t WS_GATE = WS_L + 96 * MiB;
constexpr size_t WS_QI = WS_L + 128 * MiB;
constexpr size_t WS_KI = WS_L + 144 * MiB;
constexpr size_t WS_WI = WS_L + 145 * MiB;
constexpr size_t WS_MASK = WS_L + 146 * MiB;
constexpr size_t WS_SC = WS_L + 154 * MiB;
constexpr size_t WS_XB = WS_SC + 139 * MiB;
constexpr size_t WS_END = WS_XB + 32 * MiB;

__device__ __forceinline__ unsigned cvt_pk_bf16(float lo, float hi) { unsigned r; asm volatile("v_cvt_pk_bf16_f32 %0, %1, %2" : "=v"(r) : "v"(lo), "v"(hi)); return r; }
__device__ __forceinline__ unsigned f2bf(float f) { unsigned u = __builtin_bit_cast(unsigned, f); return (u + 0x7fffu + ((u >> 16) & 1u)) >> 16; }
__device__ __forceinline__ unsigned pk2(float lo, float hi) { return f2bf(lo) | (f2bf(hi) << 16); }
__device__ __forceinline__ float bf2f(unsigned short b) { return __builtin_bit_cast(float, (unsigned)b << 16); }
__device__ __forceinline__ float fast_sigmoid(float x) { return __builtin_amdgcn_rcpf(1.0f + __builtin_amdgcn_exp2f(-1.4426950408889634f * x)); }
__device__ __forceinline__ float silu_f(float x) { return x * fast_sigmoid(x); }
template <int X> __device__ __forceinline__ float swz_xor(float v) {
    return __builtin_bit_cast(float, __builtin_amdgcn_ds_swizzle(__builtin_bit_cast(int, v), (X << 10) | 0x1f)); }
__device__ __forceinline__ float wave_sum(float v) {
    v += swz_xor<1>(v); v += swz_xor<2>(v); v += swz_xor<4>(v); v += swz_xor<8>(v); v += swz_xor<16>(v);
    const auto rr = __builtin_amdgcn_permlane32_swap(__builtin_bit_cast(unsigned, v), __builtin_bit_cast(unsigned, v), false, false);
    const unsigned r0 = rr[0], r1 = rr[1];
    return __builtin_bit_cast(float, r0) + __builtin_bit_cast(float, r1);
}
__device__ __forceinline__ int opaque_tid(int wv) { int t; asm volatile("v_mbcnt_lo_u32_b32 %0, -1, 0\n\tv_mbcnt_hi_u32_b32 %0, -1, %0\n\tv_lshl_add_u32 %0, %1, 6, %0" : "=&v"(t) : "s"(wv)); return t; }
#define LDS_WAIT() asm volatile("s_waitcnt lgkmcnt(0)" ::: "memory")
#define VM_WAIT() asm volatile("s_waitcnt vmcnt(0)" ::: "memory")

__device__ __forceinline__ void unpack8(const u32x4 w, f32x4& a, f32x4& b) {
    const unsigned w0 = w.x, w1 = w.y, w2 = w.z, w3 = w.w;
    a = (f32x4){__builtin_bit_cast(float, w0 << 16), __builtin_bit_cast(float, w0 & 0xffff0000u), __builtin_bit_cast(float, w1 << 16), __builtin_bit_cast(float, w1 & 0xffff0000u)};
    b = (f32x4){__builtin_bit_cast(float, w2 << 16), __builtin_bit_cast(float, w2 & 0xffff0000u), __builtin_bit_cast(float, w3 << 16), __builtin_bit_cast(float, w3 & 0xffff0000u)};
}
__device__ __forceinline__ u32x4 pack8(const f32x4 a, const f32x4 b) { u32x4 w; w.x = cvt_pk_bf16(a[0], a[1]); w.y = cvt_pk_bf16(a[2], a[3]); w.z = cvt_pk_bf16(b[0], b[1]); w.w = cvt_pk_bf16(b[2], b[3]); return w; }

constexpr float ATT_QSCALE = 0.08838834764831845f * 1.4426950408889634f;
namespace pg8 {
constexpr int BM = 256, BK = 64, HALF = 128, HTB = HALF * BK * 2, STAGE_BYTES = 8 * HTB, NXCD = 8, WGM = 8;
__host__ __device__ __forceinline__ int lds_byte(int r, int c) { const int st = (r >> 4) * 2 + (c >> 5), rr = r & 15, cc = c & 31, ob = rr * 64 + cc * 2; return st * 1024 + (ob ^ (((ob >> 9) & 1) << 5)); }
__host__ __device__ __forceinline__ void stage_rc(int b, int& R, int& C) { const int st = b / 1024, sb = b % 1024, swz = sb ^ (((sb >> 9) & 1) << 5); R = (st >> 1) * 16 + swz / 64; C = (st & 1) * 32 + (swz % 64) / 2; }
__host__ __device__ __forceinline__ int perm32(int rho) { const int n = rho >> 4, i = rho & 15; return 8 * (i >> 2) + 4 * n + (i & 3); }

struct Unit { int pm, pn; };
struct Gemm { const bf16_t* A; const bf16_t* Bt; int M, N, K, lda, ldb, agsh, agstride; };

struct StaticOrder {
    int nM, nN, nwg, G, c, wgm;
    __host__ __device__ void init(int M, int N, int G_, int c_, int wgm_ = WGM) { nM = M / BM; nN = N / BM; nwg = nM * nN; G = G_; c = c_; wgm = wgm_; }
    __host__ __device__ bool next(int i, Unit& u) const {
        const long L = (long)i * G + c; if (L >= nwg) return false;
        int wgid = (int)L; { const int q = nwg / NXCD, r = nwg % NXCD, xcd = wgid % NXCD, off = wgid / NXCD; wgid = (xcd < r ? xcd * (q + 1) : r * (q + 1) + (xcd - r) * q) + off; }
        const int nig = wgm * nN, gid = wgid / nig, fm = gid * wgm, gsz = (nM - fm) < wgm ? (nM - fm) : wgm;
        u.pm = fm + ((wgid % nig) % gsz); u.pn = (wgid % nig) / gsz; return true;
    }
};

template <class Epi, bool ALIGN_EPI>
__device__ __forceinline__ void gemm_phase(int wv, LAS unsigned char* lds, const Gemm g, const StaticOrder& S, const Epi& E) {
    const int tid = opaque_tid(wv), wid = __builtin_amdgcn_readfirstlane(tid >> 6), lane = tid & 63, wr = wid >> 2, wc = wid & 3, fr = lane & 15, fq = lane >> 4;
    const int K = g.K, nt = K / BK;
    unsigned voffA[2], voffB[2];
#pragma unroll
    for (int i = 0; i < 2; ++i) { int R, C; stage_rc(tid * 16 + i * 8192, R, C); const int Rb = Epi::PERM ? ((R & ~31) + perm32(R & 31)) : R;
        voffA[i] = (unsigned)(R * g.lda + C) * 2u; voffB[i] = (unsigned)(Rb * g.ldb + C) * 2u; }
    const size_t kstep = (size_t)(BK * 2);
    const size_t hstepA = (size_t)HALF * g.lda * 2, hstepB = (size_t)HALF * g.ldb * 2;
    const size_t tstepA = 2 * hstepA, tstepB = 2 * hstepB;
    const unsigned ldsw = (unsigned)wid * 1024u;
    const int aoff = lds_byte(wr * 64 + fr, fq * 8), boff = lds_byte(wc * 32 + fr, fq * 8);
#define PG8_SA(b, h) (((b) * 2 + (h)) * HTB)
#define PG8_SB(b, h) ((4 + (b) * 2 + (h)) * HTB)
#define PG8_STAGE(bufoff, gbase, voff) do { _Pragma("unroll") for (int _i = 0; _i < 2; ++_i) \
        __builtin_amdgcn_global_load_lds((const unsigned*)((const char*)(gbase) + (voff)[_i]), (LAS unsigned*)(lds + (bufoff) + ldsw + _i * 8192), 16, 0, 0); } while (0)
#define PG8_LDA(dst, b, h) do { _Pragma("unroll") for (int m = 0; m < 4; ++m) _Pragma("unroll") for (int k = 0; k < 2; ++k) dst[m][k] = *(const LAS bf16x8*)(lds + PG8_SA(b, h) + aoff + m * 2048 + k * 1024); } while (0)
#define PG8_LDB(dst, b, h) do { _Pragma("unroll") for (int n = 0; n < 2; ++n) _Pragma("unroll") for (int k = 0; k < 2; ++k) dst[n][k] = *(const LAS bf16x8*)(lds + PG8_SB(b, h) + boff + n * 2048 + k * 1024); } while (0)
#define PG8_MMA(ai, bj, At, Bt) do { __builtin_amdgcn_s_setprio(1); _Pragma("unroll") for (int m = 0; m < 4; ++m) _Pragma("unroll") for (int n = 0; n < 2; ++n) _Pragma("unroll") for (int k = 0; k < 2; ++k) \
        acc[ai][bj][m][n] = __builtin_amdgcn_mfma_f32_16x16x32_bf16(Bt[n][k], At[m][k], acc[ai][bj][m][n], 0, 0, 0); __builtin_amdgcn_s_setprio(0); } while (0)
#define PG8_WAIT_V(n) asm volatile("s_waitcnt vmcnt(" #n ")" ::: "memory")
#define PG8_WAIT_L(n) asm volatile("s_waitcnt lgkmcnt(" #n ")" ::: "memory")
#define PG8_BAR __builtin_amdgcn_s_barrier()
#define PG8_SCHED __builtin_amdgcn_sched_barrier(0)
#define PG8_AOFF(u) ((size_t)(u).pm * tstepA + (size_t)(((u).pn >> g.agsh) * g.agstride) * 2)
    Unit cur, nxt; int ui = 0;
    if (!S.next(0, cur)) return;
    f32x4 acc[2][2][4][2];
#pragma unroll
    for (int a = 0; a < 2; ++a)
#pragma unroll
        for (int b = 0; b < 2; ++b)
#pragma unroll
            for (int m = 0; m < 4; ++m)
#pragma unroll
                for (int n = 0; n < 2; ++n) acc[a][b][m][n] = (f32x4){0.f, 0.f, 0.f, 0.f};
    bf16x8 At[4][2], B0[2][2], B1[2][2];
    const char* cA = (const char*)g.A + PG8_AOFF(cur); const char* cB = (const char*)g.Bt + (size_t)cur.pn * tstepB;
    PG8_STAGE(PG8_SB(0, 0), cB, voffB); PG8_STAGE(PG8_SB(0, 1), cB + hstepB, voffB); PG8_STAGE(PG8_SA(0, 0), cA, voffA); PG8_STAGE(PG8_SA(0, 1), cA + hstepA, voffA);
    if (wr == 1) PG8_BAR;
    PG8_WAIT_V(2); PG8_BAR;
    PG8_STAGE(PG8_SB(1, 0), cB + kstep, voffB); PG8_STAGE(PG8_SA(1, 0), cA + kstep, voffA); PG8_STAGE(PG8_SB(1, 1), cB + hstepB + kstep, voffB);
    PG8_WAIT_V(6); PG8_BAR;
    for (;;) {
        const bool has_next = S.next(ui + 1, nxt);
        const char* nA = has_next ? (const char*)g.A + PG8_AOFF(nxt) : cA; const char* nB = has_next ? (const char*)g.Bt + (size_t)nxt.pn * tstepB : cB;
        for (int t = 0; t < nt; t += 2) {
            const bool last = (t == nt - 2);
            const char* a1 = cA + (size_t)(t + 1) * kstep;
            const char* a2 = last ? nA : cA + (size_t)(t + 2) * kstep; const char* b2 = last ? nB : cB + (size_t)(t + 2) * kstep;
            const char* a3 = a2 + kstep; const char* b3 = b2 + kstep;
            PG8_LDB(B0, 0, 0); PG8_LDB(B1, 0, 1); PG8_SCHED; PG8_LDA(At, 0, 0); PG8_STAGE(PG8_SA(1, 1), a1 + hstepA, voffA);
            PG8_WAIT_V(8); PG8_WAIT_L(0); PG8_BAR; PG8_MMA(0, 0, At, B0); PG8_MMA(0, 1, At, B1); PG8_BAR; PG8_SCHED;
            PG8_LDA(At, 0, 1); PG8_STAGE(PG8_SB(0, 0), b2, voffB); PG8_STAGE(PG8_SB(0, 1), b2 + hstepB, voffB); PG8_STAGE(PG8_SA(0, 0), a2, voffA);
            PG8_WAIT_V(8); PG8_WAIT_L(0); PG8_BAR; PG8_MMA(1, 0, At, B0); PG8_MMA(1, 1, At, B1); PG8_BAR; PG8_SCHED;
            PG8_LDB(B0, 1, 0); PG8_LDB(B1, 1, 1); PG8_SCHED; PG8_LDA(At, 1, 0); PG8_STAGE(PG8_SA(0, 1), a2 + hstepA, voffA);
            PG8_WAIT_V(8); PG8_WAIT_L(0); PG8_BAR; PG8_MMA(0, 0, At, B0); PG8_MMA(0, 1, At, B1); PG8_BAR; PG8_SCHED;
            PG8_LDA(At, 1, 1); PG8_STAGE(PG8_SB(1, 0), b3, voffB); PG8_STAGE(PG8_SB(1, 1), b3 + hstepB, voffB); PG8_STAGE(PG8_SA(1, 0), a3, voffA);
            PG8_WAIT_V(8); PG8_WAIT_L(0); PG8_BAR; PG8_MMA(1, 0, At, B0); PG8_MMA(1, 1, At, B1); PG8_BAR; PG8_SCHED;
        }
        if constexpr (ALIGN_EPI) { if (wr == 0) PG8_BAR; }
        E(acc, cur, wr, wc, fr, fq);
        if (!has_next) break;
#pragma unroll
        for (int a = 0; a < 2; ++a)
#pragma unroll
            for (int b = 0; b < 2; ++b)
#pragma unroll
                for (int m = 0; m < 4; ++m)
#pragma unroll
                    for (int n = 0; n < 2; ++n) acc[a][b][m][n] = (f32x4){0.f, 0.f, 0.f, 0.f};
        cur = nxt; cA = nA; cB = nB; ++ui;
        if constexpr (ALIGN_EPI) { if (wr == 1) PG8_BAR; }
    }
    PG8_WAIT_V(0);
    if constexpr (!ALIGN_EPI) { if (wr == 0) PG8_BAR; }
    PG8_BAR;
#undef PG8_SA
#undef PG8_SB
#undef PG8_STAGE
#undef PG8_LDA
#undef PG8_LDB
#undef PG8_MMA
#undef PG8_WAIT_V
#undef PG8_WAIT_L
#undef PG8_BAR
#undef PG8_SCHED
#undef PG8_AOFF
}

struct EpiBf16 {
    static constexpr bool PERM = true;
    bf16_t* O; int ldc;
    __device__ __forceinline__ void operator()(const f32x4 (&acc)[2][2][4][2], const Unit& u, int wr, int wc, int fr, int fq) const {
        const int row0 = u.pm * BM + wr * 64 + fr; const int col0 = u.pn * BM + wc * 32 + 8 * fq;
#pragma unroll
        for (int ai = 0; ai < 2; ++ai)
#pragma unroll
            for (int m = 0; m < 4; ++m) { bf16_t* rowp = O + (size_t)(row0 + ai * HALF + m * 16) * ldc + col0;
#pragma unroll
                for (int bj = 0; bj < 2; ++bj) { const f32x4 v0 = acc[ai][bj][m][0], v1 = acc[ai][bj][m][1];
                    u32x4 w; w.x = cvt_pk_bf16(v0[0], v0[1]); w.y = cvt_pk_bf16(v0[2], v0[3]); w.z = cvt_pk_bf16(v1[0], v1[1]); w.w = cvt_pk_bf16(v1[2], v1[3]);
                    *(u32x4*)(rowp + bj * HALF) = w; } }
    }
};
struct EpiPoolGrp {
    static constexpr bool PERM = true;
    bf16_t* U; const bf16_t* VG; const float* ls;
    __device__ __forceinline__ void operator()(const f32x4 (&acc)[2][2][4][2], const Unit& u, int wr, int wc, int fr, int fq) const {
        const int row0 = u.pm * BM + wr * 64 + fr; const int col0 = u.pn * BM + wc * 32 + 8 * fq;
        f32x4 lv[2][2];
#pragma unroll
        for (int bj = 0; bj < 2; ++bj)
#pragma unroll
            for (int n = 0; n < 2; ++n) lv[bj][n] = *(const f32x4*)(ls + col0 + bj * HALF + 4 * n);
#pragma unroll
        for (int ai = 0; ai < 2; ++ai) {
            u32x4 gw[4][2];
#pragma unroll
            for (int m = 0; m < 4; ++m)
#pragma unroll
                for (int bj = 0; bj < 2; ++bj) gw[m][bj] = *(const u32x4*)(VG + (size_t)(row0 + ai * HALF + m * 16) * POOL_IN + DM + col0 + bj * HALF);
            __builtin_amdgcn_sched_barrier(0);
#pragma unroll
            for (int m = 0; m < 4; ++m) { const size_t row = (size_t)(row0 + ai * HALF + m * 16);
#pragma unroll
                for (int bj = 0; bj < 2; ++bj) {
                    f32x4 v0 = acc[ai][bj][m][0] * lv[bj][0], v1 = acc[ai][bj][m][1] * lv[bj][1];
                    f32x4 g0, g1; unpack8(gw[m][bj], g0, g1);
#pragma unroll
                    for (int e = 0; e < 4; ++e) { v0[e] *= silu_f(g0[e]); v1[e] *= silu_f(g1[e]); }
                    *(u32x4*)(U + row * DM + col0 + bj * HALF) = pack8(v0, v1); } }
            __builtin_amdgcn_sched_barrier(0); }
    }
};
template <bool IN_BF16, bool OUT_BF16> struct EpiResid {
    static constexpr bool PERM = true;
    const void* xin; void* xout; const float* gmod;
    __device__ __forceinline__ void operator()(const f32x4 (&acc)[2][2][4][2], const Unit& u, int wr, int wc, int fr, int fq) const {
        const int row0 = u.pm * BM + wr * 64 + fr; const int col0 = u.pn * BM + wc * 32 + 8 * fq;
        f32x4 gv[2][2];
#pragma unroll
        for (int bj = 0; bj < 2; ++bj)
#pragma unroll
            for (int n = 0; n < 2; ++n) gv[bj][n] = *(const f32x4*)(gmod + col0 + bj * HALF + 4 * n);
#pragma unroll
        for (int ai = 0; ai < 2; ++ai)
#pragma unroll
          for (int mh = 0; mh < (IN_BF16 ? 1 : 2); ++mh) {
            constexpr int MB = IN_BF16 ? 4 : 2;
            u32x4 rw[MB][2]; f32x4 rf[MB][2][2];
#pragma unroll
            for (int mm = 0; mm < MB; ++mm)
#pragma unroll
                for (int bj = 0; bj < 2; ++bj) { const size_t off = (size_t)(row0 + ai * HALF + (mh * MB + mm) * 16) * DM + col0 + bj * HALF;
                    if (IN_BF16) rw[mm][bj] = *(const u32x4*)((const bf16_t*)xin + off);
                    else { rf[mm][bj][0] = *(const f32x4*)((const float*)xin + off); rf[mm][bj][1] = *(const f32x4*)((const float*)xin + off + 4); } }
            __builtin_amdgcn_sched_barrier(0);
#pragma unroll
            for (int mm = 0; mm < MB; ++mm)
#pragma unroll
                for (int bj = 0; bj < 2; ++bj) { const int m = mh * MB + mm; const size_t off = (size_t)(row0 + ai * HALF + m * 16) * DM + col0 + bj * HALF;
                    f32x4 b0, b1;
                    if (IN_BF16) unpack8(rw[mm][bj], b0, b1); else { b0 = rf[mm][bj][0]; b1 = rf[mm][bj][1]; }
                    const f32x4 y0 = b0 + gv[bj][0] * acc[ai][bj][m][0], y1 = b1 + gv[bj][1] * acc[ai][bj][m][1];
                    if (OUT_BF16) *(u32x4*)((bf16_t*)xout + off) = pack8(y0, y1);
                    else { *(f32x4*)((float*)xout + off) = y0; *(f32x4*)((float*)xout + off + 4) = y1; } }
            __builtin_amdgcn_sched_barrier(0); }
    }
};
struct EpiAttnIn {
    static constexpr bool PERM = true;
    unsigned char* ws; const int* pos;
    __device__ __forceinline__ void operator()(const f32x4 (&acc)[2][2][4][2], const Unit& u, int wr, int wc, int fr, int fq) const {
        const int row0 = u.pm * BM + wr * 64 + fr; const int pn = u.pn;
        bf16_t* const Qh = (bf16_t*)(ws + WS_Q); bf16_t* const SG = (bf16_t*)(ws + WS_GATE); bf16_t* const QI = (bf16_t*)(ws + WS_QI); bf16_t* const KI = (bf16_t*)(ws + WS_KI); float* const WI = (float*)(ws + WS_WI);
        const float* const cosq = (const float*)(ws + WS_TAB); const float* const sinq = cosq + SEQ * 16; const float* const cosi = sinq + SEQ * 16; const float* const sini = cosi + SEQ * 8;
#pragma unroll
        for (int ai = 0; ai < 2; ++ai)
#pragma unroll
            for (int m = 0; m < 4; ++m) {
                const int row = row0 + ai * HALF + m * 16;
                if (pn < 24) {
                    bf16_t* base = Qh + (size_t)(pn >> 3) * ((size_t)SEQ * DM);
                    const bool rope = (pn < 16) && (wc == 0);
                    f32x4 cs[2] = {{1.f, 1.f, 1.f, 1.f}, {1.f, 1.f, 1.f, 1.f}}, sn[2] = {{0.f, 0.f, 0.f, 0.f}, {0.f, 0.f, 0.f, 0.f}};
                    if (rope) { const float* cp = cosq + (size_t)row * 16 + 8 * (fq & 1); const float* sp = sinq + (size_t)row * 16 + 8 * (fq & 1);
                        cs[0] = *(const f32x4*)cp; cs[1] = *(const f32x4*)(cp + 4); sn[0] = *(const f32x4*)sp; sn[1] = *(const f32x4*)(sp + 4); }
#pragma unroll
                    for (int bj = 0; bj < 2; ++bj) { const int head = 2 * (pn & 7) + bj;
                        f32x4 v[2] = {acc[ai][bj][m][0], acc[ai][bj][m][1]};
                        if (pn < 8) { v[0] *= ATT_QSCALE; v[1] *= ATT_QSCALE; }
                        if (rope) {
#pragma unroll
                            for (int n = 0; n < 2; ++n) { f32x4 pr;
#pragma unroll
                                for (int e = 0; e < 4; ++e) { const float ve = v[n][e];
                                    const auto rr = __builtin_amdgcn_permlane32_swap(__builtin_bit_cast(unsigned, ve), __builtin_bit_cast(unsigned, ve), false, false);
                                    const unsigned pu = (fq < 2) ? rr[1] : rr[0]; pr[e] = __builtin_bit_cast(float, pu); }
                                v[n] = (fq < 2) ? (v[n] * cs[n] - pr * sn[n]) : (v[n] * cs[n] + pr * sn[n]); } }
                        *(u32x4*)(base + ((size_t)head * SEQ + row) * HD + 32 * wc + 8 * fq) = pack8(v[0], v[1]); }
                } else if (pn < 32) {
#pragma unroll
                    for (int bj = 0; bj < 2; ++bj) { f32x4 v0 = acc[ai][bj][m][0], v1 = acc[ai][bj][m][1];
#pragma unroll
                        for (int e = 0; e < 4; ++e) { v0[e] = silu_f(v0[e]); v1[e] = silu_f(v1[e]); }
                        *(u32x4*)(SG + (size_t)row * DM + (pn - 24) * BM + bj * HALF + 32 * wc + 8 * fq) = pack8(v0, v1); }
                } else {
                    const bool isq = pn < 36;
                    const bool rope = ((wc & 1) == 0) && (isq || wc == 0);
                    f32x4 cs[2], sn[2];
                    { const float* cp = cosi + (size_t)row * 8; const float* sp = sini + (size_t)row * 8;
                      cs[0] = *(const f32x4*)cp; cs[1] = *(const f32x4*)(cp + 4); sn[0] = *(const f32x4*)sp; sn[1] = *(const f32x4*)(sp + 4); }
#pragma unroll
                    for (int bj = 0; bj < 2; ++bj) {
                        if (!isq && bj == 1) continue;
                        f32x4 v[2] = {acc[ai][bj][m][0], acc[ai][bj][m][1]};
                        if (rope) {
#pragma unroll
                            for (int n = 0; n < 2; ++n) { f32x4 pr;
#pragma unroll
                                for (int e = 0; e < 4; ++e) pr[e] = swz_xor<16>(v[n][e]);
                                const f32x4 ro = (fq == 0) ? (v[n] * cs[n] - pr * sn[n]) : (v[n] * cs[n] + pr * sn[n]);
                                v[n] = (fq < 2) ? ro : v[n]; } }
                        const int cl = bj * HALF + 32 * wc + 8 * fq;
                        if (isq) *(u32x4*)(QI + (size_t)row * 1024 + (pn - 32) * BM + cl) = pack8(v[0], v[1]);
                        else if (cl < 64) *(u32x4*)(KI + (size_t)row * 64 + cl) = pack8(v[0], v[1]);
                        else if (cl < 80) { *(f32x4*)(WI + (size_t)row * 16 + (cl - 64)) = v[0]; *(f32x4*)(WI + (size_t)row * 16 + (cl - 64) + 4) = v[1]; }
                    }
                }
                asm volatile("" ::: "memory");
            }
    }
};
}

namespace att {
constexpr int D = 128, NW = 8, QBLK = 32, KVBLK = 64, QB = NW * QBLK;
constexpr int KROWB = 272;
constexpr int SHM_V = KVBLK * D * 2, SHM_K = KVBLK * KROWB;
constexpr int QROWB = 272;
constexpr int Q_OFF = 2 * SHM_V + 2 * SHM_K + NW * 64 * 4;
constexpr int LDS_BYTES = Q_OFF + QB * QROWB;
constexpr float SCALE = 0.08838834764831845f;
constexpr float THR = 8.f;
#define KSWZ(row, colB) ((row) * KROWB + (colB))
#define SBAR() __builtin_amdgcn_sched_barrier(0)
__device__ __forceinline__ int v_st(int k, int c) { const int kk = (k & ~0xC) | ((k & 4) << 1) | ((k & 8) >> 1); return ((kk >> 3) * 4 + (c >> 5)) * 512 + ((kk & 7) * 32 + (c & 31)) * 2; }
__device__ __forceinline__ int v_rd_base(int lane) { return ((lane & 3) << 3) | (((lane >> 2) & 3) << 6) | (((lane >> 4) & 1) << 5) | (((lane >> 5) & 1) << 8); }
constexpr int v_rd_off(int d0, int ks, int half) { return d0 * 512 + ks * 4096 + half * 2048; }
__device__ __forceinline__ int crow(int r, int hi) { return (r & 3) + 8 * (r >> 2) + 4 * hi; }
__device__ __forceinline__ unsigned cvtpk(float lo, float hi) { unsigned r; asm volatile("v_cvt_pk_bf16_f32 %0, %1, %2" : "=v"(r) : "v"(lo), "v"(hi)); return r; }
__device__ __forceinline__ bf16x8 load8(const bf16_t* p) { return *reinterpret_cast<const bf16x8*>(p); }
__device__ __forceinline__ float mask_and(float v, unsigned mlo, unsigned mhi, int r, int p) {
    const int pos = 16 * (r & 1) + 2 * (r >> 2) + 8 * p;
    const unsigned w = (r & 2) ? mhi : mlo;
    int bits; asm("v_bfe_i32 %0, %1, %2, 1" : "=v"(bits) : "v"(w), "n"(pos));
    return __builtin_bit_cast(float, __builtin_bit_cast(unsigned, v) & (unsigned)bits);
}
constexpr float THR2 = 64.f;
__device__ __forceinline__ void partialSM(f32x16& p0, f32x16& p1, float& m_reg, float& alpha, unsigned mlo_r, unsigned mhi_r, int hi) {
    float pmax = p0[0];
#pragma unroll
    for (int r = 1; r < 16; ++r) pmax = fmaxf(pmax, p0[r]);
#pragma unroll
    for (int r = 0; r < 16; ++r) pmax = fmaxf(pmax, p1[r]);
    { auto rr = __builtin_amdgcn_permlane32_swap(__float_as_uint(pmax), __float_as_uint(pmax), false, false);
      pmax = fmaxf(__uint_as_float(rr[0]), __uint_as_float(rr[1])); }
    const float mn = (__builtin_fabsf(pmax - m_reg) <= THR2) ? m_reg : pmax;
    alpha = 1.f; m_reg = mn;
    const f32x2 nm = {-mn, -mn};
#pragma unroll
    for (int r = 0; r < 16; r += 2) { const f32x2 a = (f32x2){p0[r], p0[r + 1]} + nm, b = (f32x2){p1[r], p1[r + 1]} + nm; p0[r] = a.x; p0[r + 1] = a.y; p1[r] = b.x; p1[r + 1] = b.y; }
    const unsigned mlo = hi ? ((mlo_r >> 1) | (mhi_r << 31)) : mlo_r, mhi = mhi_r >> hi;
#pragma unroll
    for (int r = 0; r < 16; ++r) p0[r] = mask_and(__builtin_amdgcn_exp2f(p0[r]), mlo, mhi, r, 0);
}
__device__ __forceinline__ void finishSM(f32x16& p0, f32x16& p1, float alpha, float& l_reg, bf16x8& pa0, bf16x8& pa1, bf16x8& pa2, bf16x8& pa3, unsigned mlo_r, unsigned mhi_r, int hi) {
    const unsigned mlo = hi ? ((mlo_r >> 1) | (mhi_r << 31)) : mlo_r, mhi = mhi_r >> hi;
#pragma unroll
    for (int r = 0; r < 16; ++r) p1[r] = mask_and(__builtin_amdgcn_exp2f(p1[r]), mlo, mhi, r, 1);
    f32x2 ps2 = {p0[0], p0[1]};
#pragma unroll
    for (int r = 2; r < 16; r += 2) ps2 += (f32x2){p0[r], p0[r + 1]};
#pragma unroll
    for (int r = 0; r < 16; r += 2) ps2 += (f32x2){p1[r], p1[r + 1]};
    float ps = ps2.x + ps2.y;
    { auto rr = __builtin_amdgcn_permlane32_swap(__float_as_uint(ps), __float_as_uint(ps), false, false);
      ps = __uint_as_float(rr[0]) + __uint_as_float(rr[1]); }
    l_reg = l_reg * alpha + ps;
#define PK4(P, B_, OUT) do { unsigned a0 = cvtpk(P[B_+0], P[B_+1]), a1 = cvtpk(P[B_+2], P[B_+3]);                          \
        unsigned b0 = cvtpk(P[B_+4], P[B_+5]), b1 = cvtpk(P[B_+6], P[B_+7]);                                             \
        auto r0 = __builtin_amdgcn_permlane32_swap(a0, b0, false, false); auto r1 = __builtin_amdgcn_permlane32_swap(a1, b1, false, false); \
        u32x4 w = {r0[0], r1[0], r0[1], r1[1]}; OUT = *reinterpret_cast<bf16x8*>(&w); } while (0)
    PK4(p0, 0, pa0); PK4(p0, 8, pa1); PK4(p1, 0, pa2); PK4(p1, 8, pa3);
#undef PK4
}
template <int KB>
__device__ __forceinline__ void qkt(f32x16& p0, f32x16& p1, int ka  , int qa  ) {
    const f32x16 zero16 = {};
    bf16x8 A0, B0, Q0, A1, B1, Q1;
#define LDSRD128(dst, addr, off) asm volatile("ds_read_b128 %0, %1 offset:%2" : "=&v"(dst) : "v"(addr), "i"(off) : "memory")
#define LGKM(n) asm volatile("s_waitcnt lgkmcnt(%0)" :: "i"(n) : "memory")
#define QK_LD(i, A, B, Q) do { LDSRD128(A, ka, KB * SHM_K + (i) * 32); LDSRD128(B, ka, KB * SHM_K + (i) * 32 + 32 * KROWB); LDSRD128(Q, qa, (i) * 32); } while (0)
#define QK_MM(A, B, Q) do { p0 = __builtin_amdgcn_mfma_f32_32x32x16_bf16(A, Q, p0, 0, 0, 0); p1 = __builtin_amdgcn_mfma_f32_32x32x16_bf16(B, Q, p1, 0, 0, 0); } while (0)
    QK_LD(0, A0, B0, Q0); QK_LD(1, A1, B1, Q1);
    LGKM(3); SBAR();
    p0 = __builtin_amdgcn_mfma_f32_32x32x16_bf16(A0, Q0, zero16, 0, 0, 0); p1 = __builtin_amdgcn_mfma_f32_32x32x16_bf16(B0, Q0, zero16, 0, 0, 0);
    SBAR(); QK_LD(2, A0, B0, Q0);
    LGKM(3); SBAR(); QK_MM(A1, B1, Q1); SBAR(); QK_LD(3, A1, B1, Q1);
    LGKM(3); SBAR(); QK_MM(A0, B0, Q0); SBAR(); QK_LD(4, A0, B0, Q0);
    LGKM(3); SBAR(); QK_MM(A1, B1, Q1); SBAR(); QK_LD(5, A1, B1, Q1);
    LGKM(3); SBAR(); QK_MM(A0, B0, Q0); SBAR(); QK_LD(6, A0, B0, Q0);
    LGKM(3); SBAR(); QK_MM(A1, B1, Q1); SBAR(); QK_LD(7, A1, B1, Q1);
    LGKM(3); SBAR(); QK_MM(A0, B0, Q0); SBAR();
    LGKM(0); SBAR(); QK_MM(A1, B1, Q1); SBAR();
#undef QK_LD
#undef QK_MM
}
template <int VB>
__device__ __forceinline__ void pv_tile(f32x16* o, int vb0, bf16x8 pa0, bf16x8 pa1, bf16x8 pa2, bf16x8 pa3) {
#define TRRD(dst, off) asm volatile("ds_read_b64_tr_b16 %0, %1 offset:%2" : "=&v"(dst) : "v"(vb0), "i"(off) : "memory")
#define PV_D0(d0) do { s16x4 l0, l1, l2, l3, h0, h1, h2, h3; constexpr int b_ = VB * SHM_V + v_rd_off(d0, 0, 0); \
        TRRD(l0, b_); TRRD(h0, b_ + 2048); TRRD(l1, b_ + 4096); TRRD(h1, b_ + 6144); TRRD(l2, b_ + 8192); TRRD(h2, b_ + 10240); TRRD(l3, b_ + 12288); TRRD(h3, b_ + 14336); \
        asm volatile("s_waitcnt lgkmcnt(0)" ::: "memory"); SBAR();   \
        o[d0] = __builtin_amdgcn_mfma_f32_32x32x16_bf16(pa0, (bf16x8){l0[0], l0[1], l0[2], l0[3], h0[0], h0[1], h0[2], h0[3]}, o[d0], 0, 0, 0);   \
        o[d0] = __builtin_amdgcn_mfma_f32_32x32x16_bf16(pa1, (bf16x8){l1[0], l1[1], l1[2], l1[3], h1[0], h1[1], h1[2], h1[3]}, o[d0], 0, 0, 0);   \
        o[d0] = __builtin_amdgcn_mfma_f32_32x32x16_bf16(pa2, (bf16x8){l2[0], l2[1], l2[2], l2[3], h2[0], h2[1], h2[2], h2[3]}, o[d0], 0, 0, 0);   \
        o[d0] = __builtin_amdgcn_mfma_f32_32x32x16_bf16(pa3, (bf16x8){l3[0], l3[1], l3[2], l3[3], h3[0], h3[1], h3[2], h3[3]}, o[d0], 0, 0, 0); } while (0)
    PV_D0(0); PV_D0(1); PV_D0(2); PV_D0(3);
#undef PV_D0
#undef TRRD
}
template <int KB>
__device__ __forceinline__ void qkt_fsm(f32x16& p0, f32x16& p1, int ka, int qa,
                                        f32x16& y0, f32x16& y1, float alpha, float& l_reg, bf16x8& pa0, bf16x8& pa1, bf16x8& pa2, bf16x8& pa3, unsigned mlo_r, unsigned mhi_r, int hi) {
    const unsigned mlo = hi ? ((mlo_r >> 1) | (mhi_r << 31)) : mlo_r, mhi = mhi_r >> hi;
    const f32x16 zero16 = {};
    float sa = 0.f, sb = 0.f;
#define ADD1(acc_, v_) asm("v_add_f32 %0, %1, %0" : "+v"(acc_) : "v"(v_))
    bf16x8 A0, B0, Q0, A1, B1, Q1;
#define QK_LD(i, A, B, Q) do { LDSRD128(A, ka, KB * SHM_K + (i) * 32); LDSRD128(B, ka, KB * SHM_K + (i) * 32 + 32 * KROWB); LDSRD128(Q, qa, (i) * 32); } while (0)
    QK_LD(0, A0, B0, Q0); QK_LD(1, A1, B1, Q1);
    LGKM(3); SBAR(); p0 = __builtin_amdgcn_mfma_f32_32x32x16_bf16(A0, Q0, zero16, 0, 0, 0); SBAR(); y1[0] = mask_and(__builtin_amdgcn_exp2f(y1[0]), mlo, mhi, 0, 1); ADD1(sa, y0[0]); ADD1(sa, y0[1]); ADD1(sa, y0[2]); ADD1(sa, y0[3]); SBAR();
    p1 = __builtin_amdgcn_mfma_f32_32x32x16_bf16(B0, Q0, zero16, 0, 0, 0); SBAR(); QK_LD(2, A0, B0, Q0); y1[1] = mask_and(__builtin_amdgcn_exp2f(y1[1]), mlo, mhi, 1, 1); ADD1(sa, y0[4]); ADD1(sa, y0[5]); ADD1(sa, y0[6]); ADD1(sa, y0[7]); SBAR();
    LGKM(3); SBAR(); p0 = __builtin_amdgcn_mfma_f32_32x32x16_bf16(A1, Q1, p0, 0, 0, 0); SBAR(); y1[2] = mask_and(__builtin_amdgcn_exp2f(y1[2]), mlo, mhi, 2, 1); ADD1(sa, y0[8]); ADD1(sa, y0[9]); ADD1(sa, y0[10]); ADD1(sa, y0[11]); SBAR();
    p1 = __builtin_amdgcn_mfma_f32_32x32x16_bf16(B1, Q1, p1, 0, 0, 0); SBAR(); QK_LD(3, A1, B1, Q1); y1[3] = mask_and(__builtin_amdgcn_exp2f(y1[3]), mlo, mhi, 3, 1); ADD1(sa, y0[12]); ADD1(sa, y0[13]); ADD1(sa, y0[14]); ADD1(sa, y0[15]); SBAR();
    LGKM(3); SBAR(); p0 = __builtin_amdgcn_mfma_f32_32x32x16_bf16(A0, Q0, p0, 0, 0, 0); SBAR(); y1[4] = mask_and(__builtin_amdgcn_exp2f(y1[4]), mlo, mhi, 4, 1); const unsigned a0_p = cvtpk(y0[0+0], y0[0+1]), b0_p = cvtpk(y0[0+4], y0[0+5]); const auto r0_p = __builtin_amdgcn_permlane32_swap(a0_p, b0_p, false, false); SBAR();
    p1 = __builtin_amdgcn_mfma_f32_32x32x16_bf16(B0, Q0, p1, 0, 0, 0); SBAR(); QK_LD(4, A0, B0, Q0); y1[5] = mask_and(__builtin_amdgcn_exp2f(y1[5]), mlo, mhi, 5, 1); const unsigned a1_p = cvtpk(y0[0+2], y0[0+3]), b1_p = cvtpk(y0[0+6], y0[0+7]); const auto r1_p = __builtin_amdgcn_permlane32_swap(a1_p, b1_p, false, false); { u32x4 w_ = {r0_p[0], r1_p[0], r0_p[1], r1_p[1]}; pa0 = *reinterpret_cast<bf16x8*>(&w_); } SBAR();
    LGKM(3); SBAR(); p0 = __builtin_amdgcn_mfma_f32_32x32x16_bf16(A1, Q1, p0, 0, 0, 0); SBAR(); y1[6] = mask_and(__builtin_amdgcn_exp2f(y1[6]), mlo, mhi, 6, 1); const unsigned a0_q = cvtpk(y0[8+0], y0[8+1]), b0_q = cvtpk(y0[8+4], y0[8+5]); const auto r0_q = __builtin_amdgcn_permlane32_swap(a0_q, b0_q, false, false); SBAR();
    p1 = __builtin_amdgcn_mfma_f32_32x32x16_bf16(B1, Q1, p1, 0, 0, 0); SBAR(); QK_LD(5, A1, B1, Q1); y1[7] = mask_and(__builtin_amdgcn_exp2f(y1[7]), mlo, mhi, 7, 1); const unsigned a1_q = cvtpk(y0[8+2], y0[8+3]), b1_q = cvtpk(y0[8+6], y0[8+7]); const auto r1_q = __builtin_amdgcn_permlane32_swap(a1_q, b1_q, false, false); { u32x4 w_ = {r0_q[0], r1_q[0], r0_q[1], r1_q[1]}; pa1 = *reinterpret_cast<bf16x8*>(&w_); } SBAR();
    LGKM(3); SBAR(); p0 = __builtin_amdgcn_mfma_f32_32x32x16_bf16(A0, Q0, p0, 0, 0, 0); SBAR(); y1[8] = mask_and(__builtin_amdgcn_exp2f(y1[8]), mlo, mhi, 8, 1); ADD1(sb, y1[0]); ADD1(sb, y1[1]); ADD1(sb, y1[2]); ADD1(sb, y1[3]); SBAR();
    p1 = __builtin_amdgcn_mfma_f32_32x32x16_bf16(B0, Q0, p1, 0, 0, 0); SBAR(); QK_LD(6, A0, B0, Q0); y1[9] = mask_and(__builtin_amdgcn_exp2f(y1[9]), mlo, mhi, 9, 1); ADD1(sb, y1[4]); ADD1(sb, y1[5]); ADD1(sb, y1[6]); ADD1(sb, y1[7]); SBAR();
    LGKM(3); SBAR(); p0 = __builtin_amdgcn_mfma_f32_32x32x16_bf16(A1, Q1, p0, 0, 0, 0); SBAR(); y1[10] = mask_and(__builtin_amdgcn_exp2f(y1[10]), mlo, mhi, 10, 1); const unsigned a0_u = cvtpk(y1[0+0], y1[0+1]), b0_u = cvtpk(y1[0+4], y1[0+5]); const auto r0_u = __builtin_amdgcn_permlane32_swap(a0_u, b0_u, false, false); SBAR();
    p1 = __builtin_amdgcn_mfma_f32_32x32x16_bf16(B1, Q1, p1, 0, 0, 0); SBAR(); QK_LD(7, A1, B1, Q1); y1[11] = mask_and(__builtin_amdgcn_exp2f(y1[11]), mlo, mhi, 11, 1); const unsigned a1_u = cvtpk(y1[0+2], y1[0+3]), b1_u = cvtpk(y1[0+6], y1[0+7]); const auto r1_u = __builtin_amdgcn_permlane32_swap(a1_u, b1_u, false, false); { u32x4 w_ = {r0_u[0], r1_u[0], r0_u[1], r1_u[1]}; pa2 = *reinterpret_cast<bf16x8*>(&w_); } SBAR();
    LGKM(3); SBAR(); p0 = __builtin_amdgcn_mfma_f32_32x32x16_bf16(A0, Q0, p0, 0, 0, 0); SBAR(); y1[12] = mask_and(__builtin_amdgcn_exp2f(y1[12]), mlo, mhi, 12, 1); ADD1(sb, y1[8]); ADD1(sb, y1[9]); ADD1(sb, y1[10]); ADD1(sb, y1[11]); SBAR();
    p1 = __builtin_amdgcn_mfma_f32_32x32x16_bf16(B0, Q0, p1, 0, 0, 0); SBAR(); y1[13] = mask_and(__builtin_amdgcn_exp2f(y1[13]), mlo, mhi, 13, 1);  SBAR();
    LGKM(0); SBAR(); p0 = __builtin_amdgcn_mfma_f32_32x32x16_bf16(A1, Q1, p0, 0, 0, 0); SBAR(); y1[14] = mask_and(__builtin_amdgcn_exp2f(y1[14]), mlo, mhi, 14, 1); ADD1(sb, y1[12]); ADD1(sb, y1[13]); SBAR();
    p1 = __builtin_amdgcn_mfma_f32_32x32x16_bf16(B1, Q1, p1, 0, 0, 0); SBAR(); y1[15] = mask_and(__builtin_amdgcn_exp2f(y1[15]), mlo, mhi, 15, 1);  SBAR();
    ADD1(sb, y1[14]); ADD1(sb, y1[15]);
    const unsigned a0_v = cvtpk(y1[8+0], y1[8+1]), b0_v = cvtpk(y1[8+4], y1[8+5]); const auto r0_v = __builtin_amdgcn_permlane32_swap(a0_v, b0_v, false, false); const unsigned a1_v = cvtpk(y1[8+2], y1[8+3]), b1_v = cvtpk(y1[8+6], y1[8+7]); const auto r1_v = __builtin_amdgcn_permlane32_swap(a1_v, b1_v, false, false); { u32x4 w_ = {r0_v[0], r1_v[0], r0_v[1], r1_v[1]}; pa3 = *reinterpret_cast<bf16x8*>(&w_); }
    float ps = sa + sb;
    { auto rr = __builtin_amdgcn_permlane32_swap(__float_as_uint(ps), __float_as_uint(ps), false, false);
      ps = __uint_as_float(rr[0]) + __uint_as_float(rr[1]); }
    l_reg = l_reg * alpha + ps; SBAR();
#undef QK_LD
#undef ADD1
}
template <int VB>
__device__ __forceinline__ void pv_psm(f32x16* o, int vb0, bf16x8 pa0, bf16x8 pa1, bf16x8 pa2, bf16x8 pa3,
                                       f32x16& p0, f32x16& p1, float& m_reg, float& alpha, unsigned mlo_r, unsigned mhi_r, int hi) {
    const unsigned mlo = hi ? ((mlo_r >> 1) | (mhi_r << 31)) : mlo_r, mhi = mhi_r >> hi;
    float one_ = 1.0f; asm volatile("" : "+v"(one_));
#define TRRD(dst, off) asm volatile("ds_read_b64_tr_b16 %0, %1 offset:%2" : "=&v"(dst) : "v"(vb0), "i"(off) : "memory")
#define PV_RD(X, d0) do { constexpr int b_ = VB * SHM_V + v_rd_off(d0, 0, 0); \
        TRRD(X##l0, b_); TRRD(X##h0, b_ + 2048); TRRD(X##l1, b_ + 4096); TRRD(X##h1, b_ + 6144); TRRD(X##l2, b_ + 8192); TRRD(X##h2, b_ + 10240); TRRD(X##l3, b_ + 12288); TRRD(X##h3, b_ + 14336); } while (0)
#define PV_MM(X, d0, j, PA) o[d0] = __builtin_amdgcn_mfma_f32_32x32x16_bf16(PA, (bf16x8){X##l##j[0], X##l##j[1], X##l##j[2], X##l##j[3], X##h##j[0], X##h##j[1], X##h##j[2], X##h##j[3]}, o[d0], 0, 0, 0)
    s16x4 el0, el1, el2, el3, eh0, eh1, eh2, eh3, ol0, ol1, ol2, ol3, oh0, oh1, oh2, oh3;
    PV_RD(e, 0);
    LGKM(0); SBAR(); PV_MM(e, 0, 0, pa0); SBAR(); PV_RD(o, 1); float mxa = fmaxf(fmaxf(p0[0], p0[1]), p0[2]), mxb = fmaxf(fmaxf(p1[0], p1[1]), p1[2]); mxa = fmaxf(fmaxf(mxa, p0[3]), p0[4]); mxb = fmaxf(fmaxf(mxb, p1[3]), p1[4]); SBAR();
    PV_MM(e, 0, 1, pa1); SBAR(); mxa = fmaxf(fmaxf(mxa, p0[5]), p0[6]); mxb = fmaxf(fmaxf(mxb, p1[5]), p1[6]); mxa = fmaxf(fmaxf(mxa, p0[7]), p0[8]); mxb = fmaxf(fmaxf(mxb, p1[7]), p1[8]); SBAR();
    PV_MM(e, 0, 2, pa2); SBAR(); mxa = fmaxf(fmaxf(mxa, p0[9]), p0[10]); mxb = fmaxf(fmaxf(mxb, p1[9]), p1[10]); mxa = fmaxf(fmaxf(mxa, p0[11]), p0[12]); mxb = fmaxf(fmaxf(mxb, p1[11]), p1[12]); SBAR();
    PV_MM(e, 0, 3, pa3); SBAR(); mxa = fmaxf(fmaxf(mxa, p0[13]), p0[14]); mxb = fmaxf(fmaxf(mxb, p1[13]), p1[14]); mxa = fmaxf(fmaxf(mxa, p0[15]), p1[15]); float pmax = fmaxf(mxa, mxb); SBAR();
    LGKM(0); SBAR(); PV_MM(o, 1, 0, pa0); SBAR(); PV_RD(e, 2); { auto rr = __builtin_amdgcn_permlane32_swap(__float_as_uint(pmax), __float_as_uint(pmax), false, false); pmax = fmaxf(__uint_as_float(rr[0]), __uint_as_float(rr[1])); } const float mn = (pmax - m_reg > THR2) ? pmax : m_reg;     alpha = __builtin_amdgcn_exp2f(m_reg - mn); m_reg = mn; const float nms = -mn; const bool dosub = __any(mn != 0.f); SBAR();
    PV_MM(o, 1, 1, pa1); SBAR(); if (dosub) { p0[0] = p0[0] + nms; p0[1] = __builtin_fmaf(p0[1], one_, nms); p0[2] = p0[2] + nms; p0[3] = __builtin_fmaf(p0[3], one_, nms); p0[4] = p0[4] + nms; p0[5] = __builtin_fmaf(p0[5], one_, nms); p0[6] = p0[6] + nms; p0[7] = __builtin_fmaf(p0[7], one_, nms); } SBAR();
    PV_MM(o, 1, 2, pa2); SBAR(); if (dosub) { p0[8] = p0[8] + nms; p0[9] = __builtin_fmaf(p0[9], one_, nms); p0[10] = p0[10] + nms; p0[11] = __builtin_fmaf(p0[11], one_, nms); p0[12] = p0[12] + nms; p0[13] = __builtin_fmaf(p0[13], one_, nms); p0[14] = p0[14] + nms; p0[15] = __builtin_fmaf(p0[15], one_, nms); } SBAR();
    PV_MM(o, 1, 3, pa3); SBAR(); if (dosub) { p1[0] = p1[0] + nms; p1[1] = __builtin_fmaf(p1[1], one_, nms); p1[2] = p1[2] + nms; p1[3] = __builtin_fmaf(p1[3], one_, nms); p1[4] = p1[4] + nms; p1[5] = __builtin_fmaf(p1[5], one_, nms); p1[6] = p1[6] + nms; p1[7] = __builtin_fmaf(p1[7], one_, nms); } { float t_ = mask_and(__builtin_amdgcn_exp2f(p0[0]), mlo, mhi, 0, 0); asm volatile("" : "+v"(t_)); p0[0] = t_; } SBAR();
    LGKM(0); SBAR(); PV_MM(e, 2, 0, pa0); SBAR(); PV_RD(o, 3); if (dosub) { p1[8] = p1[8] + nms; p1[9] = __builtin_fmaf(p1[9], one_, nms); p1[10] = p1[10] + nms; p1[11] = __builtin_fmaf(p1[11], one_, nms); p1[12] = p1[12] + nms; p1[13] = __builtin_fmaf(p1[13], one_, nms); p1[14] = p1[14] + nms; p1[15] = __builtin_fmaf(p1[15], one_, nms); } { float t_ = mask_and(__builtin_amdgcn_exp2f(p0[1]), mlo, mhi, 1, 0); asm volatile("" : "+v"(t_)); p0[1] = t_; } SBAR();
    PV_MM(e, 2, 1, pa1); SBAR(); { float t_ = mask_and(__builtin_amdgcn_exp2f(p0[2]), mlo, mhi, 2, 0); asm volatile("" : "+v"(t_)); p0[2] = t_; } { float t_ = mask_and(__builtin_amdgcn_exp2f(p0[3]), mlo, mhi, 3, 0); asm volatile("" : "+v"(t_)); p0[3] = t_; } SBAR();
    PV_MM(e, 2, 2, pa2); SBAR(); { float t_ = mask_and(__builtin_amdgcn_exp2f(p0[4]), mlo, mhi, 4, 0); asm volatile("" : "+v"(t_)); p0[4] = t_; } { float t_ = mask_and(__builtin_amdgcn_exp2f(p0[5]), mlo, mhi, 5, 0); asm volatile("" : "+v"(t_)); p0[5] = t_; } SBAR();
    PV_MM(e, 2, 3, pa3); SBAR(); { float t_ = mask_and(__builtin_amdgcn_exp2f(p0[6]), mlo, mhi, 6, 0); asm volatile("" : "+v"(t_)); p0[6] = t_; } { float t_ = mask_and(__builtin_amdgcn_exp2f(p0[7]), mlo, mhi, 7, 0); asm volatile("" : "+v"(t_)); p0[7] = t_; } SBAR();
    LGKM(0); SBAR(); PV_MM(o, 3, 0, pa0); SBAR(); { float t_ = mask_and(__builtin_amdgcn_exp2f(p0[8]), mlo, mhi, 8, 0); asm volatile("" : "+v"(t_)); p0[8] = t_; } { float t_ = mask_and(__builtin_amdgcn_exp2f(p0[9]), mlo, mhi, 9, 0); asm volatile("" : "+v"(t_)); p0[9] = t_; } SBAR();
    PV_MM(o, 3, 1, pa1); SBAR(); { float t_ = mask_and(__builtin_amdgcn_exp2f(p0[10]), mlo, mhi, 10, 0); asm volatile("" : "+v"(t_)); p0[10] = t_; } { float t_ = mask_and(__builtin_amdgcn_exp2f(p0[11]), mlo, mhi, 11, 0); asm volatile("" : "+v"(t_)); p0[11] = t_; } SBAR();
    PV_MM(o, 3, 2, pa2); SBAR(); { float t_ = mask_and(__builtin_amdgcn_exp2f(p0[12]), mlo, mhi, 12, 0); asm volatile("" : "+v"(t_)); p0[12] = t_; } { float t_ = mask_and(__builtin_amdgcn_exp2f(p0[13]), mlo, mhi, 13, 0); asm volatile("" : "+v"(t_)); p0[13] = t_; } SBAR();
    PV_MM(o, 3, 3, pa3); SBAR(); { float t_ = mask_and(__builtin_amdgcn_exp2f(p0[14]), mlo, mhi, 14, 0); asm volatile("" : "+v"(t_)); p0[14] = t_; } { float t_ = mask_and(__builtin_amdgcn_exp2f(p0[15]), mlo, mhi, 15, 0); asm volatile("" : "+v"(t_)); p0[15] = t_; } SBAR();
#undef PV_MM
#undef PV_RD
#undef TRRD
}
struct BlockRef { const bf16_t* Q; const bf16_t* K; const bf16_t* V; bf16_t* O; const bf16_t* G; const unsigned long long* M; int P0; long kst, mst; };
struct Seam { bf16x8 a_v0, a_v1, a_k0, a_k1, b_v0, b_v1, b_k0, b_k1; };
#define ROW(p, k0, rr) ((p) + (size_t)((k0) + (rr)) * D + sc)
#define VMW() asm volatile("s_waitcnt vmcnt(0)" ::: "memory")
#define VMWN(n) asm volatile("s_waitcnt vmcnt(%0)" :: "i"(n) : "memory")
#define SLD(X, Kp, Vp) do { S.X##_v0 = load8(ROW(Vp, 0, sr)); S.X##_v1 = load8(ROW(Vp, 0, 32 + sr)); S.X##_k0 = load8(ROW(Kp, 0, sr)); S.X##_k1 = load8(ROW(Kp, 0, 32 + sr)); } while (0)
#define SWK(X, bf) do { *(bf16x8*)(K_lds + (bf) * SHM_K + kws) = S.X##_k0; *(bf16x8*)(K_lds + (bf) * SHM_K + kws + 32 * KROWB) = S.X##_k1; } while (0)
#define SWV(X, bf) do { *(bf16x8*)(V_lds + (bf) * SHM_V + vst0) = S.X##_v0; *(bf16x8*)(V_lds + (bf) * SHM_V + vst1) = S.X##_v1; } while (0)
__device__ __forceinline__ void attn_prime(int wv, const BlockRef& cur, char* lds, Seam& S) {
    const int tid = opaque_tid(wv);
    const int sr = tid >> 4, sc = (tid & 15) * 8, kws = KSWZ(sr, sc * 2); char* K_lds = lds + 2 * SHM_V;
    SLD(a, cur.K, cur.V); SBAR(); SWK(a, 0); SBAR(); SLD(b, cur.K + cur.kst, cur.V + cur.kst);
    __syncthreads();
}
__device__ __forceinline__ void attn_block(int wv, const BlockRef& cur, const BlockRef& nxt, char* lds, Seam& S) {
    const int tid = opaque_tid(wv), wid = __builtin_amdgcn_readfirstlane(tid >> 6), lane = tid & 63, r32 = lane & 31, hi = lane >> 5;
    const int NT = cur.P0 / KVBLK + 4;
    char* V_lds = lds; char* K_lds = lds + 2 * SHM_V;
    float* ws = (float*)(lds + 2 * SHM_V + 2 * SHM_K) + wid * 64; float* li_l = ws, * al_l = ws + 32;
    float m_reg = 0.f, l_reg = 0; f32x16 o[4] = {};
    const int sr = tid >> 4, sc = (tid & 15) * 8, vst0 = v_st(sr, sc), vst1 = v_st(32 + sr, sc), kws = KSWZ(sr, sc * 2);
    const int vb0 = (int)(uintptr_t)V_lds + v_rd_base(lane);
    const bf16_t* Kh = cur.K; const bf16_t* Vh = cur.V;
    const unsigned long long* mp = cur.M + (wid * QBLK + r32); const long mst = cur.mst, kst = cur.kst;
#define MLOAD(lo_, hi_, t) do { const unsigned long long w_ = mp[(long)(t) * mst]; lo_ = (unsigned)w_; hi_ = (unsigned)(w_ >> 32); } while (0)
#define RESC(a) do { if (__any((a) != 1.f)) { if (hi == 0) al_l[r32] = (a); asm volatile("s_waitcnt lgkmcnt(0)" ::: "memory");              \
                     for (int d_ = 0; d_ < 4; ++d_) for (int r = 0; r < 16; ++r) o[d_][r] *= al_l[crow(r, hi)]; } } while (0)
#define KBASE(t) ((long)(t) * kst)
    f32x16 pA0, pA1, pB0, pB1; float alA, alB; bf16x8 pa0, pa1, pa2, pa3;
    unsigned mAlo, mAhi, mBlo, mBhi;
    MLOAD(mAlo, mAhi, 0);
    char* Qw_lds = lds + Q_OFF + wid * (QBLK * QROWB);
    { u32x4 tq[8];
#pragma unroll
        for (int i = 0; i < 8; ++i) tq[i] = *(const u32x4*)(cur.Q + (size_t)(wid * QBLK + 4 * i + (lane >> 4)) * D + (lane & 15) * 8);
#pragma unroll
        for (int i = 0; i < 8; ++i) *(u32x4*)(Qw_lds + (4 * i + (lane >> 4)) * QROWB + (lane & 15) * 16) = tq[i];
        asm volatile("s_waitcnt lgkmcnt(0)" ::: "memory"); }
    const int qal = (int)(uintptr_t)Qw_lds + r32 * QROWB + hi * 16, ka = (int)(uintptr_t)K_lds + r32 * KROWB + hi * 16;
    SWV(a, 0); SBAR();
    SLD(a, Kh + KBASE(2), Vh + KBASE(2));
    SBAR(); qkt<0>(pA0, pA1, ka, qal);
    partialSM(pA0, pA1, m_reg, alA, mAlo, mAhi, hi);
    SWV(b, 1); SWK(b, 1);
    __syncthreads();
#define HALF_STEP(PX0, PX1, mnX, alX, mXlo, mXhi, PY0, PY1, alY, mYlo, mYhi, t, KB, VB, SB, SL, SW, KP, VP) do {                   \
        SBAR(); MLOAD(mXlo, mXhi, t); qkt_fsm<KB>(PX0, PX1, ka, qal, PY0, PY1, alY, l_reg, pa0, pa1, pa2, pa3, mYlo, mYhi, hi); SBAR(); \
        SLD(SL, KP, VP); SBAR();                                                                                              \
        pv_psm<VB>(o, vb0, pa0, pa1, pa2, pa3, PX0, PX1, m_reg, alX, mXlo, mXhi, hi);                                         \
        __syncthreads();                                                                                                      \
        SWV(SW, SB); SWK(SW, SB);                                                                                             \
        RESC(alX); __syncthreads(); } while (0)
    for (int t = 1; t + 1 < NT; t += 2) {
        const bool inr = t + 3 < NT;
        const bf16_t* kp2 = inr ? Kh + KBASE(t + 3) : nxt.K; const bf16_t* vp2 = inr ? Vh + KBASE(t + 3) : nxt.V;
        HALF_STEP(pB0, pB1, mnB, alB, mBlo, mBhi, pA0, pA1, alA, mAlo, mAhi, t, 1, 0, 0, b, a, Kh + KBASE(t + 2), Vh + KBASE(t + 2));
        HALF_STEP(pA0, pA1, mnA, alA, mAlo, mAhi, pB0, pB1, alB, mBlo, mBhi, t + 1, 0, 1, 1, a, b, kp2, vp2);
    }
    MLOAD(mBlo, mBhi, NT - 1);
    SBAR(); qkt_fsm<1>(pB0, pB1, ka, qal, pA0, pA1, alA, l_reg, pa0, pa1, pa2, pa3, mAlo, mAhi, hi); SBAR();
    SLD(b, nxt.K + nxt.kst, nxt.V + nxt.kst); SBAR();
    pv_psm<0>(o, vb0, pa0, pa1, pa2, pa3, pB0, pB1, m_reg, alB, mBlo, mBhi, hi); __syncthreads(); RESC(alB);
    finishSM(pB0, pB1, alB, l_reg, pa0, pa1, pa2, pa3, mBlo, mBhi, hi); SBAR(); pv_tile<1>(o, vb0, pa0, pa1, pa2, pa3);
    SBAR(); SWK(a, 0); SBAR();
    if (hi == 0) li_l[r32] = l_reg; asm volatile("s_waitcnt lgkmcnt(0)" ::: "memory");
    { char* ow_l = Qw_lds + r32 * 2;
#pragma unroll
      for (int r = 0; r < 16; ++r) { const int orow = crow(r, hi); const float rl = __builtin_amdgcn_rcpf(li_l[orow]);
#pragma unroll
          for (int d0 = 0; d0 < 4; ++d0) *(unsigned short*)(ow_l + orow * QROWB + d0 * 64) = (unsigned short)(cvtpk(o[d0][r] * rl, 0.f) & 0xffffu); }
      asm volatile("s_waitcnt lgkmcnt(0)" ::: "memory"); SBAR();
      bf16_t* Ow = cur.O + (size_t)(wid * QBLK + (lane >> 4)) * DM + (lane & 15) * 8; const bf16_t* Gw = cur.G + (size_t)(wid * QBLK + (lane >> 4)) * DM + (lane & 15) * 8;
      u32x4 gv[8];
#pragma unroll
      for (int i = 0; i < 8; ++i) gv[i] = *(const u32x4*)(Gw + (size_t)(4 * i) * DM);
#pragma unroll
      for (int i = 0; i < 8; ++i) { const u32x4 ov = *(const u32x4*)(Qw_lds + (4 * i + (lane >> 4)) * QROWB + (lane & 15) * 16);
          f32x4 a0, a1, g0, g1; unpack8(ov, a0, a1); unpack8(gv[i], g0, g1);
          *(u32x4*)(Ow + (size_t)(4 * i) * DM) = pack8(a0 * g0, a1 * g1); }
      asm volatile("s_waitcnt lgkmcnt(0)" ::: "memory"); }
    __syncthreads();
#undef MLOAD
#undef RESC
#undef KBASE
#undef HALF_STEP
}
#undef ROW
#undef VMW
#undef VMWN
#undef SLD
#undef SWK
#undef SWV
#undef KSWZ
#undef SBAR
}

#define XB_TMO      128
#define XB_XCNT(j)  (256  + 64 * (j))
#define XB_XSUB(j)  (1280 + 64 * (j))
#define XB_XGEN(j)  (2304 + 64 * (j))
#define XB_TOP      3328
#define XB_TOPGEN   3392
#define XCD_BAR_WORDS 3456
#define XB_SPIN_CAP (1u << 22)
__device__ __forceinline__ unsigned xb_ld(unsigned* p)              { return __hip_atomic_load(p, __ATOMIC_RELAXED, __HIP_MEMORY_SCOPE_AGENT); }
__device__ __forceinline__ unsigned xb_add(unsigned* p, unsigned v) { return __hip_atomic_fetch_add(p, v, __ATOMIC_RELAXED, __HIP_MEMORY_SCOPE_AGENT); }
__device__ __forceinline__ unsigned xb_xcc_id() { return (unsigned)__builtin_amdgcn_s_getreg((3 << 11) | 20) & 0xFu; }
#define XB_SPIN(cond, bar) do { unsigned _sp = 0; while (cond) { __builtin_amdgcn_s_sleep(1); \
    if ((++_sp & 255u) == 0u) { if (xb_ld(&(bar)[XB_TMO])) break; if (_sp > XB_SPIN_CAP) { atomicAdd(&(bar)[XB_TMO], 1u); break; } } } } while (0)
struct XcdBarrier { unsigned* bar; unsigned x; volatile LAS unsigned* st; };
__device__ __forceinline__ XcdBarrier xcd_barrier_post(unsigned* bar, volatile LAS unsigned* st) {
    XcdBarrier b; b.bar = bar; b.x = xb_xcc_id(); b.st = st;
    if (threadIdx.x == 0) (void)xb_add(&bar[XB_XCNT(b.x)], 1u);
    return b;
}
__device__ __forceinline__ void xcd_barrier_complete(unsigned* bar, unsigned x, unsigned& nloc, unsigned& nx) {
    const unsigned G = gridDim.x * gridDim.y * gridDim.z;
    unsigned sum, cnt, mine, sp = 0u;
    for (;;) {
        sum = 0u; cnt = 0u; mine = 0u;
        unsigned cj[16];
#pragma unroll
        for (unsigned j = 0; j < 16; ++j) cj[j] = xb_ld(&bar[XB_XCNT(j)]);
        __builtin_amdgcn_sched_barrier(0);
#pragma unroll
        for (unsigned j = 0; j < 16; ++j) { const unsigned c = cj[j]; sum += c; cnt += (c > 0u) ? 1u : 0u; mine = (j == x) ? c : mine; }
        if (sum == G) break;
        __builtin_amdgcn_s_sleep(1);
        if ((++sp & 255u) == 0u) { if (xb_ld(&bar[XB_TMO])) break; if (sp > XB_SPIN_CAP) { atomicAdd(&bar[XB_TMO], 1u); break; } }
    }
    nloc = mine > 0u ? mine : 1u; nx = cnt > 0u ? cnt : 1u;
}
__device__ __forceinline__ void xcd_barrier(const XcdBarrier& b) {
    asm volatile("s_waitcnt vmcnt(0)" ::: "memory");
    __syncthreads();
    if (threadIdx.x == 0) {
        unsigned* bar = b.bar;
        __builtin_amdgcn_s_waitcnt(0);
        unsigned nloc = b.st[0], nx = b.st[1];
        if (nloc == 0u) { xcd_barrier_complete(bar, b.x, nloc, nx); b.st[0] = nloc; b.st[1] = nx; }
        const unsigned old = xb_add(&bar[XB_XSUB(b.x)], 1u);
        const unsigned gen = old / nloc;
        if (old + 1u == (gen + 1u) * nloc) {
            __builtin_amdgcn_fence(__ATOMIC_RELEASE, "agent");
            asm volatile("s_waitcnt vmcnt(0)" ::: "memory");
            const unsigned og = xb_add(&bar[XB_TOP], 1u);
            const unsigned tg = og / nx;
            if (og + 1u == (tg + 1u) * nx) xb_add(&bar[XB_TOPGEN], 1u);
            else XB_SPIN(xb_ld(&bar[XB_TOPGEN]) == tg, bar);
            __builtin_amdgcn_fence(__ATOMIC_ACQUIRE, "agent");
            xb_add(&bar[XB_XGEN(b.x)], 1u);
            asm volatile("s_waitcnt vmcnt(0)" ::: "memory");
        } else {
            XB_SPIN(xb_ld(&bar[XB_XGEN(b.x)]) == gen, bar);
            __builtin_amdgcn_fence(__ATOMIC_ACQUIRE, "agent");
            asm volatile("s_waitcnt vmcnt(0)" ::: "memory");
        }
    }
    __syncthreads();
}

struct Args {
    const float* x; const float* c; const int* pos; const float* norm_g; const float* mod_w; const float* mod_b;
    const float* pwi; const float* pwg; const float* pls; const float* pwo; const float* awi; const float* awo; const float* fg;
    float* out; unsigned char* ws;
    int ph_lo, ph_hi;
};
constexpr int NWAVES = 8, NTHR = 512;
constexpr int RING_BYTES = 131072, LDS_BYTES = 147456, MISC_OFF = LDS_BYTES - 256;

__device__ __forceinline__ void sincos_d(double a, float& s_out, float& c_out) {
    const double k = __builtin_rint(a * 0.6366197723675814);
    double r = __builtin_fma(-k, 1.5707963267948966, a); r = __builtin_fma(-k, 6.123233995736766e-17, r);
    const double r2 = r * r;
    double sp = -7.647163731819816e-13; sp = sp * r2 + 1.6059043836821613e-10; sp = sp * r2 - 2.505210838544172e-08; sp = sp * r2 + 2.7557319223985893e-06;
    sp = sp * r2 - 1.984126984126984e-04; sp = sp * r2 + 8.333333333333333e-03; sp = sp * r2 - 1.6666666666666666e-01; const double s = r + r * r2 * sp;
    double cp = 4.779477332387385e-14; cp = cp * r2 - 1.1470745597729725e-11; cp = cp * r2 + 2.08767569878681e-09; cp = cp * r2 - 2.755731922398589e-07;
    cp = cp * r2 + 2.48015873015873e-05; cp = cp * r2 - 1.388888888888889e-03; cp = cp * r2 + 4.1666666666666664e-02; cp = cp * r2 - 0.5; const double c = 1.0 + r2 * cp;
    const int q = (int)((long long)k & 3);
    const double ss = (q == 0) ? s : (q == 1) ? c : (q == 2) ? -s : -c;
    const double cc = (q == 0) ? c : (q == 1) ? -s : (q == 2) ? -c : s;
    s_out = (float)ss; c_out = (float)cc;
}
__device__ __forceinline__ void transpose_item(const float* W, int K, int N, bf16_t* WT, int row_off, LAS float* scr, int nblk, int item, int lane) {
    const int kb = item / nblk, nb = item % nblk, k0 = 64 * kb, n0 = 32 * nb;
    const int nn = n0 + (lane & 31);
    float tv[32];
#pragma unroll
    for (int i = 0; i < 32; ++i) { const int kk = 2 * i + (lane >> 5); tv[i] = (nn < N) ? W[(size_t)(k0 + kk) * N + nn] : 0.f; }
#pragma unroll
    for (int i = 0; i < 32; ++i) { const int kk = 2 * i + (lane >> 5); scr[kk * 33 + (lane & 31)] = tv[i]; }
    LDS_WAIT(); asm volatile("" ::: "memory");
    const int c = lane & 7;
#pragma unroll
    for (int j = 0; j < 4; ++j) { const int n = (lane >> 3) + 8 * j; const LAS float* s = scr + (8 * c) * 33 + n;
        u32x4 o; o.x = pk2(s[0 * 33], s[1 * 33]); o.y = pk2(s[2 * 33], s[3 * 33]); o.z = pk2(s[4 * 33], s[5 * 33]); o.w = pk2(s[6 * 33], s[7 * 33]);
        *(u32x4*)(WT + (size_t)(row_off + n0 + n) * K + k0 + 8 * c) = o; }
    LDS_WAIT(); asm volatile("" ::: "memory");
}
template <int VAR>
__device__ __forceinline__ void phase0(int wv, const Args& a, LAS unsigned char* lds) {
    const int tid = opaque_tid(wv), lane = tid & 63, wave = __builtin_amdgcn_readfirstlane(tid >> 6);
    const int G = gridDim.x, bx = blockIdx.x;
    unsigned char* ws = a.ws;
    if (VAR == 0 || VAR == 1)
    for (int unit = bx; unit < 256; unit += G) {
        const int layer = unit >> 6, kq = (unit >> 4) & 3, cs = unit & 15;
        const float* W = a.mod_w + ((size_t)layer * DM + 512 * kq) * 6144 + 384 * cs;
        LAS float* red = (LAS float*)lds;
        LAS float* cdl = (LAS float*)(lds + 8192);
        if (tid < 512) cdl[tid] = silu_f(a.c[512 * kq + tid]);
        if (tid < 8) cdl[512 + tid] = 0.f;
        __syncthreads();
        if (tid < 480) {
            const int kg = tid / 96, ln = tid - kg * 96;
            f32x4 acc4 = {0.f, 0.f, 0.f, 0.f};
#pragma unroll 8
            for (int i = 0; i < 103; ++i) { const int k = kg + 5 * i, kc = k < 512 ? k : 511;
                acc4 += *(const f32x4*)(W + (size_t)kc * 6144 + 4 * ln) * cdl[k]; }
            *(LAS f32x4*)(red + kg * 384 + 4 * ln) = acc4;
        }
        __syncthreads();
        if (tid < 384) { float sum = red[tid];
#pragma unroll
            for (int kg = 1; kg < 5; ++kg) sum += red[kg * 384 + tid];
            const int col = 384 * cs + tid;
            if (kq == 0) sum += a.mod_b[layer * 6144 + col];
            ((float*)(ws + WS_MOD))[(layer * 4 + kq) * 6144 + col] = sum; }
        __syncthreads();
    }
    if (VAR == 0 || VAR == 2) {
        float* cosq = (float*)(ws + WS_TAB); float* sinq = cosq + SEQ * 16; float* cosi = sinq + SEQ * 16; float* sini = cosi + SEQ * 8;
        LAS float* invl = (LAS float*)(lds + 12288);
        if (tid < 24) { const double frac = tid < 16 ? (double)tid * (1.0 / 16.0) : (double)(tid - 16) * (1.0 / 8.0); invl[tid] = (float)exp2(-18.931568569324174 * frac); }
        __syncthreads();
        for (int e = bx * NTHR + tid; e < SEQ * 24; e += G * NTHR) {
            const int p = e / 24, i = e - p * 24;
            const float pf = (float)a.pos[p];
            const float inv = invl[i];
            const float ang = pf * inv;
            float s, c; sincos_d((double)ang, s, c);
            if (i < 16) { cosq[p * 16 + i] = c; sinq[p * 16 + i] = s; } else { cosi[p * 8 + i - 16] = c; sini[p * 8 + i - 16] = s; }
        }
    }
    if (VAR == 0 || VAR == 3) {
        LAS float* scr = (LAS float*)(lds + 16384 + wave * 8704);
        const int gw = bx * NWAVES + wave, NGW = G * NWAVES;
        constexpr int I_PI = 32 * 128, I_PG = 8 * 16, I_PO = 32 * 64, I_AI = 32 * 296, I_AO = 32 * 64;
        constexpr int NITEMS = 2 * I_PI + 8 * I_PG + 2 * I_PO + 2 * I_AI + 2 * I_AO;
        for (int it = gw; it < NITEMS; it += NGW) {
            int r = it;
            if (r < 2 * I_AI) { const int l = r / I_AI; r -= l * I_AI; transpose_item(a.awi + (size_t)l * DM * ATTN_IN, DM, ATTN_IN, (bf16_t*)(ws + WS_WAI) + (size_t)l * ATTN_INP * DM, 0, scr, 296, r, lane); continue; } r -= 2 * I_AI;
            if (r < 2 * I_PI) { const int l = r / I_PI; r -= l * I_PI; transpose_item(a.pwi + (size_t)l * DM * POOL_IN, DM, POOL_IN, (bf16_t*)(ws + WS_WPI) + (size_t)l * POOL_IN * DM, 0, scr, 128, r, lane); continue; } r -= 2 * I_PI;
            if (r < 2 * I_PO) { const int l = r / I_PO; r -= l * I_PO; transpose_item(a.pwo + (size_t)l * DM * DM, DM, DM, (bf16_t*)(ws + WS_WPO) + (size_t)l * DM * DM, 0, scr, 64, r, lane); continue; } r -= 2 * I_PO;
            if (r < 2 * I_AO) { const int l = r / I_AO; r -= l * I_AO; transpose_item(a.awo + (size_t)l * DM * DM, DM, DM, (bf16_t*)(ws + WS_WAO) + (size_t)l * DM * DM, 0, scr, 64, r, lane); continue; } r -= 2 * I_AO;
            { const int lg = r / I_PG; r -= lg * I_PG; const int l = lg >> 2, gi = lg & 3;
              transpose_item(a.pwg + (size_t)lg * 512 * 512, 512, 512, (bf16_t*)(ws + WS_WPG) + (size_t)l * DM * 512, gi * 512, scr, 16, r, lane); }
        }
    }
}

template <bool IN_BF16> __device__ __forceinline__ void phase_norm(int wv, const void* x, const float* g, const float* mod  , bf16_t* h, unsigned char* lds, float* gsum  ) {
    const int tid = opaque_tid(wv), lane = tid & 63, wave = tid >> 6;
    const int gw = blockIdx.x * NWAVES + wave, NGW = gridDim.x * NWAVES;
    u32x4 t[4][4]; f32x4 tf[4][8];
#define NORM_LOAD(row_) do {                                                                                                  \
        _Pragma("unroll") for (int r = 0; r < 4; ++r) { const size_t ro = (size_t)((row_) + r * NGW) * DM;                   \
            if (IN_BF16) { const u32x4* xr = (const u32x4*)((const bf16_t*)x + ro) + lane;                                   \
                _Pragma("unroll") for (int j = 0; j < 4; ++j) t[r][j] = xr[64 * j]; }                                        \
            else { const f32x4* xr = (const f32x4*)((const float*)x + ro) + 2 * lane;                                        \
                _Pragma("unroll") for (int j = 0; j < 4; ++j) { tf[r][2 * j] = xr[128 * j]; tf[r][2 * j + 1] = xr[128 * j + 1]; } } } } while (0)
    float* la = (float*)lds; float* lsft = la + DM;
    { const int col = 4 * tid;
      const f32x4 gg = *(const f32x4*)(g + col);
      const f32x4 p0 = *(const f32x4*)(mod + col), p1 = *(const f32x4*)(mod + 6144 + col), p2 = *(const f32x4*)(mod + 2 * 6144 + col), p3 = *(const f32x4*)(mod + 3 * 6144 + col);
      const f32x4 q0 = *(const f32x4*)(mod + DM + col), q1 = *(const f32x4*)(mod + 6144 + DM + col), q2 = *(const f32x4*)(mod + 2 * 6144 + DM + col), q3 = *(const f32x4*)(mod + 3 * 6144 + DM + col);
      f32x4 r0, r1, r2, r3;
      if (blockIdx.x == 0) { r0 = *(const f32x4*)(mod + 2 * DM + col); r1 = *(const f32x4*)(mod + 6144 + 2 * DM + col); r2 = *(const f32x4*)(mod + 2 * 6144 + 2 * DM + col); r3 = *(const f32x4*)(mod + 3 * 6144 + 2 * DM + col); }
      int row = gw; if (row < SEQ) NORM_LOAD(row);
      const f32x4 sh = ((p0 + p1) + p2) + p3, sc = ((q0 + q1) + q2) + q3;
      *(f32x4*)(la + col) = gg * (sc + 1.0f); *(f32x4*)(lsft + col) = sh;
      if (blockIdx.x == 0) *(f32x4*)(gsum + col) = ((r0 + r1) + r2) + r3; }
    __syncthreads();
    f32x4 av[8], sv[8];
#pragma unroll
    for (int j = 0; j < 8; ++j) { const int col = 8 * lane + 512 * (j >> 1) + 4 * (j & 1); av[j] = *(const f32x4*)(la + col); sv[j] = *(const f32x4*)(lsft + col); }
    for (int row = gw; row < SEQ; ) {
#pragma unroll
        for (int r = 0; r < 4; ++r) {
            f32x4 v[8];
#pragma unroll
            for (int j = 0; j < 4; ++j) { if (IN_BF16) unpack8(t[r][j], v[2 * j], v[2 * j + 1]); else { v[2 * j] = tf[r][2 * j]; v[2 * j + 1] = tf[r][2 * j + 1]; } }
            float s = 0.f;
#pragma unroll
            for (int j = 0; j < 8; ++j) s += (v[j].x * v[j].x + v[j].y * v[j].y) + (v[j].z * v[j].z + v[j].w * v[j].w);
            const float rstd = 1.0f / sqrtf(wave_sum(s) * (1.f / DM) + EPS);
            u32x4* o16 = (u32x4*)(h + (size_t)(row + r * NGW) * DM) + lane;
#pragma unroll
            for (int j = 0; j < 4; ++j) o16[64 * j] = pack8(v[2 * j] * rstd * av[2 * j] + sv[2 * j], v[2 * j + 1] * rstd * av[2 * j + 1] + sv[2 * j + 1]);
        }
        row += 4 * NGW; if (row >= SEQ) break;
        NORM_LOAD(row);
    }
#undef NORM_LOAD
}
__device__ __forceinline__ void phase_final(int wv, const bf16_t* x, float* y, const float* g) {
    const int tid = opaque_tid(wv), lane = tid & 63, wave = tid >> 6;
    const int gw = blockIdx.x * NWAVES + wave, NGW = gridDim.x * NWAVES;
    f32x4 gg[8];
#pragma unroll
    for (int j = 0; j < 8; ++j) gg[j] = *(const f32x4*)(g + 8 * lane + 512 * (j >> 1) + 4 * (j & 1));
    for (int row = gw; row < SEQ; row += 4 * NGW) {
        u32x4 t[4][4];
#pragma unroll
        for (int r = 0; r < 4; ++r) { const u32x4* xr = (const u32x4*)(x + (size_t)(row + r * NGW) * DM) + lane;
#pragma unroll
            for (int j = 0; j < 4; ++j) t[r][j] = xr[64 * j]; }
#pragma unroll
        for (int r = 0; r < 4; ++r) {
            f32x4 v[8]; float s = 0.f;
#pragma unroll
            for (int j = 0; j < 4; ++j) unpack8(t[r][j], v[2 * j], v[2 * j + 1]);
#pragma unroll
            for (int j = 0; j < 8; ++j) s += (v[j].x * v[j].x + v[j].y * v[j].y) + (v[j].z * v[j].z + v[j].w * v[j].w);
            const float rstd = 1.0f / sqrtf(wave_sum(s) * (1.f / DM) + EPS);
            f32x4* yr = (f32x4*)(y + (size_t)(row + r * NGW) * DM) + 2 * lane;
#pragma unroll
            for (int j = 0; j < 8; ++j) yr[128 * (j >> 1) + (j & 1)] = v[j] * rstd * gg[j];
        }
    }
}

template <int W, int R> __device__ __forceinline__ void pool_strip(const bf16_t* VG, bf16_t* PL, int t0, int c0) {
    u32x4 r[W + R - 1];
#pragma unroll
    for (int i = 0; i < W + R - 1; ++i) { const int t = t0 - (W - 1) + i; r[i] = *(const u32x4*)(VG + (size_t)(t < 0 ? 0 : t) * POOL_IN + c0); }
    float S[8];
#pragma unroll
    for (int e = 0; e < 8; ++e) S[e] = 0.f;
#pragma unroll
    for (int i = 0; i < W - 1; ++i) { const float wg = (t0 - (W - 1) + i >= 0) ? 1.f : 0.f;
#pragma unroll
        for (int e = 0; e < 4; ++e) { const unsigned x = r[i][e]; S[2 * e] += wg * __builtin_bit_cast(float, x << 16); S[2 * e + 1] += wg * __builtin_bit_cast(float, x & 0xffff0000u); } }
#pragma unroll
    for (int j = 0; j < R; ++j) { const int t = t0 + j;
        float v[8];
#pragma unroll
        for (int e = 0; e < 4; ++e) { const unsigned x = r[W - 1 + j][e]; v[2 * e] = __builtin_bit_cast(float, x << 16); v[2 * e + 1] = __builtin_bit_cast(float, x & 0xffff0000u); }
        const int cnt = (t + 1 < W) ? (t + 1) : W; const float ic = 1.0f / (float)cnt;
        float o[8];
#pragma unroll
        for (int e = 0; e < 8; ++e) { S[e] += v[e]; o[e] = S[e] * ic - v[e]; }
        u32x4 pw; pw.x = cvt_pk_bf16(o[0], o[1]); pw.y = cvt_pk_bf16(o[2], o[3]); pw.z = cvt_pk_bf16(o[4], o[5]); pw.w = cvt_pk_bf16(o[6], o[7]);
        *(u32x4*)(PL + (size_t)t * DM + c0) = pw;
        const float wg = (t - W + 1 >= 0) ? 1.f : 0.f;
#pragma unroll
        for (int e = 0; e < 4; ++e) { const unsigned x = r[j][e]; S[2 * e] -= wg * __builtin_bit_cast(float, x << 16); S[2 * e + 1] -= wg * __builtin_bit_cast(float, x & 0xffff0000u); } }
}
__device__ __forceinline__ void phase_pool(int wv, const bf16_t* VG, bf16_t* PL) {
    const int total = 512 * 256;
    const int tid = opaque_tid(wv);
    for (int it = blockIdx.x * NTHR + tid; it < total; it += gridDim.x * NTHR) {
        const int cg = it & 255, strip = it >> 8; const int c0 = cg * 8, t0 = strip * 16;
        const int grp = __builtin_amdgcn_readfirstlane(c0 >> 9);
        if (grp == 0) pool_strip<2, 16>(VG, PL, t0, c0); else if (grp == 1) pool_strip<4, 16>(VG, PL, t0, c0); else if (grp == 2) pool_strip<8, 16>(VG, PL, t0, c0);
        else { pool_strip<16, 8>(VG, PL, t0, c0); pool_strip<16, 8>(VG, PL, t0 + 8, c0); }
    }
}

__device__ __forceinline__ size_t sc_block_base(int qb) { return (size_t)65536 * (size_t)(qb * (qb + 1) / 2); }
__device__ __forceinline__ float fma_s(float a, float b, float c) { asm("v_fma_f32 %0, %1, %2, %0" : "+v"(c) : "v"(a), "v"(b)); return c; }
__device__ __forceinline__ float relu_i(float x) { const int b = __builtin_bit_cast(int, x); return __builtin_bit_cast(float, b > 0 ? b : 0); }
template <int VAR>
__device__ __forceinline__ void phase_scores(int wv, const bf16_t* QI, const bf16_t* KI, const float* WI, float* SC, LAS unsigned char* lds, unsigned* ctr  ) {
    const int tid = opaque_tid(wv), wid = __builtin_amdgcn_readfirstlane(tid >> 6), lane = tid & 63, r32 = lane & 31, hi = lane >> 5;
    constexpr int QROW = 2064;
    volatile LAS int* slot = (volatile LAS int*)(lds + 32 * QROW);
    for (;;) {
        __syncthreads();
        if (tid == 0) slot[0] = (int)__hip_atomic_fetch_add(ctr, 1u, __ATOMIC_RELAXED, __HIP_MEMORY_SCOPE_AGENT);
        __syncthreads();
        const int L = slot[0];
        if (L >= 1152) break;
        int kc = 0, base = 0;
        for (; kc < 8; ++kc) { const int n = 256 - 32 * kc; if (L < base + n) break; base += n; }
        const int u = 32 * kc + (L - base);
        const int q0 = 32 * u, qb = u >> 3;
        const int klim = (qb + 1) * 256;
        bf16x8 kf[2][4];
        { const int key0 = kc * 1024 + wid * 64;
#pragma unroll
            for (int b = 0; b < 2; ++b)
#pragma unroll
                for (int kk = 0; kk < 4; ++kk) kf[b][kk] = *(const bf16x8*)(KI + (size_t)(key0 + 32 * b + r32) * 64 + 16 * kk + 8 * hi); }
        {
            int t_ = tid; asm volatile("" : "+v"(t_));
            const bf16_t* src = QI + (size_t)q0 * 1024 + t_ * 8;
            const int ldst = (t_ >> 7) * QROW + (t_ & 127) * 16;
            u32x4 tq[8];
#pragma unroll
            for (int i = 0; i < 8; ++i) tq[i] = *(const u32x4*)(src + i * 4096);
            __builtin_amdgcn_sched_barrier(0);
#pragma unroll
            for (int i = 0; i < 8; ++i) *(LAS u32x4*)(lds + ldst + i * (4 * QROW)) = tq[i];
        }
        f32x4 wq[4];
#pragma unroll
        for (int i = 0; i < 4; ++i) wq[i] = *(const f32x4*)(WI + (size_t)(q0 + r32) * 16 + 4 * i);
        __syncthreads();
        for (int sl = wid; sl < 16; sl += 8) {
            const int key0 = kc * 1024 + sl * 64;
            if (key0 >= klim) continue;
            if (sl != wid) {
#pragma unroll
                for (int b = 0; b < 2; ++b)
#pragma unroll
                    for (int kk = 0; kk < 4; ++kk) kf[b][kk] = *(const bf16x8*)(KI + (size_t)(key0 + 32 * b + r32) * 64 + 16 * kk + 8 * hi); }
            f32x16 acc0 = {}, acc1 = {};
            const LAS unsigned char* qa = lds + r32 * QROW + hi * 16;
#define SC_MM(h, S0, S1) do { bf16x8 af_[4];                                                                                  \
                _Pragma("unroll") for (int kk = 0; kk < 4; ++kk) af_[kk] = *(const LAS bf16x8*)(qa + (h) * 128 + kk * 32);     \
                S0 = __builtin_amdgcn_mfma_f32_32x32x16_bf16(kf[0][0], af_[0], f32x16{}, 0, 0, 0); S1 = __builtin_amdgcn_mfma_f32_32x32x16_bf16(kf[1][0], af_[0], f32x16{}, 0, 0, 0); \
                _Pragma("unroll") for (int kk = 1; kk < 4; ++kk) { S0 = __builtin_amdgcn_mfma_f32_32x32x16_bf16(kf[0][kk], af_[kk], S0, 0, 0, 0); S1 = __builtin_amdgcn_mfma_f32_32x32x16_bf16(kf[1][kk], af_[kk], S1, 0, 0, 0); } } while (0)
#define SC_VA(h, S0, S1) do { const float w_ = wq[(h) >> 2][(h) & 3];                                                          \
                _Pragma("unroll") for (int r = 0; r < 16; ++r) { acc0[r] = fma_s(relu_i(S0[r]), w_, acc0[r]); acc1[r] = fma_s(relu_i(S1[r]), w_, acc1[r]); } } while (0)
#define SC_SB() __builtin_amdgcn_sched_barrier(0)
            f32x16 sA0, sA1, sB0, sB1;
            SC_MM(0, sA0, sA1); SC_SB();
#define SC_VQ(P, ACC, r0) do { _Pragma("unroll") for (int r = (r0); r < (r0) + 4; ++r) ACC[r] = fma_s(relu_i(P[r]), w_, ACC[r]); } while (0)
#define SC_STEP(hn, N0, N1, hp, P0, P1) do { bf16x8 af_[4]; const float w_ = wq[(hp) >> 2][(hp) & 3];                                                         \
                _Pragma("unroll") for (int kk = 0; kk < 4; ++kk) af_[kk] = *(const LAS bf16x8*)(qa + (hn) * 128 + kk * 32);                                       \
                N0 = __builtin_amdgcn_mfma_f32_32x32x16_bf16(kf[0][0], af_[0], f32x16{}, 0, 0, 0); SC_SB(); SC_VQ(P0, acc0, 0); SC_SB();                          \
                N1 = __builtin_amdgcn_mfma_f32_32x32x16_bf16(kf[1][0], af_[0], f32x16{}, 0, 0, 0); SC_SB(); SC_VQ(P1, acc1, 0); SC_SB();                          \
                N0 = __builtin_amdgcn_mfma_f32_32x32x16_bf16(kf[0][1], af_[1], N0, 0, 0, 0); SC_SB(); SC_VQ(P0, acc0, 4); SC_SB();                                \
                N1 = __builtin_amdgcn_mfma_f32_32x32x16_bf16(kf[1][1], af_[1], N1, 0, 0, 0); SC_SB(); SC_VQ(P1, acc1, 4); SC_SB();                                \
                N0 = __builtin_amdgcn_mfma_f32_32x32x16_bf16(kf[0][2], af_[2], N0, 0, 0, 0); SC_SB(); SC_VQ(P0, acc0, 8); SC_SB();                                \
                N1 = __builtin_amdgcn_mfma_f32_32x32x16_bf16(kf[1][2], af_[2], N1, 0, 0, 0); SC_SB(); SC_VQ(P1, acc1, 8); SC_SB();                                \
                N0 = __builtin_amdgcn_mfma_f32_32x32x16_bf16(kf[0][3], af_[3], N0, 0, 0, 0); SC_SB(); SC_VQ(P0, acc0, 12); SC_SB();                               \
                N1 = __builtin_amdgcn_mfma_f32_32x32x16_bf16(kf[1][3], af_[3], N1, 0, 0, 0); SC_SB(); SC_VQ(P1, acc1, 12); SC_SB(); } while (0)
#pragma unroll
            for (int h = 0; h < 14; h += 2) {
                SC_STEP(h + 1, sB0, sB1, h, sA0, sA1);
                SC_STEP(h + 2, sA0, sA1, h + 1, sB0, sB1);
            }
            SC_STEP(15, sB0, sB1, 14, sA0, sA1);
            SC_VA(15, sB0, sB1);
#undef SC_STEP
#undef SC_VQ
#undef SC_SB
#undef SC_MM
#undef SC_VA
            float* out = SC + sc_block_base(qb) + (size_t)(q0 - qb * 256 + r32) * (size_t)klim + key0 + 4 * hi;
#pragma unroll
            for (int g = 0; g < 4; ++g) {
                *(f32x4*)(out + 8 * g) = (f32x4){acc0[4 * g], acc0[4 * g + 1], acc0[4 * g + 2], acc0[4 * g + 3]};
                *(f32x4*)(out + 32 + 8 * g) = (f32x4){acc1[4 * g], acc1[4 * g + 1], acc1[4 * g + 2], acc1[4 * g + 3]}; }
        }
    }
}

template <int VAR>
__device__ __forceinline__ void phase_select(int wv, const float* SC, unsigned long long* MASK, LAS unsigned char* lds) {
    const int tid = opaque_tid(wv), lane0 = tid & 63, wave = __builtin_amdgcn_readfirstlane(tid >> 6);
    LAS unsigned* hist = (LAS unsigned*)(lds + wave * 9216);
    const int gw = blockIdx.x * NWAVES + wave, NGW = gridDim.x * NWAVES;
    for (int q = gw; q < SEQ; q += NGW) {
        int lane = lane0; asm volatile("" : "+v"(lane));
        const int qb = q >> 8, klim = (qb + 1) * 256;
        const float* rowp = SC + sc_block_base(qb) + (size_t)(q - qb * 256) * (size_t)klim;
        const int ngrp = qb + 1;
        unsigned key[32][4];
#pragma unroll
        for (int g = 0; g < 8; ++g) {
            if (4 * g < ngrp) {
#pragma unroll
                for (int i = 0; i < 4; ++i) { const u32x4 v = *(const u32x4*)(rowp + 256 * (4 * g + i) + 4 * lane);
                    key[4 * g + i][0] = v.x; key[4 * g + i][1] = v.y; key[4 * g + i][2] = v.z; key[4 * g + i][3] = v.w; }
            } else {
#pragma unroll
                for (int i = 0; i < 4; ++i) { key[4 * g + i][0] = 0u; key[4 * g + i][1] = 0u; key[4 * g + i][2] = 0u; key[4 * g + i][3] = 0u; }
            }
        }
        unsigned T = 1u; unsigned need_eq = 0xffffffffu, n_eq = 0u;
        const bool radix = (q + 1 > TOPK) && (VAR != 1 && VAR != 3);
        if (VAR == 3) { unsigned x_ = 0u;
#pragma unroll
            for (int j = 0; j < 32; ++j) x_ |= key[j][0] & key[j][1] & key[j][2] & key[j][3];
            if (x_ == 0x12345u) MASK[q] = x_; continue; }
        if (radix) {
#pragma unroll
            for (int i = 0; i < 9; ++i) *(LAS u32x4*)(hist + 4 * (lane + 64 * i)) = (u32x4){0u, 0u, 0u, 0u};
        }
        __builtin_amdgcn_sched_barrier(0);
#pragma unroll
        for (int g = 0; g < 8; ++g) {
            if (4 * g + 3 < qb) {
#pragma unroll
                for (int i = 0; i < 4; ++i)
#pragma unroll
                    for (int e = 0; e < 4; ++e) { const int j = 4 * g + i; const unsigned uu = key[j][e]; key[j][e] = uu ^ ((unsigned)((int)uu >> 31) | 0x80000000u); }
            } else if (4 * g < ngrp) {
#pragma unroll
                for (int i = 0; i < 4; ++i)
#pragma unroll
                    for (int e = 0; e < 4; ++e) { const int j = 4 * g + i; const unsigned uu = key[j][e];
                        const unsigned kx = uu ^ ((unsigned)((int)uu >> 31) | 0x80000000u); key[j][e] = (256 * j + 4 * lane + e <= q) ? kx : 0u; }
            } __builtin_amdgcn_sched_barrier(0); }
        if (radix) {
            unsigned gm0 = 0u, gm1 = 0u, gm2 = 0u, gm3 = 0u;
#pragma unroll
            for (int g = 0; g < 8; ++g) if (4 * g < ngrp) {
#pragma unroll
                for (int i = 0; i < 4; ++i) { const int j = 4 * g + i; gm0 = key[j][0] > gm0 ? key[j][0] : gm0; gm1 = key[j][1] > gm1 ? key[j][1] : gm1; gm2 = key[j][2] > gm2 ? key[j][2] : gm2; gm3 = key[j][3] > gm3 ? key[j][3] : gm3; }
            }
            unsigned Pmin = gm0 < gm1 ? gm0 : gm1; { const unsigned p2 = gm2 < gm3 ? gm2 : gm3; Pmin = Pmin < p2 ? Pmin : p2; }
#pragma unroll
            for (int off = 1; off < 64; off <<= 1) { const unsigned tt = (unsigned)__builtin_amdgcn_ds_bpermute((lane ^ off) << 2, (int)Pmin); Pmin = tt < Pmin ? tt : Pmin; }
            LDS_WAIT();
#pragma unroll
            for (int g = 0; g < 8; ++g) if (4 * g < ngrp) {
#pragma unroll
                for (int i = 0; i < 4; ++i) {
#pragma unroll
                    for (int e = 0; e < 4; ++e) { const unsigned k = key[4 * g + i][e];
                        if (k >= Pmin) { const unsigned b = k >> 21; __hip_atomic_fetch_add(hist + b + ((b >> 5) << 2), 1u, __ATOMIC_RELAXED, __HIP_MEMORY_SCOPE_WORKGROUP); } }
                    __builtin_amdgcn_sched_barrier(0); }
            }
            unsigned prefix = 0u, pmask = 0u, kk = TOPK;
#pragma unroll 1
            for (int pass = 0; pass < ((VAR == 4) ? 1 : 3); ++pass) {
                const int shift = (pass == 0) ? 21 : (pass == 1) ? 10 : 0;
                const unsigned dmask = (pass == 2) ? 1023u : 2047u;
                LDS_WAIT();
                if (pass > 0) {
#pragma unroll
                    for (int g = 0; g < 8; ++g) if (4 * g < ngrp) {
#pragma unroll
                        for (int i = 0; i < 4; ++i) {
#pragma unroll
                            for (int e = 0; e < 4; ++e) { const unsigned k = key[4 * g + i][e];
                                if ((k & pmask) == prefix) { const unsigned b = (k >> shift) & dmask; __hip_atomic_fetch_add(hist + b + ((b >> 5) << 2), 1u, __ATOMIC_RELAXED, __HIP_MEMORY_SCOPE_WORKGROUP); } }
                            __builtin_amdgcn_sched_barrier(0); }
                    }
                }
                LDS_WAIT();
                if (VAR == 5) { prefix |= (0x5a5u & dmask) << shift; pmask |= dmask << shift; continue; }
                unsigned s = 0u;
#pragma unroll
                for (int i = 0; i < 8; ++i) { const u32x4 v = *(const LAS u32x4*)(hist + 36 * lane + 4 * i); s += (v.x + v.y) + (v.z + v.w); }
                unsigned suf = s;
#pragma unroll
                for (int off = 1; off < 64; off <<= 1) { const unsigned tt = (unsigned)__builtin_amdgcn_ds_bpermute(((lane + off) & 63) << 2, (int)suf); if (lane + off < 64) suf += tt; }
                const unsigned long long bal = __ballot(suf >= kk);
                const int Ls = 63 - __builtin_clzll(bal);
                const unsigned above1 = (unsigned)__builtin_amdgcn_readlane((int)(suf - s), Ls);
                const unsigned c2 = hist[36 * Ls + (lane & 31)];
                unsigned suf2 = (lane < 32) ? c2 : 0u;
#pragma unroll
                for (int off = 1; off < 32; off <<= 1) { const unsigned tt = (unsigned)__builtin_amdgcn_ds_bpermute(((lane + off) & 63) << 2, (int)suf2); if (lane + off < 32) suf2 += tt; }
                const unsigned long long bal2 = __ballot(lane < 32 && above1 + suf2 >= kk);
                const int Bs = 63 - __builtin_clzll(bal2);
                const int dsel = 32 * Ls + Bs;
                const unsigned cnt_b = (unsigned)__builtin_amdgcn_readlane((int)c2, Bs);
                const unsigned kk_new = kk - (above1 + (unsigned)__builtin_amdgcn_readlane((int)suf2, Bs) - cnt_b);
                LDS_WAIT();
#pragma unroll
                for (int i = 0; i < 9; ++i) *(LAS u32x4*)(hist + 4 * (lane + 64 * i)) = (u32x4){0u, 0u, 0u, 0u};
                const unsigned d = (unsigned)dsel; kk = kk_new; n_eq = cnt_b;
                prefix |= d << shift; pmask |= dmask << shift;
            }
            T = prefix; need_eq = kk;
        }
        if (VAR == 2 || VAR == 4 || VAR == 5) { if (T == 0x12345u) MASK[q] = T; continue; }
        const bool tie_path = (need_eq != 0xffffffffu) && (n_eq > need_eq);
        unsigned tie_seen = 0u;
        const unsigned long long lt = (lane == 0) ? 0ull : (~0ull >> (64 - lane));
        int w0lo = 0, w0hi = 0, w1lo = 0, w1hi = 0;
#pragma unroll
        for (int g = 0; g < 8; ++g) if (4 * g < ngrp) {
#pragma unroll
            for (int i = 0; i < 4; ++i) { const int j = 4 * g + i;
                unsigned long long B[4];
                if (!tie_path) {
#pragma unroll
                    for (int e = 0; e < 4; ++e) B[e] = __ballot(key[j][e] >= T);
                } else {
                    unsigned long long E[4]; unsigned before = tie_seen;
#pragma unroll
                    for (int e = 0; e < 4; ++e) { E[e] = __ballot(key[j][e] == T); before += (unsigned)__builtin_popcountll(E[e] & lt); }
                    unsigned mine = 0u;
#pragma unroll
                    for (int e = 0; e < 4; ++e) { const bool eq = (key[j][e] == T);
                        B[e] = __ballot(key[j][e] > T || (eq && (before + mine) < need_eq)); mine += eq ? 1u : 0u; }
#pragma unroll
                    for (int e = 0; e < 4; ++e) tie_seen += (unsigned)__builtin_popcountll(E[e]);
                }
#pragma unroll
                for (int k = 0; k < 4; ++k) { const int t = 4 * j + k;
                    const unsigned blo_ = (unsigned)((B[0] >> (16 * k)) & 0xffffull) | ((unsigned)((B[1] >> (16 * k)) & 0xffffull) << 16);
                    const unsigned bhi_ = (unsigned)((B[2] >> (16 * k)) & 0xffffull) | ((unsigned)((B[3] >> (16 * k)) & 0xffffull) << 16);
                    if (t < 64) asm volatile("s_nop 3\n\tv_writelane_b32 %0, %2, %4\n\tv_writelane_b32 %1, %3, %4" : "+v"(w0lo), "+v"(w0hi) : "s"(blo_), "s"(bhi_), "n"(t & 63));
                    else asm volatile("s_nop 3\n\tv_writelane_b32 %0, %2, %4\n\tv_writelane_b32 %1, %3, %4" : "+v"(w1lo), "+v"(w1hi) : "s"(blo_), "s"(bhi_), "n"(t & 63)); }
            }
        }
        const int ntile = 4 * ngrp;
        if (lane < ntile) MASK[(size_t)lane * SEQ + q] = ((unsigned long long)(unsigned)w0hi << 32) | (unsigned)w0lo;
        if (lane + 64 < ntile) MASK[(size_t)(lane + 64) * SEQ + q] = ((unsigned long long)(unsigned)w1hi << 32) | (unsigned)w1lo;
    }
}

__device__ __forceinline__ att::BlockRef attn_ref(int h, int qb, bool rev, const bf16_t* Qh, const bf16_t* Kh, const bf16_t* Vh, bf16_t* O, const bf16_t* SG, const unsigned long long* MASK) {
    att::BlockRef r;
    const long first = rev ? (long)(4 * qb + 3) : 0l;
    r.Q = Qh + ((size_t)h * SEQ + (size_t)qb * 256) * HD; r.K = Kh + (size_t)h * SEQ * HD + first * (att::KVBLK * HD); r.V = Vh + (size_t)h * SEQ * HD + first * (att::KVBLK * HD);
    r.O = O + (size_t)qb * 256 * DM + h * HD; r.G = SG + (size_t)qb * 256 * DM + h * HD; r.M = MASK + qb * 256 + first * SEQ; r.P0 = qb * 256;
    r.kst = rev ? -(long)(att::KVBLK * HD) : (long)(att::KVBLK * HD); r.mst = rev ? -(long)SEQ : (long)SEQ;
    return r;
}
__device__ __forceinline__ void phase_attn(int wv, const bf16_t* Qh, const bf16_t* Kh, const bf16_t* Vh, bf16_t* O, const bf16_t* SG, const unsigned long long* MASK, char* lds) {
    const int total = NHEAD * 16, stride = gridDim.x;
    int L = blockIdx.x; if (L >= total) return;
    if (gridDim.x == 256) { const int b = L; L = 16 * ((b & 7) + 8 * (b >> 7)) + ((b >> 3) & 15); }
    int pass = 0;
    att::BlockRef cur = attn_ref(L >> 4, L & 15, false, Qh, Kh, Vh, O, SG, MASK);
    att::Seam S;
    if (wv >= 4) __builtin_amdgcn_s_setprio(1);
    att::attn_prime(wv, cur, lds, S);
    for (;;) {
        const bool more_pass = pass == 0, more_item = L + stride < total, last = !more_pass && !more_item;
        int passn = pass + 1, Ln = L;
        if (!more_pass) { passn = 0; Ln = more_item ? L + stride : L; }
        const int hn = Ln >> 4, xn = Ln & 15;
        const att::BlockRef nxt = last ? cur : attn_ref(hn, passn ? 31 - xn : xn, passn != 0, Qh, Kh, Vh, O, SG, MASK);
        att::attn_block(wv, cur, nxt, lds, S);
        if (last) break;
        cur = nxt; pass = passn; L = Ln;
    }
    __builtin_amdgcn_s_setprio(0);
}

__global__ void __launch_bounds__(NTHR, 2) trunk_fwd(Args args) {
    extern __shared__ __attribute__((aligned(16))) unsigned char lds_raw[];
    LAS unsigned char* lds = (LAS unsigned char*)lds_raw;
    volatile LAS unsigned* MISC = (volatile LAS unsigned*)(lds + MISC_OFF);
    const int wv = __builtin_amdgcn_readfirstlane((int)threadIdx.x >> 6);
    const int tid = opaque_tid(wv);
    unsigned char* ws = args.ws;
    if (tid < 32) MISC[tid] = 0u;
    __syncthreads();
    XcdBarrier bar; bar.bar = (unsigned*)(ws + WS_CTL) + 1024; bar.x = 0; bar.st = nullptr;
    if (MK_ONE_LAUNCH) bar = xcd_barrier_post((unsigned*)(ws + WS_CTL) + 1024, MISC + 8);
    const int lo = args.ph_lo, hi = args.ph_hi;
    int ph = 0;
#ifndef PHASE_MASK
#define PHASE_MASK 0xFFFF
#endif
#define IN(k) (lo <= (k) && (k) < hi)
#define PM(b) ((PHASE_MASK >> (b)) & 1)
#ifndef DUP_MASK
#define DUP_MASK 0
#endif
#ifndef SC_VAR
#define SC_VAR 0
#endif
#define DUP(b) ((DUP_MASK >> (b)) & 1)
#define REDO(b, stmt) do { if (DUP(b)) { if (MK_ONE_LAUNCH) xcd_barrier(bar); else __syncthreads(); stmt; } } while (0)
#ifndef ECHO_MASK
#define ECHO_MASK 0
#endif
#define ECHO_K 4
    unsigned long long echo_acc = 0ull, echo_prev = ECHO_MASK ? __builtin_amdgcn_s_memrealtime() : 0ull;
#define SEAM(b) do { if (IN(ph) && IN(ph + 1)) xcd_barrier(bar); ++ph; \
        if (ECHO_MASK) { const unsigned long long now_ = __builtin_amdgcn_s_memrealtime(); if ((ECHO_MASK >> (b)) & 1) echo_acc += now_ - echo_prev; echo_prev = now_; } } while (0)

    float* mod = (float*)(ws + WS_MOD);
    bf16_t* HU = (bf16_t*)(ws + WS_HU);
    const float* cosq = (const float*)(ws + WS_TAB); const float* sinq = cosq + SEQ * 16; const float* cosi = sinq + SEQ * 16; const float* sini = cosi + SEQ * 8;
    const int G = gridDim.x, bx = blockIdx.x;

    if (PM(0) && IN(ph)) { phase0<0>(wv, args, lds); REDO(0, phase0<SC_VAR>(wv, args, lds)); }
    SEAM(0);
#pragma unroll 1
    for (int layer = 0; layer < 4; ++layer) {
        const int j = layer >> 1;
        bf16_t* XB = (bf16_t*)(ws + WS_XB);
        float* lgs = (float*)mod + 16 * 6144 + layer * DM;
        const float* lmod = mod + layer * 4 * 6144;
        if (PM(1) && IN(ph)) { if (layer == 0) phase_norm<false>(wv, args.x, args.norm_g, lmod, HU, lds_raw, lgs); else phase_norm<true>(wv, XB, args.norm_g + layer * DM, lmod, HU, lds_raw, lgs); }
        SEAM(1);
        if ((layer & 1) == 0) {
            bf16_t* VG = (bf16_t*)(ws + WS_VG); bf16_t* PL = (bf16_t*)(ws + WS_PL);
            if (PM(2) && IN(ph)) { pg8::Gemm g{HU, (const bf16_t*)(ws + WS_WPI) + (size_t)j * POOL_IN * DM, SEQ, POOL_IN, DM, DM, DM, 0, 0};
                pg8::StaticOrder S; S.init(SEQ, POOL_IN, G, bx, 4); pg8::EpiBf16 E{VG, POOL_IN};
                pg8::gemm_phase<pg8::EpiBf16, true>(wv, lds, g, S, E); REDO(2, (pg8::gemm_phase<pg8::EpiBf16, true>(wv, lds, g, S, E))); }
            SEAM(2);
            if (PM(3) && IN(ph)) { phase_pool(wv, VG, PL); REDO(3, phase_pool(wv, VG, PL)); }
            SEAM(3);
            if (PM(4) && IN(ph)) { pg8::Gemm g{PL, (const bf16_t*)(ws + WS_WPG) + (size_t)j * DM * 512, SEQ, DM, 512, DM, 512, 1, 512};
                pg8::StaticOrder S; S.init(SEQ, DM, G, bx, 2); pg8::EpiPoolGrp E{HU, VG, args.pls + j * DM};
                pg8::gemm_phase<pg8::EpiPoolGrp, true>(wv, lds, g, S, E); REDO(4, (pg8::gemm_phase<pg8::EpiPoolGrp, true>(wv, lds, g, S, E))); }
            SEAM(4);
            if (PM(5) && IN(ph)) { pg8::Gemm g{HU, (const bf16_t*)(ws + WS_WPO) + (size_t)j * DM * DM, SEQ, DM, DM, DM, DM, 0, 0};
                pg8::StaticOrder S; S.init(SEQ, DM, G, bx, 4);
                if (layer == 0) { pg8::EpiResid<false, true> E{args.x, XB, lgs}; pg8::gemm_phase<pg8::EpiResid<false, true>, true>(wv, lds, g, S, E); }
                else { pg8::EpiResid<true, true> E{XB, XB, lgs}; pg8::gemm_phase<pg8::EpiResid<true, true>, true>(wv, lds, g, S, E); } }
            SEAM(5);
        } else {
            bf16_t* Qh = (bf16_t*)(ws + WS_Q); bf16_t* Kh = (bf16_t*)(ws + WS_K); bf16_t* Vh = (bf16_t*)(ws + WS_V); bf16_t* SG = (bf16_t*)(ws + WS_GATE);
            bf16_t* QI = (bf16_t*)(ws + WS_QI); bf16_t* KI = (bf16_t*)(ws + WS_KI); float* WI = (float*)(ws + WS_WI);
            unsigned long long* MASK = (unsigned long long*)(ws + WS_MASK); float* SC = (float*)(ws + WS_SC);
            if (PM(6) && IN(ph)) { pg8::Gemm g{HU, (const bf16_t*)(ws + WS_WAI) + (size_t)j * ATTN_INP * DM, SEQ, ATTN_INP, DM, DM, DM, 0, 0};
                pg8::StaticOrder S; S.init(SEQ, ATTN_INP, G, bx); pg8::EpiAttnIn E{ws, args.pos};
                pg8::gemm_phase<pg8::EpiAttnIn, true>(wv, lds, g, S, E); REDO(6, (pg8::gemm_phase<pg8::EpiAttnIn, true>(wv, lds, g, S, E))); }
            SEAM(6);
            if (PM(7) && IN(ph)) { unsigned* qctr = (unsigned*)(ws + WS_CTL) + 8192 + 128 * j; phase_scores<0>(wv, QI, KI, WI, SC, lds, qctr); REDO(7, phase_scores<SC_VAR>(wv, QI, KI, WI, (float*)(ws + WS_END), lds, qctr + 64)); }
            SEAM(7);
            if (PM(8) && IN(ph)) { phase_select<0>(wv, SC, MASK, lds); REDO(8, phase_select<SC_VAR>(wv, SC, (unsigned long long*)(ws + WS_END), lds)); }
            SEAM(8);
            if (PM(9) && IN(ph)) { phase_attn(wv, Qh, Kh, Vh, HU, SG, MASK, (char*)lds_raw); REDO(9, phase_attn(wv, Qh, Kh, Vh, HU, SG, MASK, (char*)lds_raw)); }
            SEAM(9);
            if (PM(5) && IN(ph)) { pg8::Gemm g{HU, (const bf16_t*)(ws + WS_WAO) + (size_t)j * DM * DM, SEQ, DM, DM, DM, DM, 0, 0};
                pg8::StaticOrder S; S.init(SEQ, DM, G, bx, 4);
                { pg8::EpiResid<true, true> E{XB, XB, lgs}; pg8::gemm_phase<pg8::EpiResid<true, true>, true>(wv, lds, g, S, E); } }
            SEAM(5);
        }
    }
    if (PM(10) && IN(ph)) { phase_final(wv, (const bf16_t*)(ws + WS_XB), args.out, args.fg); REDO(10, phase_final(wv, (const bf16_t*)(ws + WS_XB), args.out, args.fg)); }
    if (ECHO_MASK) { if ((ECHO_MASK >> 10) & 1) echo_acc += __builtin_amdgcn_s_memrealtime() - echo_prev;
        if (bx == 0) { const unsigned long long target_ = __builtin_amdgcn_s_memrealtime() + (unsigned long long)ECHO_K * echo_acc; while (__builtin_amdgcn_s_memrealtime() < target_) __builtin_amdgcn_s_sleep(32); } }
#undef IN
#undef PM
#undef SEAM
#undef REDO
}
constexpr int N_PHASES = 1 + 2 * 5 + 2 * 6 + 1;

extern "C" void kernel_launch(void* const* d_in, const int* in_sizes, int n_in, void* d_out, int out_size, void* d_ws, size_t ws_size, hipStream_t stream) {
    static int grid = 0;
    if (grid == 0) {
        if (n_in != 13 || in_sizes[0] != SEQ * DM || out_size != SEQ * DM || ws_size < WS_END) {
            fprintf(stderr, "kernel_launch: unexpected shapes / workspace (n_in %d, in0 %d, out %d, ws %zu, need %zu)\n", n_in, n_in > 0 ? in_sizes[0] : -1, out_size, ws_size, (size_t)WS_END);
            grid = -1; return; }
        int dev = 0, cus = 0, per_cu = 0;
        if (hipGetDevice(&dev) != hipSuccess || hipDeviceGetAttribute(&cus, hipDeviceAttributeMultiprocessorCount, dev) != hipSuccess) { grid = -1; return; }
        if (hipFuncSetAttribute((const void*)trunk_fwd, hipFuncAttributeMaxDynamicSharedMemorySize, LDS_BYTES) != hipSuccess) { fprintf(stderr, "kernel_launch: hipFuncSetAttribute failed\n"); grid = -1; return; }
        if (hipOccupancyMaxActiveBlocksPerMultiprocessor(&per_cu, (const void*)trunk_fwd, NTHR, LDS_BYTES) != hipSuccess || per_cu < 1) {
            fprintf(stderr, "kernel_launch: occupancy query reports %d workgroups per CU\n", per_cu); per_cu = 1; }
        (void)hipGetLastError();
        grid = cus;
        if (grid > 256) grid = 256;
    }
    if (grid < 0) return;
    (void)hipMemsetAsync((char*)d_ws + WS_CTL, 0, CTL_ZERO_BYTES, stream);
    Args a{};
    a.x = (const float*)d_in[0]; a.c = (const float*)d_in[1]; a.pos = (const int*)d_in[2]; a.norm_g = (const float*)d_in[3];
    a.mod_w = (const float*)d_in[4]; a.mod_b = (const float*)d_in[5]; a.pwi = (const float*)d_in[6]; a.pwg = (const float*)d_in[7];
    a.pls = (const float*)d_in[8]; a.pwo = (const float*)d_in[9]; a.awi = (const float*)d_in[10]; a.awo = (const float*)d_in[11]; a.fg = (const float*)d_in[12];
    a.out = (float*)d_out; a.ws = (unsigned char*)d_ws;
#if MK_ONE_LAUNCH
    a.ph_lo = 0; a.ph_hi = N_PHASES;
    hipLaunchKernelGGL(trunk_fwd, dim3(grid), dim3(NTHR), LDS_BYTES, stream, a);
#else
    for (int p = 0; p < N_PHASES; ++p) { a.ph_lo = p; a.ph_hi = p + 1; hipLaunchKernelGGL(trunk_fwd, dim3(grid), dim3(NTHR), LDS_BYTES, stream, a); }
#endif
}
```
